# Optimizing an MI355X kernel written in HIP

```python
import math
import jax, jax.numpy as jnp
from jax import lax
import numpy as np

D_MODEL = 1024
BATCH = 8
SEQ = 2048
DEPTH = 4

CTX_LEN = 256
GRID_W = 64
HEAD_DIM = 64
BRANCH_WIDTH = D_MODEL // 2
N_BRANCH = 3
SSM_WIDTH = BRANCH_WIDTH
SSM_GROUP = 16
SSM_GROUPS = SSM_WIDTH // SSM_GROUP
SSM_STATE = 64
DT_MIN = 1e-3
DT_MAX = 1e-1
WIN_HEADS = BRANCH_WIDTH // HEAD_DIM
WIN_KV_HEADS = 2
WINDOW = 128
WIN_BLOCK = 128
NA_HEADS = BRANCH_WIDTH // HEAD_DIM
NA_KH = 8
NA_KW = 16
WIN_Q = WIN_HEADS * HEAD_DIM
WIN_KV = WIN_KV_HEADS * HEAD_DIM
NA_W = NA_HEADS * HEAD_DIM
IN_SPLITS = (SSM_WIDTH, WIN_Q, WIN_KV, WIN_KV, NA_W, NA_W, NA_W, N_BRANCH * D_MODEL)
IN_WIDTH = sum(IN_SPLITS)
N_EXPERTS = 32
TOP_K = 4
D_FF = D_MODEL
SWIGLU_ALPHA = 1.702
SWIGLU_LIMIT = 7.0
MOE_BLOCK = 128
ROPE_THETA = 10000.0
EPS = 1e-6
NEG_INF = -1e30

kernel_name = 'hybrid_ssm_window_natten_moe_dit'


def rms_norm(t, g):
    tf = t.astype(jnp.float32)
    y = tf * lax.rsqrt(jnp.mean(tf * tf, axis=-1, keepdims=True) + EPS) * g.astype(jnp.float32)
    return y.astype(t.dtype)


def rope_2d(t, row_pos, col_pos):
    half = t.shape[-1] // 2
    quarter = half // 2
    inv_freq = ROPE_THETA ** (-jnp.arange(quarter, dtype=jnp.float32) / quarter)

    def rotate(th, pos):
        ang = pos.astype(jnp.float32)[:, None] * inv_freq[None, :]
        cos = jnp.cos(ang)[None, :, None, :]
        sin = jnp.sin(ang)[None, :, None, :]
        t1 = th[..., :quarter].astype(jnp.float32)
        t2 = th[..., quarter:].astype(jnp.float32)
        return jnp.concatenate([t1 * cos - t2 * sin, t1 * sin + t2 * cos], axis=-1)

    out = jnp.concatenate([rotate(t[..., :half], row_pos), rotate(t[..., half:], col_pos)], axis=-1)
    return out.astype(t.dtype)


def complex_linear_combine(e1, e2):
    a1r, a1i, b1r, b1i = e1
    a2r, a2i, b2r, b2i = e2
    return (a2r * a1r - a2i * a1i,
            a2r * a1i + a2i * a1r,
            a2r * b1r - a2i * b1i + b2r,
            a2r * b1i + a2i * b1r + b2i)


def s5_mixer(u_l, u_c, need_ctx, lam_re, lam_im, log_dt, b_re, b_im, c_re, c_im, d_skip, w_glu):
    f32 = jnp.float32
    Bsz, L, P = u_l.shape
    C = u_c.shape[1]
    T = C + L
    lr = lam_re.astype(f32)
    li = lam_im.astype(f32)
    dt = jnp.exp(log_dt.astype(f32))[..., None]
    mag = jnp.exp(lr * dt)
    ar = mag * jnp.cos(li * dt)
    ai = mag * jnp.sin(li * dt)
    den = lr * lr + li * li
    fr = ((ar - 1.0) * lr + ai * li) / den
    fi = (ai * lr - (ar - 1.0) * li) / den
    br = b_re.astype(f32)
    bi = b_im.astype(f32)
    bbr = fr[..., None] * br - fi[..., None] * bi
    bbi = fr[..., None] * bi + fi[..., None] * br

    def scan_direction(dirn, seq):
        ug = seq.astype(f32).reshape(Bsz, T, SSM_GROUPS, SSM_GROUP)
        xr = jnp.einsum('btgp,gnp->tbgn', ug, bbr[dirn])
        xi = jnp.einsum('btgp,gnp->tbgn', ug, bbi[dirn])
        a_r = jnp.broadcast_to(ar[dirn][None, None], (T, 1, SSM_GROUPS, SSM_STATE))
        a_i = jnp.broadcast_to(ai[dirn][None, None], (T, 1, SSM_GROUPS, SSM_STATE))
        _, _, hr, hi = lax.associative_scan(complex_linear_combine, (a_r, a_i, xr, xi), axis=0)
        y = (jnp.einsum('tbgn,gpn->btgp', hr, c_re[dirn].astype(f32))
             - jnp.einsum('tbgn,gpn->btgp', hi, c_im[dirn].astype(f32)))
        return y.reshape(Bsz, T, P)

    y_f = scan_direction(0, jnp.concatenate([u_c, u_l], axis=1))
    y_b = scan_direction(1, jnp.concatenate([jnp.flip(u_c, 1), jnp.flip(u_l, 1)], axis=1))
    y_b_c = jnp.flip(y_b[:, :C], 1)
    y_b_l = jnp.flip(y_b[:, C:], 1)

    def readout(yf, yb, u):
        y = yf + yb + d_skip.astype(f32) * u.astype(f32)
        g = jax.nn.gelu(y).astype(u.dtype)
        return g * jax.nn.sigmoid(g @ w_glu)

    y_l = readout(y_f[:, C:], y_b_l, u_l)
    y_c = readout(y_f[:, :C], y_b_c, u_c) if need_ctx else None
    return y_l, y_c


def context_attention(q, k, v, sink):
    Bsz, C, H, d = q.shape
    hkv = k.shape[2]
    grp = H // hkv
    qg = q.reshape(Bsz, C, hkv, grp, d)
    s = jnp.einsum('bqhgd,bkhd->bhgqk', qg, k, preferred_element_type=jnp.float32) * (d ** -0.5)
    if sink is not None:
        s_sink = jnp.broadcast_to(sink.astype(jnp.float32).reshape(1, hkv, grp, 1, 1), s.shape[:-1] + (1,))
        s = jnp.concatenate([s, s_sink], axis=-1)
    p = jax.nn.softmax(s, axis=-1)[..., :C].astype(v.dtype)
    o = jnp.einsum('bhgqk,bkhd->bqhgd', p, v)
    return o.reshape(Bsz, C, H * d)


def window_attention(q, k, v, k_ctx, v_ctx, sink):
    Bsz, L, H, d = q.shape
    hkv = k.shape[2]
    grp = H // hkv
    nb = L // WIN_BLOCK
    C = k_ctx.shape[1]
    nk = 3 * WIN_BLOCK
    qb = q.reshape(Bsz, nb, WIN_BLOCK, hkv, grp, d)

    def band(t):
        tp = jnp.pad(t, ((0, 0), (WIN_BLOCK, WIN_BLOCK), (0, 0), (0, 0))).reshape(Bsz, nb + 2, WIN_BLOCK, hkv, d)
        return jnp.concatenate([tp[:, :-2], tp[:, 1:-1], tp[:, 2:]], axis=2)

    kb, vb = band(k), band(v)
    qpos = jnp.arange(L).reshape(nb, WIN_BLOCK)
    kpos = jnp.arange(nb)[:, None] * WIN_BLOCK - WIN_BLOCK + jnp.arange(nk)[None, :]
    valid = ((kpos[:, None, :] >= 0) & (kpos[:, None, :] < L)
             & (jnp.abs(qpos[:, :, None] - kpos[:, None, :]) <= WINDOW))
    scale = d ** -0.5
    s_loc = jnp.einsum('bnqhgd,bnkhd->bnhgqk', qb, kb, preferred_element_type=jnp.float32) * scale
    s_loc = jnp.where(valid[None, :, None, None], s_loc, NEG_INF)
    s_ctx = jnp.einsum('bnqhgd,bchd->bnhgqc', qb, k_ctx, preferred_element_type=jnp.float32) * scale
    s_sink = jnp.broadcast_to(sink.astype(jnp.float32).reshape(1, 1, hkv, grp, 1, 1), s_loc.shape[:-1] + (1,))
    p = jax.nn.softmax(jnp.concatenate([s_loc, s_ctx, s_sink], axis=-1), axis=-1).astype(v.dtype)
    o = (jnp.einsum('bnhgqk,bnkhd->bnqhgd', p[..., :nk], vb)
         + jnp.einsum('bnhgqc,bchd->bnqhgd', p[..., nk:nk + C], v_ctx))
    return o.reshape(Bsz, L, H * d)


def neighbourhood_attention(q, k, v, k_ctx, v_ctx, rpb):
    Bsz, L, H, d = q.shape
    rows = L // GRID_W
    kh = min(NA_KH, rows)
    C = k_ctx.shape[1]
    scale = d ** -0.5

    def grid(t):
        return t.reshape(Bsz, rows, GRID_W, H, d)

    qg, kg, vg = grid(q), grid(k), grid(v)
    r = jnp.arange(rows)
    row_idx = jnp.clip(r - kh // 2, 0, rows - kh)[:, None] + jnp.arange(kh)[None, :]
    k_rows = kg[:, row_idx]
    v_rows = vg[:, row_idx]
    col = jnp.arange(GRID_W)
    col_start = jnp.clip(col - NA_KW // 2, 0, GRID_W - NA_KW)
    col_in = (col[None, :] >= col_start[:, None]) & (col[None, :] < col_start[:, None] + NA_KW)
    d_row = row_idx - r[:, None] + (NA_KH - 1)
    d_col = jnp.clip(col[None, :] - col[:, None], 1 - NA_KW, NA_KW - 1) + (NA_KW - 1)
    bias = rpb.astype(jnp.float32)[:, d_row[:, None, :, None], d_col[None, :, None, :]]
    s = jnp.einsum('brchd,brkwhd->bhrckw', qg, k_rows, preferred_element_type=jnp.float32) * scale + bias[None]
    s = jnp.where(col_in[:, None, :], s, NEG_INF)
    nloc = kh * GRID_W
    s = s.reshape(Bsz, H, rows, GRID_W, nloc)
    s_ctx = jnp.einsum('brchd,bshd->bhrcs', qg, k_ctx, preferred_element_type=jnp.float32) * scale
    p = jax.nn.softmax(jnp.concatenate([s, s_ctx], axis=-1), axis=-1).astype(v.dtype)
    p_loc = p[..., :nloc].reshape(Bsz, H, rows, GRID_W, kh, GRID_W)
    o = (jnp.einsum('bhrckw,brkwhd->brchd', p_loc, v_rows)
         + jnp.einsum('bhrcs,bshd->brchd', p[..., nloc:nloc + C], v_ctx))
    return o.reshape(Bsz, L, H * d)


def token_mixing(h_l, h_c, row_pos, col_pos, need_ctx, w_in, lam_re, lam_im, log_dt, b_re, b_im,
                 c_re, c_im, d_skip, w_glu, win_qn, win_kn, win_sink, na_qn, na_kn, na_rpb, w_branch, w_out):
    split_pts = [int(s) for s in np.cumsum(IN_SPLITS)[:-1]]
    a_l, wq_l, wk_l, wv_l, nq_l, nk_l, nv_l, gate_l = jnp.split(h_l @ w_in, split_pts, axis=-1)
    a_c, wq_c, wk_c, wv_c, nq_c, nk_c, nv_c, gate_c = jnp.split(h_c @ w_in, split_pts, axis=-1)

    def heads(t, n):
        return t.reshape(t.shape[0], t.shape[1], n, HEAD_DIM)

    y_a_l, y_a_c = s5_mixer(a_l, a_c, need_ctx, lam_re, lam_im, log_dt, b_re, b_im, c_re, c_im, d_skip, w_glu)

    q_b = rope_2d(rms_norm(heads(wq_l, WIN_HEADS), win_qn), row_pos, col_pos)
    k_b = rope_2d(rms_norm(heads(wk_l, WIN_KV_HEADS), win_kn), row_pos, col_pos)
    v_b = heads(wv_l, WIN_KV_HEADS)
    k_bc = rms_norm(heads(wk_c, WIN_KV_HEADS), win_kn)
    v_bc = heads(wv_c, WIN_KV_HEADS)
    y_b_l = window_attention(q_b, k_b, v_b, k_bc, v_bc, win_sink)

    q_n = rms_norm(heads(nq_l, NA_HEADS), na_qn)
    k_n = rms_norm(heads(nk_l, NA_HEADS), na_kn)
    v_n = heads(nv_l, NA_HEADS)
    k_nc = rms_norm(heads(nk_c, NA_HEADS), na_kn)
    v_nc = heads(nv_c, NA_HEADS)
    y_n_l = neighbourhood_attention(q_n, k_n, v_n, k_nc, v_nc, na_rpb)

    def merge(ys, gates):
        stacked = jnp.stack(ys, axis=2)
        proj = jnp.einsum('btip,ipd->btid', stacked, w_branch)
        g = jax.nn.sigmoid(gates.reshape(gates.shape[0], gates.shape[1], N_BRANCH, D_MODEL))
        return jnp.sum(g * proj, axis=2) @ w_out

    m_l = merge([y_a_l, y_b_l, y_n_l], gate_l)
    if not need_ctx:
        return m_l, None
    y_b_c = context_attention(rms_norm(heads(wq_c, WIN_HEADS), win_qn), k_bc, v_bc, win_sink)
    y_n_c = context_attention(rms_norm(heads(nq_c, NA_HEADS), na_qn), k_nc, v_nc, None)
    m_c = merge([y_a_c, y_b_c, y_n_c], gate_c)
    return m_l, m_c


def moe_ffn(h, router_w, router_b, w_gate_up, b_gate_up, w_down, b_down):
    T, D = h.shape
    logits = (h @ router_w + router_b).astype(jnp.float32)
    top_val, top_idx = lax.top_k(logits, TOP_K)
    gates = jax.nn.softmax(top_val, axis=-1)
    TK = T * TOP_K
    flat_e = top_idx.reshape(TK)
    flat_tok = jnp.arange(TK, dtype=jnp.int32) // TOP_K
    order = jnp.argsort(flat_e)
    sorted_e = flat_e[order]
    sorted_tok = flat_tok[order]
    counts = jnp.bincount(flat_e, length=N_EXPERTS)
    padded = (counts + MOE_BLOCK - 1) // MOE_BLOCK * MOE_BLOCK
    seg_end = jnp.cumsum(padded)
    pad_start = seg_end - padded
    start = jnp.cumsum(counts) - counts
    dest = pad_start[sorted_e] + jnp.arange(TK, dtype=jnp.int32) - start[sorted_e]
    n_blocks = -(-TK // MOE_BLOCK) + N_EXPERTS
    buf_tok = jnp.full((n_blocks * MOE_BLOCK,), T, jnp.int32).at[dest].set(sorted_tok)
    block_expert = jnp.minimum(jnp.searchsorted(seg_end, jnp.arange(n_blocks) * MOE_BLOCK, side='right'),
                               N_EXPERTS - 1)
    h_pad = jnp.concatenate([h, jnp.zeros((1, D), h.dtype)], axis=0)
    xb = h_pad[buf_tok].reshape(n_blocks, MOE_BLOCK, D)

    def expert_block(args):
        xblk, e = args
        gu = xblk @ w_gate_up[e] + b_gate_up[e]
        g = jnp.minimum(gu[:, :D_FF], SWIGLU_LIMIT)
        u = jnp.clip(gu[:, D_FF:], -SWIGLU_LIMIT, SWIGLU_LIMIT)
        act = (u + 1.0) * (g * jax.nn.sigmoid(SWIGLU_ALPHA * g))
        return act @ w_down[e] + b_down[e]

    yb = lax.map(expert_block, (xb, block_expert)).reshape(n_blocks * MOE_BLOCK, D)
    y = yb[dest] * gates.reshape(TK)[order][:, None].astype(h.dtype)
    return jax.ops.segment_sum(y, sorted_tok, num_segments=T)


def setup_inputs(seed: int = 0) -> dict:
    key = jax.random.key(seed)
    ks = list(jax.random.split(key, 32))
    f32 = jnp.float32

    def nrm(i, shape, s):
        return jax.random.normal(ks[i], shape, f32) * s

    G, N, Pg = SSM_GROUPS, SSM_STATE, SSM_GROUP
    lam_im = jnp.broadcast_to(jnp.pi * jnp.arange(N, dtype=f32), (DEPTH, 2, G, N))
    return {
        'x': nrm(0, (BATCH, SEQ, D_MODEL), 1.0),
        'c': nrm(1, (BATCH, D_MODEL), 1.0),
        'ctx': nrm(2, (BATCH, CTX_LEN, D_MODEL), 1.0),
        'c_ctx': nrm(3, (D_MODEL,), 1.0),
        'w_mod': nrm(4, (DEPTH, D_MODEL, 6 * D_MODEL), 0.5 * D_MODEL ** -0.5),
        'b_mod': nrm(5, (DEPTH, 6 * D_MODEL), 0.02),
        'norm_mix': 1.0 + nrm(6, (DEPTH, D_MODEL), 0.05),
        'norm_ffn': 1.0 + nrm(7, (DEPTH, D_MODEL), 0.05),
        'w_in': nrm(8, (DEPTH, D_MODEL, IN_WIDTH), D_MODEL ** -0.5),
        'ssm_lam_re': -0.5 + nrm(9, (DEPTH, 2, G, N), 0.02),
        'ssm_lam_im': lam_im,
        'ssm_log_dt': jax.random.uniform(ks[10], (DEPTH, 2, G), f32, math.log(DT_MIN), math.log(DT_MAX)),
        'ssm_b_re': nrm(11, (DEPTH, 2, G, N, Pg), Pg ** -0.5),
        'ssm_b_im': nrm(12, (DEPTH, 2, G, N, Pg), Pg ** -0.5),
        'ssm_c_re': nrm(13, (DEPTH, 2, G, Pg, N), N ** -0.5),
        'ssm_c_im': nrm(14, (DEPTH, 2, G, Pg, N), N ** -0.5),
        'ssm_d': nrm(15, (DEPTH, SSM_WIDTH), 1.0),
        'ssm_w_glu': nrm(16, (DEPTH, SSM_WIDTH, SSM_WIDTH), SSM_WIDTH ** -0.5),
        'win_q_norm': 1.0 + nrm(17, (DEPTH, HEAD_DIM), 0.05),
        'win_k_norm': 1.0 + nrm(18, (DEPTH, HEAD_DIM), 0.05),
        'win_sink': nrm(19, (DEPTH, WIN_HEADS), 0.5),
        'na_q_norm': 1.0 + nrm(20, (DEPTH, HEAD_DIM), 0.05),
        'na_k_norm': 1.0 + nrm(21, (DEPTH, HEAD_DIM), 0.05),
        'na_rpb': nrm(22, (DEPTH, NA_HEADS, 2 * NA_KH - 1, 2 * NA_KW - 1), 0.5),
        'w_branch': nrm(23, (DEPTH, N_BRANCH, BRANCH_WIDTH, D_MODEL), BRANCH_WIDTH ** -0.5),
        'w_out': nrm(24, (DEPTH, D_MODEL, D_MODEL), D_MODEL ** -0.5),
        'router_w': nrm(25, (DEPTH, D_MODEL, N_EXPERTS), D_MODEL ** -0.5),
        'router_b': nrm(26, (DEPTH, N_EXPERTS), 0.01),
        'w_gate_up': nrm(27, (DEPTH, N_EXPERTS, D_MODEL, 2 * D_FF), D_MODEL ** -0.5),
        'b_gate_up': nrm(28, (DEPTH, N_EXPERTS, 2 * D_FF), 0.01),
        'w_down': nrm(29, (DEPTH, N_EXPERTS, D_FF, D_MODEL), D_FF ** -0.5),
        'b_down': nrm(30, (DEPTH, N_EXPERTS, D_MODEL), 0.01),
    }


def reference(x, c, ctx, c_ctx, w_mod, b_mod, norm_mix, norm_ffn, w_in, ssm_lam_re, ssm_lam_im, ssm_log_dt,
              ssm_b_re, ssm_b_im, ssm_c_re, ssm_c_im, ssm_d, ssm_w_glu, win_q_norm, win_k_norm, win_sink,
              na_q_norm, na_k_norm, na_rpb, w_branch, w_out, router_w, router_b, w_gate_up, b_gate_up,
              w_down, b_down):
    Bsz, L, D = x.shape
    C = ctx.shape[1]
    pos = jnp.arange(L)
    row_pos = pos // GRID_W
    col_pos = pos % GRID_W
    lat, cx = x, ctx
    for li in range(DEPTH):
        need_ctx = li < DEPTH - 1
        mod_l = jnp.split((jax.nn.silu(c) @ w_mod[li] + b_mod[li])[:, None, :], 6, axis=-1)
        mod_c = jnp.split(jax.nn.silu(c_ctx) @ w_mod[li] + b_mod[li], 6, axis=-1)
        h_l = rms_norm(lat, norm_mix[li]) * (1.0 + mod_l[1]) + mod_l[0]
        h_c = rms_norm(cx, norm_mix[li]) * (1.0 + mod_c[1]) + mod_c[0]
        m_l, m_c = token_mixing(h_l, h_c, row_pos, col_pos, need_ctx, w_in[li], ssm_lam_re[li], ssm_lam_im[li],
                                ssm_log_dt[li], ssm_b_re[li], ssm_b_im[li], ssm_c_re[li], ssm_c_im[li], ssm_d[li],
                                ssm_w_glu[li], win_q_norm[li], win_k_norm[li], win_sink[li], na_q_norm[li],
                                na_k_norm[li], na_rpb[li], w_branch[li], w_out[li])
        lat = lat + mod_l[2] * m_l
        f_l = rms_norm(lat, norm_ffn[li]) * (1.0 + mod_l[4]) + mod_l[3]
        if need_ctx:
            cx = cx + mod_c[2] * m_c
            f_c = rms_norm(cx, norm_ffn[li]) * (1.0 + mod_c[4]) + mod_c[3]
            toks = jnp.concatenate([f_l.reshape(Bsz * L, D), f_c.reshape(Bsz * C, D)], axis=0)
        else:
            toks = f_l.reshape(Bsz * L, D)
        y = moe_ffn(toks, router_w[li], router_b[li], w_gate_up[li], b_gate_up[li], w_down[li], b_down[li])
        lat = lat + mod_l[5] * y[:Bsz * L].reshape(Bsz, L, D)
        if need_ctx:
            cx = cx + mod_c[5] * y[Bsz * L:].reshape(Bsz, C, D)
    return lat
```

```cpp
#include <hip/hip_runtime.h>
#include <stdint.h>
#include <stdio.h>

typedef unsigned short bf16_t;
typedef short bf16x8 __attribute__((ext_vector_type(8)));
typedef float f32x4 __attribute__((ext_vector_type(4)));
#define LAS __attribute__((address_space(3)))

constexpr int D = 1024, NB = 8, SEQ = 2048, DEPTH = 4, CTXL = 256;
constexpr int NLAT = NB * SEQ, NCTX = NB * CTXL, NTOK = NLAT + NCTX;
constexpr int INW = 5888;
constexpr int C_U = 0, C_WQ = 512, C_WK = 1024, C_WV = 1152, C_NQ = 1280, C_NK = 1792, C_NV = 2304, C_GATE = 2816;
constexpr int NEXP = 32, TOPK = 4, DFF = 1024;
constexpr int NTHR = 512;

constexpr size_t al256(size_t x) { return (x + 255) & ~(size_t)255; }
constexpr size_t WS_CTL   = 0;
constexpr size_t CTL_BYTES = 65536;
constexpr size_t WS_MOD   = WS_CTL + CTL_BYTES;
constexpr size_t WS_WIN   = al256(WS_MOD + (size_t)DEPTH * 9 * 6144 * 4);
constexpr size_t WS_WGLU  = al256(WS_WIN + (size_t)DEPTH * INW * 1024 * 2);
constexpr size_t WS_WBR   = al256(WS_WGLU + (size_t)DEPTH * 512 * 512 * 2);
constexpr size_t WS_WOUT  = al256(WS_WBR + (size_t)DEPTH * 3 * 1024 * 512 * 2);
constexpr size_t WS_WGU   = al256(WS_WOUT + (size_t)DEPTH * 1024 * 1024 * 2);
constexpr size_t WS_WDN   = al256(WS_WGU + (size_t)DEPTH * NEXP * 2048 * 1024 * 2);
constexpr size_t WS_CX    = al256(WS_WDN + (size_t)DEPTH * NEXP * 1024 * 1024 * 2);
constexpr size_t WS_H     = al256(WS_CX + (size_t)NCTX * D * 4);
constexpr size_t WS_P     = al256(WS_H + (size_t)NTOK * D * 2);
constexpr size_t WS_YD    = al256(WS_P + (size_t)NTOK * INW * 2);
constexpr size_t WS_G     = al256(WS_YD + (size_t)2 * NTOK * 512 * 4);
constexpr size_t WS_Y     = al256(WS_G + (size_t)NTOK * 512 * 2);
constexpr size_t WS_S     = al256(WS_Y + (size_t)NTOK * 1536 * 2);
constexpr size_t WS_SB    = al256(WS_S + (size_t)NTOK * D * 4);
constexpr size_t WS_TKE   = al256(WS_SB + (size_t)NTOK * D * 2);
constexpr size_t WS_TKP   = al256(WS_TKE + (size_t)NTOK * 4 * 4);
constexpr size_t WS_TKG   = al256(WS_TKP + (size_t)NTOK * 4 * 4);
constexpr size_t WS_TLIST = al256(WS_TKG + (size_t)NTOK * 4 * 4);
constexpr size_t WS_ACT   = al256(WS_TLIST + (size_t)NEXP * NTOK * 4);
constexpr size_t WS_YB    = al256(WS_ACT + (size_t)(NTOK * 4 + 256) * 1024 * 2);
constexpr size_t WS_END   = al256(WS_YB + (size_t)(NTOK * 4 + 256) * 1024 * 2);

constexpr int CW_BAR = 0;
constexpr int CW_WQ = 4096;
constexpr int CW_CNT = 8192;

__device__ __forceinline__ bf16_t f2bf(float f) { unsigned u = __float_as_uint(f); u += 0x7fffu + ((u >> 16) & 1u); return (bf16_t)(u >> 16); }
__device__ __forceinline__ float bf2f(bf16_t h) { return __uint_as_float(((unsigned)h) << 16); }
__device__ __forceinline__ unsigned pack2(float a, float b) { return (unsigned)f2bf(a) | ((unsigned)f2bf(b) << 16); }
__device__ __forceinline__ float sigmoidf(float x) { return 1.0f / (1.0f + __expf(-x)); }
__device__ __forceinline__ int opaque_tid() { int tz = threadIdx.x; asm volatile("" : "+v"(tz)); return tz; }
__device__ __forceinline__ float wave_sum(float v) {
#pragma unroll
  for (int o = 32; o >= 1; o >>= 1) v += __shfl_xor(v, o);
  return v;
}
__device__ __forceinline__ float wave_max(float v) {
#pragma unroll
  for (int o = 32; o >= 1; o >>= 1) v = fmaxf(v, __shfl_xor(v, o));
  return v;
}

#define XB_TMO      128
#define XB_XCNT(j)  (256  + 64 * (j))
#define XB_XSUB(j)  (1280 + 64 * (j))
#define XB_XGEN(j)  (2304 + 64 * (j))
#define XB_TOP      3328
#define XB_TOPGEN   3392
#define XCD_BAR_WORDS 3456
#define XB_SPIN_CAP (1u << 20)

__device__ __forceinline__ unsigned xb_ld(unsigned* p)              { return __hip_atomic_load(p, __ATOMIC_RELAXED, __HIP_MEMORY_SCOPE_AGENT); }
__device__ __forceinline__ unsigned xb_add(unsigned* p, unsigned v) { return __hip_atomic_fetch_add(p, v, __ATOMIC_RELAXED, __HIP_MEMORY_SCOPE_AGENT); }
__device__ __forceinline__ unsigned xb_xcc_id() { return (unsigned)__builtin_amdgcn_s_getreg((3 << 11) | 20) & 0xFu; }
#define XB_SPIN(cond, bar) do { unsigned _sp = 0; while (cond) { __builtin_amdgcn_s_sleep(1); \
    if ((++_sp & 255u) == 0u) { if (xb_ld(&(bar)[XB_TMO])) break; if (_sp > XB_SPIN_CAP) { atomicAdd(&(bar)[XB_TMO], 1u); break; } } } } while (0)

struct XcdBarrier { unsigned* bar; unsigned x; volatile LAS unsigned* st; };

__device__ __forceinline__ XcdBarrier xcd_barrier_post(unsigned* bar, volatile LAS unsigned* st) {
    XcdBarrier b; b.bar = bar; b.x = xb_xcc_id(); b.st = st;
    if (threadIdx.x == 0) (void)xb_add(&bar[XB_XCNT(b.x)], 1u);
    return b;
}
__device__ __forceinline__ void xcd_barrier_complete(unsigned* bar, unsigned x, unsigned& nloc, unsigned& nx) {
    const unsigned G = gridDim.x * gridDim.y * gridDim.z;
    unsigned sum, cnt, mine, sp = 0u;
    for (;;) {
        sum = 0u; cnt = 0u; mine = 0u;
#pragma unroll
        for (unsigned j = 0; j < 16; ++j) { const unsigned c = xb_ld(&bar[XB_XCNT(j)]); sum += c; cnt += (c > 0u) ? 1u : 0u; mine = (j == x) ? c : mine; }
        if (sum == G) break;
        __builtin_amdgcn_s_sleep(1);
        if ((++sp & 255u) == 0u) { if (xb_ld(&bar[XB_TMO])) break; if (sp > XB_SPIN_CAP) { atomicAdd(&bar[XB_TMO], 1u); break; } }
    }
    nloc = mine > 0u ? mine : 1u; nx = cnt > 0u ? cnt : 1u;
}
__device__ __forceinline__ void xcd_barrier(const XcdBarrier& b) {
    asm volatile("s_waitcnt vmcnt(0)" ::: "memory");
    __syncthreads();
    if (threadIdx.x == 0) {
        unsigned* bar = b.bar;
        __builtin_amdgcn_s_waitcnt(0);
        unsigned nloc = b.st[0], nx = b.st[1];
        if (nloc == 0u) { xcd_barrier_complete(bar, b.x, nloc, nx); b.st[0] = nloc; b.st[1] = nx; }
        const unsigned old = xb_add(&bar[XB_XSUB(b.x)], 1u);
        const unsigned gen = old / nloc;
        if (old + 1u == (gen + 1u) * nloc) {
            __builtin_amdgcn_fence(__ATOMIC_RELEASE, "agent");
            asm volatile("s_waitcnt vmcnt(0)" ::: "memory");
            const unsigned og = xb_add(&bar[XB_TOP], 1u);
            const unsigned tg = og / nx;
            if (og + 1u == (tg + 1u) * nx) xb_add(&bar[XB_TOPGEN], 1u);
            else XB_SPIN(xb_ld(&bar[XB_TOPGEN]) == tg, bar);
            __builtin_amdgcn_fence(__ATOMIC_ACQUIRE, "agent");
            xb_add(&bar[XB_XGEN(b.x)], 1u);
            asm volatile("s_waitcnt vmcnt(0)" ::: "memory");
        } else {
            XB_SPIN(xb_ld(&bar[XB_XGEN(b.x)]) == gen, bar);
            __builtin_amdgcn_fence(__ATOMIC_ACQUIRE, "agent");
            asm volatile("s_waitcnt vmcnt(0)" ::: "memory");
        }
    }
    __syncthreads();
}

struct Params {
  const float *x, *c, *ctx, *c_ctx, *w_mod, *b_mod, *norm_mix, *norm_ffn, *w_in, *lam_re, *lam_im, *log_dt,
              *b_re, *b_im, *c_re, *c_im, *ssm_d, *w_glu, *win_qn, *win_kn, *win_sink, *na_qn, *na_kn, *na_rpb,
              *w_branch, *w_out, *router_w, *router_b, *w_gu, *b_gu, *w_dn, *b_dn;
  float* out;
  unsigned char* ws;
  int ph_lo, ph_hi;
};

constexpr int LDS_MISC = 131072;
constexpr int LDS_BYTES = 131072 + 8192;

constexpr int HT = 128 * 64;
__device__ __forceinline__ int lds_byte(int r, int c) {
  int st = (r >> 4) * 2 + (c >> 5), rr = r & 15, cc = c & 31, ob = rr * 64 + cc * 2;
  return st * 1024 + (ob ^ (((ob >> 9) & 1) << 5));
}
__device__ __forceinline__ void stage_rc(int b, int& R, int& C) {
  int st = b / 1024, sb = b % 1024, swz = sb ^ (((sb >> 9) & 1) << 5);
  R = (st >> 1) * 16 + swz / 64; C = (st & 1) * 32 + (swz % 64) / 2;
}

#define G_SA(b, h) (((b) * 2 + (h)) * 16384)
#define G_SB(b, h) ((4 + (b) * 2 + (h)) * 16384)
#define G_STAGE(bufoff, gbase, v0, v1) do { \
    __builtin_amdgcn_global_load_lds((const unsigned*)((gbase) + (v0)), (LAS unsigned*)(lds + (bufoff) + ldsw), 16, 0, 0); \
    __builtin_amdgcn_global_load_lds((const unsigned*)((gbase) + (v1)), (LAS unsigned*)(lds + (bufoff) + ldsw + 8192), 16, 0, 0); } while (0)
#define G_LDA(dst, b, h) do { _Pragma("unroll") for (int m = 0; m < 4; ++m) _Pragma("unroll") for (int k = 0; k < 2; ++k) dst[m][k] = *(const LAS bf16x8*)(lds + G_SA(b, h) + aoff + m * 2048 + k * 1024); } while (0)
#define G_LDB(dst, b, h) do { _Pragma("unroll") for (int n = 0; n < 2; ++n) _Pragma("unroll") for (int k = 0; k < 2; ++k) dst[n][k] = *(const LAS bf16x8*)(lds + G_SB(b, h) + boff + n * 2048 + k * 1024); } while (0)
#define G_MMA(ai, bj, At, Bx) do { __builtin_amdgcn_s_setprio(1); \
    _Pragma("unroll") for (int m = 0; m < 4; ++m) _Pragma("unroll") for (int n = 0; n < 2; ++n) _Pragma("unroll") for (int k = 0; k < 2; ++k) \
      acc[ai][bj][m][n] = __builtin_amdgcn_mfma_f32_16x16x32_bf16(Bx[n][k], At[m][k], acc[ai][bj][m][n], 0, 0, 0); \
    __builtin_amdgcn_s_setprio(0); } while (0)
#define WAIT_V(n) asm volatile("s_waitcnt vmcnt(" #n ")" ::: "memory")
#define WAIT_L(n) asm volatile("s_waitcnt lgkmcnt(" #n ")" ::: "memory")
#define BAR __builtin_amdgcn_s_barrier()
#define SCHED __builtin_amdgcn_sched_barrier(0)

template <class Epi>
__device__ __forceinline__ void gemm_tile(LAS unsigned char* lds, const char* a0, const char* a1, unsigned va00, unsigned va01, unsigned va10, unsigned va11,
                                          const char* b0, const char* b1, unsigned vb0, unsigned vb1, int nt, int tid, Epi epi)
{
  asm volatile("s_waitcnt vmcnt(0)" ::: "memory");
  __syncthreads();
  const int wid = __builtin_amdgcn_readfirstlane(tid >> 6), lane = tid & 63, wr = wid >> 2, wc = wid & 3, fr = lane & 15, fq = lane >> 4;
  const unsigned ldsw = (unsigned)wid * 1024u;
  const int aoff = lds_byte(wr * 64 + fr, fq * 8), boff = lds_byte(wc * 32 + fr, fq * 8);
  f32x4 acc[2][2][4][2];
#pragma unroll
  for (int a = 0; a < 2; ++a)
#pragma unroll
    for (int b = 0; b < 2; ++b)
#pragma unroll
      for (int m = 0; m < 4; ++m)
#pragma unroll
        for (int n = 0; n < 2; ++n) acc[a][b][m][n] = f32x4{0.f, 0.f, 0.f, 0.f};
  bf16x8 At[4][2], B0[2][2], B1[2][2];
  G_STAGE(G_SB(0, 0), b0, vb0, vb1); G_STAGE(G_SA(0, 0), a0, va00, va01);
  G_STAGE(G_SB(0, 1), b1, vb0, vb1); G_STAGE(G_SA(0, 1), a1, va10, va11);
  if (wr == 1) BAR;
  WAIT_V(4); BAR;
  G_STAGE(G_SB(1, 0), b0 + 128, vb0, vb1); G_STAGE(G_SA(1, 0), a0 + 128, va00, va01); G_STAGE(G_SB(1, 1), b1 + 128, vb0, vb1);
  WAIT_V(6); BAR;
  for (int t = 0; t < nt - 2; t += 2) {
    const char* a0t = a0 + (size_t)t * 128; const char* a1t = a1 + (size_t)t * 128; const char* b0t = b0 + (size_t)t * 128; const char* b1t = b1 + (size_t)t * 128;
    G_LDB(B0, 0, 0); SCHED; G_LDA(At, 0, 0); G_STAGE(G_SA(1, 1), a1t + 128, va10, va11);
    WAIT_L(8); BAR; WAIT_L(0); G_MMA(0, 0, At, B0); BAR; SCHED;
    G_LDB(B1, 0, 1); G_STAGE(G_SB(0, 0), b0t + 256, vb0, vb1);
    BAR; WAIT_L(0); G_MMA(0, 1, At, B1); BAR;
    G_LDA(At, 0, 1); G_STAGE(G_SA(0, 0), a0t + 256, va00, va01);
    BAR; WAIT_L(0); G_MMA(1, 0, At, B0); BAR; SCHED;
    G_STAGE(G_SB(0, 1), b1t + 256, vb0, vb1);
    WAIT_V(6); BAR; G_MMA(1, 1, At, B1); BAR;
    G_LDB(B0, 1, 0); SCHED; G_LDA(At, 1, 0); G_STAGE(G_SA(0, 1), a1t + 256, va10, va11);
    WAIT_L(8); BAR; WAIT_L(0); G_MMA(0, 0, At, B0); BAR; SCHED;
    G_LDB(B1, 1, 1); G_STAGE(G_SB(1, 0), b0t + 384, vb0, vb1);
    BAR; WAIT_L(0); G_MMA(0, 1, At, B1); BAR;
    G_LDA(At, 1, 1); G_STAGE(G_SA(1, 0), a0t + 384, va00, va01);
    BAR; WAIT_L(0); G_MMA(1, 0, At, B0); BAR; SCHED;
    G_STAGE(G_SB(1, 1), b1t + 384, vb0, vb1);
    WAIT_V(6); BAR; G_MMA(1, 1, At, B1); BAR;
  }
  { G_LDB(B0, 0, 0); WAIT_V(0); G_LDA(At, 0, 0); G_STAGE(G_SA(1, 1), a1 + (size_t)(nt - 1) * 128, va10, va11);
    BAR; WAIT_L(0); G_MMA(0, 0, At, B0); BAR;
    G_LDB(B1, 0, 1); BAR; WAIT_L(0); G_MMA(0, 1, At, B1); BAR;
    G_LDA(At, 0, 1); WAIT_V(4); BAR; WAIT_L(0); G_MMA(1, 0, At, B0); G_MMA(1, 1, At, B1); BAR; }
  { G_LDB(B0, 1, 0); G_LDA(At, 1, 0); WAIT_V(2); BAR; WAIT_L(0); G_MMA(0, 0, At, B0); BAR;
    G_LDB(B1, 1, 1); WAIT_V(0); BAR; WAIT_L(0); G_MMA(0, 1, At, B1); BAR;
    G_LDA(At, 1, 1); BAR; WAIT_L(0); G_MMA(1, 0, At, B0); G_MMA(1, 1, At, B1); BAR; }
  if (wr == 0) BAR;
#pragma unroll
  for (int ai = 0; ai < 2; ++ai)
#pragma unroll
    for (int m = 0; m < 4; ++m)
#pragma unroll
      for (int n = 0; n < 2; ++n)
        epi(ai * 128 + wr * 64 + m * 16 + fr, wc * 32 + n * 16 + fq * 4, acc[ai][0][m][n], acc[ai][1][m][n]);
}

__device__ __forceinline__ unsigned stage_voff(int tid, int i, int ld) { int R, C; stage_rc(tid * 16 + i * 8192, R, C); return (unsigned)(R * ld + C) * 2u; }


__device__ __forceinline__ bool unit_next(int L, int nM, int nN, int& pm, int& pn) {
  const int nwg = nM * nN; if (L >= nwg) return false;
  int wgid = L; { const int q = nwg / 8, r = nwg % 8, xcd = wgid % 8, off = wgid / 8; wgid = (xcd < r ? xcd * (q + 1) : r * (q + 1) + (xcd - r) * q) + off; }
  const int nig = 8 * nN, gid = wgid / nig, fm = gid * 8, gsz = (nM - fm) < 8 ? (nM - fm) : 8;
  pm = fm + ((wgid % nig) % gsz); pn = (wgid % nig) / gsz; return true;
}

__device__ __forceinline__ void st_bf4(bf16_t* p, float a, float b, float c, float d) {
  uint2 v; v.x = pack2(a, b); v.y = pack2(c, d); *reinterpret_cast<uint2*>(p) = v;
}
__device__ __forceinline__ void ld_bf4(const bf16_t* p, float& a, float& b, float& c, float& d) {
  uint2 v = *reinterpret_cast<const uint2*>(p);
  a = __uint_as_float(v.x << 16); b = __uint_as_float(v.x & 0xffff0000u); c = __uint_as_float(v.y << 16); d = __uint_as_float(v.y & 0xffff0000u);
}

template <int PERM>
__device__ __forceinline__ void conv_mats(const float* __restrict__ src, bf16_t* __restrict__ dst, int nmat, int K, int N, float* lds, int tid_) {
  const int tK = K / 64, tN = N / 64, per = tK * tN, total = nmat * per;
  const int t = tid_;
  for (int tile = blockIdx.x; tile < total; tile += gridDim.x) {
    const int mat = tile / per, rem = tile % per, kt = rem / tN, ntl = rem % tN;
    const int p0 = ntl * 64;
    int s0 = p0;
    if (PERM == 1) { const int t256 = p0 >> 8, w = p0 & 255; s0 = (w < 128) ? (t256 * 128 + w) : (1024 + t256 * 128 + (w - 128)); }
    const float* S = src + (size_t)mat * K * N + (size_t)(kt * 64) * N + s0;
    __syncthreads();
    { const int c = t & 63, r = t >> 6;
#pragma unroll
      for (int i = 0; i < 8; ++i) { const int k = r + 8 * i; lds[k * 65 + c] = S[(size_t)k * N + c]; } }
    __syncthreads();
    { const int n = t >> 3, kc = (t & 7) * 8;
      uint4 v;
      v.x = pack2(lds[(kc + 0) * 65 + n], lds[(kc + 1) * 65 + n]);
      v.y = pack2(lds[(kc + 2) * 65 + n], lds[(kc + 3) * 65 + n]);
      v.z = pack2(lds[(kc + 4) * 65 + n], lds[(kc + 5) * 65 + n]);
      v.w = pack2(lds[(kc + 6) * 65 + n], lds[(kc + 7) * 65 + n]);
      *reinterpret_cast<uint4*>(dst + (size_t)mat * N * K + (size_t)(p0 + n) * K + kt * 64 + kc) = v; }
  }
}

__device__ __forceinline__ float siluf(float x) { return x / (1.0f + __expf(-x)); }
__device__ __forceinline__ float gelu_tanh(float x) {
  const float u = 0.7978845608028654f * (x + 0.044715f * x * x * x);
  return 0.5f * x * (1.0f + tanhf(u));
}

__device__ __forceinline__ void mod_phase(const Params& p, float* lds) {
  const int tid_ = opaque_tid();
  float* sc = lds;
  float* red = lds + 9 * 1024;
  const int t = tid_;
  __syncthreads();
  for (int i = t; i < 9 * 1024; i += NTHR) { const int r = i >> 10, k = i & 1023; const float v = (r < 8) ? p.c[r * 1024 + k] : p.c_ctx[k]; sc[i] = siluf(v); }
  __syncthreads();
  float* mod = reinterpret_cast<float*>(p.ws + WS_MOD);
  for (int u = blockIdx.x; u < DEPTH * 48; u += gridDim.x) {
    const int l = u / 48, col0 = (u % 48) * 128;
    const int col = t & 127, kq = t >> 7;
    float a[9];
#pragma unroll
    for (int r = 0; r < 9; ++r) a[r] = 0.f;
    const float* W = p.w_mod + (size_t)l * 1024 * 6144 + col0 + col;
    for (int k = kq * 256; k < kq * 256 + 256; ++k) {
      const float w = W[(size_t)k * 6144];
#pragma unroll
      for (int r = 0; r < 9; ++r) a[r] += sc[r * 1024 + k] * w;
    }
#pragma unroll
    for (int r = 0; r < 9; ++r) red[(kq * 9 + r) * 128 + col] = a[r];
    __syncthreads();
    for (int i = t; i < 9 * 128; i += NTHR) {
      const int r = i >> 7, cc = i & 127;
      const float v = red[(0 * 9 + r) * 128 + cc] + red[(1 * 9 + r) * 128 + cc] + red[(2 * 9 + r) * 128 + cc] + red[(3 * 9 + r) * 128 + cc];
      mod[((size_t)l * 9 + r) * 6144 + col0 + cc] = v + p.b_mod[l * 6144 + col0 + cc];
    }
    __syncthreads();
  }
}

__device__ __forceinline__ float* stream_row(const Params& p, int row) {
  return (row < NLAT) ? (p.out + (size_t)row * D) : (reinterpret_cast<float*>(p.ws + WS_CX) + (size_t)(row - NLAT) * D);
}
__device__ __forceinline__ int row_modidx(int row) { return (row < NLAT) ? (row >> 11) : 8; }

__device__ __forceinline__ void expert_starts(const unsigned* cnt, int* st) {
  if (threadIdx.x == 0) { int s = 0; for (int e = 0; e < NEXP; ++e) { st[e] = s; s += (int)cnt[e]; } st[NEXP] = s; }
  __syncthreads();
}

__device__ __forceinline__ void norm_phase(const Params& p, int layer, bool combine, int* lds_i) {
  const int tid_ = opaque_tid();
  const float* mod = reinterpret_cast<const float*>(p.ws + WS_MOD);
  bf16_t* H = reinterpret_cast<bf16_t*>(p.ws + WS_H);
  const int* tke = reinterpret_cast<const int*>(p.ws + WS_TKE);
  const int* tkp = reinterpret_cast<const int*>(p.ws + WS_TKP);
  const float* tkg = reinterpret_cast<const float*>(p.ws + WS_TKG);
  const bf16_t* YB = reinterpret_cast<const bf16_t*>(p.ws + WS_YB);
  const unsigned* ctl = reinterpret_cast<const unsigned*>(p.ws + WS_CTL);
  if (combine) expert_starts(ctl + CW_CNT + (layer - 1) * 32, lds_i);
  const int lane = tid_ & 63, wv = tid_ >> 6;
  const float* gw = p.norm_mix + layer * D;
  for (int row = blockIdx.x * 8 + wv; row < NTOK; row += gridDim.x * 8) {
    float* xr = stream_row(p, row);
    const int mi = row_modidx(row);
    float v[16];
#pragma unroll
    for (int i = 0; i < 4; ++i) { const float4 q = *reinterpret_cast<const float4*>(xr + i * 256 + lane * 4); v[4 * i] = q.x; v[4 * i + 1] = q.y; v[4 * i + 2] = q.z; v[4 * i + 3] = q.w; }
    if (combine) {
      const float* m5 = mod + ((size_t)(layer - 1) * 9 + mi) * 6144 + 5 * 1024;
      float a[16];
#pragma unroll
      for (int i = 0; i < 16; ++i) a[i] = 0.f;
#pragma unroll
      for (int k = 0; k < 4; ++k) {
        const int e = tke[row * 4 + k]; const int pos = tkp[row * 4 + k]; const float g = tkg[row * 4 + k];
        const bf16_t* yr = YB + (size_t)(lds_i[e] + pos) * D;
#pragma unroll
        for (int i = 0; i < 4; ++i) { float a0, a1, a2, a3; ld_bf4(yr + i * 256 + lane * 4, a0, a1, a2, a3); a[4 * i] += g * a0; a[4 * i + 1] += g * a1; a[4 * i + 2] += g * a2; a[4 * i + 3] += g * a3; }
      }
#pragma unroll
      for (int i = 0; i < 4; ++i) {
        const float4 mm = *reinterpret_cast<const float4*>(m5 + i * 256 + lane * 4);
        v[4 * i] += mm.x * a[4 * i]; v[4 * i + 1] += mm.y * a[4 * i + 1]; v[4 * i + 2] += mm.z * a[4 * i + 2]; v[4 * i + 3] += mm.w * a[4 * i + 3];
        *reinterpret_cast<float4*>(xr + i * 256 + lane * 4) = float4{v[4 * i], v[4 * i + 1], v[4 * i + 2], v[4 * i + 3]};
      }
    }
    float ss = 0.f;
#pragma unroll
    for (int i = 0; i < 16; ++i) ss += v[i] * v[i];
    ss = wave_sum(ss);
    const float rinv = rsqrtf(ss * (1.0f / D) + 1e-6f);
    const float* msh = mod + ((size_t)layer * 9 + mi) * 6144;
#pragma unroll
    for (int i = 0; i < 4; ++i) {
      const int c = i * 256 + lane * 4;
      const float4 g = *reinterpret_cast<const float4*>(gw + c);
      const float4 sh = *reinterpret_cast<const float4*>(msh + c);
      const float4 sc = *reinterpret_cast<const float4*>(msh + 1024 + c);
      st_bf4(H + (size_t)row * D + c, v[4 * i] * rinv * g.x * (1.f + sc.x) + sh.x, v[4 * i + 1] * rinv * g.y * (1.f + sc.y) + sh.y,
             v[4 * i + 2] * rinv * g.z * (1.f + sc.z) + sh.z, v[4 * i + 3] * rinv * g.w * (1.f + sc.w) + sh.w);
    }
  }
}

__device__ __forceinline__ void final_combine(const Params& p, int* lds_i) {
  const int tid_ = opaque_tid();
  const float* mod = reinterpret_cast<const float*>(p.ws + WS_MOD);
  const int* tke = reinterpret_cast<const int*>(p.ws + WS_TKE);
  const int* tkp = reinterpret_cast<const int*>(p.ws + WS_TKP);
  const float* tkg = reinterpret_cast<const float*>(p.ws + WS_TKG);
  const bf16_t* YB = reinterpret_cast<const bf16_t*>(p.ws + WS_YB);
  const unsigned* ctl = reinterpret_cast<const unsigned*>(p.ws + WS_CTL);
  expert_starts(ctl + CW_CNT + (DEPTH - 1) * 32, lds_i);
  const int lane = tid_ & 63, wv = tid_ >> 6;
  for (int row = blockIdx.x * 8 + wv; row < NLAT; row += gridDim.x * 8) {
    float* xr = p.out + (size_t)row * D;
    const int mi = row >> 11;
    const float* m5 = mod + ((size_t)(DEPTH - 1) * 9 + mi) * 6144 + 5 * 1024;
    float a[16];
#pragma unroll
    for (int i = 0; i < 16; ++i) a[i] = 0.f;
#pragma unroll
    for (int k = 0; k < 4; ++k) {
      const int e = tke[row * 4 + k]; const int pos = tkp[row * 4 + k]; const float g = tkg[row * 4 + k];
      const bf16_t* yr = YB + (size_t)(lds_i[e] + pos) * D;
#pragma unroll
      for (int i = 0; i < 4; ++i) { float a0, a1, a2, a3; ld_bf4(yr + i * 256 + lane * 4, a0, a1, a2, a3); a[4 * i] += g * a0; a[4 * i + 1] += g * a1; a[4 * i + 2] += g * a2; a[4 * i + 3] += g * a3; }
    }
#pragma unroll
    for (int i = 0; i < 4; ++i) {
      const float4 mm = *reinterpret_cast<const float4*>(m5 + i * 256 + lane * 4);
      float4 q = *reinterpret_cast<const float4*>(xr + i * 256 + lane * 4);
      q.x += mm.x * a[4 * i]; q.y += mm.y * a[4 * i + 1]; q.z += mm.z * a[4 * i + 2]; q.w += mm.w * a[4 * i + 3];
      *reinterpret_cast<float4*>(xr + i * 256 + lane * 4) = q;
    }
  }
}

__device__ __forceinline__ void qknorm_phase(const Params& p, int layer) {
  const int tid_ = opaque_tid();
  bf16_t* P = reinterpret_cast<bf16_t*>(p.ws + WS_P);
  const int lane = tid_ & 63, wv = tid_ >> 6;
  const float wqn = p.win_qn[layer * 64 + lane], wkn = p.win_kn[layer * 64 + lane];
  const float nqn = p.na_qn[layer * 64 + lane], nkn = p.na_kn[layer * 64 + lane];
  const int fi = lane & 15;
  const float inv_freq = powf(10000.0f, -(float)fi / 16.0f);
  for (int row = blockIdx.x * 8 + wv; row < NTOK; row += gridDim.x * 8) {
    bf16_t* pr = P + (size_t)row * INW;
    const bool lat = row < NLAT;
    float cs = 1.f, sn = 0.f;
    if (lat) { const int t = row & 2047; const int pos = (lane < 32) ? (t >> 6) : (t & 63); const float ang = (float)pos * inv_freq; cs = cosf(ang); sn = sinf(ang); }
    for (int hd = 0; hd < 26; ++hd) {
      int col; float w; bool rope;
      if (hd < 8) { col = C_WQ + hd * 64; w = wqn; rope = lat; }
      else if (hd < 10) { col = C_WK + (hd - 8) * 64; w = wkn; rope = lat; }
      else if (hd < 18) { col = C_NQ + (hd - 10) * 64; w = nqn; rope = false; }
      else { col = C_NK + (hd - 18) * 64; w = nkn; rope = false; }
      const float v = bf2f(pr[col + lane]);
      const float ss = wave_sum(v * v);
      float y = v * rsqrtf(ss * (1.0f / 64.0f) + 1e-6f) * w;
      if (rope) {
        const float o = __shfl_xor(y, 16);
        y = ((lane & 16) == 0) ? (y * cs - o * sn) : (o * sn + y * cs);
      }
      pr[col + lane] = f2bf(y);
    }
  }
}

__device__ __forceinline__ int ssm_row(int b, int dir, int tau) {
  if (tau < CTXL) return NLAT + b * CTXL + (dir ? (CTXL - 1 - tau) : tau);
  const int t = tau - CTXL;
  return b * SEQ + (dir ? (SEQ - 1 - t) : t);
}

__device__ __forceinline__ void ssm_item(const Params& p, int layer, int item) {
  const int tid_ = opaque_tid();
  const int b = item >> 3, gq = item & 7;
  const int lane = tid_ & 63, wv = tid_ >> 6;
  const int dir = wv & 1, g = gq * 4 + (wv >> 1);
  const bf16_t* P = reinterpret_cast<const bf16_t*>(p.ws + WS_P);
  float* YD = reinterpret_cast<float*>(p.ws + WS_YD) + (size_t)dir * NTOK * 512;
  {
    const int n = lane;
    const size_t pg = ((size_t)(layer * 2 + dir) * 32 + g);
    const float lr = p.lam_re[pg * 64 + n], li = p.lam_im[pg * 64 + n];
    const float dt = expf(p.log_dt[pg]);
    const float mag = expf(lr * dt);
    const float ar = mag * cosf(li * dt), ai = mag * sinf(li * dt);
    const float den = lr * lr + li * li;
    const float fr = ((ar - 1.0f) * lr + ai * li) / den;
    const float fi = (ai * lr - (ar - 1.0f) * li) / den;
    float bbr[16], bbi[16], cr[16], ci[16];
#pragma unroll
    for (int q = 0; q < 16; ++q) {
      const float br = p.b_re[(pg * 64 + n) * 16 + q], bi = p.b_im[(pg * 64 + n) * 16 + q];
      bbr[q] = fr * br - fi * bi; bbi[q] = fr * bi + fi * br;
      cr[q] = p.c_re[(pg * 16 + q) * 64 + n]; ci[q] = p.c_im[(pg * 16 + q) * 64 + n];
    }
    float hr = 0.f, hi = 0.f;
    for (int tau = 0; tau < CTXL + SEQ; ++tau) {
      const int row = ssm_row(b, dir, tau);
      const uint4* up = reinterpret_cast<const uint4*>(P + (size_t)row * INW + C_U + g * 16);
      const uint4 u0 = up[0], u1 = up[1];
      float u[16];
      u[0] = __uint_as_float(u0.x << 16); u[1] = __uint_as_float(u0.x & 0xffff0000u); u[2] = __uint_as_float(u0.y << 16); u[3] = __uint_as_float(u0.y & 0xffff0000u);
      u[4] = __uint_as_float(u0.z << 16); u[5] = __uint_as_float(u0.z & 0xffff0000u); u[6] = __uint_as_float(u0.w << 16); u[7] = __uint_as_float(u0.w & 0xffff0000u);
      u[8] = __uint_as_float(u1.x << 16); u[9] = __uint_as_float(u1.x & 0xffff0000u); u[10] = __uint_as_float(u1.y << 16); u[11] = __uint_as_float(u1.y & 0xffff0000u);
      u[12] = __uint_as_float(u1.z << 16); u[13] = __uint_as_float(u1.z & 0xffff0000u); u[14] = __uint_as_float(u1.w << 16); u[15] = __uint_as_float(u1.w & 0xffff0000u);
      float xr = 0.f, xi = 0.f;
#pragma unroll
      for (int q = 0; q < 16; ++q) { xr += bbr[q] * u[q]; xi += bbi[q] * u[q]; }
      const float nhr = ar * hr - ai * hi + xr;
      const float nhi = ar * hi + ai * hr + xi;
      hr = nhr; hi = nhi;
      float v[16];
#pragma unroll
      for (int q = 0; q < 16; ++q) v[q] = hr * cr[q] - hi * ci[q];
#pragma unroll
      for (int i = 0; i < 8; ++i) { const bool up_ = (lane & 32) != 0; const float send = up_ ? v[i] : v[i + 8]; const float keep = up_ ? v[i + 8] : v[i]; v[i] = keep + __shfl_xor(send, 32); }
#pragma unroll
      for (int i = 0; i < 4; ++i) { const bool up_ = (lane & 16) != 0; const float send = up_ ? v[i] : v[i + 4]; const float keep = up_ ? v[i + 4] : v[i]; v[i] = keep + __shfl_xor(send, 16); }
#pragma unroll
      for (int i = 0; i < 2; ++i) { const bool up_ = (lane & 8) != 0; const float send = up_ ? v[i] : v[i + 2]; const float keep = up_ ? v[i + 2] : v[i]; v[i] = keep + __shfl_xor(send, 8); }
      { const bool up_ = (lane & 4) != 0; const float send = up_ ? v[0] : v[1]; const float keep = up_ ? v[1] : v[0]; v[0] = keep + __shfl_xor(send, 4); }
      v[0] += __shfl_xor(v[0], 2);
      v[0] += __shfl_xor(v[0], 1);
      if ((lane & 3) == 0) YD[(size_t)row * 512 + g * 16 + (lane >> 2)] = v[0];
    }
  }
  asm volatile("s_waitcnt vmcnt(0)" ::: "memory");
  __threadfence();
  __syncthreads();
  {
    const float* Y0 = reinterpret_cast<const float*>(p.ws + WS_YD);
    const float* Y1 = Y0 + (size_t)NTOK * 512;
    bf16_t* G = reinterpret_cast<bf16_t*>(p.ws + WS_G);
    const int ch = gq * 64 + (tid_ & 63);
    const float dsk = p.ssm_d[layer * 512 + ch];
    for (int i = tid_ >> 6; i < CTXL + SEQ; i += 8) {
      const int row = (i < CTXL) ? (NLAT + b * CTXL + i) : (b * SEQ + i - CTXL);
      const float y = Y0[(size_t)row * 512 + ch] + Y1[(size_t)row * 512 + ch] + dsk * bf2f(P[(size_t)row * INW + C_U + ch]);
      G[(size_t)row * 512 + ch] = f2bf(gelu_tanh(y));
    }
  }
}

template <int NBT, class KF>
__device__ __forceinline__ void attn_query(const bf16_t* qptr, const bf16_t* P, int kcol, int vcol, bool has_sink, float sink, bf16_t* optr, int lane, KF kf) {
  float q[64];
  {
    const uint4* qp = reinterpret_cast<const uint4*>(qptr);
#pragma unroll
    for (int i = 0; i < 8; ++i) {
      const uint4 w = qp[i];
      q[8 * i + 0] = __uint_as_float(w.x << 16); q[8 * i + 1] = __uint_as_float(w.x & 0xffff0000u);
      q[8 * i + 2] = __uint_as_float(w.y << 16); q[8 * i + 3] = __uint_as_float(w.y & 0xffff0000u);
      q[8 * i + 4] = __uint_as_float(w.z << 16); q[8 * i + 5] = __uint_as_float(w.z & 0xffff0000u);
      q[8 * i + 6] = __uint_as_float(w.w << 16); q[8 * i + 7] = __uint_as_float(w.w & 0xffff0000u);
    }
  }
  float s[NBT]; int kr[NBT];
  float mx = has_sink ? sink : -1e30f;
#pragma unroll
  for (int j = 0; j < NBT; ++j) {
    int krow; float bias;
    const bool valid = kf(j, lane, krow, bias);
    kr[j] = valid ? krow : -1;
    float dot = 0.f;
    if (valid) {
      const uint4* kp = reinterpret_cast<const uint4*>(P + (size_t)krow * INW + kcol);
#pragma unroll
      for (int i = 0; i < 8; ++i) {
        const uint4 w = kp[i];
        dot += q[8 * i + 0] * __uint_as_float(w.x << 16) + q[8 * i + 1] * __uint_as_float(w.x & 0xffff0000u)
             + q[8 * i + 2] * __uint_as_float(w.y << 16) + q[8 * i + 3] * __uint_as_float(w.y & 0xffff0000u)
             + q[8 * i + 4] * __uint_as_float(w.z << 16) + q[8 * i + 5] * __uint_as_float(w.z & 0xffff0000u)
             + q[8 * i + 6] * __uint_as_float(w.w << 16) + q[8 * i + 7] * __uint_as_float(w.w & 0xffff0000u);
      }
    }
    s[j] = valid ? (dot * 0.125f + bias) : -1e30f;
    mx = fmaxf(mx, s[j]);
  }
  mx = wave_max(mx);
  float l = 0.f;
#pragma unroll
  for (int j = 0; j < NBT; ++j) { s[j] = (kr[j] >= 0) ? __expf(s[j] - mx) : 0.f; l += s[j]; }
  l = wave_sum(l);
  if (has_sink) l += __expf(sink - mx);
  float o[64];
#pragma unroll
  for (int i = 0; i < 64; ++i) o[i] = 0.f;
#pragma unroll
  for (int j = 0; j < NBT; ++j) {
    if (kr[j] >= 0) {
      const uint4* vp = reinterpret_cast<const uint4*>(P + (size_t)kr[j] * INW + vcol);
      const float pj = s[j];
#pragma unroll
      for (int i = 0; i < 8; ++i) {
        const uint4 w = vp[i];
        o[8 * i + 0] += pj * __uint_as_float(w.x << 16); o[8 * i + 1] += pj * __uint_as_float(w.x & 0xffff0000u);
        o[8 * i + 2] += pj * __uint_as_float(w.y << 16); o[8 * i + 3] += pj * __uint_as_float(w.y & 0xffff0000u);
        o[8 * i + 4] += pj * __uint_as_float(w.z << 16); o[8 * i + 5] += pj * __uint_as_float(w.z & 0xffff0000u);
        o[8 * i + 6] += pj * __uint_as_float(w.w << 16); o[8 * i + 7] += pj * __uint_as_float(w.w & 0xffff0000u);
      }
    }
  }
#pragma unroll
  for (int i = 0; i < 32; ++i) { const bool up_ = (lane & 32) != 0; const float send = up_ ? o[i] : o[i + 32]; const float keep = up_ ? o[i + 32] : o[i]; o[i] = keep + __shfl_xor(send, 32); }
#pragma unroll
  for (int i = 0; i < 16; ++i) { const bool up_ = (lane & 16) != 0; const float send = up_ ? o[i] : o[i + 16]; const float keep = up_ ? o[i + 16] : o[i]; o[i] = keep + __shfl_xor(send, 16); }
#pragma unroll
  for (int i = 0; i < 8; ++i) { const bool up_ = (lane & 8) != 0; const float send = up_ ? o[i] : o[i + 8]; const float keep = up_ ? o[i + 8] : o[i]; o[i] = keep + __shfl_xor(send, 8); }
#pragma unroll
  for (int i = 0; i < 4; ++i) { const bool up_ = (lane & 4) != 0; const float send = up_ ? o[i] : o[i + 4]; const float keep = up_ ? o[i + 4] : o[i]; o[i] = keep + __shfl_xor(send, 4); }
#pragma unroll
  for (int i = 0; i < 2; ++i) { const bool up_ = (lane & 2) != 0; const float send = up_ ? o[i] : o[i + 2]; const float keep = up_ ? o[i + 2] : o[i]; o[i] = keep + __shfl_xor(send, 2); }
  { const bool up_ = (lane & 1) != 0; const float send = up_ ? o[0] : o[1]; const float keep = up_ ? o[1] : o[0]; o[0] = keep + __shfl_xor(send, 1); }
  optr[lane] = f2bf(o[0] / l);
}

__device__ __forceinline__ void mixer_item(const Params& p, int layer, int item, bool need_ctx) {
  const int tid_ = opaque_tid();
  const bf16_t* P = reinterpret_cast<const bf16_t*>(p.ws + WS_P);
  bf16_t* Y = reinterpret_cast<bf16_t*>(p.ws + WS_Y);
  const int wv = tid_ >> 6;
  if (item < 64) { ssm_item(p, layer, item); return; }
  if (item < 320) {
    const int it = item - 64; const int b = it >> 5, blk = (it >> 1) & 15, hk = it & 1;
    const int hq = hk * 4 + (wv >> 1), half = wv & 1;
    const float sink = p.win_sink[layer * 8 + hq];
    for (int qi = 0; qi < 64; ++qi) {
      const int t = blk * 128 + half * 64 + qi;
      const int row = b * SEQ + t;
      attn_query<9>(P + (size_t)row * INW + C_WQ + hq * 64, P, C_WK + hk * 64, C_WV + hk * 64, true, sink, Y + (size_t)row * 1536 + 512 + hq * 64, tid_ & 63,
        [&](int j, int lane, int& krow, float& bias) -> bool {
          bias = 0.f;
          if (j < 5) { const int kp = t - 128 + j * 64 + lane; krow = b * SEQ + kp; return kp >= 0 && kp < SEQ && kp <= t + 128; }
          krow = NLAT + b * CTXL + (j - 5) * 64 + lane; return true;
        });
    }
    return;
  }
  if (item < 576) {
    const int it = item - 320; const int b = it >> 5, h = (it >> 2) & 7, rg = it & 3;
    const int r = rg * 8 + wv;
    int rs = r - 4; rs = rs < 0 ? 0 : (rs > 24 ? 24 : rs);
    const float* rpb = p.na_rpb + ((size_t)layer * 8 + h) * 15 * 31;
    for (int c = 0; c < 64; ++c) {
      const int row = b * SEQ + r * 64 + c;
      int cs = c - 8; cs = cs < 0 ? 0 : (cs > 48 ? 48 : cs);
      attn_query<6>(P + (size_t)row * INW + C_NQ + h * 64, P, C_NK + h * 64, C_NV + h * 64, false, 0.f, Y + (size_t)row * 1536 + 1024 + h * 64, tid_ & 63,
        [&](int j, int lane, int& krow, float& bias) -> bool {
          if (j < 2) {
            const int i = j * 64 + lane; const int kr_ = rs + (i >> 4), kc = cs + (i & 15);
            krow = b * SEQ + kr_ * 64 + kc;
            int dc = kc - c; dc = dc < -15 ? -15 : (dc > 15 ? 15 : dc);
            bias = rpb[(kr_ - r + 7) * 31 + dc + 15];
            return true;
          }
          bias = 0.f; krow = NLAT + b * CTXL + (j - 2) * 64 + lane; return true;
        });
    }
    return;
  }
  if (!need_ctx) return;
  if (item < 608) {
    const int it = item - 576; const int b = it >> 2, qb = it & 3;
    const int hq = wv, hk = hq >> 2;
    const float sink = p.win_sink[layer * 8 + hq];
    for (int qi = 0; qi < 64; ++qi) {
      const int row = NLAT + b * CTXL + qb * 64 + qi;
      attn_query<4>(P + (size_t)row * INW + C_WQ + hq * 64, P, C_WK + hk * 64, C_WV + hk * 64, true, sink, Y + (size_t)row * 1536 + 512 + hq * 64, tid_ & 63,
        [&](int j, int lane, int& krow, float& bias) -> bool { bias = 0.f; krow = NLAT + b * CTXL + j * 64 + lane; return true; });
    }
    return;
  }
  {
    const int it = item - 608; const int b = it >> 2, qb = it & 3;
    const int h = wv;
    for (int qi = 0; qi < 64; ++qi) {
      const int row = NLAT + b * CTXL + qb * 64 + qi;
      attn_query<4>(P + (size_t)row * INW + C_NQ + h * 64, P, C_NK + h * 64, C_NV + h * 64, false, 0.f, Y + (size_t)row * 1536 + 1024 + h * 64, tid_ & 63,
        [&](int j, int lane, int& krow, float& bias) -> bool { bias = 0.f; krow = NLAT + b * CTXL + j * 64 + lane; return true; });
    }
  }
}

__device__ __forceinline__ void route_phase(const Params& p, int layer, int ntok, float* lds_f) {
  const int tid_ = opaque_tid();
  const float* mod = reinterpret_cast<const float*>(p.ws + WS_MOD);
  bf16_t* F = reinterpret_cast<bf16_t*>(p.ws + WS_H);
  int* tke = reinterpret_cast<int*>(p.ws + WS_TKE);
  int* tkp = reinterpret_cast<int*>(p.ws + WS_TKP);
  float* tkg = reinterpret_cast<float*>(p.ws + WS_TKG);
  int* tlist = reinterpret_cast<int*>(p.ws + WS_TLIST);
  unsigned* cnt = reinterpret_cast<unsigned*>(p.ws + WS_CTL) + CW_CNT + layer * 32;
  const int lane = tid_ & 63, wv = tid_ >> 6;
  float* fr = lds_f + wv * 1024;
  const float* gw = p.norm_ffn + layer * D;
  const float* rw = p.router_w + (size_t)layer * D * NEXP;
  const float rb = p.router_b[layer * NEXP + (lane & 31)];
  for (int row = blockIdx.x * 8 + wv; row < ntok; row += gridDim.x * 8) {
    const float* xr = stream_row(p, row);
    const int mi = row_modidx(row);
    float v[16];
#pragma unroll
    for (int i = 0; i < 4; ++i) { const float4 q = *reinterpret_cast<const float4*>(xr + i * 256 + lane * 4); v[4 * i] = q.x; v[4 * i + 1] = q.y; v[4 * i + 2] = q.z; v[4 * i + 3] = q.w; }
    float ss = 0.f;
#pragma unroll
    for (int i = 0; i < 16; ++i) ss += v[i] * v[i];
    ss = wave_sum(ss);
    const float rinv = rsqrtf(ss * (1.0f / D) + 1e-6f);
    const float* msh = mod + ((size_t)layer * 9 + mi) * 6144 + 3 * 1024;
#pragma unroll
    for (int i = 0; i < 4; ++i) {
      const int c = i * 256 + lane * 4;
      const float4 g = *reinterpret_cast<const float4*>(gw + c);
      const float4 sh = *reinterpret_cast<const float4*>(msh + c);
      const float4 sc = *reinterpret_cast<const float4*>(msh + 1024 + c);
      const float f0 = v[4 * i] * rinv * g.x * (1.f + sc.x) + sh.x, f1 = v[4 * i + 1] * rinv * g.y * (1.f + sc.y) + sh.y;
      const float f2 = v[4 * i + 2] * rinv * g.z * (1.f + sc.z) + sh.z, f3 = v[4 * i + 3] * rinv * g.w * (1.f + sc.w) + sh.w;
      st_bf4(F + (size_t)row * D + c, f0, f1, f2, f3);
      *reinterpret_cast<float4*>(fr + c) = float4{f0, f1, f2, f3};
    }
    const int e = lane & 31, hf = lane >> 5;
    float acc = 0.f;
    const float* rwp = rw + (size_t)(hf * 512) * NEXP + e;
    const float* fp = fr + hf * 512;
#pragma unroll 8
    for (int k = 0; k < 512; ++k) acc += fp[k] * rwp[(size_t)k * NEXP];
    acc += __shfl_xor(acc, 32);
    float logit = acc + rb;
    int sel_e[4]; float sel_v[4];
    float cur = logit;
#pragma unroll
    for (int k = 0; k < 4; ++k) {
      float bv = cur; int bi = e;
#pragma unroll
      for (int o = 16; o >= 1; o >>= 1) {
        const float ov = __shfl_xor(bv, o); const int oi = __shfl_xor(bi, o);
        if (ov > bv || (ov == bv && oi < bi)) { bv = ov; bi = oi; }
      }
      sel_e[k] = bi; sel_v[k] = bv;
      if (e == bi) cur = -3.0e38f;
    }
    const float m0 = sel_v[0];
    const float e0 = 1.f, e1 = __expf(sel_v[1] - m0), e2 = __expf(sel_v[2] - m0), e3 = __expf(sel_v[3] - m0);
    const float inv = 1.f / (e0 + e1 + e2 + e3);
    if (lane < 4) {
      const int ee = (lane == 0) ? sel_e[0] : (lane == 1) ? sel_e[1] : (lane == 2) ? sel_e[2] : sel_e[3];
      const float gg = ((lane == 0) ? e0 : (lane == 1) ? e1 : (lane == 2) ? e2 : e3) * inv;
      const unsigned pos = __hip_atomic_fetch_add(&cnt[ee], 1u, __ATOMIC_RELAXED, __HIP_MEMORY_SCOPE_AGENT);
      tke[row * 4 + lane] = ee; tkp[row * 4 + lane] = (int)pos; tkg[row * 4 + lane] = gg;
      tlist[(size_t)ee * NTOK + pos] = row;
    }
  }
}

__device__ __forceinline__ void phase_inproj(const Params& p, int layer, LAS unsigned char* lds) {
  const int G = gridDim.x, bid = blockIdx.x;
  const bf16_t* A = reinterpret_cast<const bf16_t*>(p.ws + WS_H);
  const bf16_t* Bt = reinterpret_cast<const bf16_t*>(p.ws + WS_WIN) + (size_t)layer * INW * 1024;
  bf16_t* P = reinterpret_cast<bf16_t*>(p.ws + WS_P);
  for (int i = 0;; ++i) {
    int pm, pn; if (!unit_next(i * G + bid, NTOK / 256, INW / 256, pm, pn)) break;
    const int ar0 = pm * 256, br0 = pn * 256; const int tz = opaque_tid();
    gemm_tile(lds, (const char*)(A + (size_t)ar0 * 1024), (const char*)(A + (size_t)(ar0 + 128) * 1024), stage_voff(tz, 0, 1024), stage_voff(tz, 1, 1024), stage_voff(tz, 0, 1024), stage_voff(tz, 1, 1024),
              (const char*)(Bt + (size_t)br0 * 1024), (const char*)(Bt + (size_t)(br0 + 128) * 1024), stage_voff(tz, 0, 1024), stage_voff(tz, 1, 1024), 16, tz,
      [&](int r, int c, f32x4 v0, f32x4 v1) {
        bf16_t* o = P + (size_t)(ar0 + r) * INW + br0 + c;
        if (br0 >= C_GATE) { st_bf4(o, sigmoidf(v0[0]), sigmoidf(v0[1]), sigmoidf(v0[2]), sigmoidf(v0[3])); st_bf4(o + 128, sigmoidf(v1[0]), sigmoidf(v1[1]), sigmoidf(v1[2]), sigmoidf(v1[3])); }
        else { st_bf4(o, v0[0], v0[1], v0[2], v0[3]); st_bf4(o + 128, v1[0], v1[1], v1[2], v1[3]); }
      });
  }
}

__device__ __forceinline__ void phase_mixers(const Params& p, int layer, bool need_ctx, int* misc_i) {
  unsigned* head = reinterpret_cast<unsigned*>(p.ws + WS_CTL) + CW_WQ + layer * 64;
  for (;;) {
    __syncthreads();
    if (threadIdx.x == 0) misc_i[40] = (int)__hip_atomic_fetch_add(head, 1u, __ATOMIC_RELAXED, __HIP_MEMORY_SCOPE_AGENT);
    __syncthreads();
    const int item = misc_i[40];
    if (item >= 640) break;
    mixer_item(p, layer, item, need_ctx);
  }
}

__device__ __forceinline__ void phase_glu(const Params& p, int layer, int mrows, LAS unsigned char* lds) {
  const int G = gridDim.x, bid = blockIdx.x;
  const bf16_t* A = reinterpret_cast<const bf16_t*>(p.ws + WS_G);
  const bf16_t* Bt = reinterpret_cast<const bf16_t*>(p.ws + WS_WGLU) + (size_t)layer * 512 * 512;
  bf16_t* Y = reinterpret_cast<bf16_t*>(p.ws + WS_Y);
  for (int i = 0;; ++i) {
    int pm, pn; if (!unit_next(i * G + bid, mrows / 256, 2, pm, pn)) break;
    const int ar0 = pm * 256, br0 = pn * 256; const int tz = opaque_tid();
    gemm_tile(lds, (const char*)(A + (size_t)ar0 * 512), (const char*)(A + (size_t)(ar0 + 128) * 512), stage_voff(tz, 0, 512), stage_voff(tz, 1, 512), stage_voff(tz, 0, 512), stage_voff(tz, 1, 512),
              (const char*)(Bt + (size_t)br0 * 512), (const char*)(Bt + (size_t)(br0 + 128) * 512), stage_voff(tz, 0, 512), stage_voff(tz, 1, 512), 8, tz,
      [&](int r, int c, f32x4 v0, f32x4 v1) {
        const bf16_t* gi = A + (size_t)(ar0 + r) * 512 + br0 + c;
        bf16_t* o = Y + (size_t)(ar0 + r) * 1536 + br0 + c;
        float g0, g1, g2, g3;
        ld_bf4(gi, g0, g1, g2, g3); st_bf4(o, g0 * sigmoidf(v0[0]), g1 * sigmoidf(v0[1]), g2 * sigmoidf(v0[2]), g3 * sigmoidf(v0[3]));
        ld_bf4(gi + 128, g0, g1, g2, g3); st_bf4(o + 128, g0 * sigmoidf(v1[0]), g1 * sigmoidf(v1[1]), g2 * sigmoidf(v1[2]), g3 * sigmoidf(v1[3]));
      });
  }
}

__device__ __forceinline__ void phase_merge1(const Params& p, int layer, int mrows, LAS unsigned char* lds) {
  const int G = gridDim.x, bid = blockIdx.x;
  const bf16_t* Yb = reinterpret_cast<const bf16_t*>(p.ws + WS_Y);
  const bf16_t* P = reinterpret_cast<const bf16_t*>(p.ws + WS_P);
  float* S = reinterpret_cast<float*>(p.ws + WS_S);
  bf16_t* SB = reinterpret_cast<bf16_t*>(p.ws + WS_SB);
  for (int i = 0;; ++i) {
    int pm, pn; if (!unit_next(i * G + bid, mrows / 256, 4, pm, pn)) break;
    const int ar0 = pm * 256, br0 = pn * 256; const int tz = opaque_tid();
    for (int br = 0; br < 3; ++br) {
      const bf16_t* A = Yb + br * 512;
      const bf16_t* Bt = reinterpret_cast<const bf16_t*>(p.ws + WS_WBR) + (size_t)(layer * 3 + br) * 1024 * 512;
      gemm_tile(lds, (const char*)(A + (size_t)ar0 * 1536), (const char*)(A + (size_t)(ar0 + 128) * 1536), stage_voff(tz, 0, 1536), stage_voff(tz, 1, 1536), stage_voff(tz, 0, 1536), stage_voff(tz, 1, 1536),
                (const char*)(Bt + (size_t)br0 * 512), (const char*)(Bt + (size_t)(br0 + 128) * 512), stage_voff(tz, 0, 512), stage_voff(tz, 1, 512), 8, tz,
        [&](int r, int c, f32x4 v0, f32x4 v1) {
          const size_t ro = (size_t)(ar0 + r);
          const bf16_t* gp = P + ro * INW + C_GATE + br * 1024 + br0 + c;
          float* sp = S + ro * D + br0 + c;
          float g0, g1, g2, g3;
          ld_bf4(gp, g0, g1, g2, g3);
          float4 a = float4{g0 * v0[0], g1 * v0[1], g2 * v0[2], g3 * v0[3]};
          ld_bf4(gp + 128, g0, g1, g2, g3);
          float4 b = float4{g0 * v1[0], g1 * v1[1], g2 * v1[2], g3 * v1[3]};
          if (br > 0) { const float4 pa = *reinterpret_cast<const float4*>(sp); const float4 pb2 = *reinterpret_cast<const float4*>(sp + 128);
                        a.x += pa.x; a.y += pa.y; a.z += pa.z; a.w += pa.w; b.x += pb2.x; b.y += pb2.y; b.z += pb2.z; b.w += pb2.w; }
          if (br < 2) { *reinterpret_cast<float4*>(sp) = a; *reinterpret_cast<float4*>(sp + 128) = b; }
          else { bf16_t* o = SB + ro * D + br0 + c; st_bf4(o, a.x, a.y, a.z, a.w); st_bf4(o + 128, b.x, b.y, b.z, b.w); }
        });
    }
  }
}

__device__ __forceinline__ void phase_merge2(const Params& p, int layer, int mrows, LAS unsigned char* lds) {
  const int G = gridDim.x, bid = blockIdx.x;
  const bf16_t* A = reinterpret_cast<const bf16_t*>(p.ws + WS_SB);
  const bf16_t* Bt = reinterpret_cast<const bf16_t*>(p.ws + WS_WOUT) + (size_t)layer * 1024 * 1024;
  const float* mod = reinterpret_cast<const float*>(p.ws + WS_MOD);
  for (int i = 0;; ++i) {
    int pm, pn; if (!unit_next(i * G + bid, mrows / 256, 4, pm, pn)) break;
    const int ar0 = pm * 256, br0 = pn * 256; const int tz = opaque_tid();
    gemm_tile(lds, (const char*)(A + (size_t)ar0 * 1024), (const char*)(A + (size_t)(ar0 + 128) * 1024), stage_voff(tz, 0, 1024), stage_voff(tz, 1, 1024), stage_voff(tz, 0, 1024), stage_voff(tz, 1, 1024),
              (const char*)(Bt + (size_t)br0 * 1024), (const char*)(Bt + (size_t)(br0 + 128) * 1024), stage_voff(tz, 0, 1024), stage_voff(tz, 1, 1024), 16, tz,
      [&](int r, int c, f32x4 v0, f32x4 v1) {
        const int row = ar0 + r;
        float* xr = stream_row(p, row) + br0 + c;
        const float* m2 = mod + ((size_t)layer * 9 + row_modidx(row)) * 6144 + 2 * 1024 + br0 + c;
        float4 a = *reinterpret_cast<const float4*>(xr); const float4 ma = *reinterpret_cast<const float4*>(m2);
        a.x += ma.x * v0[0]; a.y += ma.y * v0[1]; a.z += ma.z * v0[2]; a.w += ma.w * v0[3];
        *reinterpret_cast<float4*>(xr) = a;
        float4 b = *reinterpret_cast<const float4*>(xr + 128); const float4 mb = *reinterpret_cast<const float4*>(m2 + 128);
        b.x += mb.x * v1[0]; b.y += mb.y * v1[1]; b.z += mb.z * v1[2]; b.w += mb.w * v1[3];
        *reinterpret_cast<float4*>(xr + 128) = b;
      });
  }
}

__device__ __forceinline__ int moe_tables(const unsigned* cnt, int* est, int ntn) {
  __syncthreads();
  if (threadIdx.x == 0) { int s = 0, u = 0; for (int e = 0; e < NEXP; ++e) { est[e] = s; est[64 + e] = u; const int c = (int)cnt[e]; s += c; u += ((c + 255) >> 8) * ntn; } est[NEXP] = s; est[64 + NEXP] = u; }
  __syncthreads();
  return est[64 + NEXP];
}
__device__ __forceinline__ void moe_unit(const int* est, int total, int L, int& e, int& cnte, int& pmt, int& pnt) {
  int wgid = L; { const int q = total / 8, r = total % 8, xcd = wgid % 8, off = wgid / 8; wgid = (xcd < r ? xcd * (q + 1) : r * (q + 1) + (xcd - r) * q) + off; }
  e = 0; while (est[64 + e + 1] <= wgid) ++e;
  const int idx = wgid - est[64 + e]; cnte = est[e + 1] - est[e]; const int tm = (cnte + 255) >> 8;
  pmt = idx % tm; pnt = idx / tm;
}

__device__ __forceinline__ void phase_moe1(const Params& p, int layer, LAS unsigned char* lds, int* est) {
  const int G = gridDim.x, bid = blockIdx.x;
  const unsigned* cnt = reinterpret_cast<const unsigned*>(p.ws + WS_CTL) + CW_CNT + layer * 32;
  const int total = moe_tables(cnt, est, 8);
  const bf16_t* F = reinterpret_cast<const bf16_t*>(p.ws + WS_H);
  const int* tlist = reinterpret_cast<const int*>(p.ws + WS_TLIST);
  bf16_t* ACT = reinterpret_cast<bf16_t*>(p.ws + WS_ACT);
  for (int L = bid; L < total; L += G) {
    int e, cnte, pmt, pnt; moe_unit(est, total, L, e, cnte, pmt, pnt);
    const int m0 = pmt * 256, br0 = pnt * 256; const int tz = opaque_tid();
    const int* tl = tlist + (size_t)e * NTOK;
    int R0, C0, R1, C1; stage_rc(tz * 16, R0, C0); stage_rc(tz * 16 + 8192, R1, C1);
    const int r00 = m0 + R0, r01 = m0 + R1, r10 = m0 + 128 + R0, r11 = m0 + 128 + R1;
    const int t00 = ((r00 < cnte) ? tl[r00] : 0) * 1024, t01 = ((r01 < cnte) ? tl[r01] : 0) * 1024, t10 = ((r10 < cnte) ? tl[r10] : 0) * 1024, t11 = ((r11 < cnte) ? tl[r11] : 0) * 1024;
    const bf16_t* Bt = reinterpret_cast<const bf16_t*>(p.ws + WS_WGU) + (size_t)(layer * NEXP + e) * 2048 * 1024;
    const float* bg = p.b_gu + (size_t)(layer * NEXP + e) * 2048 + pnt * 128;
    const int arow0 = est[e] + m0;
    gemm_tile(lds, (const char*)F, (const char*)F, (unsigned)(t00 + C0) * 2u, (unsigned)(t01 + C1) * 2u, (unsigned)(t10 + C0) * 2u, (unsigned)(t11 + C1) * 2u,
              (const char*)(Bt + (size_t)br0 * 1024), (const char*)(Bt + (size_t)(br0 + 128) * 1024), stage_voff(tz, 0, 1024), stage_voff(tz, 1, 1024), 16, tz,
      [&](int r, int c, f32x4 v0, f32x4 v1) {
        if (m0 + r < cnte) {
          const float4 b0 = *reinterpret_cast<const float4*>(bg + c); const float4 b1 = *reinterpret_cast<const float4*>(bg + 1024 + c);
          float o[4];
          const float gg[4] = {v0[0] + b0.x, v0[1] + b0.y, v0[2] + b0.z, v0[3] + b0.w};
          const float uu[4] = {v1[0] + b1.x, v1[1] + b1.y, v1[2] + b1.z, v1[3] + b1.w};
#pragma unroll
          for (int j = 0; j < 4; ++j) { const float g = fminf(gg[j], 7.0f); const float u = fminf(fmaxf(uu[j], -7.0f), 7.0f); o[j] = (u + 1.0f) * (g * sigmoidf(1.702f * g)); }
          st_bf4(ACT + (size_t)(arow0 + r) * 1024 + pnt * 128 + c, o[0], o[1], o[2], o[3]);
        }
      });
  }
}

__device__ __forceinline__ void phase_moe2(const Params& p, int layer, LAS unsigned char* lds, int* est) {
  const int G = gridDim.x, bid = blockIdx.x;
  const unsigned* cnt = reinterpret_cast<const unsigned*>(p.ws + WS_CTL) + CW_CNT + layer * 32;
  const int total = moe_tables(cnt, est, 4);
  const bf16_t* ACT = reinterpret_cast<const bf16_t*>(p.ws + WS_ACT);
  bf16_t* YB = reinterpret_cast<bf16_t*>(p.ws + WS_YB);
  for (int L = bid; L < total; L += G) {
    int e, cnte, pmt, pnt; moe_unit(est, total, L, e, cnte, pmt, pnt);
    const int m0 = pmt * 256, br0 = pnt * 256; const int tz = opaque_tid();
    const int arow0 = est[e] + m0;
    const bf16_t* Bt = reinterpret_cast<const bf16_t*>(p.ws + WS_WDN) + (size_t)(layer * NEXP + e) * 1024 * 1024;
    const float* bd = p.b_dn + (size_t)(layer * NEXP + e) * 1024 + br0;
    gemm_tile(lds, (const char*)(ACT + (size_t)arow0 * 1024), (const char*)(ACT + (size_t)(arow0 + 128) * 1024), stage_voff(tz, 0, 1024), stage_voff(tz, 1, 1024), stage_voff(tz, 0, 1024), stage_voff(tz, 1, 1024),
              (const char*)(Bt + (size_t)br0 * 1024), (const char*)(Bt + (size_t)(br0 + 128) * 1024), stage_voff(tz, 0, 1024), stage_voff(tz, 1, 1024), 16, tz,
      [&](int r, int c, f32x4 v0, f32x4 v1) {
        if (m0 + r < cnte) {
          const float4 b0 = *reinterpret_cast<const float4*>(bd + c); const float4 b1 = *reinterpret_cast<const float4*>(bd + 128 + c);
          bf16_t* o = YB + (size_t)(arow0 + r) * 1024 + br0 + c;
          st_bf4(o, v0[0] + b0.x, v0[1] + b0.y, v0[2] + b0.z, v0[3] + b0.w);
          st_bf4(o + 128, v1[0] + b1.x, v1[1] + b1.y, v1[2] + b1.z, v1[3] + b1.w);
        }
      });
  }
}

__device__ __forceinline__ void phase_prologue(const Params& p, float* ldsf) {
  const int tid_ = opaque_tid();
  const int G = gridDim.x, bid = blockIdx.x;
  conv_mats<0>(p.w_in, reinterpret_cast<bf16_t*>(p.ws + WS_WIN), DEPTH, 1024, INW, ldsf, tid_);
  conv_mats<0>(p.w_glu, reinterpret_cast<bf16_t*>(p.ws + WS_WGLU), DEPTH, 512, 512, ldsf, tid_);
  conv_mats<0>(p.w_branch, reinterpret_cast<bf16_t*>(p.ws + WS_WBR), DEPTH * 3, 512, 1024, ldsf, tid_);
  conv_mats<0>(p.w_out, reinterpret_cast<bf16_t*>(p.ws + WS_WOUT), DEPTH, 1024, 1024, ldsf, tid_);
  conv_mats<1>(p.w_gu, reinterpret_cast<bf16_t*>(p.ws + WS_WGU), DEPTH * NEXP, 1024, 2048, ldsf, tid_);
  conv_mats<0>(p.w_dn, reinterpret_cast<bf16_t*>(p.ws + WS_WDN), DEPTH * NEXP, 1024, 1024, ldsf, tid_);
  mod_phase(p, ldsf);
  const float4* xs = reinterpret_cast<const float4*>(p.x); float4* xo = reinterpret_cast<float4*>(p.out);
  for (size_t i = (size_t)bid * NTHR + tid_; i < (size_t)NLAT * D / 4; i += (size_t)G * NTHR) xo[i] = xs[i];
  const float4* cs = reinterpret_cast<const float4*>(p.ctx); float4* co = reinterpret_cast<float4*>(p.ws + WS_CX);
  for (size_t i = (size_t)bid * NTHR + tid_; i < (size_t)NCTX * D / 4; i += (size_t)G * NTHR) co[i] = cs[i];
}

#ifndef ONLY
#define ONLY -1
#endif
#define PH_ON(idx, k) ((ONLY < 0 || ONLY == (k)) && p.ph_lo <= (idx) && (idx) < p.ph_hi)
#define PH_END(idx) do { if ((idx) + 1 < p.ph_hi) xcd_barrier(bar); } while (0)

__global__ void __launch_bounds__(512, 2) fwd(Params p) {
  extern __shared__ __attribute__((aligned(16))) unsigned char lds_raw[];
  LAS unsigned char* shm = (LAS unsigned char*)lds_raw;
  unsigned* misc_u = reinterpret_cast<unsigned*>(lds_raw + LDS_MISC);
  int* misc_i = reinterpret_cast<int*>(lds_raw + LDS_MISC + 64);
  unsigned* ctl = reinterpret_cast<unsigned*>(p.ws + WS_CTL);
  if (threadIdx.x < 4) misc_u[threadIdx.x] = 0u;
  __syncthreads();
  XcdBarrier bar = xcd_barrier_post(ctl + CW_BAR, (volatile LAS unsigned*)misc_u);

  if (PH_ON(0, 10)) { phase_prologue(p, reinterpret_cast<float*>(lds_raw)); PH_END(0); }

  for (int layer = 0; layer < DEPTH; ++layer) {
    const int pb = 1 + layer * 10;
    const bool need_ctx = layer < DEPTH - 1;
    const int mrows = need_ctx ? NTOK : NLAT;
    if (PH_ON(pb + 0, 0)) { norm_phase(p, layer, layer > 0, misc_i); PH_END(pb + 0); }
    if (PH_ON(pb + 1, 1)) { phase_inproj(p, layer, shm); PH_END(pb + 1); }
    if (PH_ON(pb + 2, 2)) { qknorm_phase(p, layer); PH_END(pb + 2); }
    if (PH_ON(pb + 3, 3)) { phase_mixers(p, layer, need_ctx, misc_i); PH_END(pb + 3); }
    if (PH_ON(pb + 4, 4)) { phase_glu(p, layer, mrows, shm); PH_END(pb + 4); }
    if (PH_ON(pb + 5, 5)) { phase_merge1(p, layer, mrows, shm); PH_END(pb + 5); }
    if (PH_ON(pb + 6, 6)) { phase_merge2(p, layer, mrows, shm); PH_END(pb + 6); }
    if (PH_ON(pb + 7, 7)) { route_phase(p, layer, mrows, reinterpret_cast<float*>(lds_raw)); PH_END(pb + 7); }
    if (PH_ON(pb + 8, 8)) { phase_moe1(p, layer, shm, misc_i); PH_END(pb + 8); }
    if (PH_ON(pb + 9, 9)) { phase_moe2(p, layer, shm, misc_i); PH_END(pb + 9); }
  }
  if (PH_ON(41, 11)) { final_combine(p, misc_i); }
}

extern "C" void kernel_launch(void* const* d_in, const int* in_sizes, int n_in, void* d_out, int out_size, void* d_ws, size_t ws_size, hipStream_t stream) {
  static int grid = 0;
  if (grid == 0) {
    if (n_in != 32 || out_size != NLAT * D || ws_size < WS_END) { fprintf(stderr, "kernel_launch: unexpected shapes (n_in %d out %d ws %zu need %zu)\n", n_in, out_size, ws_size, (size_t)WS_END); grid = -1; return; }
    int dev = 0, cus = 0, per_cu = 0;
    if (hipGetDevice(&dev) != hipSuccess || hipDeviceGetAttribute(&cus, hipDeviceAttributeMultiprocessorCount, dev) != hipSuccess) { grid = -1; return; }
    if (hipFuncSetAttribute((const void*)fwd, hipFuncAttributeMaxDynamicSharedMemorySize, LDS_BYTES) != hipSuccess) { fprintf(stderr, "kernel_launch: hipFuncSetAttribute failed\n"); grid = -1; return; }
    if (hipOccupancyMaxActiveBlocksPerMultiprocessor(&per_cu, (const void*)fwd, NTHR, LDS_BYTES) != hipSuccess || per_cu < 1) fprintf(stderr, "kernel_launch: occupancy query reports %d\n", per_cu);
    (void)hipGetLastError();
    grid = cus;
  }
  if (grid < 0) return;
  (void)hipMemsetAsync((char*)d_ws + WS_CTL, 0, CTL_BYTES, stream);
  Params p{};
  const float** f = reinterpret_cast<const float**>(&p);
  for (int i = 0; i < 32; ++i) f[i] = (const float*)d_in[i];
  p.out = (float*)d_out; p.ws = (unsigned char*)d_ws; p.ph_lo = 0; p.ph_hi = 42;
  hipLaunchKernelGGL(fwd, dim3(grid), dim3(NTHR), LDS_BYTES, stream, p);
}
```

```cpp
#include <hip/hip_runtime.h>
#include <stdint.h>
#include <stdio.h>

typedef unsigned short bf16_t;
typedef short bf16x8 __attribute__((ext_vector_type(8)));
typedef float f32x4 __attribute__((ext_vector_type(4)));
#define LAS __attribute__((address_space(3)))

constexpr int D = 1024, NB = 8, SEQ = 2048, DEPTH = 4, CTXL = 256;
constexpr int NLAT = NB * SEQ, NCTX = NB * CTXL, NTOK = NLAT + NCTX;
constexpr int INW = 5888;
constexpr int C_U = 0, C_WQ = 512, C_WK = 1024, C_WV = 1152, C_NQ = 1280, C_NK = 1792, C_NV = 2304, C_GATE = 2816;
constexpr int NEXP = 32, TOPK = 4, DFF = 1024;
constexpr int NTHR = 512;

constexpr size_t al256(size_t x) { return (x + 255) & ~(size_t)255; }
constexpr size_t WS_CTL   = 0;
constexpr size_t CTL_BYTES = 65536;
constexpr size_t WS_MOD   = WS_CTL + CTL_BYTES;
constexpr size_t WS_WIN   = al256(WS_MOD + (size_t)DEPTH * 9 * 6144 * 4);
constexpr size_t WS_WGLU  = al256(WS_WIN + (size_t)DEPTH * INW * 1024 * 2);
constexpr size_t WS_WBR   = al256(WS_WGLU + (size_t)DEPTH * 512 * 512 * 2);
constexpr size_t WS_WOUT  = al256(WS_WBR + (size_t)DEPTH * 3 * 1024 * 512 * 2);
constexpr size_t WS_WGU   = al256(WS_WOUT + (size_t)DEPTH * 1024 * 1024 * 2);
constexpr size_t WS_WDN   = al256(WS_WGU + (size_t)DEPTH * NEXP * 2048 * 1024 * 2);
constexpr size_t WS_CX    = al256(WS_WDN + (size_t)DEPTH * NEXP * 1024 * 1024 * 2);
constexpr size_t WS_H     = al256(WS_CX + (size_t)NCTX * D * 4);
constexpr size_t WS_P     = al256(WS_H + (size_t)NTOK * D * 2);
constexpr size_t WS_YD    = al256(WS_P + (size_t)NTOK * INW * 2);
constexpr size_t WS_G     = al256(WS_YD + (size_t)2 * NTOK * 512 * 4);
constexpr size_t WS_Y     = al256(WS_G + (size_t)NTOK * 512 * 2);
constexpr size_t WS_S     = al256(WS_Y + (size_t)NTOK * 1536 * 2);
constexpr size_t WS_SB    = al256(WS_S + (size_t)NTOK * D * 4);
constexpr size_t WS_TKE   = al256(WS_SB + (size_t)NTOK * D * 2);
constexpr size_t WS_TKP   = al256(WS_TKE + (size_t)NTOK * 4 * 4);
constexpr size_t WS_TKG   = al256(WS_TKP + (size_t)NTOK * 4 * 4);
constexpr size_t WS_TLIST = al256(WS_TKG + (size_t)NTOK * 4 * 4);
constexpr size_t WS_ACT   = al256(WS_TLIST + (size_t)NEXP * NTOK * 4);
constexpr size_t WS_YB    = al256(WS_ACT + (size_t)(NTOK * 4 + 256) * 1024 * 2);
constexpr size_t WS_VT    = al256(WS_YB + (size_t)(NTOK * 4 + 256) * 1024 * 2);
constexpr size_t WS_END   = al256(WS_VT + (size_t)NB * 10 * 64 * (CTXL + SEQ) * 2);

constexpr int CW_BAR = 0;
constexpr int CW_WQ = 4096;
constexpr int CW_CNT = 8192;

__device__ __forceinline__ bf16_t f2bf(float f) { unsigned u = __float_as_uint(f); u += 0x7fffu + ((u >> 16) & 1u); return (bf16_t)(u >> 16); }
__device__ __forceinline__ float bf2f(bf16_t h) { return __uint_as_float(((unsigned)h) << 16); }
__device__ __forceinline__ unsigned pack2(float a, float b) { return (unsigned)f2bf(a) | ((unsigned)f2bf(b) << 16); }
__device__ __forceinline__ float sigmoidf(float x) { return 1.0f / (1.0f + __expf(-x)); }
__device__ __forceinline__ int opaque_tid() { int tz = threadIdx.x; asm volatile("" : "+v"(tz)); return tz; }
__device__ __forceinline__ float shx(float v, int o, int lane) { return __int_as_float(__builtin_amdgcn_ds_bpermute((lane ^ o) << 2, __float_as_int(v))); }
__device__ __forceinline__ int shx(int v, int o, int lane) { return __builtin_amdgcn_ds_bpermute((lane ^ o) << 2, v); }
__device__ __forceinline__ float wave_sum(float v, int lane) {
#pragma unroll
  for (int o = 32; o >= 1; o >>= 1) v += shx(v, o, lane);
  return v;
}
__device__ __forceinline__ float wave_max(float v, int lane) {
#pragma unroll
  for (int o = 32; o >= 1; o >>= 1) v = fmaxf(v, shx(v, o, lane));
  return v;
}

#define XB_TMO      128
#define XB_XCNT(j)  (256  + 64 * (j))
#define XB_XSUB(j)  (1280 + 64 * (j))
#define XB_XGEN(j)  (2304 + 64 * (j))
#define XB_TOP      3328
#define XB_TOPGEN   3392
#define XCD_BAR_WORDS 3456
#define XB_SPIN_CAP (1u << 20)

__device__ __forceinline__ unsigned xb_ld(unsigned* p)              { return __hip_atomic_load(p, __ATOMIC_RELAXED, __HIP_MEMORY_SCOPE_AGENT); }
__device__ __forceinline__ unsigned xb_add(unsigned* p, unsigned v) { return __hip_atomic_fetch_add(p, v, __ATOMIC_RELAXED, __HIP_MEMORY_SCOPE_AGENT); }
__device__ __forceinline__ unsigned xb_xcc_id() { return (unsigned)__builtin_amdgcn_s_getreg((3 << 11) | 20) & 0xFu; }
#define XB_SPIN(cond, bar) do { unsigned _sp = 0; while (cond) { __builtin_amdgcn_s_sleep(1); \
    if ((++_sp & 255u) == 0u) { if (xb_ld(&(bar)[XB_TMO])) break; if (_sp > XB_SPIN_CAP) { atomicAdd(&(bar)[XB_TMO], 1u); break; } } } } while (0)

struct XcdBarrier { unsigned* bar; unsigned x; volatile LAS unsigned* st; };

__device__ __forceinline__ XcdBarrier xcd_barrier_post(unsigned* bar, volatile LAS unsigned* st) {
    XcdBarrier b; b.bar = bar; b.x = xb_xcc_id(); b.st = st;
    if (threadIdx.x == 0) (void)xb_add(&bar[XB_XCNT(b.x)], 1u);
    return b;
}
__device__ __forceinline__ void xcd_barrier_complete(unsigned* bar, unsigned x, unsigned& nloc, unsigned& nx) {
    const unsigned G = gridDim.x * gridDim.y * gridDim.z;
    unsigned sum, cnt, mine, sp = 0u;
    for (;;) {
        sum = 0u; cnt = 0u; mine = 0u;
#pragma unroll
        for (unsigned j = 0; j < 16; ++j) { const unsigned c = xb_ld(&bar[XB_XCNT(j)]); sum += c; cnt += (c > 0u) ? 1u : 0u; mine = (j == x) ? c : mine; }
        if (sum == G) break;
        __builtin_amdgcn_s_sleep(1);
        if ((++sp & 255u) == 0u) { if (xb_ld(&bar[XB_TMO])) break; if (sp > XB_SPIN_CAP) { atomicAdd(&bar[XB_TMO], 1u); break; } }
    }
    nloc = mine > 0u ? mine : 1u; nx = cnt > 0u ? cnt : 1u;
}
__device__ __forceinline__ void xcd_barrier(const XcdBarrier& b) {
    asm volatile("s_waitcnt vmcnt(0)" ::: "memory");
    __syncthreads();
    if (threadIdx.x == 0) {
        unsigned* bar = b.bar;
        __builtin_amdgcn_s_waitcnt(0);
        unsigned nloc = b.st[0], nx = b.st[1];
        if (nloc == 0u) { xcd_barrier_complete(bar, b.x, nloc, nx); b.st[0] = nloc; b.st[1] = nx; }
        const unsigned old = xb_add(&bar[XB_XSUB(b.x)], 1u);
        const unsigned gen = old / nloc;
        if (old + 1u == (gen + 1u) * nloc) {
            __builtin_amdgcn_fence(__ATOMIC_RELEASE, "agent");
            asm volatile("s_waitcnt vmcnt(0)" ::: "memory");
            const unsigned og = xb_add(&bar[XB_TOP], 1u);
            const unsigned tg = og / nx;
            if (og + 1u == (tg + 1u) * nx) xb_add(&bar[XB_TOPGEN], 1u);
            else XB_SPIN(xb_ld(&bar[XB_TOPGEN]) == tg, bar);
            __builtin_amdgcn_fence(__ATOMIC_ACQUIRE, "agent");
            xb_add(&bar[XB_XGEN(b.x)], 1u);
            asm volatile("s_waitcnt vmcnt(0)" ::: "memory");
        } else {
            XB_SPIN(xb_ld(&bar[XB_XGEN(b.x)]) == gen, bar);
            __builtin_amdgcn_fence(__ATOMIC_ACQUIRE, "agent");
            asm volatile("s_waitcnt vmcnt(0)" ::: "memory");
        }
    }
    __syncthreads();
}

struct Params {
  const float *x, *c, *ctx, *c_ctx, *w_mod, *b_mod, *norm_mix, *norm_ffn, *w_in, *lam_re, *lam_im, *log_dt,
              *b_re, *b_im, *c_re, *c_im, *ssm_d, *w_glu, *win_qn, *win_kn, *win_sink, *na_qn, *na_kn, *na_rpb,
              *w_branch, *w_out, *router_w, *router_b, *w_gu, *b_gu, *w_dn, *b_dn;
  float* out;
  unsigned char* ws;
  int ph_lo, ph_hi;
};

constexpr int LDS_MISC = 131072;
constexpr int LDS_BYTES = 131072 + 8192;

constexpr int HT = 128 * 64;
__device__ __forceinline__ int lds_byte(int r, int c) {
  int st = (r >> 4) * 2 + (c >> 5), rr = r & 15, cc = c & 31, ob = rr * 64 + cc * 2;
  return st * 1024 + (ob ^ (((ob >> 9) & 1) << 5));
}
__device__ __forceinline__ void stage_rc(int b, int& R, int& C) {
  int st = b / 1024, sb = b % 1024, swz = sb ^ (((sb >> 9) & 1) << 5);
  R = (st >> 1) * 16 + swz / 64; C = (st & 1) * 32 + (swz % 64) / 2;
}

#define G_SA(b, h) (((b) * 2 + (h)) * 16384)
#define G_SB(b, h) ((4 + (b) * 2 + (h)) * 16384)
#define G_STAGE(bufoff, gbase, v0, v1) do { \
    __builtin_amdgcn_global_load_lds((const unsigned*)((gbase) + (v0)), (LAS unsigned*)(lds + (bufoff) + ldsw), 16, 0, 0); \
    __builtin_amdgcn_global_load_lds((const unsigned*)((gbase) + (v1)), (LAS unsigned*)(lds + (bufoff) + ldsw + 8192), 16, 0, 0); } while (0)
#define G_LDA(dst, b, h) do { _Pragma("unroll") for (int m = 0; m < 4; ++m) _Pragma("unroll") for (int k = 0; k < 2; ++k) dst[m][k] = *(const LAS bf16x8*)(lds + G_SA(b, h) + aoff + m * 2048 + k * 1024); } while (0)
#define G_LDB(dst, b, h) do { _Pragma("unroll") for (int n = 0; n < 2; ++n) _Pragma("unroll") for (int k = 0; k < 2; ++k) dst[n][k] = *(const LAS bf16x8*)(lds + G_SB(b, h) + boff + n * 2048 + k * 1024); } while (0)
#define G_MMA(ai, bj, At, Bx) do { __builtin_amdgcn_s_setprio(1); \
    _Pragma("unroll") for (int m = 0; m < 4; ++m) _Pragma("unroll") for (int n = 0; n < 2; ++n) _Pragma("unroll") for (int k = 0; k < 2; ++k) \
      acc[ai][bj][m][n] = __builtin_amdgcn_mfma_f32_16x16x32_bf16(Bx[n][k], At[m][k], acc[ai][bj][m][n], 0, 0, 0); \
    __builtin_amdgcn_s_setprio(0); } while (0)
#define WAIT_V(n) asm volatile("s_waitcnt vmcnt(" #n ")" ::: "memory")
#define WAIT_L(n) asm volatile("s_waitcnt lgkmcnt(" #n ")" ::: "memory")
#define BAR __builtin_amdgcn_s_barrier()
#define SCHED __builtin_amdgcn_sched_barrier(0)

template <class Epi>
__device__ __forceinline__ void gemm_tile(LAS unsigned char* lds, const char* a0, const char* a1, unsigned va00, unsigned va01, unsigned va10, unsigned va11,
                                          const char* b0, const char* b1, unsigned vb0, unsigned vb1, int nt, int tid, Epi epi)
{
  asm volatile("s_waitcnt vmcnt(0)" ::: "memory");
  __syncthreads();
  const int wid = __builtin_amdgcn_readfirstlane(tid >> 6), lane = tid & 63, wr = wid >> 2, wc = wid & 3, fr = lane & 15, fq = lane >> 4;
  const unsigned ldsw = (unsigned)wid * 1024u;
  const int aoff = lds_byte(wr * 64 + fr, fq * 8), boff = lds_byte(wc * 32 + fr, fq * 8);
  f32x4 acc[2][2][4][2];
#pragma unroll
  for (int a = 0; a < 2; ++a)
#pragma unroll
    for (int b = 0; b < 2; ++b)
#pragma unroll
      for (int m = 0; m < 4; ++m)
#pragma unroll
        for (int n = 0; n < 2; ++n) acc[a][b][m][n] = f32x4{0.f, 0.f, 0.f, 0.f};
  bf16x8 At[4][2], B0[2][2], B1[2][2];
  G_STAGE(G_SB(0, 0), b0, vb0, vb1); G_STAGE(G_SA(0, 0), a0, va00, va01);
  G_STAGE(G_SB(0, 1), b1, vb0, vb1); G_STAGE(G_SA(0, 1), a1, va10, va11);
  if (wr == 1) BAR;
  WAIT_V(4); BAR;
  G_STAGE(G_SB(1, 0), b0 + 128, vb0, vb1); G_STAGE(G_SA(1, 0), a0 + 128, va00, va01); G_STAGE(G_SB(1, 1), b1 + 128, vb0, vb1);
  WAIT_V(6); BAR;
  for (int t = 0; t < nt - 2; t += 2) {
    const char* a0t = a0 + (size_t)t * 128; const char* a1t = a1 + (size_t)t * 128; const char* b0t = b0 + (size_t)t * 128; const char* b1t = b1 + (size_t)t * 128;
    G_LDB(B0, 0, 0); SCHED; G_LDA(At, 0, 0); G_STAGE(G_SA(1, 1), a1t + 128, va10, va11);
    WAIT_L(8); BAR; WAIT_L(0); G_MMA(0, 0, At, B0); BAR; SCHED;
    G_LDB(B1, 0, 1); G_STAGE(G_SB(0, 0), b0t + 256, vb0, vb1);
    BAR; WAIT_L(0); G_MMA(0, 1, At, B1); BAR;
    G_LDA(At, 0, 1); G_STAGE(G_SA(0, 0), a0t + 256, va00, va01);
    BAR; WAIT_L(0); G_MMA(1, 0, At, B0); BAR; SCHED;
    G_STAGE(G_SB(0, 1), b1t + 256, vb0, vb1);
    WAIT_V(6); BAR; G_MMA(1, 1, At, B1); BAR;
    G_LDB(B0, 1, 0); SCHED; G_LDA(At, 1, 0); G_STAGE(G_SA(0, 1), a1t + 256, va10, va11);
    WAIT_L(8); BAR; WAIT_L(0); G_MMA(0, 0, At, B0); BAR; SCHED;
    G_LDB(B1, 1, 1); G_STAGE(G_SB(1, 0), b0t + 384, vb0, vb1);
    BAR; WAIT_L(0); G_MMA(0, 1, At, B1); BAR;
    G_LDA(At, 1, 1); G_STAGE(G_SA(1, 0), a0t + 384, va00, va01);
    BAR; WAIT_L(0); G_MMA(1, 0, At, B0); BAR; SCHED;
    G_STAGE(G_SB(1, 1), b1t + 384, vb0, vb1);
    WAIT_V(6); BAR; G_MMA(1, 1, At, B1); BAR;
  }
  { G_LDB(B0, 0, 0); WAIT_V(0); G_LDA(At, 0, 0); G_STAGE(G_SA(1, 1), a1 + (size_t)(nt - 1) * 128, va10, va11);
    BAR; WAIT_L(0); G_MMA(0, 0, At, B0); BAR;
    G_LDB(B1, 0, 1); BAR; WAIT_L(0); G_MMA(0, 1, At, B1); BAR;
    G_LDA(At, 0, 1); WAIT_V(4); BAR; WAIT_L(0); G_MMA(1, 0, At, B0); G_MMA(1, 1, At, B1); BAR; }
  { G_LDB(B0, 1, 0); G_LDA(At, 1, 0); WAIT_V(2); BAR; WAIT_L(0); G_MMA(0, 0, At, B0); BAR;
    G_LDB(B1, 1, 1); WAIT_V(0); BAR; WAIT_L(0); G_MMA(0, 1, At, B1); BAR;
    G_LDA(At, 1, 1); BAR; WAIT_L(0); G_MMA(1, 0, At, B0); G_MMA(1, 1, At, B1); BAR; }
  if (wr == 0) BAR;
#pragma unroll
  for (int ai = 0; ai < 2; ++ai)
#pragma unroll
    for (int m = 0; m < 4; ++m)
#pragma unroll
      for (int n = 0; n < 2; ++n)
        epi(ai * 128 + wr * 64 + m * 16 + fr, wc * 32 + n * 16 + fq * 4, acc[ai][0][m][n], acc[ai][1][m][n]);
}

__device__ __forceinline__ unsigned stage_voff(int tid, int i, int ld) { int R, C; stage_rc(tid * 16 + i * 8192, R, C); return (unsigned)(R * ld + C) * 2u; }


__device__ __forceinline__ bool unit_next(int L, int nM, int nN, int& pm, int& pn) {
  const int nwg = nM * nN; if (L >= nwg) return false;
  int wgid = L; { const int q = nwg / 8, r = nwg % 8, xcd = wgid % 8, off = wgid / 8; wgid = (xcd < r ? xcd * (q + 1) : r * (q + 1) + (xcd - r) * q) + off; }
  const int nig = 8 * nN, gid = wgid / nig, fm = gid * 8, gsz = (nM - fm) < 8 ? (nM - fm) : 8;
  pm = fm + ((wgid % nig) % gsz); pn = (wgid % nig) / gsz; return true;
}

__device__ __forceinline__ void st_bf4(bf16_t* p, float a, float b, float c, float d) {
  uint2 v; v.x = pack2(a, b); v.y = pack2(c, d); *reinterpret_cast<uint2*>(p) = v;
}
__device__ __forceinline__ void ld_bf4(const bf16_t* p, float& a, float& b, float& c, float& d) {
  uint2 v = *reinterpret_cast<const uint2*>(p);
  a = __uint_as_float(v.x << 16); b = __uint_as_float(v.x & 0xffff0000u); c = __uint_as_float(v.y << 16); d = __uint_as_float(v.y & 0xffff0000u);
}

template <int PERM>
__device__ __forceinline__ void conv_mats(const float* __restrict__ src, bf16_t* __restrict__ dst, int nmat, int K, int N, float* lds, int tid_) {
  const int tK = K / 64, tN = N / 64, per = tK * tN, total = nmat * per;
  const int t = tid_;
  for (int tile = blockIdx.x; tile < total; tile += gridDim.x) {
    const int mat = tile / per, rem = tile % per, kt = rem / tN, ntl = rem % tN;
    const int p0 = ntl * 64;
    int s0 = p0;
    if (PERM == 1) { const int t256 = p0 >> 8, w = p0 & 255; s0 = (w < 128) ? (t256 * 128 + w) : (1024 + t256 * 128 + (w - 128)); }
    const float* S = src + (size_t)mat * K * N + (size_t)(kt * 64) * N + s0;
    __syncthreads();
    { const int c = t & 63, r = t >> 6;
#pragma unroll
      for (int i = 0; i < 8; ++i) { const int k = r + 8 * i; lds[k * 65 + c] = S[(size_t)k * N + c]; } }
    __syncthreads();
    { const int n = t >> 3, kc = (t & 7) * 8;
      uint4 v;
      v.x = pack2(lds[(kc + 0) * 65 + n], lds[(kc + 1) * 65 + n]);
      v.y = pack2(lds[(kc + 2) * 65 + n], lds[(kc + 3) * 65 + n]);
      v.z = pack2(lds[(kc + 4) * 65 + n], lds[(kc + 5) * 65 + n]);
      v.w = pack2(lds[(kc + 6) * 65 + n], lds[(kc + 7) * 65 + n]);
      *reinterpret_cast<uint4*>(dst + (size_t)mat * N * K + (size_t)(p0 + n) * K + kt * 64 + kc) = v; }
  }
}

__device__ __forceinline__ float siluf(float x) { return x / (1.0f + __expf(-x)); }
__device__ __forceinline__ float gelu_tanh(float x) {
  const float u = 0.7978845608028654f * (x + 0.044715f * x * x * x);
  return 0.5f * x * (1.0f + tanhf(u));
}

__device__ __forceinline__ void mod_phase(const Params& p, float* lds) {
  const int tid_ = opaque_tid();
  float* sc = lds;
  float* red = lds + 9 * 1024;
  const int t = tid_;
  __syncthreads();
  for (int i = t; i < 9 * 1024; i += NTHR) { const int r = i >> 10, k = i & 1023; const float v = (r < 8) ? p.c[r * 1024 + k] : p.c_ctx[k]; sc[i] = siluf(v); }
  __syncthreads();
  float* mod = reinterpret_cast<float*>(p.ws + WS_MOD);
  for (int u = blockIdx.x; u < DEPTH * 48; u += gridDim.x) {
    const int l = u / 48, col0 = (u % 48) * 128;
    const int col = t & 127, kq = t >> 7;
    float a[9];
#pragma unroll
    for (int r = 0; r < 9; ++r) a[r] = 0.f;
    const float* W = p.w_mod + (size_t)l * 1024 * 6144 + col0 + col;
    for (int k = kq * 256; k < kq * 256 + 256; ++k) {
      const float w = W[(size_t)k * 6144];
#pragma unroll
      for (int r = 0; r < 9; ++r) a[r] += sc[r * 1024 + k] * w;
    }
#pragma unroll
    for (int r = 0; r < 9; ++r) red[(kq * 9 + r) * 128 + col] = a[r];
    __syncthreads();
    for (int i = t; i < 9 * 128; i += NTHR) {
      const int r = i >> 7, cc = i & 127;
      const float v = red[(0 * 9 + r) * 128 + cc] + red[(1 * 9 + r) * 128 + cc] + red[(2 * 9 + r) * 128 + cc] + red[(3 * 9 + r) * 128 + cc];
      mod[((size_t)l * 9 + r) * 6144 + col0 + cc] = v + p.b_mod[l * 6144 + col0 + cc];
    }
    __syncthreads();
  }
}

__device__ __forceinline__ float* stream_row(const Params& p, int row) {
  return (row < NLAT) ? (p.out + (size_t)row * D) : (reinterpret_cast<float*>(p.ws + WS_CX) + (size_t)(row - NLAT) * D);
}
__device__ __forceinline__ int row_modidx(int row) { return (row < NLAT) ? (row >> 11) : 8; }

__device__ __forceinline__ void expert_starts(const unsigned* cnt, int* st) {
  if (threadIdx.x == 0) { int s = 0; for (int e = 0; e < NEXP; ++e) { st[e] = s; s += (int)cnt[e]; } st[NEXP] = s; }
  __syncthreads();
}

__device__ __forceinline__ void norm_phase(const Params& p, int layer, bool combine, int* lds_i) {
  const int tid_ = opaque_tid();
  const float* mod = reinterpret_cast<const float*>(p.ws + WS_MOD);
  bf16_t* H = reinterpret_cast<bf16_t*>(p.ws + WS_H);
  const int* tke = reinterpret_cast<const int*>(p.ws + WS_TKE);
  const int* tkp = reinterpret_cast<const int*>(p.ws + WS_TKP);
  const float* tkg = reinterpret_cast<const float*>(p.ws + WS_TKG);
  const bf16_t* YB = reinterpret_cast<const bf16_t*>(p.ws + WS_YB);
  const unsigned* ctl = reinterpret_cast<const unsigned*>(p.ws + WS_CTL);
  if (combine) expert_starts(ctl + CW_CNT + (layer - 1) * 32, lds_i);
  const int lane = tid_ & 63, wv = tid_ >> 6;
  const float* gw = p.norm_mix + layer * D;
  for (int row = blockIdx.x * 8 + wv; row < NTOK; row += gridDim.x * 8) {
    float* xr = stream_row(p, row);
    const int mi = row_modidx(row);
    float v[16];
#pragma unroll
    for (int i = 0; i < 4; ++i) { const float4 q = *reinterpret_cast<const float4*>(xr + i * 256 + lane * 4); v[4 * i] = q.x; v[4 * i + 1] = q.y; v[4 * i + 2] = q.z; v[4 * i + 3] = q.w; }
    if (combine) {
      const float* m5 = mod + ((size_t)(layer - 1) * 9 + mi) * 6144 + 5 * 1024;
      float a[16];
#pragma unroll
      for (int i = 0; i < 16; ++i) a[i] = 0.f;
#pragma unroll
      for (int k = 0; k < 4; ++k) {
        const int e = tke[row * 4 + k]; const int pos = tkp[row * 4 + k]; const float g = tkg[row * 4 + k];
        const bf16_t* yr = YB + (size_t)(lds_i[e] + pos) * D;
#pragma unroll
        for (int i = 0; i < 4; ++i) { float a0, a1, a2, a3; ld_bf4(yr + i * 256 + lane * 4, a0, a1, a2, a3); a[4 * i] += g * a0; a[4 * i + 1] += g * a1; a[4 * i + 2] += g * a2; a[4 * i + 3] += g * a3; }
      }
#pragma unroll
      for (int i = 0; i < 4; ++i) {
        const float4 mm = *reinterpret_cast<const float4*>(m5 + i * 256 + lane * 4);
        v[4 * i] += mm.x * a[4 * i]; v[4 * i + 1] += mm.y * a[4 * i + 1]; v[4 * i + 2] += mm.z * a[4 * i + 2]; v[4 * i + 3] += mm.w * a[4 * i + 3];
        *reinterpret_cast<float4*>(xr + i * 256 + lane * 4) = float4{v[4 * i], v[4 * i + 1], v[4 * i + 2], v[4 * i + 3]};
      }
    }
    float ss = 0.f;
#pragma unroll
    for (int i = 0; i < 16; ++i) ss += v[i] * v[i];
    ss = wave_sum(ss, lane);
    const float rinv = rsqrtf(ss * (1.0f / D) + 1e-6f);
    const float* msh = mod + ((size_t)layer * 9 + mi) * 6144;
#pragma unroll
    for (int i = 0; i < 4; ++i) {
      const int c = i * 256 + lane * 4;
      const float4 g = *reinterpret_cast<const float4*>(gw + c);
      const float4 sh = *reinterpret_cast<const float4*>(msh + c);
      const float4 sc = *reinterpret_cast<const float4*>(msh + 1024 + c);
      st_bf4(H + (size_t)row * D + c, v[4 * i] * rinv * g.x * (1.f + sc.x) + sh.x, v[4 * i + 1] * rinv * g.y * (1.f + sc.y) + sh.y,
             v[4 * i + 2] * rinv * g.z * (1.f + sc.z) + sh.z, v[4 * i + 3] * rinv * g.w * (1.f + sc.w) + sh.w);
    }
  }
}

__device__ __forceinline__ void final_combine(const Params& p, int* lds_i) {
  const int tid_ = opaque_tid();
  const float* mod = reinterpret_cast<const float*>(p.ws + WS_MOD);
  const int* tke = reinterpret_cast<const int*>(p.ws + WS_TKE);
  const int* tkp = reinterpret_cast<const int*>(p.ws + WS_TKP);
  const float* tkg = reinterpret_cast<const float*>(p.ws + WS_TKG);
  const bf16_t* YB = reinterpret_cast<const bf16_t*>(p.ws + WS_YB);
  const unsigned* ctl = reinterpret_cast<const unsigned*>(p.ws + WS_CTL);
  expert_starts(ctl + CW_CNT + (DEPTH - 1) * 32, lds_i);
  const int lane = tid_ & 63, wv = tid_ >> 6;
  for (int row = blockIdx.x * 8 + wv; row < NLAT; row += gridDim.x * 8) {
    float* xr = p.out + (size_t)row * D;
    const int mi = row >> 11;
    const float* m5 = mod + ((size_t)(DEPTH - 1) * 9 + mi) * 6144 + 5 * 1024;
    float a[16];
#pragma unroll
    for (int i = 0; i < 16; ++i) a[i] = 0.f;
#pragma unroll
    for (int k = 0; k < 4; ++k) {
      const int e = tke[row * 4 + k]; const int pos = tkp[row * 4 + k]; const float g = tkg[row * 4 + k];
      const bf16_t* yr = YB + (size_t)(lds_i[e] + pos) * D;
#pragma unroll
      for (int i = 0; i < 4; ++i) { float a0, a1, a2, a3; ld_bf4(yr + i * 256 + lane * 4, a0, a1, a2, a3); a[4 * i] += g * a0; a[4 * i + 1] += g * a1; a[4 * i + 2] += g * a2; a[4 * i + 3] += g * a3; }
    }
#pragma unroll
    for (int i = 0; i < 4; ++i) {
      const float4 mm = *reinterpret_cast<const float4*>(m5 + i * 256 + lane * 4);
      float4 q = *reinterpret_cast<const float4*>(xr + i * 256 + lane * 4);
      q.x += mm.x * a[4 * i]; q.y += mm.y * a[4 * i + 1]; q.z += mm.z * a[4 * i + 2]; q.w += mm.w * a[4 * i + 3];
      *reinterpret_cast<float4*>(xr + i * 256 + lane * 4) = q;
    }
  }
}

__device__ __forceinline__ void qknorm_phase(const Params& p, int layer) {
  const int tid_ = opaque_tid();
  bf16_t* P = reinterpret_cast<bf16_t*>(p.ws + WS_P);
  const int lane = tid_ & 63, wv = tid_ >> 6;
  const float wqn = p.win_qn[layer * 64 + lane], wkn = p.win_kn[layer * 64 + lane];
  const float nqn = p.na_qn[layer * 64 + lane], nkn = p.na_kn[layer * 64 + lane];
  const int fi = lane & 15;
  const float inv_freq = powf(10000.0f, -(float)fi / 16.0f);
  for (int row = blockIdx.x * 8 + wv; row < NTOK; row += gridDim.x * 8) {
    bf16_t* pr = P + (size_t)row * INW;
    const bool lat = row < NLAT;
    float cs = 1.f, sn = 0.f;
    if (lat) { const int t = row & 2047; const int pos = (lane < 32) ? (t >> 6) : (t & 63); const float ang = (float)pos * inv_freq; cs = cosf(ang); sn = sinf(ang); }
    for (int hd = 0; hd < 26; ++hd) {
      int col; float w; bool rope;
      if (hd < 8) { col = C_WQ + hd * 64; w = wqn; rope = lat; }
      else if (hd < 10) { col = C_WK + (hd - 8) * 64; w = wkn; rope = lat; }
      else if (hd < 18) { col = C_NQ + (hd - 10) * 64; w = nqn; rope = false; }
      else { col = C_NK + (hd - 18) * 64; w = nkn; rope = false; }
      const float v = bf2f(pr[col + lane]);
      const float ss = wave_sum(v * v, lane);
      float y = v * rsqrtf(ss * (1.0f / 64.0f) + 1e-6f) * w;
      if (rope) {
        const float o = shx(y, 16, lane);
        y = ((lane & 16) == 0) ? (y * cs - o * sn) : (o * sn + y * cs);
      }
      pr[col + lane] = f2bf(y);
    }
    {
      bf16_t* VT = reinterpret_cast<bf16_t*>(p.ws + WS_VT);
      const int bb = lat ? (row >> 11) : ((row - NLAT) >> 8);
      const int tpos = lat ? (CTXL + (row & 2047)) : ((row - NLAT) & 255);
#pragma unroll
      for (int hv = 0; hv < 10; ++hv) {
        const int col = (hv < 2) ? (C_WV + hv * 64) : (C_NV + (hv - 2) * 64);
        VT[((size_t)(bb * 10 + hv) * 64 + lane) * (CTXL + SEQ) + tpos] = pr[col + lane];
      }
    }
  }
}

__device__ __forceinline__ int ssm_row(int b, int dir, int tau) {
  if (tau < CTXL) return NLAT + b * CTXL + (dir ? (CTXL - 1 - tau) : tau);
  const int t = tau - CTXL;
  return b * SEQ + (dir ? (SEQ - 1 - t) : t);
}

__device__ __forceinline__ void ssm_item_naive(const Params& p, int layer, int item) {
  const int tid_ = opaque_tid();
  const int b = item >> 3, gq = item & 7;
  const int lane = tid_ & 63, wv = tid_ >> 6;
  const int dir = wv & 1, g = gq * 4 + (wv >> 1);
  const bf16_t* P = reinterpret_cast<const bf16_t*>(p.ws + WS_P);
  float* YD = reinterpret_cast<float*>(p.ws + WS_YD) + (size_t)dir * NTOK * 512;
  {
    const int n = lane;
    const size_t pg = ((size_t)(layer * 2 + dir) * 32 + g);
    const float lr = p.lam_re[pg * 64 + n], li = p.lam_im[pg * 64 + n];
    const float dt = expf(p.log_dt[pg]);
    const float mag = expf(lr * dt);
    const float ar = mag * cosf(li * dt), ai = mag * sinf(li * dt);
    const float den = lr * lr + li * li;
    const float fr = ((ar - 1.0f) * lr + ai * li) / den;
    const float fi = (ai * lr - (ar - 1.0f) * li) / den;
    float bbr[16], bbi[16], cr[16], ci[16];
#pragma unroll
    for (int q = 0; q < 16; ++q) {
      const float br = p.b_re[(pg * 64 + n) * 16 + q], bi = p.b_im[(pg * 64 + n) * 16 + q];
      bbr[q] = fr * br - fi * bi; bbi[q] = fr * bi + fi * br;
      cr[q] = p.c_re[(pg * 16 + q) * 64 + n]; ci[q] = p.c_im[(pg * 16 + q) * 64 + n];
    }
    float hr = 0.f, hi = 0.f;
    for (int tau = 0; tau < CTXL + SEQ; ++tau) {
      const int row = ssm_row(b, dir, tau);
      const uint4* up = reinterpret_cast<const uint4*>(P + (size_t)row * INW + C_U + g * 16);
      const uint4 u0 = up[0], u1 = up[1];
      float u[16];
      u[0] = __uint_as_float(u0.x << 16); u[1] = __uint_as_float(u0.x & 0xffff0000u); u[2] = __uint_as_float(u0.y << 16); u[3] = __uint_as_float(u0.y & 0xffff0000u);
      u[4] = __uint_as_float(u0.z << 16); u[5] = __uint_as_float(u0.z & 0xffff0000u); u[6] = __uint_as_float(u0.w << 16); u[7] = __uint_as_float(u0.w & 0xffff0000u);
      u[8] = __uint_as_float(u1.x << 16); u[9] = __uint_as_float(u1.x & 0xffff0000u); u[10] = __uint_as_float(u1.y << 16); u[11] = __uint_as_float(u1.y & 0xffff0000u);
      u[12] = __uint_as_float(u1.z << 16); u[13] = __uint_as_float(u1.z & 0xffff0000u); u[14] = __uint_as_float(u1.w << 16); u[15] = __uint_as_float(u1.w & 0xffff0000u);
      float xr = 0.f, xi = 0.f;
#pragma unroll
      for (int q = 0; q < 16; ++q) { xr += bbr[q] * u[q]; xi += bbi[q] * u[q]; }
      const float nhr = ar * hr - ai * hi + xr;
      const float nhi = ar * hi + ai * hr + xi;
      hr = nhr; hi = nhi;
      float v[16];
#pragma unroll
      for (int q = 0; q < 16; ++q) v[q] = hr * cr[q] - hi * ci[q];
#pragma unroll
      for (int i = 0; i < 8; ++i) { const bool up_ = (lane & 32) != 0; const float send = up_ ? v[i] : v[i + 8]; const float keep = up_ ? v[i + 8] : v[i]; v[i] = keep + shx(send, 32, lane); }
#pragma unroll
      for (int i = 0; i < 4; ++i) { const bool up_ = (lane & 16) != 0; const float send = up_ ? v[i] : v[i + 4]; const float keep = up_ ? v[i + 4] : v[i]; v[i] = keep + shx(send, 16, lane); }
#pragma unroll
      for (int i = 0; i < 2; ++i) { const bool up_ = (lane & 8) != 0; const float send = up_ ? v[i] : v[i + 2]; const float keep = up_ ? v[i + 2] : v[i]; v[i] = keep + shx(send, 8, lane); }
      { const bool up_ = (lane & 4) != 0; const float send = up_ ? v[0] : v[1]; const float keep = up_ ? v[1] : v[0]; v[0] = keep + shx(send, 4, lane); }
      v[0] += shx(v[0], 2, lane);
      v[0] += shx(v[0], 1, lane);
      if ((lane & 3) == 0) YD[(size_t)row * 512 + g * 16 + (lane >> 2)] = v[0];
    }
  }
  asm volatile("s_waitcnt vmcnt(0)" ::: "memory");
  __threadfence();
  __syncthreads();
  {
    const float* Y0 = reinterpret_cast<const float*>(p.ws + WS_YD);
    const float* Y1 = Y0 + (size_t)NTOK * 512;
    bf16_t* G = reinterpret_cast<bf16_t*>(p.ws + WS_G);
    const int ch = gq * 64 + (tid_ & 63);
    const float dsk = p.ssm_d[layer * 512 + ch];
    for (int i = tid_ >> 6; i < CTXL + SEQ; i += 8) {
      const int row = (i < CTXL) ? (NLAT + b * CTXL + i) : (b * SEQ + i - CTXL);
      const float y = Y0[(size_t)row * 512 + ch] + Y1[(size_t)row * 512 + ch] + dsk * bf2f(P[(size_t)row * INW + C_U + ch]);
      G[(size_t)row * 512 + ch] = f2bf(gelu_tanh(y));
    }
  }
}


typedef float f32x16 __attribute__((ext_vector_type(16)));
__device__ __forceinline__ bf16x8 pack8(const float* v) {
  union { unsigned u[4]; bf16x8 b; } t;
  t.u[0] = pack2(v[0], v[1]); t.u[1] = pack2(v[2], v[3]); t.u[2] = pack2(v[4], v[5]); t.u[3] = pack2(v[6], v[7]);
  return t.b;
}
constexpr int SSM_PITCH = 272;
__device__ __forceinline__ void ssm_item(const Params& p, int layer, int item, unsigned char* lds_raw) {
  const int tid_ = opaque_tid();
  const int b = item >> 3, gq = item & 7;
  const int lane = tid_ & 63, wv = tid_ >> 6;
  const int dir = wv & 1, g = gq * 4 + (wv >> 1);
  const bf16_t* P = reinterpret_cast<const bf16_t*>(p.ws + WS_P);
  float* YD = reinterpret_cast<float*>(p.ws + WS_YD) + (size_t)dir * NTOK * 512;
  unsigned char* hl = lds_raw + wv * (32 * SSM_PITCH);
  {
    const int n0 = lane & 31, hh = lane >> 5;
    const size_t pg = ((size_t)(layer * 2 + dir) * 32 + g);
    const float dt = expf(p.log_dt[pg]);
    float pwr[2][4], pwi[2][4];
    bf16x8 Bop[4];
#pragma unroll
    for (int sb = 0; sb < 2; ++sb) {
      const int n = n0 + 32 * sb;
      const float lr = p.lam_re[pg * 64 + n], li = p.lam_im[pg * 64 + n];
      const float mag = expf(lr * dt);
      const float ar = mag * cosf(li * dt), ai = mag * sinf(li * dt);
      const float den = lr * lr + li * li;
      const float fr = ((ar - 1.0f) * lr + ai * li) / den;
      const float fi = (ai * lr - (ar - 1.0f) * li) / den;
      float vr[8], vi[8];
#pragma unroll
      for (int j = 0; j < 8; ++j) {
        const int q = 8 * hh + j;
        const float br = p.b_re[(pg * 64 + n) * 16 + q], bi = p.b_im[(pg * 64 + n) * 16 + q];
        vr[j] = fr * br - fi * bi; vi[j] = fr * bi + fi * br;
      }
      Bop[sb * 2 + 0] = pack8(vr); Bop[sb * 2 + 1] = pack8(vi);
      pwr[sb][0] = ar; pwi[sb][0] = ai;
      pwr[sb][1] = ar * ar - ai * ai; pwi[sb][1] = 2.0f * ar * ai;
      pwr[sb][2] = pwr[sb][1] * ar - pwi[sb][1] * ai; pwi[sb][2] = pwr[sb][1] * ai + pwi[sb][1] * ar;
      pwr[sb][3] = pwr[sb][1] * pwr[sb][1] - pwi[sb][1] * pwi[sb][1]; pwi[sb][3] = 2.0f * pwr[sb][1] * pwi[sb][1];
    }
    bf16x8 Cop[4];
    {
      const int pch = lane & 15, q4 = lane >> 4;
#pragma unroll
      for (int kb = 0; kb < 4; ++kb) {
        float v[8];
#pragma unroll
        for (int j = 0; j < 8; ++j) {
          const int n = 8 * kb + 2 * q4 + (j >> 2), c = j & 3, nn = n + 32 * (c >> 1);
          v[j] = (c & 1) ? -p.c_im[(pg * 16 + pch) * 64 + nn] : p.c_re[(pg * 16 + pch) * 64 + nn];
        }
        Cop[kb] = pack8(v);
      }
    }
    float hpr[2] = {0.f, 0.f}, hpi[2] = {0.f, 0.f};
    const int ucol = C_U + g * 16 + 8 * hh;
    auto chunk_base = [&](int c, int& base, int& sgn) {
      sgn = dir ? -1 : 1;
      if (c < 8) base = NLAT + b * CTXL + (dir ? (CTXL - 1 - c * 32) : c * 32);
      else base = b * SEQ + (dir ? (SEQ - 1 - (c - 8) * 32) : (c - 8) * 32);
    };
    uint4 unext;
    { int base, sgn; chunk_base(0, base, sgn); unext = *reinterpret_cast<const uint4*>(P + (size_t)(base + sgn * n0) * INW + ucol); }
    for (int c = 0; c < 72; ++c) {
      int base, sgn; chunk_base(c, base, sgn);
      union { uint4 u; bf16x8 b; } ua; ua.u = unext;
      if (c + 1 < 72) { int nb, ns; chunk_base(c + 1, nb, ns); unext = *reinterpret_cast<const uint4*>(P + (size_t)(nb + ns * n0) * INW + ucol); }
      f32x16 X[4];
#pragma unroll
      for (int k = 0; k < 4; ++k) {
        f32x16 z;
#pragma unroll
        for (int r = 0; r < 16; ++r) z[r] = 0.f;
        X[k] = __builtin_amdgcn_mfma_f32_32x32x16_bf16(ua.b, Bop[k], z, 0, 0, 0);
      }
#pragma unroll
      for (int sb = 0; sb < 2; ++sb) {
        f32x16& xr = X[sb * 2]; f32x16& xi = X[sb * 2 + 1];
        const float ar = pwr[sb][0], ai = pwi[sb][0], a4r = pwr[sb][3], a4i = pwi[sb][3];
        float Er[4], Ei[4], Or[4], Oi[4], mcr[4], mci[4];
#pragma unroll
        for (int q = 0; q < 4; ++q) {
#pragma unroll
          for (int i = 1; i < 4; ++i) {
            const int r = 4 * q + i;
            const float nr = ar * xr[r - 1] - ai * xi[r - 1] + xr[r];
            const float ni = ar * xi[r - 1] + ai * xr[r - 1] + xi[r];
            xr[r] = nr; xi[r] = ni;
          }
          Er[q] = xr[4 * q + 3]; Ei[q] = xi[4 * q + 3];
        }
#pragma unroll
        for (int q = 0; q < 4; ++q) { Or[q] = shx(Er[q], 32, lane); Oi[q] = shx(Ei[q], 32, lane); }
        float cr = hpr[sb], ci = hpi[sb];
#pragma unroll
        for (int q = 0; q < 4; ++q) {
          const float cer = cr, cei = ci;
          const float eer = hh ? Or[q] : Er[q], eei = hh ? Oi[q] : Ei[q];
          float tr = a4r * cr - a4i * ci + eer, ti = a4r * ci + a4i * cr + eei;
          cr = tr; ci = ti;
          const float cor = cr, coi = ci;
          const float eor = hh ? Er[q] : Or[q], eoi = hh ? Ei[q] : Oi[q];
          tr = a4r * cr - a4i * ci + eor; ti = a4r * ci + a4i * cr + eoi;
          cr = tr; ci = ti;
          mcr[q] = hh ? cor : cer; mci[q] = hh ? coi : cei;
        }
        hpr[sb] = cr; hpi[sb] = ci;
#pragma unroll
        for (int q = 0; q < 4; ++q)
#pragma unroll
          for (int i = 0; i < 4; ++i) {
            const int r = 4 * q + i;
            xr[r] += pwr[sb][i] * mcr[q] - pwi[sb][i] * mci[q];
            xi[r] += pwr[sb][i] * mci[q] + pwi[sb][i] * mcr[q];
          }
      }
#pragma unroll
      for (int q = 0; q < 4; ++q)
#pragma unroll
        for (int i = 0; i < 4; ++i) {
          const int r = 4 * q + i, tok = 8 * q + 4 * hh + i;
          uint2 w; w.x = pack2(X[0][r], X[1][r]); w.y = pack2(X[2][r], X[3][r]);
          *reinterpret_cast<uint2*>(hl + tok * SSM_PITCH + n0 * 8) = w;
        }
#pragma unroll
      for (int th = 0; th < 2; ++th) {
        f32x4 acc = f32x4{0.f, 0.f, 0.f, 0.f};
        const int tok = 16 * th + (lane & 15);
#pragma unroll
        for (int kb = 0; kb < 4; ++kb) {
          const bf16x8 hb = *reinterpret_cast<const bf16x8*>(hl + tok * SSM_PITCH + kb * 64 + (lane >> 4) * 16);
          acc = __builtin_amdgcn_mfma_f32_16x16x32_bf16(Cop[kb], hb, acc, 0, 0, 0);
        }
        const int row = base + sgn * tok;
        *reinterpret_cast<float4*>(YD + (size_t)row * 512 + g * 16 + 4 * (lane >> 4)) = float4{acc[0], acc[1], acc[2], acc[3]};
      }
    }
  }
  asm volatile("s_waitcnt vmcnt(0)" ::: "memory");
  __threadfence();
  __syncthreads();
  {
    const float* Y0 = reinterpret_cast<const float*>(p.ws + WS_YD);
    const float* Y1 = Y0 + (size_t)NTOK * 512;
    bf16_t* G = reinterpret_cast<bf16_t*>(p.ws + WS_G);
    const int ch = gq * 64 + (tid_ & 63);
    const float dsk = p.ssm_d[layer * 512 + ch];
    for (int i = tid_ >> 6; i < CTXL + SEQ; i += 8) {
      const int row = (i < CTXL) ? (NLAT + b * CTXL + i) : (b * SEQ + i - CTXL);
      const float y = Y0[(size_t)row * 512 + ch] + Y1[(size_t)row * 512 + ch] + dsk * bf2f(P[(size_t)row * INW + C_U + ch]);
      G[(size_t)row * 512 + ch] = f2bf(gelu_tanh(y));
    }
  }
}

template <int NBT, class KF>
__device__ __forceinline__ void attn_query(const bf16_t* qptr, const bf16_t* P, int kcol, int vcol, bool has_sink, float sink, bf16_t* optr, int lane, KF kf) {
  float q[64];
  {
    const uint4* qp = reinterpret_cast<const uint4*>(qptr);
#pragma unroll
    for (int i = 0; i < 8; ++i) {
      const uint4 w = qp[i];
      q[8 * i + 0] = __uint_as_float(w.x << 16); q[8 * i + 1] = __uint_as_float(w.x & 0xffff0000u);
      q[8 * i + 2] = __uint_as_float(w.y << 16); q[8 * i + 3] = __uint_as_float(w.y & 0xffff0000u);
      q[8 * i + 4] = __uint_as_float(w.z << 16); q[8 * i + 5] = __uint_as_float(w.z & 0xffff0000u);
      q[8 * i + 6] = __uint_as_float(w.w << 16); q[8 * i + 7] = __uint_as_float(w.w & 0xffff0000u);
    }
  }
  float s[NBT]; int kr[NBT];
  float mx = has_sink ? sink : -1e30f;
#pragma unroll
  for (int j = 0; j < NBT; ++j) {
    int krow; float bias;
    const bool valid = kf(j, lane, krow, bias);
    kr[j] = valid ? krow : -1;
    float dot = 0.f;
    if (valid) {
      const uint4* kp = reinterpret_cast<const uint4*>(P + (size_t)krow * INW + kcol);
#pragma unroll
      for (int i = 0; i < 8; ++i) {
        const uint4 w = kp[i];
        dot += q[8 * i + 0] * __uint_as_float(w.x << 16) + q[8 * i + 1] * __uint_as_float(w.x & 0xffff0000u)
             + q[8 * i + 2] * __uint_as_float(w.y << 16) + q[8 * i + 3] * __uint_as_float(w.y & 0xffff0000u)
             + q[8 * i + 4] * __uint_as_float(w.z << 16) + q[8 * i + 5] * __uint_as_float(w.z & 0xffff0000u)
             + q[8 * i + 6] * __uint_as_float(w.w << 16) + q[8 * i + 7] * __uint_as_float(w.w & 0xffff0000u);
      }
    }
    s[j] = valid ? (dot * 0.125f + bias) : -1e30f;
    mx = fmaxf(mx, s[j]);
  }
  mx = wave_max(mx, lane);
  float l = 0.f;
#pragma unroll
  for (int j = 0; j < NBT; ++j) { s[j] = (kr[j] >= 0) ? __expf(s[j] - mx) : 0.f; l += s[j]; }
  l = wave_sum(l, lane);
  if (has_sink) l += __expf(sink - mx);
  float o[64];
#pragma unroll
  for (int i = 0; i < 64; ++i) o[i] = 0.f;
#pragma unroll
  for (int j = 0; j < NBT; ++j) {
    if (kr[j] >= 0) {
      const uint4* vp = reinterpret_cast<const uint4*>(P + (size_t)kr[j] * INW + vcol);
      const float pj = s[j];
#pragma unroll
      for (int i = 0; i < 8; ++i) {
        const uint4 w = vp[i];
        o[8 * i + 0] += pj * __uint_as_float(w.x << 16); o[8 * i + 1] += pj * __uint_as_float(w.x & 0xffff0000u);
        o[8 * i + 2] += pj * __uint_as_float(w.y << 16); o[8 * i + 3] += pj * __uint_as_float(w.y & 0xffff0000u);
        o[8 * i + 4] += pj * __uint_as_float(w.z << 16); o[8 * i + 5] += pj * __uint_as_float(w.z & 0xffff0000u);
        o[8 * i + 6] += pj * __uint_as_float(w.w << 16); o[8 * i + 7] += pj * __uint_as_float(w.w & 0xffff0000u);
      }
    }
  }
#pragma unroll
  for (int i = 0; i < 32; ++i) { const bool up_ = (lane & 32) != 0; const float send = up_ ? o[i] : o[i + 32]; const float keep = up_ ? o[i + 32] : o[i]; o[i] = keep + shx(send, 32, lane); }
#pragma unroll
  for (int i = 0; i < 16; ++i) { const bool up_ = (lane & 16) != 0; const float send = up_ ? o[i] : o[i + 16]; const float keep = up_ ? o[i + 16] : o[i]; o[i] = keep + shx(send, 16, lane); }
#pragma unroll
  for (int i = 0; i < 8; ++i) { const bool up_ = (lane & 8) != 0; const float send = up_ ? o[i] : o[i + 8]; const float keep = up_ ? o[i + 8] : o[i]; o[i] = keep + shx(send, 8, lane); }
#pragma unroll
  for (int i = 0; i < 4; ++i) { const bool up_ = (lane & 4) != 0; const float send = up_ ? o[i] : o[i + 4]; const float keep = up_ ? o[i + 4] : o[i]; o[i] = keep + shx(send, 4, lane); }
#pragma unroll
  for (int i = 0; i < 2; ++i) { const bool up_ = (lane & 2) != 0; const float send = up_ ? o[i] : o[i + 2]; const float keep = up_ ? o[i + 2] : o[i]; o[i] = keep + shx(send, 2, lane); }
  { const bool up_ = (lane & 1) != 0; const float send = up_ ? o[0] : o[1]; const float keep = up_ ? o[1] : o[0]; o[0] = keep + shx(send, 1, lane); }
  optr[lane] = f2bf(o[0] / l);
}

__device__ __forceinline__ void mixer_item_naive(const Params& p, int layer, int item, bool need_ctx, unsigned char* lds_raw) {
  const int tid_ = opaque_tid();
  const bf16_t* P = reinterpret_cast<const bf16_t*>(p.ws + WS_P);
  bf16_t* Y = reinterpret_cast<bf16_t*>(p.ws + WS_Y);
  const int wv = tid_ >> 6;
  if (item < 64) { ssm_item(p, layer, item, lds_raw); return; }
  if (item < 320) {
    const int it = item - 64; const int b = it >> 5, blk = (it >> 1) & 15, hk = it & 1;
    const int hq = hk * 4 + (wv >> 1), half = wv & 1;
    const float sink = p.win_sink[layer * 8 + hq];
    for (int qi = 0; qi < 64; ++qi) {
      const int t = blk * 128 + half * 64 + qi;
      const int row = b * SEQ + t;
      attn_query<9>(P + (size_t)row * INW + C_WQ + hq * 64, P, C_WK + hk * 64, C_WV + hk * 64, true, sink, Y + (size_t)row * 1536 + 512 + hq * 64, tid_ & 63,
        [&](int j, int lane, int& krow, float& bias) -> bool {
          bias = 0.f;
          if (j < 5) { const int kp = t - 128 + j * 64 + lane; krow = b * SEQ + kp; return kp >= 0 && kp < SEQ && kp <= t + 128; }
          krow = NLAT + b * CTXL + (j - 5) * 64 + lane; return true;
        });
    }
    return;
  }
  if (item < 576) {
    const int it = item - 320; const int b = it >> 5, h = (it >> 2) & 7, rg = it & 3;
    const int r = rg * 8 + wv;
    int rs = r - 4; rs = rs < 0 ? 0 : (rs > 24 ? 24 : rs);
    const float* rpb = p.na_rpb + ((size_t)layer * 8 + h) * 15 * 31;
    for (int c = 0; c < 64; ++c) {
      const int row = b * SEQ + r * 64 + c;
      int cs = c - 8; cs = cs < 0 ? 0 : (cs > 48 ? 48 : cs);
      attn_query<6>(P + (size_t)row * INW + C_NQ + h * 64, P, C_NK + h * 64, C_NV + h * 64, false, 0.f, Y + (size_t)row * 1536 + 1024 + h * 64, tid_ & 63,
        [&](int j, int lane, int& krow, float& bias) -> bool {
          if (j < 2) {
            const int i = j * 64 + lane; const int kr_ = rs + (i >> 4), kc = cs + (i & 15);
            krow = b * SEQ + kr_ * 64 + kc;
            int dc = kc - c; dc = dc < -15 ? -15 : (dc > 15 ? 15 : dc);
            bias = rpb[(kr_ - r + 7) * 31 + dc + 15];
            return true;
          }
          bias = 0.f; krow = NLAT + b * CTXL + (j - 2) * 64 + lane; return true;
        });
    }
    return;
  }
  if (!need_ctx) return;
  if (item < 608) {
    const int it = item - 576; const int b = it >> 2, qb = it & 3;
    const int hq = wv, hk = hq >> 2;
    const float sink = p.win_sink[layer * 8 + hq];
    for (int qi = 0; qi < 64; ++qi) {
      const int row = NLAT + b * CTXL + qb * 64 + qi;
      attn_query<4>(P + (size_t)row * INW + C_WQ + hq * 64, P, C_WK + hk * 64, C_WV + hk * 64, true, sink, Y + (size_t)row * 1536 + 512 + hq * 64, tid_ & 63,
        [&](int j, int lane, int& krow, float& bias) -> bool { bias = 0.f; krow = NLAT + b * CTXL + j * 64 + lane; return true; });
    }
    return;
  }
  {
    const int it = item - 608; const int b = it >> 2, qb = it & 3;
    const int h = wv;
    for (int qi = 0; qi < 64; ++qi) {
      const int row = NLAT + b * CTXL + qb * 64 + qi;
      attn_query<4>(P + (size_t)row * INW + C_NQ + h * 64, P, C_NK + h * 64, C_NV + h * 64, false, 0.f, Y + (size_t)row * 1536 + 1024 + h * 64, tid_ & 63,
        [&](int j, int lane, int& krow, float& bias) -> bool { bias = 0.f; krow = NLAT + b * CTXL + j * 64 + lane; return true; });
    }
  }
}


constexpr int VT_TOK = CTXL + SEQ;
template <class TileFn, class ScoreFn>
__device__ __forceinline__ void attn_wave(const bf16_t* qrow0, int ntiles, TileFn tilefn, ScoreFn scorefn, float m_init, float l_init, bf16_t* orow0, int lane) {
  const int l31 = lane & 31, hh = lane >> 5;
  bf16x8 Qop[2][4];
#pragma unroll
  for (int qb = 0; qb < 2; ++qb)
#pragma unroll
    for (int s = 0; s < 4; ++s) Qop[qb][s] = *reinterpret_cast<const bf16x8*>(qrow0 + (size_t)(32 * qb + l31) * INW + 32 * hh + 8 * s);
  f32x16 O[2][2];
#pragma unroll
  for (int a = 0; a < 2; ++a)
#pragma unroll
    for (int b2 = 0; b2 < 2; ++b2)
#pragma unroll
      for (int r = 0; r < 16; ++r) O[a][b2][r] = 0.f;
  float m[2] = {m_init, m_init};
  float l[2]; l[0] = hh ? 0.f : l_init; l[1] = l[0];
  const unsigned kvo = (unsigned)(l31 * INW + 32 * hh) * 2u;
  const unsigned vvo = (unsigned)(l31 * VT_TOK + 4 * hh) * 2u;
  const bf16_t* kp; const bf16_t* vp; int info;
  tilefn(0, kp, vp, info);
  bf16x8 Kc[4]; uint2 Vc[2][2][2];
#pragma unroll
  for (int s = 0; s < 4; ++s) Kc[s] = *reinterpret_cast<const bf16x8*>(reinterpret_cast<const char*>(kp) + kvo + 16 * s);
#pragma unroll
  for (int db = 0; db < 2; ++db)
#pragma unroll
    for (int s = 0; s < 2; ++s)
#pragma unroll
      for (int pc = 0; pc < 2; ++pc) Vc[db][s][pc] = *reinterpret_cast<const uint2*>(reinterpret_cast<const char*>(vp) + vvo + (size_t)db * 32 * VT_TOK * 2 + (16 * s + 8 * pc) * 2);
  for (int t = 0; t < ntiles; ++t) {
    const int info_c = info;
    const int tn = (t + 1 < ntiles) ? (t + 1) : t;
    tilefn(tn, kp, vp, info);
    f32x16 S[2];
#pragma unroll
    for (int qb = 0; qb < 2; ++qb) {
#pragma unroll
      for (int r = 0; r < 16; ++r) S[qb][r] = 0.f;
#pragma unroll
      for (int s = 0; s < 4; ++s) S[qb] = __builtin_amdgcn_mfma_f32_32x32x16_bf16(Kc[s], Qop[qb][s], S[qb], 0, 0, 0);
    }
#pragma unroll
    for (int s = 0; s < 4; ++s) Kc[s] = *reinterpret_cast<const bf16x8*>(reinterpret_cast<const char*>(kp) + kvo + 16 * s);
    bf16x8 Pop[2][2];
#pragma unroll
    for (int qb = 0; qb < 2; ++qb) {
      scorefn(info_c, qb, S[qb]);
      float mt = S[qb][0];
#pragma unroll
      for (int r = 1; r < 16; ++r) mt = fmaxf(mt, S[qb][r]);
      mt = fmaxf(mt, shx(mt, 32, lane));
      const float mnew = fmaxf(m[qb], mt);
      const float alpha = __expf(m[qb] - mnew);
      m[qb] = mnew;
      float ls = 0.f;
#pragma unroll
      for (int r = 0; r < 16; ++r) { const float pv = __expf(S[qb][r] - mnew); S[qb][r] = pv; ls += pv; }
      l[qb] = l[qb] * alpha + ls;
#pragma unroll
      for (int db = 0; db < 2; ++db)
#pragma unroll
        for (int r = 0; r < 16; ++r) O[db][qb][r] *= alpha;
#pragma unroll
      for (int s = 0; s < 2; ++s) {
        union { unsigned u[4]; bf16x8 b; } pk;
#pragma unroll
        for (int j = 0; j < 4; ++j) pk.u[j] = pack2(S[qb][8 * s + 2 * j], S[qb][8 * s + 2 * j + 1]);
        Pop[qb][s] = pk.b;
      }
    }
#pragma unroll
    for (int db = 0; db < 2; ++db)
#pragma unroll
      for (int s = 0; s < 2; ++s) {
        union { uint2 u[2]; bf16x8 b; } va; va.u[0] = Vc[db][s][0]; va.u[1] = Vc[db][s][1];
#pragma unroll
        for (int qb = 0; qb < 2; ++qb) O[db][qb] = __builtin_amdgcn_mfma_f32_32x32x16_bf16(va.b, Pop[qb][s], O[db][qb], 0, 0, 0);
      }
#pragma unroll
    for (int db = 0; db < 2; ++db)
#pragma unroll
      for (int s = 0; s < 2; ++s)
#pragma unroll
        for (int pc = 0; pc < 2; ++pc) Vc[db][s][pc] = *reinterpret_cast<const uint2*>(reinterpret_cast<const char*>(vp) + vvo + (size_t)db * 32 * VT_TOK * 2 + (16 * s + 8 * pc) * 2);
  }
#pragma unroll
  for (int qb = 0; qb < 2; ++qb) {
    const float lt = l[qb] + shx(l[qb], 32, lane);
    const float inv = 1.0f / lt;
    bf16_t* orow = orow0 + (size_t)(32 * qb + l31) * 1536;
#pragma unroll
    for (int db = 0; db < 2; ++db)
#pragma unroll
      for (int gq = 0; gq < 4; ++gq)
        st_bf4(orow + 32 * db + 8 * gq + 4 * hh, O[db][qb][4 * gq] * inv, O[db][qb][4 * gq + 1] * inv, O[db][qb][4 * gq + 2] * inv, O[db][qb][4 * gq + 3] * inv);
  }
}

__device__ __forceinline__ void mixer_item(const Params& p, int layer, int item, bool need_ctx, unsigned char* lds_raw) {
  const int tid_ = opaque_tid();
  const bf16_t* P = reinterpret_cast<const bf16_t*>(p.ws + WS_P);
  const bf16_t* VT = reinterpret_cast<const bf16_t*>(p.ws + WS_VT);
  bf16_t* Y = reinterpret_cast<bf16_t*>(p.ws + WS_Y);
  const int wv = tid_ >> 6, lane = tid_ & 63;
  if (item < 64) { ssm_item(p, layer, item, lds_raw); return; }
  if (item < 320) {
    const int it = item - 64; const int b = it >> 5, blk = (it >> 1) & 15, hk = it & 1;
    const int hq = hk * 4 + (wv >> 1), half = wv & 1;
    const float sink = p.win_sink[layer * 8 + hq];
    const int t0 = blk * 128 + half * 64;
    int ilo = 0, ihi = 10;
    if (t0 - 128 < 0) ilo = (128 - t0) >> 5;
    if (t0 + 192 > SEQ) ihi = 10 - ((t0 + 192 - SEQ) >> 5);
    const bf16_t* kctx = P + (size_t)(NLAT + b * CTXL) * INW + C_WK + hk * 64;
    const bf16_t* klat = P + (size_t)(b * SEQ) * INW + C_WK + hk * 64;
    const bf16_t* vth = VT + (size_t)(b * 10 + hk) * 64 * VT_TOK;
    const int qrow0 = b * SEQ + t0;
    attn_wave(P + (size_t)qrow0 * INW + C_WQ + hq * 64, 8 + (ihi - ilo),
      [&](int i, const bf16_t*& kp, const bf16_t*& vp, int& info) {
        if (i < 8) { kp = kctx + (size_t)(32 * i) * INW; vp = vth + 32 * i; info = -100000; }
        else { const int key0 = t0 - 128 + 32 * (i - 8 + ilo); kp = klat + (size_t)key0 * INW; vp = vth + CTXL + key0; info = key0; }
      },
      [&](int info, int qb, f32x16& S) {
        if (info == -100000) {
#pragma unroll
          for (int r = 0; r < 16; ++r) S[r] *= 0.125f;
        } else {
          const int d0 = info + 4 * (lane >> 5) - (t0 + 32 * qb + (lane & 31));
#pragma unroll
          for (int r = 0; r < 16; ++r) { const int d = d0 + (r & 3) + 8 * (r >> 2); S[r] = (d >= -128 && d <= 128) ? S[r] * 0.125f : -1e30f; }
        }
      }, sink, 1.0f, Y + (size_t)qrow0 * 1536 + 512 + hq * 64, lane);
    return;
  }
  if (item < 576) {
    const int it = item - 320; const int b = it >> 5, h = (it >> 2) & 7, rg = it & 3;
    const int r = rg * 8 + wv;
    int rs = r - 4; rs = rs < 0 ? 0 : (rs > 24 ? 24 : rs);
    float* tbl = reinterpret_cast<float*>(lds_raw);
    __syncthreads();
    { const float* rpb = p.na_rpb + ((size_t)layer * 8 + h) * 15 * 31; for (int i = tid_; i < 15 * 31 + 128; i += NTHR) { const int j = i - 64; tbl[i] = (j >= 0 && j < 15 * 31) ? rpb[j] : 0.f; } }
    __syncthreads();
    const bf16_t* kctx = P + (size_t)(NLAT + b * CTXL) * INW + C_NK + h * 64;
    const bf16_t* klat = P + (size_t)(b * SEQ) * INW + C_NK + h * 64;
    const bf16_t* vth = VT + (size_t)(b * 10 + 2 + h) * 64 * VT_TOK;
    const int qrow0 = b * SEQ + r * 64;
    attn_wave(P + (size_t)qrow0 * INW + C_NQ + h * 64, 8 + 16,
      [&](int i, const bf16_t*& kp, const bf16_t*& vp, int& info) {
        if (i < 8) { kp = kctx + (size_t)(32 * i) * INW; vp = vth + 32 * i; info = -1; }
        else { const int j = i - 8; const int key0 = rs * 64 + 32 * j; kp = klat + (size_t)key0 * INW; vp = vth + CTXL + key0; info = j; }
      },
      [&](int info, int qb, f32x16& S) {
        if (info < 0) {
#pragma unroll
          for (int r2 = 0; r2 < 16; ++r2) S[r2] *= 0.125f;
        } else {
          const int kr = rs + (info >> 1), jh = info & 1;
          const int qc = 32 * qb + (lane & 31);
          int cs = qc - 8; cs = cs < 0 ? 0 : (cs > 48 ? 48 : cs);
          const int kc0 = jh * 32 + 4 * (lane >> 5);
          const float* tb = tbl + 64 + (kr - r + 7) * 31 + kc0 - qc + 15;
#pragma unroll
          for (int r2 = 0; r2 < 16; ++r2) {
            const int ko = (r2 & 3) + 8 * (r2 >> 2);
            const int kc = kc0 + ko;
            S[r2] = (kc >= cs && kc < cs + 16) ? (S[r2] * 0.125f + tb[ko]) : -1e30f;
          }
        }
      }, -1e30f, 0.0f, Y + (size_t)qrow0 * 1536 + 1024 + h * 64, lane);
    return;
  }
  if (!need_ctx) return;
  if (item < 608) {
    const int it = item - 576; const int b = it >> 2, qb4 = it & 3;
    const int hq = wv, hk = hq >> 2;
    const float sink = p.win_sink[layer * 8 + hq];
    const bf16_t* kctx = P + (size_t)(NLAT + b * CTXL) * INW + C_WK + hk * 64;
    const bf16_t* vth = VT + (size_t)(b * 10 + hk) * 64 * VT_TOK;
    const int qrow0 = NLAT + b * CTXL + qb4 * 64;
    attn_wave(P + (size_t)qrow0 * INW + C_WQ + hq * 64, 8,
      [&](int i, const bf16_t*& kp, const bf16_t*& vp, int& info) { kp = kctx + (size_t)(32 * i) * INW; vp = vth + 32 * i; info = 0; },
      [&](int info, int qb, f32x16& S) {
#pragma unroll
        for (int r2 = 0; r2 < 16; ++r2) S[r2] *= 0.125f;
      }, sink, 1.0f, Y + (size_t)qrow0 * 1536 + 512 + hq * 64, lane);
    return;
  }
  {
    const int it = item - 608; const int b = it >> 2, qb4 = it & 3;
    const int h = wv;
    const bf16_t* kctx = P + (size_t)(NLAT + b * CTXL) * INW + C_NK + h * 64;
    const bf16_t* vth = VT + (size_t)(b * 10 + 2 + h) * 64 * VT_TOK;
    const int qrow0 = NLAT + b * CTXL + qb4 * 64;
    attn_wave(P + (size_t)qrow0 * INW + C_NQ + h * 64, 8,
      [&](int i, const bf16_t*& kp, const bf16_t*& vp, int& info) { kp = kctx + (size_t)(32 * i) * INW; vp = vth + 32 * i; info = 0; },
      [&](int info, int qb, f32x16& S) {
#pragma unroll
        for (int r2 = 0; r2 < 16; ++r2) S[r2] *= 0.125f;
      }, -1e30f, 0.0f, Y + (size_t)qrow0 * 1536 + 1024 + h * 64, lane);
  }
}

__device__ __forceinline__ void route_phase(const Params& p, int layer, int ntok, float* lds_f) {
  const int tid_ = opaque_tid();
  const float* mod = reinterpret_cast<const float*>(p.ws + WS_MOD);
  bf16_t* F = reinterpret_cast<bf16_t*>(p.ws + WS_H);
  int* tke = reinterpret_cast<int*>(p.ws + WS_TKE);
  int* tkp = reinterpret_cast<int*>(p.ws + WS_TKP);
  float* tkg = reinterpret_cast<float*>(p.ws + WS_TKG);
  int* tlist = reinterpret_cast<int*>(p.ws + WS_TLIST);
  unsigned* cnt = reinterpret_cast<unsigned*>(p.ws + WS_CTL) + CW_CNT + layer * 32;
  const int lane = tid_ & 63, wv = tid_ >> 6;
  float* fr = lds_f + wv * 1024;
  const float* gw = p.norm_ffn + layer * D;
  const float* rw = p.router_w + (size_t)layer * D * NEXP;
  const float rb = p.router_b[layer * NEXP + (lane & 31)];
  for (int row = blockIdx.x * 8 + wv; row < ntok; row += gridDim.x * 8) {
    const float* xr = stream_row(p, row);
    const int mi = row_modidx(row);
    float v[16];
#pragma unroll
    for (int i = 0; i < 4; ++i) { const float4 q = *reinterpret_cast<const float4*>(xr + i * 256 + lane * 4); v[4 * i] = q.x; v[4 * i + 1] = q.y; v[4 * i + 2] = q.z; v[4 * i + 3] = q.w; }
    float ss = 0.f;
#pragma unroll
    for (int i = 0; i < 16; ++i) ss += v[i] * v[i];
    ss = wave_sum(ss, lane);
    const float rinv = rsqrtf(ss * (1.0f / D) + 1e-6f);
    const float* msh = mod + ((size_t)layer * 9 + mi) * 6144 + 3 * 1024;
#pragma unroll
    for (int i = 0; i < 4; ++i) {
      const int c = i * 256 + lane * 4;
      const float4 g = *reinterpret_cast<const float4*>(gw + c);
      const float4 sh = *reinterpret_cast<const float4*>(msh + c);
      const float4 sc = *reinterpret_cast<const float4*>(msh + 1024 + c);
      const float f0 = v[4 * i] * rinv * g.x * (1.f + sc.x) + sh.x, f1 = v[4 * i + 1] * rinv * g.y * (1.f + sc.y) + sh.y;
      const float f2 = v[4 * i + 2] * rinv * g.z * (1.f + sc.z) + sh.z, f3 = v[4 * i + 3] * rinv * g.w * (1.f + sc.w) + sh.w;
      st_bf4(F + (size_t)row * D + c, f0, f1, f2, f3);
      *reinterpret_cast<float4*>(fr + c) = float4{f0, f1, f2, f3};
    }
    const int e = lane & 31, hf = lane >> 5;
    float acc = 0.f;
    const float* rwp = rw + (size_t)(hf * 512) * NEXP + e;
    const float* fp = fr + hf * 512;
#pragma unroll 8
    for (int k = 0; k < 512; ++k) acc += fp[k] * rwp[(size_t)k * NEXP];
    acc += shx(acc, 32, lane);
    float logit = acc + rb;
    int sel_e[4]; float sel_v[4];
    float cur = logit;
#pragma unroll
    for (int k = 0; k < 4; ++k) {
      float bv = cur; int bi = e;
#pragma unroll
      for (int o = 16; o >= 1; o >>= 1) {
        const float ov = shx(bv, o, lane); const int oi = shx(bi, o, lane);
        if (ov > bv || (ov == bv && oi < bi)) { bv = ov; bi = oi; }
      }
      sel_e[k] = bi; sel_v[k] = bv;
      if (e == bi) cur = -3.0e38f;
    }
    const float m0 = sel_v[0];
    const float e0 = 1.f, e1 = __expf(sel_v[1] - m0), e2 = __expf(sel_v[2] - m0), e3 = __expf(sel_v[3] - m0);
    const float inv = 1.f / (e0 + e1 + e2 + e3);
    if (lane < 4) {
      const int ee = (lane == 0) ? sel_e[0] : (lane == 1) ? sel_e[1] : (lane == 2) ? sel_e[2] : sel_e[3];
      const float gg = ((lane == 0) ? e0 : (lane == 1) ? e1 : (lane == 2) ? e2 : e3) * inv;
      const unsigned pos = __hip_atomic_fetch_add(&cnt[ee], 1u, __ATOMIC_RELAXED, __HIP_MEMORY_SCOPE_AGENT);
      tke[row * 4 + lane] = ee; tkp[row * 4 + lane] = (int)pos; tkg[row * 4 + lane] = gg;
      tlist[(size_t)ee * NTOK + pos] = row;
    }
  }
}

__device__ __forceinline__ void phase_inproj(const Params& p, int layer, LAS unsigned char* lds) {
  const int G = gridDim.x, bid = blockIdx.x;
  const bf16_t* A = reinterpret_cast<const bf16_t*>(p.ws + WS_H);
  const bf16_t* Bt = reinterpret_cast<const bf16_t*>(p.ws + WS_WIN) + (size_t)layer * INW * 1024;
  bf16_t* P = reinterpret_cast<bf16_t*>(p.ws + WS_P);
  for (int i = 0;; ++i) {
    int pm, pn; if (!unit_next(i * G + bid, NTOK / 256, INW / 256, pm, pn)) break;
    const int ar0 = pm * 256, br0 = pn * 256; const int tz = opaque_tid();
    gemm_tile(lds, (const char*)(A + (size_t)ar0 * 1024), (const char*)(A + (size_t)(ar0 + 128) * 1024), stage_voff(tz, 0, 1024), stage_voff(tz, 1, 1024), stage_voff(tz, 0, 1024), stage_voff(tz, 1, 1024),
              (const char*)(Bt + (size_t)br0 * 1024), (const char*)(Bt + (size_t)(br0 + 128) * 1024), stage_voff(tz, 0, 1024), stage_voff(tz, 1, 1024), 16, tz,
      [&](int r, int c, f32x4 v0, f32x4 v1) {
        bf16_t* o = P + (size_t)(ar0 + r) * INW + br0 + c;
        if (br0 >= C_GATE) { st_bf4(o, sigmoidf(v0[0]), sigmoidf(v0[1]), sigmoidf(v0[2]), sigmoidf(v0[3])); st_bf4(o + 128, sigmoidf(v1[0]), sigmoidf(v1[1]), sigmoidf(v1[2]), sigmoidf(v1[3])); }
        else { st_bf4(o, v0[0], v0[1], v0[2], v0[3]); st_bf4(o + 128, v1[0], v1[1], v1[2], v1[3]); }
      });
  }
}

__device__ __forceinline__ void phase_mixers(const Params& p, int layer, bool need_ctx, int* misc_i, unsigned char* lds_raw, int rep) {
  unsigned* head = reinterpret_cast<unsigned*>(p.ws + WS_CTL) + CW_WQ + layer * 64 + rep * 16;
  for (;;) {
    __syncthreads();
    if (threadIdx.x == 0) misc_i[40] = (int)__hip_atomic_fetch_add(head, 1u, __ATOMIC_RELAXED, __HIP_MEMORY_SCOPE_AGENT);
    __syncthreads();
    const int item = misc_i[40];
    if (item >= 640) break;
    mixer_item(p, layer, item, need_ctx, lds_raw);
  }
}

__device__ __forceinline__ void phase_glu(const Params& p, int layer, int mrows, LAS unsigned char* lds) {
  const int G = gridDim.x, bid = blockIdx.x;
  const bf16_t* A = reinterpret_cast<const bf16_t*>(p.ws + WS_G);
  const bf16_t* Bt = reinterpret_cast<const bf16_t*>(p.ws + WS_WGLU) + (size_t)layer * 512 * 512;
  bf16_t* Y = reinterpret_cast<bf16_t*>(p.ws + WS_Y);
  for (int i = 0;; ++i) {
    int pm, pn; if (!unit_next(i * G + bid, mrows / 256, 2, pm, pn)) break;
    const int ar0 = pm * 256, br0 = pn * 256; const int tz = opaque_tid();
    gemm_tile(lds, (const char*)(A + (size_t)ar0 * 512), (const char*)(A + (size_t)(ar0 + 128) * 512), stage_voff(tz, 0, 512), stage_voff(tz, 1, 512), stage_voff(tz, 0, 512), stage_voff(tz, 1, 512),
              (const char*)(Bt + (size_t)br0 * 512), (const char*)(Bt + (size_t)(br0 + 128) * 512), stage_voff(tz, 0, 512), stage_voff(tz, 1, 512), 8, tz,
      [&](int r, int c, f32x4 v0, f32x4 v1) {
        const bf16_t* gi = A + (size_t)(ar0 + r) * 512 + br0 + c;
        bf16_t* o = Y + (size_t)(ar0 + r) * 1536 + br0 + c;
        float g0, g1, g2, g3;
        ld_bf4(gi, g0, g1, g2, g3); st_bf4(o, g0 * sigmoidf(v0[0]), g1 * sigmoidf(v0[1]), g2 * sigmoidf(v0[2]), g3 * sigmoidf(v0[3]));
        ld_bf4(gi + 128, g0, g1, g2, g3); st_bf4(o + 128, g0 * sigmoidf(v1[0]), g1 * sigmoidf(v1[1]), g2 * sigmoidf(v1[2]), g3 * sigmoidf(v1[3]));
      });
  }
}

__device__ __forceinline__ void phase_merge1(const Params& p, int layer, int mrows, LAS unsigned char* lds) {
  const int G = gridDim.x, bid = blockIdx.x;
  const bf16_t* Yb = reinterpret_cast<const bf16_t*>(p.ws + WS_Y);
  const bf16_t* P = reinterpret_cast<const bf16_t*>(p.ws + WS_P);
  float* S = reinterpret_cast<float*>(p.ws + WS_S);
  bf16_t* SB = reinterpret_cast<bf16_t*>(p.ws + WS_SB);
  for (int i = 0;; ++i) {
    int pm, pn; if (!unit_next(i * G + bid, mrows / 256, 4, pm, pn)) break;
    const int ar0 = pm * 256, br0 = pn * 256; const int tz = opaque_tid();
    for (int br = 0; br < 3; ++br) {
      const bf16_t* A = Yb + br * 512;
      const bf16_t* Bt = reinterpret_cast<const bf16_t*>(p.ws + WS_WBR) + (size_t)(layer * 3 + br) * 1024 * 512;
      gemm_tile(lds, (const char*)(A + (size_t)ar0 * 1536), (const char*)(A + (size_t)(ar0 + 128) * 1536), stage_voff(tz, 0, 1536), stage_voff(tz, 1, 1536), stage_voff(tz, 0, 1536), stage_voff(tz, 1, 1536),
                (const char*)(Bt + (size_t)br0 * 512), (const char*)(Bt + (size_t)(br0 + 128) * 512), stage_voff(tz, 0, 512), stage_voff(tz, 1, 512), 8, tz,
        [&](int r, int c, f32x4 v0, f32x4 v1) {
          const size_t ro = (size_t)(ar0 + r);
          const bf16_t* gp = P + ro * INW + C_GATE + br * 1024 + br0 + c;
          float* sp = S + ro * D + br0 + c;
          float g0, g1, g2, g3;
          ld_bf4(gp, g0, g1, g2, g3);
          float4 a = float4{g0 * v0[0], g1 * v0[1], g2 * v0[2], g3 * v0[3]};
          ld_bf4(gp + 128, g0, g1, g2, g3);
          float4 b = float4{g0 * v1[0], g1 * v1[1], g2 * v1[2], g3 * v1[3]};
          if (br > 0) { const float4 pa = *reinterpret_cast<const float4*>(sp); const float4 pb2 = *reinterpret_cast<const float4*>(sp + 128);
                        a.x += pa.x; a.y += pa.y; a.z += pa.z; a.w += pa.w; b.x += pb2.x; b.y += pb2.y; b.z += pb2.z; b.w += pb2.w; }
          if (br < 2) { *reinterpret_cast<float4*>(sp) = a; *reinterpret_cast<float4*>(sp + 128) = b; }
          else { bf16_t* o = SB + ro * D + br0 + c; st_bf4(o, a.x, a.y, a.z, a.w); st_bf4(o + 128, b.x, b.y, b.z, b.w); }
        });
    }
  }
}

__device__ __forceinline__ void phase_merge2(const Params& p, int layer, int mrows, LAS unsigned char* lds) {
  const int G = gridDim.x, bid = blockIdx.x;
  const bf16_t* A = reinterpret_cast<const bf16_t*>(p.ws + WS_SB);
  const bf16_t* Bt = reinterpret_cast<const bf16_t*>(p.ws + WS_WOUT) + (size_t)layer * 1024 * 1024;
  const float* mod = reinterpret_cast<const float*>(p.ws + WS_MOD);
  for (int i = 0;; ++i) {
    int pm, pn; if (!unit_next(i * G + bid, mrows / 256, 4, pm, pn)) break;
    const int ar0 = pm * 256, br0 = pn * 256; const int tz = opaque_tid();
    gemm_tile(lds, (const char*)(A + (size_t)ar0 * 1024), (const char*)(A + (size_t)(ar0 + 128) * 1024), stage_voff(tz, 0, 1024), stage_voff(tz, 1, 1024), stage_voff(tz, 0, 1024), stage_voff(tz, 1, 1024),
              (const char*)(Bt + (size_t)br0 * 1024), (const char*)(Bt + (size_t)(br0 + 128) * 1024), stage_voff(tz, 0, 1024), stage_voff(tz, 1, 1024), 16, tz,
      [&](int r, int c, f32x4 v0, f32x4 v1) {
        const int row = ar0 + r;
        float* xr = stream_row(p, row) + br0 + c;
        const float* m2 = mod + ((size_t)layer * 9 + row_modidx(row)) * 6144 + 2 * 1024 + br0 + c;
        float4 a = *reinterpret_cast<const float4*>(xr); const float4 ma = *reinterpret_cast<const float4*>(m2);
        a.x += ma.x * v0[0]; a.y += ma.y * v0[1]; a.z += ma.z * v0[2]; a.w += ma.w * v0[3];
        *reinterpret_cast<float4*>(xr) = a;
        float4 b = *reinterpret_cast<const float4*>(xr + 128); const float4 mb = *reinterpret_cast<const float4*>(m2 + 128);
        b.x += mb.x * v1[0]; b.y += mb.y * v1[1]; b.z += mb.z * v1[2]; b.w += mb.w * v1[3];
        *reinterpret_cast<float4*>(xr + 128) = b;
      });
  }
}

__device__ __forceinline__ int moe_tables(const unsigned* cnt, int* est, int ntn) {
  __syncthreads();
  if (threadIdx.x == 0) { int s = 0, u = 0; for (int e = 0; e < NEXP; ++e) { est[e] = s; est[64 + e] = u; const int c = (int)cnt[e]; s += c; u += ((c + 255) >> 8) * ntn; } est[NEXP] = s; est[64 + NEXP] = u; }
  __syncthreads();
  return est[64 + NEXP];
}
__device__ __forceinline__ void moe_unit(const int* est, int total, int L, int& e, int& cnte, int& pmt, int& pnt) {
  int wgid = L; { const int q = total / 8, r = total % 8, xcd = wgid % 8, off = wgid / 8; wgid = (xcd < r ? xcd * (q + 1) : r * (q + 1) + (xcd - r) * q) + off; }
  e = 0; while (est[64 + e + 1] <= wgid) ++e;
  const int idx = wgid - est[64 + e]; cnte = est[e + 1] - est[e]; const int tm = (cnte + 255) >> 8;
  pmt = idx % tm; pnt = idx / tm;
}

__device__ __forceinline__ void phase_moe1(const Params& p, int layer, LAS unsigned char* lds, int* est) {
  const int G = gridDim.x, bid = blockIdx.x;
  const unsigned* cnt = reinterpret_cast<const unsigned*>(p.ws + WS_CTL) + CW_CNT + layer * 32;
  const int total = moe_tables(cnt, est, 8);
  const bf16_t* F = reinterpret_cast<const bf16_t*>(p.ws + WS_H);
  const int* tlist = reinterpret_cast<const int*>(p.ws + WS_TLIST);
  bf16_t* ACT = reinterpret_cast<bf16_t*>(p.ws + WS_ACT);
  for (int L = bid; L < total; L += G) {
    int e, cnte, pmt, pnt; moe_unit(est, total, L, e, cnte, pmt, pnt);
    const int m0 = pmt * 256, br0 = pnt * 256; const int tz = opaque_tid();
    const int* tl = tlist + (size_t)e * NTOK;
    int R0, C0, R1, C1; stage_rc(tz * 16, R0, C0); stage_rc(tz * 16 + 8192, R1, C1);
    const int r00 = m0 + R0, r01 = m0 + R1, r10 = m0 + 128 + R0, r11 = m0 + 128 + R1;
    const int t00 = ((r00 < cnte) ? tl[r00] : 0) * 1024, t01 = ((r01 < cnte) ? tl[r01] : 0) * 1024, t10 = ((r10 < cnte) ? tl[r10] : 0) * 1024, t11 = ((r11 < cnte) ? tl[r11] : 0) * 1024;
    const bf16_t* Bt = reinterpret_cast<const bf16_t*>(p.ws + WS_WGU) + (size_t)(layer * NEXP + e) * 2048 * 1024;
    const float* bg = p.b_gu + (size_t)(layer * NEXP + e) * 2048 + pnt * 128;
    const int arow0 = est[e] + m0;
    gemm_tile(lds, (const char*)F, (const char*)F, (unsigned)(t00 + C0) * 2u, (unsigned)(t01 + C1) * 2u, (unsigned)(t10 + C0) * 2u, (unsigned)(t11 + C1) * 2u,
              (const char*)(Bt + (size_t)br0 * 1024), (const char*)(Bt + (size_t)(br0 + 128) * 1024), stage_voff(tz, 0, 1024), stage_voff(tz, 1, 1024), 16, tz,
      [&](int r, int c, f32x4 v0, f32x4 v1) {
        if (m0 + r < cnte) {
          const float4 b0 = *reinterpret_cast<const float4*>(bg + c); const float4 b1 = *reinterpret_cast<const float4*>(bg + 1024 + c);
          float o[4];
          const float gg[4] = {v0[0] + b0.x, v0[1] + b0.y, v0[2] + b0.z, v0[3] + b0.w};
          const float uu[4] = {v1[0] + b1.x, v1[1] + b1.y, v1[2] + b1.z, v1[3] + b1.w};
#pragma unroll
          for (int j = 0; j < 4; ++j) { const float g = fminf(gg[j], 7.0f); const float u = fminf(fmaxf(uu[j], -7.0f), 7.0f); o[j] = (u + 1.0f) * (g * sigmoidf(1.702f * g)); }
          st_bf4(ACT + (size_t)(arow0 + r) * 1024 + pnt * 128 + c, o[0], o[1], o[2], o[3]);
        }
      });
  }
}

__device__ __forceinline__ void phase_moe2(const Params& p, int layer, LAS unsigned char* lds, int* est) {
  const int G = gridDim.x, bid = blockIdx.x;
  const unsigned* cnt = reinterpret_cast<const unsigned*>(p.ws + WS_CTL) + CW_CNT + layer * 32;
  const int total = moe_tables(cnt, est, 4);
  const bf16_t* ACT = reinterpret_cast<const bf16_t*>(p.ws + WS_ACT);
  bf16_t* YB = reinterpret_cast<bf16_t*>(p.ws + WS_YB);
  for (int L = bid; L < total; L += G) {
    int e, cnte, pmt, pnt; moe_unit(est, total, L, e, cnte, pmt, pnt);
    const int m0 = pmt * 256, br0 = pnt * 256; const int tz = opaque_tid();
    const int arow0 = est[e] + m0;
    const bf16_t* Bt = reinterpret_cast<const bf16_t*>(p.ws + WS_WDN) + (size_t)(layer * NEXP + e) * 1024 * 1024;
    const float* bd = p.b_dn + (size_t)(layer * NEXP + e) * 1024 + br0;
    gemm_tile(lds, (const char*)(ACT + (size_t)arow0 * 1024), (const char*)(ACT + (size_t)(arow0 + 128) * 1024), stage_voff(tz, 0, 1024), stage_voff(tz, 1, 1024), stage_voff(tz, 0, 1024), stage_voff(tz, 1, 1024),
              (const char*)(Bt + (size_t)br0 * 1024), (const char*)(Bt + (size_t)(br0 + 128) * 1024), stage_voff(tz, 0, 1024), stage_voff(tz, 1, 1024), 16, tz,
      [&](int r, int c, f32x4 v0, f32x4 v1) {
        if (m0 + r < cnte) {
          const float4 b0 = *reinterpret_cast<const float4*>(bd + c); const float4 b1 = *reinterpret_cast<const float4*>(bd + 128 + c);
          bf16_t* o = YB + (size_t)(arow0 + r) * 1024 + br0 + c;
          st_bf4(o, v0[0] + b0.x, v0[1] + b0.y, v0[2] + b0.z, v0[3] + b0.w);
          st_bf4(o + 128, v1[0] + b1.x, v1[1] + b1.y, v1[2] + b1.z, v1[3] + b1.w);
        }
      });
  }
}

__device__ __forceinline__ void phase_prologue(const Params& p, float* ldsf) {
  const int tid_ = opaque_tid();
  const int G = gridDim.x, bid = blockIdx.x;
  conv_mats<0>(p.w_in, reinterpret_cast<bf16_t*>(p.ws + WS_WIN), DEPTH, 1024, INW, ldsf, tid_);
  conv_mats<0>(p.w_glu, reinterpret_cast<bf16_t*>(p.ws + WS_WGLU), DEPTH, 512, 512, ldsf, tid_);
  conv_mats<0>(p.w_branch, reinterpret_cast<bf16_t*>(p.ws + WS_WBR), DEPTH * 3, 512, 1024, ldsf, tid_);
  conv_mats<0>(p.w_out, reinterpret_cast<bf16_t*>(p.ws + WS_WOUT), DEPTH, 1024, 1024, ldsf, tid_);
  conv_mats<1>(p.w_gu, reinterpret_cast<bf16_t*>(p.ws + WS_WGU), DEPTH * NEXP, 1024, 2048, ldsf, tid_);
  conv_mats<0>(p.w_dn, reinterpret_cast<bf16_t*>(p.ws + WS_WDN), DEPTH * NEXP, 1024, 1024, ldsf, tid_);
  mod_phase(p, ldsf);
  const float4* xs = reinterpret_cast<const float4*>(p.x); float4* xo = reinterpret_cast<float4*>(p.out);
  for (size_t i = (size_t)bid * NTHR + tid_; i < (size_t)NLAT * D / 4; i += (size_t)G * NTHR) xo[i] = xs[i];
  const float4* cs = reinterpret_cast<const float4*>(p.ctx); float4* co = reinterpret_cast<float4*>(p.ws + WS_CX);
  for (size_t i = (size_t)bid * NTHR + tid_; i < (size_t)NCTX * D / 4; i += (size_t)G * NTHR) co[i] = cs[i];
}

#ifndef ONLY
#define ONLY -1
#endif
#ifndef REP_PRO
#define REP_PRO 1
#endif
#ifndef REP_GEMM
#define REP_GEMM 1
#endif
#ifndef REP_PC
#define REP_PC 1
#endif
#ifndef REP_MOE
#define REP_MOE 1
#endif
#define PH_ON(idx, k) ((ONLY < 0 || ONLY == (k)) && p.ph_lo <= (idx) && (idx) < p.ph_hi)
#define PH_END(idx) do { if ((idx) + 1 < p.ph_hi) xcd_barrier(bar); } while (0)

__global__ void __launch_bounds__(512, 2) fwd(Params p) {
  extern __shared__ __attribute__((aligned(16))) unsigned char lds_raw[];
  LAS unsigned char* shm = (LAS unsigned char*)lds_raw;
  unsigned* misc_u = reinterpret_cast<unsigned*>(lds_raw + LDS_MISC);
  int* misc_i = reinterpret_cast<int*>(lds_raw + LDS_MISC + 64);
  unsigned* ctl = reinterpret_cast<unsigned*>(p.ws + WS_CTL);
  if (threadIdx.x < 4) misc_u[threadIdx.x] = 0u;
  __syncthreads();
  XcdBarrier bar = xcd_barrier_post(ctl + CW_BAR, (volatile LAS unsigned*)misc_u);

  if (PH_ON(0, 10)) { for (int rep = 0; rep < REP_PRO; ++rep) phase_prologue(p, reinterpret_cast<float*>(lds_raw)); PH_END(0); }

  for (int layer = 0; layer < DEPTH; ++layer) {
    const int pb = 1 + layer * 10;
    const bool need_ctx = layer < DEPTH - 1;
    const int mrows = need_ctx ? NTOK : NLAT;
    if (PH_ON(pb + 0, 0)) { norm_phase(p, layer, layer > 0, misc_i); PH_END(pb + 0); }
    if (PH_ON(pb + 1, 1)) { for (int rep = 0; rep < REP_GEMM; ++rep) phase_inproj(p, layer, shm); PH_END(pb + 1); }
    if (PH_ON(pb + 2, 2)) { qknorm_phase(p, layer); PH_END(pb + 2); }
    if (PH_ON(pb + 3, 3)) { for (int rep = 0; rep < REP_PC; ++rep) phase_mixers(p, layer, need_ctx, misc_i, lds_raw, rep); PH_END(pb + 3); }
    if (PH_ON(pb + 4, 4)) { for (int rep = 0; rep < REP_GEMM; ++rep) phase_glu(p, layer, mrows, shm); PH_END(pb + 4); }
    if (PH_ON(pb + 5, 5)) { for (int rep = 0; rep < REP_GEMM; ++rep) phase_merge1(p, layer, mrows, shm); PH_END(pb + 5); }
    if (PH_ON(pb + 6, 6)) { phase_merge2(p, layer, mrows, shm); PH_END(pb + 6); }
    if (PH_ON(pb + 7, 7)) { route_phase(p, layer, mrows, reinterpret_cast<float*>(lds_raw)); PH_END(pb + 7); }
    if (PH_ON(pb + 8, 8)) { for (int rep = 0; rep < REP_MOE; ++rep) phase_moe1(p, layer, shm, misc_i); PH_END(pb + 8); }
    if (PH_ON(pb + 9, 9)) { for (int rep = 0; rep < REP_MOE; ++rep) phase_moe2(p, layer, shm, misc_i); PH_END(pb + 9); }
  }
  if (PH_ON(41, 11)) { final_combine(p, misc_i); }
}

extern "C" void kernel_launch(void* const* d_in, const int* in_sizes, int n_in, void* d_out, int out_size, void* d_ws, size_t ws_size, hipStream_t stream) {
  static int grid = 0;
  if (grid == 0) {
    if (n_in != 32 || out_size != NLAT * D || ws_size < WS_END) { fprintf(stderr, "kernel_launch: unexpected shapes (n_in %d out %d ws %zu need %zu)\n", n_in, out_size, ws_size, (size_t)WS_END); grid = -1; return; }
    int dev = 0, cus = 0, per_cu = 0;
    if (hipGetDevice(&dev) != hipSuccess || hipDeviceGetAttribute(&cus, hipDeviceAttributeMultiprocessorCount, dev) != hipSuccess) { grid = -1; return; }
    if (hipFuncSetAttribute((const void*)fwd, hipFuncAttributeMaxDynamicSharedMemorySize, LDS_BYTES) != hipSuccess) { fprintf(stderr, "kernel_launch: hipFuncSetAttribute failed\n"); grid = -1; return; }
    if (hipOccupancyMaxActiveBlocksPerMultiprocessor(&per_cu, (const void*)fwd, NTHR, LDS_BYTES) != hipSuccess || per_cu < 1) fprintf(stderr, "kernel_launch: occupancy query reports %d\n", per_cu);
    (void)hipGetLastError();
    grid = cus;
  }
  if (grid < 0) return;
  (void)hipMemsetAsync((char*)d_ws + WS_CTL, 0, CTL_BYTES, stream);
  Params p{};
  const float** f = reinterpret_cast<const float**>(&p);
  for (int i = 0; i < 32; ++i) f[i] = (const float*)d_in[i];
  p.out = (float*)d_out; p.ws = (unsigned char*)d_ws; p.ph_lo = 0; p.ph_hi = 42;
  hipLaunchKernelGGL(fwd, dim3(grid), dim3(NTHR), LDS_BYTES, stream, p);
}
```

```cpp
#include <hip/hip_runtime.h>
#include <stdint.h>
#include <stdio.h>

typedef unsigned short bf16_t;
typedef short bf16x8 __attribute__((ext_vector_type(8)));
typedef float f32x4 __attribute__((ext_vector_type(4)));
#define LAS __attribute__((address_space(3)))

constexpr int D = 1024, NB = 8, SEQ = 2048, DEPTH = 4, CTXL = 256;
constexpr int NLAT = NB * SEQ, NCTX = NB * CTXL, NTOK = NLAT + NCTX;
constexpr int INW = 5888;
constexpr int C_U = 0, C_WQ = 512, C_WK = 1024, C_WV = 1152, C_NQ = 1280, C_NK = 1792, C_NV = 2304, C_GATE = 2816;
constexpr int NEXP = 32, TOPK = 4, DFF = 1024;
constexpr int NTHR = 512;

constexpr size_t al256(size_t x) { return (x + 255) & ~(size_t)255; }
constexpr size_t WS_CTL   = 0;
constexpr size_t CTL_BYTES = 65536;
constexpr size_t WS_MOD   = WS_CTL + CTL_BYTES;
constexpr size_t WS_WIN   = al256(WS_MOD + (size_t)DEPTH * 9 * 6144 * 4);
constexpr size_t WS_WGLU  = al256(WS_WIN + (size_t)DEPTH * INW * 1024 * 2);
constexpr size_t WS_WBR   = al256(WS_WGLU + (size_t)DEPTH * 512 * 512 * 2);
constexpr size_t WS_WOUT  = al256(WS_WBR + (size_t)DEPTH * 3 * 1024 * 512 * 2);
constexpr size_t WS_WGU   = al256(WS_WOUT + (size_t)DEPTH * 1024 * 1024 * 2);
constexpr size_t WS_WDN   = al256(WS_WGU + (size_t)DEPTH * NEXP * 2048 * 1024 * 2);
constexpr size_t WS_CX    = al256(WS_WDN + (size_t)DEPTH * NEXP * 1024 * 1024 * 2);
constexpr size_t WS_H     = al256(WS_CX + (size_t)NCTX * D * 4);
constexpr size_t WS_P     = al256(WS_H + (size_t)NTOK * D * 2);
constexpr size_t WS_YD    = al256(WS_P + (size_t)NTOK * INW * 2);
constexpr size_t WS_G     = al256(WS_YD + (size_t)2 * NTOK * 512 * 4);
constexpr size_t WS_Y     = al256(WS_G + (size_t)NTOK * 512 * 2);
constexpr size_t WS_S     = al256(WS_Y + (size_t)NTOK * 1536 * 2);
constexpr size_t WS_SB    = al256(WS_S + (size_t)NTOK * D * 4);
constexpr size_t WS_TKE   = al256(WS_SB + (size_t)NTOK * D * 2);
constexpr size_t WS_TKP   = al256(WS_TKE + (size_t)NTOK * 4 * 4);
constexpr size_t WS_TKG   = al256(WS_TKP + (size_t)NTOK * 4 * 4);
constexpr size_t WS_TLIST = al256(WS_TKG + (size_t)NTOK * 4 * 4);
constexpr size_t WS_ACT   = al256(WS_TLIST + (size_t)NEXP * NTOK * 4);
constexpr size_t WS_YB    = al256(WS_ACT + (size_t)(NTOK * 4 + 256) * 1024 * 2);
constexpr size_t WS_VT    = al256(WS_YB + (size_t)(NTOK * 4 + 256) * 1024 * 2);
constexpr size_t WS_END   = al256(WS_VT + (size_t)NB * 10 * 64 * (CTXL + SEQ) * 2);

constexpr int CW_BAR = 0;
constexpr int CW_WQ = 4096;
constexpr int CW_CNT = 8192;

__device__ __forceinline__ bf16_t f2bf(float f) { unsigned u = __float_as_uint(f); u += 0x7fffu + ((u >> 16) & 1u); return (bf16_t)(u >> 16); }
__device__ __forceinline__ float bf2f(bf16_t h) { return __uint_as_float(((unsigned)h) << 16); }
__device__ __forceinline__ unsigned pack2(float a, float b) { return (unsigned)f2bf(a) | ((unsigned)f2bf(b) << 16); }
__device__ __forceinline__ float sigmoidf(float x) { return 1.0f / (1.0f + __expf(-x)); }
__device__ __forceinline__ int opaque_tid() { int tz = threadIdx.x; asm volatile("" : "+v"(tz)); return tz; }
__device__ __forceinline__ float shx(float v, int o, int lane) { return __int_as_float(__builtin_amdgcn_ds_bpermute((lane ^ o) << 2, __float_as_int(v))); }
__device__ __forceinline__ int shx(int v, int o, int lane) { return __builtin_amdgcn_ds_bpermute((lane ^ o) << 2, v); }
__device__ __forceinline__ float wave_sum(float v, int lane) {
#pragma unroll
  for (int o = 32; o >= 1; o >>= 1) v += shx(v, o, lane);
  return v;
}
__device__ __forceinline__ float wave_max(float v, int lane) {
#pragma unroll
  for (int o = 32; o >= 1; o >>= 1) v = fmaxf(v, shx(v, o, lane));
  return v;
}

#define XB_TMO      128
#define XB_XCNT(j)  (256  + 64 * (j))
#define XB_XSUB(j)  (1280 + 64 * (j))
#define XB_XGEN(j)  (2304 + 64 * (j))
#define XB_TOP      3328
#define XB_TOPGEN   3392
#define XCD_BAR_WORDS 3456
#define XB_SPIN_CAP (1u << 20)

__device__ __forceinline__ unsigned xb_ld(unsigned* p)              { return __hip_atomic_load(p, __ATOMIC_RELAXED, __HIP_MEMORY_SCOPE_AGENT); }
__device__ __forceinline__ unsigned xb_add(unsigned* p, unsigned v) { return __hip_atomic_fetch_add(p, v, __ATOMIC_RELAXED, __HIP_MEMORY_SCOPE_AGENT); }
__device__ __forceinline__ unsigned xb_xcc_id() { return (unsigned)__builtin_amdgcn_s_getreg((3 << 11) | 20) & 0xFu; }
#define XB_SPIN(cond, bar) do { unsigned _sp = 0; while (cond) { __builtin_amdgcn_s_sleep(1); \
    if ((++_sp & 255u) == 0u) { if (xb_ld(&(bar)[XB_TMO])) break; if (_sp > XB_SPIN_CAP) { atomicAdd(&(bar)[XB_TMO], 1u); break; } } } } while (0)

struct XcdBarrier { unsigned* bar; unsigned x; volatile LAS unsigned* st; };

__device__ __forceinline__ XcdBarrier xcd_barrier_post(unsigned* bar, volatile LAS unsigned* st) {
    XcdBarrier b; b.bar = bar; b.x = xb_xcc_id(); b.st = st;
    if (threadIdx.x == 0) (void)xb_add(&bar[XB_XCNT(b.x)], 1u);
    return b;
}
__device__ __forceinline__ void xcd_barrier_complete(unsigned* bar, unsigned x, unsigned& nloc, unsigned& nx) {
    const unsigned G = gridDim.x * gridDim.y * gridDim.z;
    unsigned sum, cnt, mine, sp = 0u;
    for (;;) {
        sum = 0u; cnt = 0u; mine = 0u;
#pragma unroll
        for (unsigned j = 0; j < 16; ++j) { const unsigned c = xb_ld(&bar[XB_XCNT(j)]); sum += c; cnt += (c > 0u) ? 1u : 0u; mine = (j == x) ? c : mine; }
        if (sum == G) break;
        __builtin_amdgcn_s_sleep(1);
        if ((++sp & 255u) == 0u) { if (xb_ld(&bar[XB_TMO])) break; if (sp > XB_SPIN_CAP) { atomicAdd(&bar[XB_TMO], 1u); break; } }
    }
    nloc = mine > 0u ? mine : 1u; nx = cnt > 0u ? cnt : 1u;
}
__device__ __forceinline__ void xcd_barrier(const XcdBarrier& b) {
    asm volatile("s_waitcnt vmcnt(0)" ::: "memory");
    __syncthreads();
    if (threadIdx.x == 0) {
        unsigned* bar = b.bar;
        __builtin_amdgcn_s_waitcnt(0);
        unsigned nloc = b.st[0], nx = b.st[1];
        if (nloc == 0u) { xcd_barrier_complete(bar, b.x, nloc, nx); b.st[0] = nloc; b.st[1] = nx; }
        const unsigned old = xb_add(&bar[XB_XSUB(b.x)], 1u);
        const unsigned gen = old / nloc;
        if (old + 1u == (gen + 1u) * nloc) {
            __builtin_amdgcn_fence(__ATOMIC_RELEASE, "agent");
            asm volatile("s_waitcnt vmcnt(0)" ::: "memory");
            const unsigned og = xb_add(&bar[XB_TOP], 1u);
            const unsigned tg = og / nx;
            if (og + 1u == (tg + 1u) * nx) xb_add(&bar[XB_TOPGEN], 1u);
            else XB_SPIN(xb_ld(&bar[XB_TOPGEN]) == tg, bar);
            __builtin_amdgcn_fence(__ATOMIC_ACQUIRE, "agent");
            xb_add(&bar[XB_XGEN(b.x)], 1u);
            asm volatile("s_waitcnt vmcnt(0)" ::: "memory");
        } else {
            XB_SPIN(xb_ld(&bar[XB_XGEN(b.x)]) == gen, bar);
            __builtin_amdgcn_fence(__ATOMIC_ACQUIRE, "agent");
            asm volatile("s_waitcnt vmcnt(0)" ::: "memory");
        }
    }
    __syncthreads();
}

struct Params {
  const float *x, *c, *ctx, *c_ctx, *w_mod, *b_mod, *norm_mix, *norm_ffn, *w_in, *lam_re, *lam_im, *log_dt,
              *b_re, *b_im, *c_re, *c_im, *ssm_d, *w_glu, *win_qn, *win_kn, *win_sink, *na_qn, *na_kn, *na_rpb,
              *w_branch, *w_out, *router_w, *router_b, *w_gu, *b_gu, *w_dn, *b_dn;
  float* out;
  unsigned char* ws;
  int ph_lo, ph_hi;
};

constexpr int LDS_MISC = 131072;
constexpr int LDS_BYTES = 131072 + 8192;

constexpr int HT = 128 * 64;
__device__ __forceinline__ int lds_byte(int r, int c) {
  int st = (r >> 4) * 2 + (c >> 5), rr = r & 15, cc = c & 31, ob = rr * 64 + cc * 2;
  return st * 1024 + (ob ^ (((ob >> 9) & 1) << 5));
}
__device__ __forceinline__ void stage_rc(int b, int& R, int& C) {
  int st = b / 1024, sb = b % 1024, swz = sb ^ (((sb >> 9) & 1) << 5);
  R = (st >> 1) * 16 + swz / 64; C = (st & 1) * 32 + (swz % 64) / 2;
}

#define G_SA(b, h) (((b) * 2 + (h)) * 16384)
#define G_SB(b, h) ((4 + (b) * 2 + (h)) * 16384)
#define G_STAGE(bufoff, gbase, v0, v1) do { \
    __builtin_amdgcn_global_load_lds((const unsigned*)((gbase) + (v0)), (LAS unsigned*)(lds + (bufoff) + ldsw), 16, 0, 0); \
    __builtin_amdgcn_global_load_lds((const unsigned*)((gbase) + (v1)), (LAS unsigned*)(lds + (bufoff) + ldsw + 8192), 16, 0, 0); } while (0)
#define G_LDA(dst, b, h) do { _Pragma("unroll") for (int m = 0; m < 4; ++m) _Pragma("unroll") for (int k = 0; k < 2; ++k) dst[m][k] = *(const LAS bf16x8*)(lds + G_SA(b, h) + aoff + m * 2048 + k * 1024); } while (0)
#define G_LDB(dst, b, h) do { _Pragma("unroll") for (int n = 0; n < 2; ++n) _Pragma("unroll") for (int k = 0; k < 2; ++k) dst[n][k] = *(const LAS bf16x8*)(lds + G_SB(b, h) + boff + n * 2048 + k * 1024); } while (0)
#define G_MMA(ai, bj, At, Bx) do { __builtin_amdgcn_s_setprio(1); \
    _Pragma("unroll") for (int m = 0; m < 4; ++m) _Pragma("unroll") for (int n = 0; n < 2; ++n) _Pragma("unroll") for (int k = 0; k < 2; ++k) \
      acc[ai][bj][m][n] = __builtin_amdgcn_mfma_f32_16x16x32_bf16(Bx[n][k], At[m][k], acc[ai][bj][m][n], 0, 0, 0); \
    __builtin_amdgcn_s_setprio(0); } while (0)
#define WAIT_V(n) asm volatile("s_waitcnt vmcnt(" #n ")" ::: "memory")
#define WAIT_L(n) asm volatile("s_waitcnt lgkmcnt(" #n ")" ::: "memory")
#define BAR __builtin_amdgcn_s_barrier()
#define SCHED __builtin_amdgcn_sched_barrier(0)

template <class Epi>
__device__ __forceinline__ void gemm_tile(LAS unsigned char* lds, const char* a0, const char* a1, unsigned va00, unsigned va01, unsigned va10, unsigned va11,
                                          const char* b0, const char* b1, unsigned vb0, unsigned vb1, int nt, int tid, Epi epi)
{
  asm volatile("s_waitcnt vmcnt(0)" ::: "memory");
  __syncthreads();
  const int wid = __builtin_amdgcn_readfirstlane(tid >> 6), lane = tid & 63, wr = wid >> 2, wc = wid & 3, fr = lane & 15, fq = lane >> 4;
  const unsigned ldsw = (unsigned)wid * 1024u;
  const int aoff = lds_byte(wr * 64 + fr, fq * 8), boff = lds_byte(wc * 32 + fr, fq * 8);
  f32x4 acc[2][2][4][2];
#pragma unroll
  for (int a = 0; a < 2; ++a)
#pragma unroll
    for (int b = 0; b < 2; ++b)
#pragma unroll
      for (int m = 0; m < 4; ++m)
#pragma unroll
        for (int n = 0; n < 2; ++n) acc[a][b][m][n] = f32x4{0.f, 0.f, 0.f, 0.f};
  bf16x8 At[4][2], B0[2][2], B1[2][2];
  G_STAGE(G_SB(0, 0), b0, vb0, vb1); G_STAGE(G_SA(0, 0), a0, va00, va01);
  G_STAGE(G_SB(0, 1), b1, vb0, vb1); G_STAGE(G_SA(0, 1), a1, va10, va11);
  if (wr == 1) BAR;
  WAIT_V(4); BAR;
  G_STAGE(G_SB(1, 0), b0 + 128, vb0, vb1); G_STAGE(G_SA(1, 0), a0 + 128, va00, va01); G_STAGE(G_SB(1, 1), b1 + 128, vb0, vb1);
  WAIT_V(6); BAR;
  for (int t = 0; t < nt - 2; t += 2) {
    const char* a0t = a0 + (size_t)t * 128; const char* a1t = a1 + (size_t)t * 128; const char* b0t = b0 + (size_t)t * 128; const char* b1t = b1 + (size_t)t * 128;
    G_LDB(B0, 0, 0); SCHED; G_LDA(At, 0, 0); G_STAGE(G_SA(1, 1), a1t + 128, va10, va11);
    WAIT_L(8); BAR; WAIT_L(0); G_MMA(0, 0, At, B0); BAR; SCHED;
    G_LDB(B1, 0, 1); G_STAGE(G_SB(0, 0), b0t + 256, vb0, vb1);
    BAR; WAIT_L(0); G_MMA(0, 1, At, B1); BAR;
    G_LDA(At, 0, 1); G_STAGE(G_SA(0, 0), a0t + 256, va00, va01);
    BAR; WAIT_L(0); G_MMA(1, 0, At, B0); BAR; SCHED;
    G_STAGE(G_SB(0, 1), b1t + 256, vb0, vb1);
    WAIT_V(6); BAR; G_MMA(1, 1, At, B1); BAR;
    G_LDB(B0, 1, 0); SCHED; G_LDA(At, 1, 0); G_STAGE(G_SA(0, 1), a1t + 256, va10, va11);
    WAIT_L(8); BAR; WAIT_L(0); G_MMA(0, 0, At, B0); BAR; SCHED;
    G_LDB(B1, 1, 1); G_STAGE(G_SB(1, 0), b0t + 384, vb0, vb1);
    BAR; WAIT_L(0); G_MMA(0, 1, At, B1); BAR;
    G_LDA(At, 1, 1); G_STAGE(G_SA(1, 0), a0t + 384, va00, va01);
    BAR; WAIT_L(0); G_MMA(1, 0, At, B0); BAR; SCHED;
    G_STAGE(G_SB(1, 1), b1t + 384, vb0, vb1);
    WAIT_V(6); BAR; G_MMA(1, 1, At, B1); BAR;
  }
  { G_LDB(B0, 0, 0); WAIT_V(0); G_LDA(At, 0, 0); G_STAGE(G_SA(1, 1), a1 + (size_t)(nt - 1) * 128, va10, va11);
    BAR; WAIT_L(0); G_MMA(0, 0, At, B0); BAR;
    G_LDB(B1, 0, 1); BAR; WAIT_L(0); G_MMA(0, 1, At, B1); BAR;
    G_LDA(At, 0, 1); WAIT_V(4); BAR; WAIT_L(0); G_MMA(1, 0, At, B0); G_MMA(1, 1, At, B1); BAR; }
  { G_LDB(B0, 1, 0); G_LDA(At, 1, 0); WAIT_V(2); BAR; WAIT_L(0); G_MMA(0, 0, At, B0); BAR;
    G_LDB(B1, 1, 1); WAIT_V(0); BAR; WAIT_L(0); G_MMA(0, 1, At, B1); BAR;
    G_LDA(At, 1, 1); BAR; WAIT_L(0); G_MMA(1, 0, At, B0); G_MMA(1, 1, At, B1); BAR; }
  if (wr == 0) BAR;
#pragma unroll
  for (int ai = 0; ai < 2; ++ai)
#pragma unroll
    for (int m = 0; m < 4; ++m)
#pragma unroll
      for (int n = 0; n < 2; ++n)
        epi(ai * 128 + wr * 64 + m * 16 + fr, wc * 32 + n * 16 + fq * 4, acc[ai][0][m][n], acc[ai][1][m][n]);
}

__device__ __forceinline__ unsigned stage_voff(int tid, int i, int ld) { int R, C; stage_rc(tid * 16 + i * 8192, R, C); return (unsigned)(R * ld + C) * 2u; }


__device__ __forceinline__ bool unit_next(int L, int nM, int nN, int& pm, int& pn) {
  const int nwg = nM * nN; if (L >= nwg) return false;
  int wgid = L; { const int q = nwg / 8, r = nwg % 8, xcd = wgid % 8, off = wgid / 8; wgid = (xcd < r ? xcd * (q + 1) : r * (q + 1) + (xcd - r) * q) + off; }
  const int nig = 8 * nN, gid = wgid / nig, fm = gid * 8, gsz = (nM - fm) < 8 ? (nM - fm) : 8;
  pm = fm + ((wgid % nig) % gsz); pn = (wgid % nig) / gsz; return true;
}

__device__ __forceinline__ void st_bf4(bf16_t* p, float a, float b, float c, float d) {
  uint2 v; v.x = pack2(a, b); v.y = pack2(c, d); *reinterpret_cast<uint2*>(p) = v;
}
__device__ __forceinline__ void ld_bf4(const bf16_t* p, float& a, float& b, float& c, float& d) {
  uint2 v = *reinterpret_cast<const uint2*>(p);
  a = __uint_as_float(v.x << 16); b = __uint_as_float(v.x & 0xffff0000u); c = __uint_as_float(v.y << 16); d = __uint_as_float(v.y & 0xffff0000u);
}

template <int PERM>
__device__ __forceinline__ void conv_mats(const float* __restrict__ src, bf16_t* __restrict__ dst, int nmat, int K, int N, float* lds, int tid_) {
  const int tK = K / 64, tN = N / 64, per = tK * tN, total = nmat * per;
  const int t = tid_;
  for (int tile = blockIdx.x; tile < total; tile += gridDim.x) {
    const int mat = tile / per, rem = tile % per, kt = rem / tN, ntl = rem % tN;
    const int p0 = ntl * 64;
    int s0 = p0;
    if (PERM == 1) { const int t256 = p0 >> 8, w = p0 & 255; s0 = (w < 128) ? (t256 * 128 + w) : (1024 + t256 * 128 + (w - 128)); }
    const float* S = src + (size_t)mat * K * N + (size_t)(kt * 64) * N + s0;
    __syncthreads();
    { const int c = t & 63, r = t >> 6;
#pragma unroll
      for (int i = 0; i < 8; ++i) { const int k = r + 8 * i; lds[k * 65 + c] = S[(size_t)k * N + c]; } }
    __syncthreads();
    { const int n = t >> 3, kc = (t & 7) * 8;
      uint4 v;
      v.x = pack2(lds[(kc + 0) * 65 + n], lds[(kc + 1) * 65 + n]);
      v.y = pack2(lds[(kc + 2) * 65 + n], lds[(kc + 3) * 65 + n]);
      v.z = pack2(lds[(kc + 4) * 65 + n], lds[(kc + 5) * 65 + n]);
      v.w = pack2(lds[(kc + 6) * 65 + n], lds[(kc + 7) * 65 + n]);
      *reinterpret_cast<uint4*>(dst + (size_t)mat * N * K + (size_t)(p0 + n) * K + kt * 64 + kc) = v; }
  }
}

__device__ __forceinline__ float siluf(float x) { return x / (1.0f + __expf(-x)); }
__device__ __forceinline__ float gelu_tanh(float x) {
  const float u = 0.7978845608028654f * (x + 0.044715f * x * x * x);
  return 0.5f * x * (1.0f + tanhf(u));
}

__device__ __forceinline__ void mod_phase(const Params& p, float* lds) {
  const int tid_ = opaque_tid();
  float* sc = lds;
  float* red = lds + 9 * 1024;
  const int t = tid_;
  __syncthreads();
  for (int i = t; i < 9 * 1024; i += NTHR) { const int r = i >> 10, k = i & 1023; const float v = (r < 8) ? p.c[r * 1024 + k] : p.c_ctx[k]; sc[i] = siluf(v); }
  __syncthreads();
  float* mod = reinterpret_cast<float*>(p.ws + WS_MOD);
  for (int u = blockIdx.x; u < DEPTH * 48; u += gridDim.x) {
    const int l = u / 48, col0 = (u % 48) * 128;
    const int col = t & 127, kq = t >> 7;
    float a[9];
#pragma unroll
    for (int r = 0; r < 9; ++r) a[r] = 0.f;
    const float* W = p.w_mod + (size_t)l * 1024 * 6144 + col0 + col;
    for (int k = kq * 256; k < kq * 256 + 256; ++k) {
      const float w = W[(size_t)k * 6144];
#pragma unroll
      for (int r = 0; r < 9; ++r) a[r] += sc[r * 1024 + k] * w;
    }
#pragma unroll
    for (int r = 0; r < 9; ++r) red[(kq * 9 + r) * 128 + col] = a[r];
    __syncthreads();
    for (int i = t; i < 9 * 128; i += NTHR) {
      const int r = i >> 7, cc = i & 127;
      const float v = red[(0 * 9 + r) * 128 + cc] + red[(1 * 9 + r) * 128 + cc] + red[(2 * 9 + r) * 128 + cc] + red[(3 * 9 + r) * 128 + cc];
      mod[((size_t)l * 9 + r) * 6144 + col0 + cc] = v + p.b_mod[l * 6144 + col0 + cc];
    }
    __syncthreads();
  }
}

__device__ __forceinline__ float* stream_row(const Params& p, int row) {
  return (row < NLAT) ? (p.out + (size_t)row * D) : (reinterpret_cast<float*>(p.ws + WS_CX) + (size_t)(row - NLAT) * D);
}
__device__ __forceinline__ int row_modidx(int row) { return (row < NLAT) ? (row >> 11) : 8; }

__device__ __forceinline__ void expert_starts(const unsigned* cnt, int* st) {
  if (threadIdx.x == 0) { int s = 0; for (int e = 0; e < NEXP; ++e) { st[e] = s; s += (int)cnt[e]; } st[NEXP] = s; }
  __syncthreads();
}

__device__ __forceinline__ void norm_phase(const Params& p, int layer, bool combine, int* lds_i) {
  const int tid_ = opaque_tid();
  const float* mod = reinterpret_cast<const float*>(p.ws + WS_MOD);
  bf16_t* H = reinterpret_cast<bf16_t*>(p.ws + WS_H);
  const int* tke = reinterpret_cast<const int*>(p.ws + WS_TKE);
  const int* tkp = reinterpret_cast<const int*>(p.ws + WS_TKP);
  const float* tkg = reinterpret_cast<const float*>(p.ws + WS_TKG);
  const bf16_t* YB = reinterpret_cast<const bf16_t*>(p.ws + WS_YB);
  const unsigned* ctl = reinterpret_cast<const unsigned*>(p.ws + WS_CTL);
  if (combine) expert_starts(ctl + CW_CNT + (layer - 1) * 32, lds_i);
  const int lane = tid_ & 63, wv = tid_ >> 6;
  const float* gw = p.norm_mix + layer * D;
  for (int row = blockIdx.x * 8 + wv; row < NTOK; row += gridDim.x * 8) {
    float* xr = stream_row(p, row);
    const int mi = row_modidx(row);
    float v[16];
#pragma unroll
    for (int i = 0; i < 4; ++i) { const float4 q = *reinterpret_cast<const float4*>(xr + i * 256 + lane * 4); v[4 * i] = q.x; v[4 * i + 1] = q.y; v[4 * i + 2] = q.z; v[4 * i + 3] = q.w; }
    if (combine) {
      const float* m5 = mod + ((size_t)(layer - 1) * 9 + mi) * 6144 + 5 * 1024;
      float a[16];
#pragma unroll
      for (int i = 0; i < 16; ++i) a[i] = 0.f;
#pragma unroll
      for (int k = 0; k < 4; ++k) {
        const int e = tke[row * 4 + k]; const int pos = tkp[row * 4 + k]; const float g = tkg[row * 4 + k];
        const bf16_t* yr = YB + (size_t)(lds_i[e] + pos) * D;
#pragma unroll
        for (int i = 0; i < 4; ++i) { float a0, a1, a2, a3; ld_bf4(yr + i * 256 + lane * 4, a0, a1, a2, a3); a[4 * i] += g * a0; a[4 * i + 1] += g * a1; a[4 * i + 2] += g * a2; a[4 * i + 3] += g * a3; }
      }
#pragma unroll
      for (int i = 0; i < 4; ++i) {
        const float4 mm = *reinterpret_cast<const float4*>(m5 + i * 256 + lane * 4);
        v[4 * i] += mm.x * a[4 * i]; v[4 * i + 1] += mm.y * a[4 * i + 1]; v[4 * i + 2] += mm.z * a[4 * i + 2]; v[4 * i + 3] += mm.w * a[4 * i + 3];
        *reinterpret_cast<float4*>(xr + i * 256 + lane * 4) = float4{v[4 * i], v[4 * i + 1], v[4 * i + 2], v[4 * i + 3]};
      }
    }
    float ss = 0.f;
#pragma unroll
    for (int i = 0; i < 16; ++i) ss += v[i] * v[i];
    ss = wave_sum(ss, lane);
    const float rinv = rsqrtf(ss * (1.0f / D) + 1e-6f);
    const float* msh = mod + ((size_t)layer * 9 + mi) * 6144;
#pragma unroll
    for (int i = 0; i < 4; ++i) {
      const int c = i * 256 + lane * 4;
      const float4 g = *reinterpret_cast<const float4*>(gw + c);
      const float4 sh = *reinterpret_cast<const float4*>(msh + c);
      const float4 sc = *reinterpret_cast<const float4*>(msh + 1024 + c);
      st_bf4(H + (size_t)row * D + c, v[4 * i] * rinv * g.x * (1.f + sc.x) + sh.x, v[4 * i + 1] * rinv * g.y * (1.f + sc.y) + sh.y,
             v[4 * i + 2] * rinv * g.z * (1.f + sc.z) + sh.z, v[4 * i + 3] * rinv * g.w * (1.f + sc.w) + sh.w);
    }
  }
}

__device__ __forceinline__ void final_combine(const Params& p, int* lds_i) {
  const int tid_ = opaque_tid();
  const float* mod = reinterpret_cast<const float*>(p.ws + WS_MOD);
  const int* tke = reinterpret_cast<const int*>(p.ws + WS_TKE);
  const int* tkp = reinterpret_cast<const int*>(p.ws + WS_TKP);
  const float* tkg = reinterpret_cast<const float*>(p.ws + WS_TKG);
  const bf16_t* YB = reinterpret_cast<const bf16_t*>(p.ws + WS_YB);
  const unsigned* ctl = reinterpret_cast<const unsigned*>(p.ws + WS_CTL);
  expert_starts(ctl + CW_CNT + (DEPTH - 1) * 32, lds_i);
  const int lane = tid_ & 63, wv = tid_ >> 6;
  for (int row = blockIdx.x * 8 + wv; row < NLAT; row += gridDim.x * 8) {
    float* xr = p.out + (size_t)row * D;
    const int mi = row >> 11;
    const float* m5 = mod + ((size_t)(DEPTH - 1) * 9 + mi) * 6144 + 5 * 1024;
    float a[16];
#pragma unroll
    for (int i = 0; i < 16; ++i) a[i] = 0.f;
#pragma unroll
    for (int k = 0; k < 4; ++k) {
      const int e = tke[row * 4 + k]; const int pos = tkp[row * 4 + k]; const float g = tkg[row * 4 + k];
      const bf16_t* yr = YB + (size_t)(lds_i[e] + pos) * D;
#pragma unroll
      for (int i = 0; i < 4; ++i) { float a0, a1, a2, a3; ld_bf4(yr + i * 256 + lane * 4, a0, a1, a2, a3); a[4 * i] += g * a0; a[4 * i + 1] += g * a1; a[4 * i + 2] += g * a2; a[4 * i + 3] += g * a3; }
    }
#pragma unroll
    for (int i = 0; i < 4; ++i) {
      const float4 mm = *reinterpret_cast<const float4*>(m5 + i * 256 + lane * 4);
      float4 q = *reinterpret_cast<const float4*>(xr + i * 256 + lane * 4);
      q.x += mm.x * a[4 * i]; q.y += mm.y * a[4 * i + 1]; q.z += mm.z * a[4 * i + 2]; q.w += mm.w * a[4 * i + 3];
      *reinterpret_cast<float4*>(xr + i * 256 + lane * 4) = q;
    }
  }
}

__device__ __forceinline__ void qknorm_phase(const Params& p, int layer) {
  const int tid_ = opaque_tid();
  bf16_t* P = reinterpret_cast<bf16_t*>(p.ws + WS_P);
  const int lane = tid_ & 63, wv = tid_ >> 6;
  const float wqn = p.win_qn[layer * 64 + lane], wkn = p.win_kn[layer * 64 + lane];
  const float nqn = p.na_qn[layer * 64 + lane], nkn = p.na_kn[layer * 64 + lane];
  const int fi = lane & 15;
  const float inv_freq = powf(10000.0f, -(float)fi / 16.0f);
  for (int row = blockIdx.x * 8 + wv; row < NTOK; row += gridDim.x * 8) {
    bf16_t* pr = P + (size_t)row * INW;
    const bool lat = row < NLAT;
    float cs = 1.f, sn = 0.f;
    if (lat) { const int t = row & 2047; const int pos = (lane < 32) ? (t >> 6) : (t & 63); const float ang = (float)pos * inv_freq; cs = cosf(ang); sn = sinf(ang); }
    for (int hd = 0; hd < 26; ++hd) {
      int col; float w; bool rope;
      if (hd < 8) { col = C_WQ + hd * 64; w = wqn; rope = lat; }
      else if (hd < 10) { col = C_WK + (hd - 8) * 64; w = wkn; rope = lat; }
      else if (hd < 18) { col = C_NQ + (hd - 10) * 64; w = nqn; rope = false; }
      else { col = C_NK + (hd - 18) * 64; w = nkn; rope = false; }
      const float v = bf2f(pr[col + lane]);
      const float ss = wave_sum(v * v, lane);
      float y = v * rsqrtf(ss * (1.0f / 64.0f) + 1e-6f) * w;
      if (rope) {
        const float o = shx(y, 16, lane);
        y = ((lane & 16) == 0) ? (y * cs - o * sn) : (o * sn + y * cs);
      }
      pr[col + lane] = f2bf(y);
    }
    {
      bf16_t* VT = reinterpret_cast<bf16_t*>(p.ws + WS_VT);
      const int bb = lat ? (row >> 11) : ((row - NLAT) >> 8);
      const int tpos = lat ? (CTXL + (row & 2047)) : ((row - NLAT) & 255);
#pragma unroll
      for (int hv = 0; hv < 10; ++hv) {
        const int col = (hv < 2) ? (C_WV + hv * 64) : (C_NV + (hv - 2) * 64);
        VT[((size_t)(bb * 10 + hv) * 64 + lane) * (CTXL + SEQ) + tpos] = pr[col + lane];
      }
    }
  }
}

__device__ __forceinline__ int ssm_row(int b, int dir, int tau) {
  if (tau < CTXL) return NLAT + b * CTXL + (dir ? (CTXL - 1 - tau) : tau);
  const int t = tau - CTXL;
  return b * SEQ + (dir ? (SEQ - 1 - t) : t);
}

__device__ __forceinline__ void ssm_item_naive(const Params& p, int layer, int item) {
  const int tid_ = opaque_tid();
  const int b = item >> 3, gq = item & 7;
  const int lane = tid_ & 63, wv = tid_ >> 6;
  const int dir = wv & 1, g = gq * 4 + (wv >> 1);
  const bf16_t* P = reinterpret_cast<const bf16_t*>(p.ws + WS_P);
  float* YD = reinterpret_cast<float*>(p.ws + WS_YD) + (size_t)dir * NTOK * 512;
  {
    const int n = lane;
    const size_t pg = ((size_t)(layer * 2 + dir) * 32 + g);
    const float lr = p.lam_re[pg * 64 + n], li = p.lam_im[pg * 64 + n];
    const float dt = expf(p.log_dt[pg]);
    const float mag = expf(lr * dt);
    const float ar = mag * cosf(li * dt), ai = mag * sinf(li * dt);
    const float den = lr * lr + li * li;
    const float fr = ((ar - 1.0f) * lr + ai * li) / den;
    const float fi = (ai * lr - (ar - 1.0f) * li) / den;
    float bbr[16], bbi[16], cr[16], ci[16];
#pragma unroll
    for (int q = 0; q < 16; ++q) {
      const float br = p.b_re[(pg * 64 + n) * 16 + q], bi = p.b_im[(pg * 64 + n) * 16 + q];
      bbr[q] = fr * br - fi * bi; bbi[q] = fr * bi + fi * br;
      cr[q] = p.c_re[(pg * 16 + q) * 64 + n]; ci[q] = p.c_im[(pg * 16 + q) * 64 + n];
    }
    float hr = 0.f, hi = 0.f;
    for (int tau = 0; tau < CTXL + SEQ; ++tau) {
      const int row = ssm_row(b, dir, tau);
      const uint4* up = reinterpret_cast<const uint4*>(P + (size_t)row * INW + C_U + g * 16);
      const uint4 u0 = up[0], u1 = up[1];
      float u[16];
      u[0] = __uint_as_float(u0.x << 16); u[1] = __uint_as_float(u0.x & 0xffff0000u); u[2] = __uint_as_float(u0.y << 16); u[3] = __uint_as_float(u0.y & 0xffff0000u);
      u[4] = __uint_as_float(u0.z << 16); u[5] = __uint_as_float(u0.z & 0xffff0000u); u[6] = __uint_as_float(u0.w << 16); u[7] = __uint_as_float(u0.w & 0xffff0000u);
      u[8] = __uint_as_float(u1.x << 16); u[9] = __uint_as_float(u1.x & 0xffff0000u); u[10] = __uint_as_float(u1.y << 16); u[11] = __uint_as_float(u1.y & 0xffff0000u);
      u[12] = __uint_as_float(u1.z << 16); u[13] = __uint_as_float(u1.z & 0xffff0000u); u[14] = __uint_as_float(u1.w << 16); u[15] = __uint_as_float(u1.w & 0xffff0000u);
      float xr = 0.f, xi = 0.f;
#pragma unroll
      for (int q = 0; q < 16; ++q) { xr += bbr[q] * u[q]; xi += bbi[q] * u[q]; }
      const float nhr = ar * hr - ai * hi + xr;
      const float nhi = ar * hi + ai * hr + xi;
      hr = nhr; hi = nhi;
      float v[16];
#pragma unroll
      for (int q = 0; q < 16; ++q) v[q] = hr * cr[q] - hi * ci[q];
#pragma unroll
      for (int i = 0; i < 8; ++i) { const bool up_ = (lane & 32) != 0; const float send = up_ ? v[i] : v[i + 8]; const float keep = up_ ? v[i + 8] : v[i]; v[i] = keep + shx(send, 32, lane); }
#pragma unroll
      for (int i = 0; i < 4; ++i) { const bool up_ = (lane & 16) != 0; const float send = up_ ? v[i] : v[i + 4]; const float keep = up_ ? v[i + 4] : v[i]; v[i] = keep + shx(send, 16, lane); }
#pragma unroll
      for (int i = 0; i < 2; ++i) { const bool up_ = (lane & 8) != 0; const float send = up_ ? v[i] : v[i + 2]; const float keep = up_ ? v[i + 2] : v[i]; v[i] = keep + shx(send, 8, lane); }
      { const bool up_ = (lane & 4) != 0; const float send = up_ ? v[0] : v[1]; const float keep = up_ ? v[1] : v[0]; v[0] = keep + shx(send, 4, lane); }
      v[0] += shx(v[0], 2, lane);
      v[0] += shx(v[0], 1, lane);
      if ((lane & 3) == 0) YD[(size_t)row * 512 + g * 16 + (lane >> 2)] = v[0];
    }
  }
  asm volatile("s_waitcnt vmcnt(0)" ::: "memory");
  __threadfence();
  __syncthreads();
  {
    const float* Y0 = reinterpret_cast<const float*>(p.ws + WS_YD);
    const float* Y1 = Y0 + (size_t)NTOK * 512;
    bf16_t* G = reinterpret_cast<bf16_t*>(p.ws + WS_G);
    const int ch = gq * 64 + (tid_ & 63);
    const float dsk = p.ssm_d[layer * 512 + ch];
    for (int i = tid_ >> 6; i < CTXL + SEQ; i += 8) {
      const int row = (i < CTXL) ? (NLAT + b * CTXL + i) : (b * SEQ + i - CTXL);
      const float y = Y0[(size_t)row * 512 + ch] + Y1[(size_t)row * 512 + ch] + dsk * bf2f(P[(size_t)row * INW + C_U + ch]);
      G[(size_t)row * 512 + ch] = f2bf(gelu_tanh(y));
    }
  }
}


typedef float f32x16 __attribute__((ext_vector_type(16)));
__device__ __forceinline__ bf16x8 pack8(const float* v) {
  union { unsigned u[4]; bf16x8 b; } t;
  t.u[0] = pack2(v[0], v[1]); t.u[1] = pack2(v[2], v[3]); t.u[2] = pack2(v[4], v[5]); t.u[3] = pack2(v[6], v[7]);
  return t.b;
}
constexpr int SSM_PITCH = 272;
__device__ __forceinline__ void ssm_item(const Params& p, int layer, int item, unsigned char* lds_raw) {
  const int tid_ = opaque_tid();
  const int b = item >> 3, gq = item & 7;
  const int lane = tid_ & 63, wv = tid_ >> 6;
  const int dir = wv & 1, g = gq * 4 + (wv >> 1);
  const bf16_t* P = reinterpret_cast<const bf16_t*>(p.ws + WS_P);
  float* YD = reinterpret_cast<float*>(p.ws + WS_YD) + (size_t)dir * NTOK * 512;
  unsigned char* hl = lds_raw + wv * (32 * SSM_PITCH);
  {
    const int n0 = lane & 31, hh = lane >> 5;
    const size_t pg = ((size_t)(layer * 2 + dir) * 32 + g);
    const float dt = expf(p.log_dt[pg]);
    float pwr[2][4], pwi[2][4];
    bf16x8 Bop[4];
#pragma unroll
    for (int sb = 0; sb < 2; ++sb) {
      const int n = n0 + 32 * sb;
      const float lr = p.lam_re[pg * 64 + n], li = p.lam_im[pg * 64 + n];
      const float mag = expf(lr * dt);
      const float ar = mag * cosf(li * dt), ai = mag * sinf(li * dt);
      const float den = lr * lr + li * li;
      const float fr = ((ar - 1.0f) * lr + ai * li) / den;
      const float fi = (ai * lr - (ar - 1.0f) * li) / den;
      float vr[8], vi[8];
#pragma unroll
      for (int j = 0; j < 8; ++j) {
        const int q = 8 * hh + j;
        const float br = p.b_re[(pg * 64 + n) * 16 + q], bi = p.b_im[(pg * 64 + n) * 16 + q];
        vr[j] = fr * br - fi * bi; vi[j] = fr * bi + fi * br;
      }
      Bop[sb * 2 + 0] = pack8(vr); Bop[sb * 2 + 1] = pack8(vi);
      pwr[sb][0] = ar; pwi[sb][0] = ai;
      pwr[sb][1] = ar * ar - ai * ai; pwi[sb][1] = 2.0f * ar * ai;
      pwr[sb][2] = pwr[sb][1] * ar - pwi[sb][1] * ai; pwi[sb][2] = pwr[sb][1] * ai + pwi[sb][1] * ar;
      pwr[sb][3] = pwr[sb][1] * pwr[sb][1] - pwi[sb][1] * pwi[sb][1]; pwi[sb][3] = 2.0f * pwr[sb][1] * pwi[sb][1];
    }
    bf16x8 Cop[4];
    {
      const int pch = lane & 15, q4 = lane >> 4;
#pragma unroll
      for (int kb = 0; kb < 4; ++kb) {
        float v[8];
#pragma unroll
        for (int j = 0; j < 8; ++j) {
          const int n = 8 * kb + 2 * q4 + (j >> 2), c = j & 3, nn = n + 32 * (c >> 1);
          v[j] = (c & 1) ? -p.c_im[(pg * 16 + pch) * 64 + nn] : p.c_re[(pg * 16 + pch) * 64 + nn];
        }
        Cop[kb] = pack8(v);
      }
    }
    float hpr[2] = {0.f, 0.f}, hpi[2] = {0.f, 0.f};
    const int ucol = C_U + g * 16 + 8 * hh;
    auto chunk_base = [&](int c, int& base, int& sgn) {
      sgn = dir ? -1 : 1;
      if (c < 8) base = NLAT + b * CTXL + (dir ? (CTXL - 1 - c * 32) : c * 32);
      else base = b * SEQ + (dir ? (SEQ - 1 - (c - 8) * 32) : (c - 8) * 32);
    };
    uint4 unext;
    { int base, sgn; chunk_base(0, base, sgn); unext = *reinterpret_cast<const uint4*>(P + (size_t)(base + sgn * n0) * INW + ucol); }
    for (int c = 0; c < 72; ++c) {
      int base, sgn; chunk_base(c, base, sgn);
      union { uint4 u; bf16x8 b; } ua; ua.u = unext;
      if (c + 1 < 72) { int nb, ns; chunk_base(c + 1, nb, ns); unext = *reinterpret_cast<const uint4*>(P + (size_t)(nb + ns * n0) * INW + ucol); }
      f32x16 X[4];
#pragma unroll
      for (int k = 0; k < 4; ++k) {
        f32x16 z;
#pragma unroll
        for (int r = 0; r < 16; ++r) z[r] = 0.f;
        X[k] = __builtin_amdgcn_mfma_f32_32x32x16_bf16(ua.b, Bop[k], z, 0, 0, 0);
      }
#pragma unroll
      for (int sb = 0; sb < 2; ++sb) {
        f32x16& xr = X[sb * 2]; f32x16& xi = X[sb * 2 + 1];
        const float ar = pwr[sb][0], ai = pwi[sb][0], a4r = pwr[sb][3], a4i = pwi[sb][3];
        float Er[4], Ei[4], Or[4], Oi[4], mcr[4], mci[4];
#pragma unroll
        for (int q = 0; q < 4; ++q) {
#pragma unroll
          for (int i = 1; i < 4; ++i) {
            const int r = 4 * q + i;
            const float nr = ar * xr[r - 1] - ai * xi[r - 1] + xr[r];
            const float ni = ar * xi[r - 1] + ai * xr[r - 1] + xi[r];
            xr[r] = nr; xi[r] = ni;
          }
          Er[q] = xr[4 * q + 3]; Ei[q] = xi[4 * q + 3];
        }
#pragma unroll
        for (int q = 0; q < 4; ++q) { Or[q] = shx(Er[q], 32, lane); Oi[q] = shx(Ei[q], 32, lane); }
        float cr = hpr[sb], ci = hpi[sb];
#pragma unroll
        for (int q = 0; q < 4; ++q) {
          const float cer = cr, cei = ci;
          const float eer = hh ? Or[q] : Er[q], eei = hh ? Oi[q] : Ei[q];
          float tr = a4r * cr - a4i * ci + eer, ti = a4r * ci + a4i * cr + eei;
          cr = tr; ci = ti;
          const float cor = cr, coi = ci;
          const float eor = hh ? Er[q] : Or[q], eoi = hh ? Ei[q] : Oi[q];
          tr = a4r * cr - a4i * ci + eor; ti = a4r * ci + a4i * cr + eoi;
          cr = tr; ci = ti;
          mcr[q] = hh ? cor : cer; mci[q] = hh ? coi : cei;
        }
        hpr[sb] = cr; hpi[sb] = ci;
#pragma unroll
        for (int q = 0; q < 4; ++q)
#pragma unroll
          for (int i = 0; i < 4; ++i) {
            const int r = 4 * q + i;
            xr[r] += pwr[sb][i] * mcr[q] - pwi[sb][i] * mci[q];
            xi[r] += pwr[sb][i] * mci[q] + pwi[sb][i] * mcr[q];
          }
      }
#pragma unroll
      for (int q = 0; q < 4; ++q)
#pragma unroll
        for (int i = 0; i < 4; ++i) {
          const int r = 4 * q + i, tok = 8 * q + 4 * hh + i;
          uint2 w; w.x = pack2(X[0][r], X[1][r]); w.y = pack2(X[2][r], X[3][r]);
          *reinterpret_cast<uint2*>(hl + tok * SSM_PITCH + n0 * 8) = w;
        }
#pragma unroll
      for (int th = 0; th < 2; ++th) {
        f32x4 acc = f32x4{0.f, 0.f, 0.f, 0.f};
        const int tok = 16 * th + (lane & 15);
#pragma unroll
        for (int kb = 0; kb < 4; ++kb) {
          const bf16x8 hb = *reinterpret_cast<const bf16x8*>(hl + tok * SSM_PITCH + kb * 64 + (lane >> 4) * 16);
          acc = __builtin_amdgcn_mfma_f32_16x16x32_bf16(Cop[kb], hb, acc, 0, 0, 0);
        }
        const int row = base + sgn * tok;
        *reinterpret_cast<float4*>(YD + (size_t)row * 512 + g * 16 + 4 * (lane >> 4)) = float4{acc[0], acc[1], acc[2], acc[3]};
      }
    }
  }
  asm volatile("s_waitcnt vmcnt(0)" ::: "memory");
  __threadfence();
  __syncthreads();
  {
    const float* Y0 = reinterpret_cast<const float*>(p.ws + WS_YD);
    const float* Y1 = Y0 + (size_t)NTOK * 512;
    bf16_t* G = reinterpret_cast<bf16_t*>(p.ws + WS_G);
    const int ch = gq * 64 + (tid_ & 63);
    const float dsk = p.ssm_d[layer * 512 + ch];
    for (int i = tid_ >> 6; i < CTXL + SEQ; i += 8) {
      const int row = (i < CTXL) ? (NLAT + b * CTXL + i) : (b * SEQ + i - CTXL);
      const float y = Y0[(size_t)row * 512 + ch] + Y1[(size_t)row * 512 + ch] + dsk * bf2f(P[(size_t)row * INW + C_U + ch]);
      G[(size_t)row * 512 + ch] = f2bf(gelu_tanh(y));
    }
  }
}

template <int NBT, class KF>
__device__ __forceinline__ void attn_query(const bf16_t* qptr, const bf16_t* P, int kcol, int vcol, bool has_sink, float sink, bf16_t* optr, int lane, KF kf) {
  float q[64];
  {
    const uint4* qp = reinterpret_cast<const uint4*>(qptr);
#pragma unroll
    for (int i = 0; i < 8; ++i) {
      const uint4 w = qp[i];
      q[8 * i + 0] = __uint_as_float(w.x << 16); q[8 * i + 1] = __uint_as_float(w.x & 0xffff0000u);
      q[8 * i + 2] = __uint_as_float(w.y << 16); q[8 * i + 3] = __uint_as_float(w.y & 0xffff0000u);
      q[8 * i + 4] = __uint_as_float(w.z << 16); q[8 * i + 5] = __uint_as_float(w.z & 0xffff0000u);
      q[8 * i + 6] = __uint_as_float(w.w << 16); q[8 * i + 7] = __uint_as_float(w.w & 0xffff0000u);
    }
  }
  float s[NBT]; int kr[NBT];
  float mx = has_sink ? sink : -1e30f;
#pragma unroll
  for (int j = 0; j < NBT; ++j) {
    int krow; float bias;
    const bool valid = kf(j, lane, krow, bias);
    kr[j] = valid ? krow : -1;
    float dot = 0.f;
    if (valid) {
      const uint4* kp = reinterpret_cast<const uint4*>(P + (size_t)krow * INW + kcol);
#pragma unroll
      for (int i = 0; i < 8; ++i) {
        const uint4 w = kp[i];
        dot += q[8 * i + 0] * __uint_as_float(w.x << 16) + q[8 * i + 1] * __uint_as_float(w.x & 0xffff0000u)
             + q[8 * i + 2] * __uint_as_float(w.y << 16) + q[8 * i + 3] * __uint_as_float(w.y & 0xffff0000u)
             + q[8 * i + 4] * __uint_as_float(w.z << 16) + q[8 * i + 5] * __uint_as_float(w.z & 0xffff0000u)
             + q[8 * i + 6] * __uint_as_float(w.w << 16) + q[8 * i + 7] * __uint_as_float(w.w & 0xffff0000u);
      }
    }
    s[j] = valid ? (dot * 0.125f + bias) : -1e30f;
    mx = fmaxf(mx, s[j]);
  }
  mx = wave_max(mx, lane);
  float l = 0.f;
#pragma unroll
  for (int j = 0; j < NBT; ++j) { s[j] = (kr[j] >= 0) ? __expf(s[j] - mx) : 0.f; l += s[j]; }
  l = wave_sum(l, lane);
  if (has_sink) l += __expf(sink - mx);
  float o[64];
#pragma unroll
  for (int i = 0; i < 64; ++i) o[i] = 0.f;
#pragma unroll
  for (int j = 0; j < NBT; ++j) {
    if (kr[j] >= 0) {
      const uint4* vp = reinterpret_cast<const uint4*>(P + (size_t)kr[j] * INW + vcol);
      const float pj = s[j];
#pragma unroll
      for (int i = 0; i < 8; ++i) {
        const uint4 w = vp[i];
        o[8 * i + 0] += pj * __uint_as_float(w.x << 16); o[8 * i + 1] += pj * __uint_as_float(w.x & 0xffff0000u);
        o[8 * i + 2] += pj * __uint_as_float(w.y << 16); o[8 * i + 3] += pj * __uint_as_float(w.y & 0xffff0000u);
        o[8 * i + 4] += pj * __uint_as_float(w.z << 16); o[8 * i + 5] += pj * __uint_as_float(w.z & 0xffff0000u);
        o[8 * i + 6] += pj * __uint_as_float(w.w << 16); o[8 * i + 7] += pj * __uint_as_float(w.w & 0xffff0000u);
      }
    }
  }
#pragma unroll
  for (int i = 0; i < 32; ++i) { const bool up_ = (lane & 32) != 0; const float send = up_ ? o[i] : o[i + 32]; const float keep = up_ ? o[i + 32] : o[i]; o[i] = keep + shx(send, 32, lane); }
#pragma unroll
  for (int i = 0; i < 16; ++i) { const bool up_ = (lane & 16) != 0; const float send = up_ ? o[i] : o[i + 16]; const float keep = up_ ? o[i + 16] : o[i]; o[i] = keep + shx(send, 16, lane); }
#pragma unroll
  for (int i = 0; i < 8; ++i) { const bool up_ = (lane & 8) != 0; const float send = up_ ? o[i] : o[i + 8]; const float keep = up_ ? o[i + 8] : o[i]; o[i] = keep + shx(send, 8, lane); }
#pragma unroll
  for (int i = 0; i < 4; ++i) { const bool up_ = (lane & 4) != 0; const float send = up_ ? o[i] : o[i + 4]; const float keep = up_ ? o[i + 4] : o[i]; o[i] = keep + shx(send, 4, lane); }
#pragma unroll
  for (int i = 0; i < 2; ++i) { const bool up_ = (lane & 2) != 0; const float send = up_ ? o[i] : o[i + 2]; const float keep = up_ ? o[i + 2] : o[i]; o[i] = keep + shx(send, 2, lane); }
  { const bool up_ = (lane & 1) != 0; const float send = up_ ? o[0] : o[1]; const float keep = up_ ? o[1] : o[0]; o[0] = keep + shx(send, 1, lane); }
  optr[lane] = f2bf(o[0] / l);
}

__device__ __forceinline__ void mixer_item_naive(const Params& p, int layer, int item, bool need_ctx, unsigned char* lds_raw) {
  const int tid_ = opaque_tid();
  const bf16_t* P = reinterpret_cast<const bf16_t*>(p.ws + WS_P);
  bf16_t* Y = reinterpret_cast<bf16_t*>(p.ws + WS_Y);
  const int wv = tid_ >> 6;
  if (item < 64) { ssm_item(p, layer, item, lds_raw); return; }
  if (item < 320) {
    const int it = item - 64; const int b = it >> 5, blk = (it >> 1) & 15, hk = it & 1;
    const int hq = hk * 4 + (wv >> 1), half = wv & 1;
    const float sink = p.win_sink[layer * 8 + hq];
    for (int qi = 0; qi < 64; ++qi) {
      const int t = blk * 128 + half * 64 + qi;
      const int row = b * SEQ + t;
      attn_query<9>(P + (size_t)row * INW + C_WQ + hq * 64, P, C_WK + hk * 64, C_WV + hk * 64, true, sink, Y + (size_t)row * 1536 + 512 + hq * 64, tid_ & 63,
        [&](int j, int lane, int& krow, float& bias) -> bool {
          bias = 0.f;
          if (j < 5) { const int kp = t - 128 + j * 64 + lane; krow = b * SEQ + kp; return kp >= 0 && kp < SEQ && kp <= t + 128; }
          krow = NLAT + b * CTXL + (j - 5) * 64 + lane; return true;
        });
    }
    return;
  }
  if (item < 576) {
    const int it = item - 320; const int b = it >> 5, h = (it >> 2) & 7, rg = it & 3;
    const int r = rg * 8 + wv;
    int rs = r - 4; rs = rs < 0 ? 0 : (rs > 24 ? 24 : rs);
    const float* rpb = p.na_rpb + ((size_t)layer * 8 + h) * 15 * 31;
    for (int c = 0; c < 64; ++c) {
      const int row = b * SEQ + r * 64 + c;
      int cs = c - 8; cs = cs < 0 ? 0 : (cs > 48 ? 48 : cs);
      attn_query<6>(P + (size_t)row * INW + C_NQ + h * 64, P, C_NK + h * 64, C_NV + h * 64, false, 0.f, Y + (size_t)row * 1536 + 1024 + h * 64, tid_ & 63,
        [&](int j, int lane, int& krow, float& bias) -> bool {
          if (j < 2) {
            const int i = j * 64 + lane; const int kr_ = rs + (i >> 4), kc = cs + (i & 15);
            krow = b * SEQ + kr_ * 64 + kc;
            int dc = kc - c; dc = dc < -15 ? -15 : (dc > 15 ? 15 : dc);
            bias = rpb[(kr_ - r + 7) * 31 + dc + 15];
            return true;
          }
          bias = 0.f; krow = NLAT + b * CTXL + (j - 2) * 64 + lane; return true;
        });
    }
    return;
  }
  if (!need_ctx) return;
  if (item < 608) {
    const int it = item - 576; const int b = it >> 2, qb = it & 3;
    const int hq = wv, hk = hq >> 2;
    const float sink = p.win_sink[layer * 8 + hq];
    for (int qi = 0; qi < 64; ++qi) {
      const int row = NLAT + b * CTXL + qb * 64 + qi;
      attn_query<4>(P + (size_t)row * INW + C_WQ + hq * 64, P, C_WK + hk * 64, C_WV + hk * 64, true, sink, Y + (size_t)row * 1536 + 512 + hq * 64, tid_ & 63,
        [&](int j, int lane, int& krow, float& bias) -> bool { bias = 0.f; krow = NLAT + b * CTXL + j * 64 + lane; return true; });
    }
    return;
  }
  {
    const int it = item - 608; const int b = it >> 2, qb = it & 3;
    const int h = wv;
    for (int qi = 0; qi < 64; ++qi) {
      const int row = NLAT + b * CTXL + qb * 64 + qi;
      attn_query<4>(P + (size_t)row * INW + C_NQ + h * 64, P, C_NK + h * 64, C_NV + h * 64, false, 0.f, Y + (size_t)row * 1536 + 1024 + h * 64, tid_ & 63,
        [&](int j, int lane, int& krow, float& bias) -> bool { bias = 0.f; krow = NLAT + b * CTXL + j * 64 + lane; return true; });
    }
  }
}


constexpr int VT_TOK = CTXL + SEQ;
template <class TileFn, class ScoreFn>
__device__ __forceinline__ void attn_wave(const bf16_t* qrow0, int ntiles, TileFn tilefn, ScoreFn scorefn, float m_init, float l_init, bf16_t* orow0, int lane) {
  const int l31 = lane & 31, hh = lane >> 5;
  bf16x8 Qop[2][4];
#pragma unroll
  for (int qb = 0; qb < 2; ++qb)
#pragma unroll
    for (int s = 0; s < 4; ++s) Qop[qb][s] = *reinterpret_cast<const bf16x8*>(qrow0 + (size_t)(32 * qb + l31) * INW + 32 * hh + 8 * s);
  f32x16 O[2][2];
#pragma unroll
  for (int a = 0; a < 2; ++a)
#pragma unroll
    for (int b2 = 0; b2 < 2; ++b2)
#pragma unroll
      for (int r = 0; r < 16; ++r) O[a][b2][r] = 0.f;
  float m[2] = {m_init, m_init};
  float l[2]; l[0] = hh ? 0.f : l_init; l[1] = l[0];
  const unsigned kvo = (unsigned)(l31 * INW + 32 * hh) * 2u;
  const unsigned vvo = (unsigned)(l31 * VT_TOK + 4 * hh) * 2u;
  const bf16_t* kp; const bf16_t* vp; int info;
  tilefn(0, kp, vp, info);
  bf16x8 Kc[4]; uint2 Vc[2][2][2];
#pragma unroll
  for (int s = 0; s < 4; ++s) Kc[s] = *reinterpret_cast<const bf16x8*>(reinterpret_cast<const char*>(kp) + kvo + 16 * s);
#pragma unroll
  for (int db = 0; db < 2; ++db)
#pragma unroll
    for (int s = 0; s < 2; ++s)
#pragma unroll
      for (int pc = 0; pc < 2; ++pc) Vc[db][s][pc] = *reinterpret_cast<const uint2*>(reinterpret_cast<const char*>(vp) + vvo + (size_t)db * 32 * VT_TOK * 2 + (16 * s + 8 * pc) * 2);
  for (int t = 0; t < ntiles; ++t) {
    const int info_c = info;
    const int tn = (t + 1 < ntiles) ? (t + 1) : t;
    tilefn(tn, kp, vp, info);
    f32x16 S[2];
#pragma unroll
    for (int qb = 0; qb < 2; ++qb) {
#pragma unroll
      for (int r = 0; r < 16; ++r) S[qb][r] = 0.f;
#pragma unroll
      for (int s = 0; s < 4; ++s) S[qb] = __builtin_amdgcn_mfma_f32_32x32x16_bf16(Kc[s], Qop[qb][s], S[qb], 0, 0, 0);
    }
#pragma unroll
    for (int s = 0; s < 4; ++s) Kc[s] = *reinterpret_cast<const bf16x8*>(reinterpret_cast<const char*>(kp) + kvo + 16 * s);
    bf16x8 Pop[2][2];
#pragma unroll
    for (int qb = 0; qb < 2; ++qb) {
      scorefn(info_c, qb, S[qb]);
      float mt = S[qb][0];
#pragma unroll
      for (int r = 1; r < 16; ++r) mt = fmaxf(mt, S[qb][r]);
      mt = fmaxf(mt, shx(mt, 32, lane));
      const float mnew = fmaxf(m[qb], mt);
      const float alpha = __expf(m[qb] - mnew);
      m[qb] = mnew;
      float ls = 0.f;
#pragma unroll
      for (int r = 0; r < 16; ++r) { const float pv = __expf(S[qb][r] - mnew); S[qb][r] = pv; ls += pv; }
      l[qb] = l[qb] * alpha + ls;
#pragma unroll
      for (int db = 0; db < 2; ++db)
#pragma unroll
        for (int r = 0; r < 16; ++r) O[db][qb][r] *= alpha;
#pragma unroll
      for (int s = 0; s < 2; ++s) {
        union { unsigned u[4]; bf16x8 b; } pk;
#pragma unroll
        for (int j = 0; j < 4; ++j) pk.u[j] = pack2(S[qb][8 * s + 2 * j], S[qb][8 * s + 2 * j + 1]);
        Pop[qb][s] = pk.b;
      }
    }
#pragma unroll
    for (int db = 0; db < 2; ++db)
#pragma unroll
      for (int s = 0; s < 2; ++s) {
        union { uint2 u[2]; bf16x8 b; } va; va.u[0] = Vc[db][s][0]; va.u[1] = Vc[db][s][1];
#pragma unroll
        for (int qb = 0; qb < 2; ++qb) O[db][qb] = __builtin_amdgcn_mfma_f32_32x32x16_bf16(va.b, Pop[qb][s], O[db][qb], 0, 0, 0);
      }
#pragma unroll
    for (int db = 0; db < 2; ++db)
#pragma unroll
      for (int s = 0; s < 2; ++s)
#pragma unroll
        for (int pc = 0; pc < 2; ++pc) Vc[db][s][pc] = *reinterpret_cast<const uint2*>(reinterpret_cast<const char*>(vp) + vvo + (size_t)db * 32 * VT_TOK * 2 + (16 * s + 8 * pc) * 2);
  }
#pragma unroll
  for (int qb = 0; qb < 2; ++qb) {
    const float lt = l[qb] + shx(l[qb], 32, lane);
    const float inv = 1.0f / lt;
    bf16_t* orow = orow0 + (size_t)(32 * qb + l31) * 1536;
#pragma unroll
    for (int db = 0; db < 2; ++db)
#pragma unroll
      for (int gq = 0; gq < 4; ++gq)
        st_bf4(orow + 32 * db + 8 * gq + 4 * hh, O[db][qb][4 * gq] * inv, O[db][qb][4 * gq + 1] * inv, O[db][qb][4 * gq + 2] * inv, O[db][qb][4 * gq + 3] * inv);
  }
}

__device__ __forceinline__ void mixer_item(const Params& p, int layer, int item, bool need_ctx, unsigned char* lds_raw) {
  const int tid_ = opaque_tid();
  const bf16_t* P = reinterpret_cast<const bf16_t*>(p.ws + WS_P);
  const bf16_t* VT = reinterpret_cast<const bf16_t*>(p.ws + WS_VT);
  bf16_t* Y = reinterpret_cast<bf16_t*>(p.ws + WS_Y);
  const int wv = tid_ >> 6, lane = tid_ & 63;
  if (item < 64) { ssm_item(p, layer, item, lds_raw); return; }
  if (item < 320) {
    const int it = item - 64; const int b = it >> 5, blk = (it >> 1) & 15, hk = it & 1;
    const int hq = hk * 4 + (wv >> 1), half = wv & 1;
    const float sink = p.win_sink[layer * 8 + hq];
    const int t0 = blk * 128 + half * 64;
    int ilo = 0, ihi = 10;
    if (t0 - 128 < 0) ilo = (128 - t0) >> 5;
    if (t0 + 192 > SEQ) ihi = 10 - ((t0 + 192 - SEQ) >> 5);
    const bf16_t* kctx = P + (size_t)(NLAT + b * CTXL) * INW + C_WK + hk * 64;
    const bf16_t* klat = P + (size_t)(b * SEQ) * INW + C_WK + hk * 64;
    const bf16_t* vth = VT + (size_t)(b * 10 + hk) * 64 * VT_TOK;
    const int qrow0 = b * SEQ + t0;
    attn_wave(P + (size_t)qrow0 * INW + C_WQ + hq * 64, 8 + (ihi - ilo),
      [&](int i, const bf16_t*& kp, const bf16_t*& vp, int& info) {
        if (i < 8) { kp = kctx + (size_t)(32 * i) * INW; vp = vth + 32 * i; info = -100000; }
        else { const int key0 = t0 - 128 + 32 * (i - 8 + ilo); kp = klat + (size_t)key0 * INW; vp = vth + CTXL + key0; info = key0; }
      },
      [&](int info, int qb, f32x16& S) {
        if (info == -100000) {
#pragma unroll
          for (int r = 0; r < 16; ++r) S[r] *= 0.125f;
        } else {
          const int d0 = info + 4 * (lane >> 5) - (t0 + 32 * qb + (lane & 31));
#pragma unroll
          for (int r = 0; r < 16; ++r) { const int d = d0 + (r & 3) + 8 * (r >> 2); S[r] = (d >= -128 && d <= 128) ? S[r] * 0.125f : -1e30f; }
        }
      }, sink, 1.0f, Y + (size_t)qrow0 * 1536 + 512 + hq * 64, lane);
    return;
  }
  if (item < 576) {
    const int it = item - 320; const int b = it >> 5, h = (it >> 2) & 7, rg = it & 3;
    const int r = rg * 8 + wv;
    int rs = r - 4; rs = rs < 0 ? 0 : (rs > 24 ? 24 : rs);
    float* tbl = reinterpret_cast<float*>(lds_raw);
    __syncthreads();
    { const float* rpb = p.na_rpb + ((size_t)layer * 8 + h) * 15 * 31; for (int i = tid_; i < 15 * 31 + 128; i += NTHR) { const int j = i - 64; tbl[i] = (j >= 0 && j < 15 * 31) ? rpb[j] : 0.f; } }
    __syncthreads();
    const bf16_t* kctx = P + (size_t)(NLAT + b * CTXL) * INW + C_NK + h * 64;
    const bf16_t* klat = P + (size_t)(b * SEQ) * INW + C_NK + h * 64;
    const bf16_t* vth = VT + (size_t)(b * 10 + 2 + h) * 64 * VT_TOK;
    const int qrow0 = b * SEQ + r * 64;
    attn_wave(P + (size_t)qrow0 * INW + C_NQ + h * 64, 8 + 16,
      [&](int i, const bf16_t*& kp, const bf16_t*& vp, int& info) {
        if (i < 8) { kp = kctx + (size_t)(32 * i) * INW; vp = vth + 32 * i; info = -1; }
        else { const int j = i - 8; const int key0 = rs * 64 + 32 * j; kp = klat + (size_t)key0 * INW; vp = vth + CTXL + key0; info = j; }
      },
      [&](int info, int qb, f32x16& S) {
        if (info < 0) {
#pragma unroll
          for (int r2 = 0; r2 < 16; ++r2) S[r2] *= 0.125f;
        } else {
          const int kr = rs + (info >> 1), jh = info & 1;
          const int qc = 32 * qb + (lane & 31);
          int cs = qc - 8; cs = cs < 0 ? 0 : (cs > 48 ? 48 : cs);
          const int kc0 = jh * 32 + 4 * (lane >> 5);
          const float* tb = tbl + 64 + (kr - r + 7) * 31 + kc0 - qc + 15;
#pragma unroll
          for (int r2 = 0; r2 < 16; ++r2) {
            const int ko = (r2 & 3) + 8 * (r2 >> 2);
            const int kc = kc0 + ko;
            S[r2] = (kc >= cs && kc < cs + 16) ? (S[r2] * 0.125f + tb[ko]) : -1e30f;
          }
        }
      }, -1e30f, 0.0f, Y + (size_t)qrow0 * 1536 + 1024 + h * 64, lane);
    return;
  }
  if (!need_ctx) return;
  if (item < 608) {
    const int it = item - 576; const int b = it >> 2, qb4 = it & 3;
    const int hq = wv, hk = hq >> 2;
    const float sink = p.win_sink[layer * 8 + hq];
    const bf16_t* kctx = P + (size_t)(NLAT + b * CTXL) * INW + C_WK + hk * 64;
    const bf16_t* vth = VT + (size_t)(b * 10 + hk) * 64 * VT_TOK;
    const int qrow0 = NLAT + b * CTXL + qb4 * 64;
    attn_wave(P + (size_t)qrow0 * INW + C_WQ + hq * 64, 8,
      [&](int i, const bf16_t*& kp, const bf16_t*& vp, int& info) { kp = kctx + (size_t)(32 * i) * INW; vp = vth + 32 * i; info = 0; },
      [&](int info, int qb, f32x16& S) {
#pragma unroll
        for (int r2 = 0; r2 < 16; ++r2) S[r2] *= 0.125f;
      }, sink, 1.0f, Y + (size_t)qrow0 * 1536 + 512 + hq * 64, lane);
    return;
  }
  {
    const int it = item - 608; const int b = it >> 2, qb4 = it & 3;
    const int h = wv;
    const bf16_t* kctx = P + (size_t)(NLAT + b * CTXL) * INW + C_NK + h * 64;
    const bf16_t* vth = VT + (size_t)(b * 10 + 2 + h) * 64 * VT_TOK;
    const int qrow0 = NLAT + b * CTXL + qb4 * 64;
    attn_wave(P + (size_t)qrow0 * INW + C_NQ + h * 64, 8,
      [&](int i, const bf16_t*& kp, const bf16_t*& vp, int& info) { kp = kctx + (size_t)(32 * i) * INW; vp = vth + 32 * i; info = 0; },
      [&](int info, int qb, f32x16& S) {
#pragma unroll
        for (int r2 = 0; r2 < 16; ++r2) S[r2] *= 0.125f;
      }, -1e30f, 0.0f, Y + (size_t)qrow0 * 1536 + 1024 + h * 64, lane);
  }
}

__device__ __forceinline__ void route_phase(const Params& p, int layer, int ntok, float* lds_f) {
  const int tid_ = opaque_tid();
  const float* mod = reinterpret_cast<const float*>(p.ws + WS_MOD);
  bf16_t* F = reinterpret_cast<bf16_t*>(p.ws + WS_H);
  int* tke = reinterpret_cast<int*>(p.ws + WS_TKE);
  int* tkp = reinterpret_cast<int*>(p.ws + WS_TKP);
  float* tkg = reinterpret_cast<float*>(p.ws + WS_TKG);
  int* tlist = reinterpret_cast<int*>(p.ws + WS_TLIST);
  unsigned* cnt = reinterpret_cast<unsigned*>(p.ws + WS_CTL) + CW_CNT + layer * 32;
  const int lane = tid_ & 63, wv = tid_ >> 6;
  float* frow = lds_f;
  float* part = lds_f + 8 * 1024;
  const float* gw = p.norm_ffn + layer * D;
  const float* rw = p.router_w + (size_t)layer * D * NEXP;
  const float rb = p.router_b[layer * NEXP + (lane & 31)];
  const int e = tid_ & 31, ks = tid_ >> 5;
  float rwreg[64];
#pragma unroll
  for (int i = 0; i < 64; ++i) rwreg[i] = rw[(size_t)(ks * 64 + i) * NEXP + e];
  const int ngroups = ntok >> 3;
  for (int grp = blockIdx.x; grp < ngroups; grp += gridDim.x) {
    const int row = grp * 8 + wv;
    {
      const float* xr = stream_row(p, row);
      const int mi = row_modidx(row);
      float v[16];
#pragma unroll
      for (int i = 0; i < 4; ++i) { const float4 q = *reinterpret_cast<const float4*>(xr + i * 256 + lane * 4); v[4 * i] = q.x; v[4 * i + 1] = q.y; v[4 * i + 2] = q.z; v[4 * i + 3] = q.w; }
      float ss = 0.f;
#pragma unroll
      for (int i = 0; i < 16; ++i) ss += v[i] * v[i];
      ss = wave_sum(ss, lane);
      const float rinv = rsqrtf(ss * (1.0f / D) + 1e-6f);
      const float* msh = mod + ((size_t)layer * 9 + mi) * 6144 + 3 * 1024;
#pragma unroll
      for (int i = 0; i < 4; ++i) {
        const int c = i * 256 + lane * 4;
        const float4 g = *reinterpret_cast<const float4*>(gw + c);
        const float4 sh = *reinterpret_cast<const float4*>(msh + c);
        const float4 sc = *reinterpret_cast<const float4*>(msh + 1024 + c);
        const float f0 = v[4 * i] * rinv * g.x * (1.f + sc.x) + sh.x, f1 = v[4 * i + 1] * rinv * g.y * (1.f + sc.y) + sh.y;
        const float f2 = v[4 * i + 2] * rinv * g.z * (1.f + sc.z) + sh.z, f3 = v[4 * i + 3] * rinv * g.w * (1.f + sc.w) + sh.w;
        st_bf4(F + (size_t)row * D + c, f0, f1, f2, f3);
        *reinterpret_cast<float4*>(frow + wv * 1024 + c) = float4{f0, f1, f2, f3};
      }
    }
    __syncthreads();
#pragma unroll
    for (int j = 0; j < 8; ++j) {
      const float* fp = frow + j * 1024 + ks * 64;
      float a0 = 0.f, a1 = 0.f;
#pragma unroll
      for (int i = 0; i < 64; i += 4) {
        const float4 f4 = *reinterpret_cast<const float4*>(fp + i);
        a0 += f4.x * rwreg[i]; a1 += f4.y * rwreg[i + 1]; a0 += f4.z * rwreg[i + 2]; a1 += f4.w * rwreg[i + 3];
      }
      part[(j * 16 + ks) * 32 + e] = a0 + a1;
    }
    __syncthreads();
    {
      const int ee = lane & 31;
      float acc = 0.f;
#pragma unroll
      for (int k2 = 0; k2 < 16; ++k2) acc += part[(wv * 16 + k2) * 32 + ee];
      const float logit = acc + rb;
      int sel_e[4]; float sel_v[4];
      float cur = logit;
#pragma unroll
      for (int k = 0; k < 4; ++k) {
        float bv = cur; int bi = ee;
#pragma unroll
        for (int o = 16; o >= 1; o >>= 1) {
          const float ov = shx(bv, o, lane); const int oi = shx(bi, o, lane);
          if (ov > bv || (ov == bv && oi < bi)) { bv = ov; bi = oi; }
        }
        sel_e[k] = bi; sel_v[k] = bv;
        if (ee == bi) cur = -3.0e38f;
      }
      const float m0 = sel_v[0];
      const float e0 = 1.f, e1 = __expf(sel_v[1] - m0), e2 = __expf(sel_v[2] - m0), e3 = __expf(sel_v[3] - m0);
      const float inv = 1.f / (e0 + e1 + e2 + e3);
      if (lane < 4) {
        const int ex = (lane == 0) ? sel_e[0] : (lane == 1) ? sel_e[1] : (lane == 2) ? sel_e[2] : sel_e[3];
        const float gg = ((lane == 0) ? e0 : (lane == 1) ? e1 : (lane == 2) ? e2 : e3) * inv;
        const unsigned pos = __hip_atomic_fetch_add(&cnt[ex], 1u, __ATOMIC_RELAXED, __HIP_MEMORY_SCOPE_AGENT);
        tke[row * 4 + lane] = ex; tkp[row * 4 + lane] = (int)pos; tkg[row * 4 + lane] = gg;
        tlist[(size_t)ex * NTOK + pos] = row;
      }
    }
  }
}

__device__ __forceinline__ void phase_inproj(const Params& p, int layer, LAS unsigned char* lds) {
  const int G = gridDim.x, bid = blockIdx.x;
  const bf16_t* A = reinterpret_cast<const bf16_t*>(p.ws + WS_H);
  const bf16_t* Bt = reinterpret_cast<const bf16_t*>(p.ws + WS_WIN) + (size_t)layer * INW * 1024;
  bf16_t* P = reinterpret_cast<bf16_t*>(p.ws + WS_P);
  for (int i = 0;; ++i) {
    int pm, pn; if (!unit_next(i * G + bid, NTOK / 256, INW / 256, pm, pn)) break;
    const int ar0 = pm * 256, br0 = pn * 256; const int tz = opaque_tid();
    gemm_tile(lds, (const char*)(A + (size_t)ar0 * 1024), (const char*)(A + (size_t)(ar0 + 128) * 1024), stage_voff(tz, 0, 1024), stage_voff(tz, 1, 1024), stage_voff(tz, 0, 1024), stage_voff(tz, 1, 1024),
              (const char*)(Bt + (size_t)br0 * 1024), (const char*)(Bt + (size_t)(br0 + 128) * 1024), stage_voff(tz, 0, 1024), stage_voff(tz, 1, 1024), 16, tz,
      [&](int r, int c, f32x4 v0, f32x4 v1) {
        bf16_t* o = P + (size_t)(ar0 + r) * INW + br0 + c;
        if (br0 >= C_GATE) { st_bf4(o, sigmoidf(v0[0]), sigmoidf(v0[1]), sigmoidf(v0[2]), sigmoidf(v0[3])); st_bf4(o + 128, sigmoidf(v1[0]), sigmoidf(v1[1]), sigmoidf(v1[2]), sigmoidf(v1[3])); }
        else { st_bf4(o, v0[0], v0[1], v0[2], v0[3]); st_bf4(o + 128, v1[0], v1[1], v1[2], v1[3]); }
      });
  }
}

__device__ __forceinline__ void phase_mixers(const Params& p, int layer, bool need_ctx, int* misc_i, unsigned char* lds_raw, int rep) {
  unsigned* head = reinterpret_cast<unsigned*>(p.ws + WS_CTL) + CW_WQ + layer * 64 + rep * 16;
  for (;;) {
    __syncthreads();
    if (threadIdx.x == 0) misc_i[40] = (int)__hip_atomic_fetch_add(head, 1u, __ATOMIC_RELAXED, __HIP_MEMORY_SCOPE_AGENT);
    __syncthreads();
    const int item = misc_i[40];
    if (item >= 640) break;
    mixer_item(p, layer, item, need_ctx, lds_raw);
  }
}

__device__ __forceinline__ void phase_glu(const Params& p, int layer, int mrows, LAS unsigned char* lds) {
  const int G = gridDim.x, bid = blockIdx.x;
  const bf16_t* A = reinterpret_cast<const bf16_t*>(p.ws + WS_G);
  const bf16_t* Bt = reinterpret_cast<const bf16_t*>(p.ws + WS_WGLU) + (size_t)layer * 512 * 512;
  bf16_t* Y = reinterpret_cast<bf16_t*>(p.ws + WS_Y);
  for (int i = 0;; ++i) {
    int pm, pn; if (!unit_next(i * G + bid, mrows / 256, 2, pm, pn)) break;
    const int ar0 = pm * 256, br0 = pn * 256; const int tz = opaque_tid();
    gemm_tile(lds, (const char*)(A + (size_t)ar0 * 512), (const char*)(A + (size_t)(ar0 + 128) * 512), stage_voff(tz, 0, 512), stage_voff(tz, 1, 512), stage_voff(tz, 0, 512), stage_voff(tz, 1, 512),
              (const char*)(Bt + (size_t)br0 * 512), (const char*)(Bt + (size_t)(br0 + 128) * 512), stage_voff(tz, 0, 512), stage_voff(tz, 1, 512), 8, tz,
      [&](int r, int c, f32x4 v0, f32x4 v1) {
        const bf16_t* gi = A + (size_t)(ar0 + r) * 512 + br0 + c;
        bf16_t* o = Y + (size_t)(ar0 + r) * 1536 + br0 + c;
        float g0, g1, g2, g3;
        ld_bf4(gi, g0, g1, g2, g3); st_bf4(o, g0 * sigmoidf(v0[0]), g1 * sigmoidf(v0[1]), g2 * sigmoidf(v0[2]), g3 * sigmoidf(v0[3]));
        ld_bf4(gi + 128, g0, g1, g2, g3); st_bf4(o + 128, g0 * sigmoidf(v1[0]), g1 * sigmoidf(v1[1]), g2 * sigmoidf(v1[2]), g3 * sigmoidf(v1[3]));
      });
  }
}

__device__ __forceinline__ void phase_merge1(const Params& p, int layer, int mrows, LAS unsigned char* lds) {
  const int G = gridDim.x, bid = blockIdx.x;
  const bf16_t* Yb = reinterpret_cast<const bf16_t*>(p.ws + WS_Y);
  const bf16_t* P = reinterpret_cast<const bf16_t*>(p.ws + WS_P);
  float* S = reinterpret_cast<float*>(p.ws + WS_S);
  bf16_t* SB = reinterpret_cast<bf16_t*>(p.ws + WS_SB);
  for (int i = 0;; ++i) {
    int pm, pn; if (!unit_next(i * G + bid, mrows / 256, 4, pm, pn)) break;
    const int ar0 = pm * 256, br0 = pn * 256; const int tz = opaque_tid();
    for (int br = 0; br < 3; ++br) {
      const bf16_t* A = Yb + br * 512;
      const bf16_t* Bt = reinterpret_cast<const bf16_t*>(p.ws + WS_WBR) + (size_t)(layer * 3 + br) * 1024 * 512;
      gemm_tile(lds, (const char*)(A + (size_t)ar0 * 1536), (const char*)(A + (size_t)(ar0 + 128) * 1536), stage_voff(tz, 0, 1536), stage_voff(tz, 1, 1536), stage_voff(tz, 0, 1536), stage_voff(tz, 1, 1536),
                (const char*)(Bt + (size_t)br0 * 512), (const char*)(Bt + (size_t)(br0 + 128) * 512), stage_voff(tz, 0, 512), stage_voff(tz, 1, 512), 8, tz,
        [&](int r, int c, f32x4 v0, f32x4 v1) {
          const size_t ro = (size_t)(ar0 + r);
          const bf16_t* gp = P + ro * INW + C_GATE + br * 1024 + br0 + c;
          float* sp = S + ro * D + br0 + c;
          float g0, g1, g2, g3;
          ld_bf4(gp, g0, g1, g2, g3);
          float4 a = float4{g0 * v0[0], g1 * v0[1], g2 * v0[2], g3 * v0[3]};
          ld_bf4(gp + 128, g0, g1, g2, g3);
          float4 b = float4{g0 * v1[0], g1 * v1[1], g2 * v1[2], g3 * v1[3]};
          if (br > 0) { const float4 pa = *reinterpret_cast<const float4*>(sp); const float4 pb2 = *reinterpret_cast<const float4*>(sp + 128);
                        a.x += pa.x; a.y += pa.y; a.z += pa.z; a.w += pa.w; b.x += pb2.x; b.y += pb2.y; b.z += pb2.z; b.w += pb2.w; }
          if (br < 2) { *reinterpret_cast<float4*>(sp) = a; *reinterpret_cast<float4*>(sp + 128) = b; }
          else { bf16_t* o = SB + ro * D + br0 + c; st_bf4(o, a.x, a.y, a.z, a.w); st_bf4(o + 128, b.x, b.y, b.z, b.w); }
        });
    }
  }
}

__device__ __forceinline__ void phase_merge2(const Params& p, int layer, int mrows, LAS unsigned char* lds) {
  const int G = gridDim.x, bid = blockIdx.x;
  const bf16_t* A = reinterpret_cast<const bf16_t*>(p.ws + WS_SB);
  const bf16_t* Bt = reinterpret_cast<const bf16_t*>(p.ws + WS_WOUT) + (size_t)layer * 1024 * 1024;
  const float* mod = reinterpret_cast<const float*>(p.ws + WS_MOD);
  for (int i = 0;; ++i) {
    int pm, pn; if (!unit_next(i * G + bid, mrows / 256, 4, pm, pn)) break;
    const int ar0 = pm * 256, br0 = pn * 256; const int tz = opaque_tid();
    gemm_tile(lds, (const char*)(A + (size_t)ar0 * 1024), (const char*)(A + (size_t)(ar0 + 128) * 1024), stage_voff(tz, 0, 1024), stage_voff(tz, 1, 1024), stage_voff(tz, 0, 1024), stage_voff(tz, 1, 1024),
              (const char*)(Bt + (size_t)br0 * 1024), (const char*)(Bt + (size_t)(br0 + 128) * 1024), stage_voff(tz, 0, 1024), stage_voff(tz, 1, 1024), 16, tz,
      [&](int r, int c, f32x4 v0, f32x4 v1) {
        const int row = ar0 + r;
        float* xr = stream_row(p, row) + br0 + c;
        const float* m2 = mod + ((size_t)layer * 9 + row_modidx(row)) * 6144 + 2 * 1024 + br0 + c;
        float4 a = *reinterpret_cast<const float4*>(xr); const float4 ma = *reinterpret_cast<const float4*>(m2);
        a.x += ma.x * v0[0]; a.y += ma.y * v0[1]; a.z += ma.z * v0[2]; a.w += ma.w * v0[3];
        *reinterpret_cast<float4*>(xr) = a;
        float4 b = *reinterpret_cast<const float4*>(xr + 128); const float4 mb = *reinterpret_cast<const float4*>(m2 + 128);
        b.x += mb.x * v1[0]; b.y += mb.y * v1[1]; b.z += mb.z * v1[2]; b.w += mb.w * v1[3];
        *reinterpret_cast<float4*>(xr + 128) = b;
      });
  }
}

__device__ __forceinline__ int moe_tables(const unsigned* cnt, int* est, int ntn) {
  __syncthreads();
  if (threadIdx.x == 0) { int s = 0, u = 0; for (int e = 0; e < NEXP; ++e) { est[e] = s; est[64 + e] = u; const int c = (int)cnt[e]; s += c; u += ((c + 255) >> 8) * ntn; } est[NEXP] = s; est[64 + NEXP] = u; }
  __syncthreads();
  return est[64 + NEXP];
}
__device__ __forceinline__ void moe_unit(const int* est, int total, int L, int& e, int& cnte, int& pmt, int& pnt) {
  int wgid = L; { const int q = total / 8, r = total % 8, xcd = wgid % 8, off = wgid / 8; wgid = (xcd < r ? xcd * (q + 1) : r * (q + 1) + (xcd - r) * q) + off; }
  e = 0; while (est[64 + e + 1] <= wgid) ++e;
  const int idx = wgid - est[64 + e]; cnte = est[e + 1] - est[e]; const int tm = (cnte + 255) >> 8;
  pmt = idx % tm; pnt = idx / tm;
}

__device__ __forceinline__ void phase_moe1(const Params& p, int layer, LAS unsigned char* lds, int* est) {
  const int G = gridDim.x, bid = blockIdx.x;
  const unsigned* cnt = reinterpret_cast<const unsigned*>(p.ws + WS_CTL) + CW_CNT + layer * 32;
  const int total = moe_tables(cnt, est, 8);
  const bf16_t* F = reinterpret_cast<const bf16_t*>(p.ws + WS_H);
  const int* tlist = reinterpret_cast<const int*>(p.ws + WS_TLIST);
  bf16_t* ACT = reinterpret_cast<bf16_t*>(p.ws + WS_ACT);
  for (int L = bid; L < total; L += G) {
    int e, cnte, pmt, pnt; moe_unit(est, total, L, e, cnte, pmt, pnt);
    const int m0 = pmt * 256, br0 = pnt * 256; const int tz = opaque_tid();
    const int* tl = tlist + (size_t)e * NTOK;
    int R0, C0, R1, C1; stage_rc(tz * 16, R0, C0); stage_rc(tz * 16 + 8192, R1, C1);
    const int r00 = m0 + R0, r01 = m0 + R1, r10 = m0 + 128 + R0, r11 = m0 + 128 + R1;
    const int t00 = ((r00 < cnte) ? tl[r00] : 0) * 1024, t01 = ((r01 < cnte) ? tl[r01] : 0) * 1024, t10 = ((r10 < cnte) ? tl[r10] : 0) * 1024, t11 = ((r11 < cnte) ? tl[r11] : 0) * 1024;
    const bf16_t* Bt = reinterpret_cast<const bf16_t*>(p.ws + WS_WGU) + (size_t)(layer * NEXP + e) * 2048 * 1024;
    const float* bg = p.b_gu + (size_t)(layer * NEXP + e) * 2048 + pnt * 128;
    const int arow0 = est[e] + m0;
    gemm_tile(lds, (const char*)F, (const char*)F, (unsigned)(t00 + C0) * 2u, (unsigned)(t01 + C1) * 2u, (unsigned)(t10 + C0) * 2u, (unsigned)(t11 + C1) * 2u,
              (const char*)(Bt + (size_t)br0 * 1024), (const char*)(Bt + (size_t)(br0 + 128) * 1024), stage_voff(tz, 0, 1024), stage_voff(tz, 1, 1024), 16, tz,
      [&](int r, int c, f32x4 v0, f32x4 v1) {
        if (m0 + r < cnte) {
          const float4 b0 = *reinterpret_cast<const float4*>(bg + c); const float4 b1 = *reinterpret_cast<const float4*>(bg + 1024 + c);
          float o[4];
          const float gg[4] = {v0[0] + b0.x, v0[1] + b0.y, v0[2] + b0.z, v0[3] + b0.w};
          const float uu[4] = {v1[0] + b1.x, v1[1] + b1.y, v1[2] + b1.z, v1[3] + b1.w};
#pragma unroll
          for (int j = 0; j < 4; ++j) { const float g = fminf(gg[j], 7.0f); const float u = fminf(fmaxf(uu[j], -7.0f), 7.0f); o[j] = (u + 1.0f) * (g * sigmoidf(1.702f * g)); }
          st_bf4(ACT + (size_t)(arow0 + r) * 1024 + pnt * 128 + c, o[0], o[1], o[2], o[3]);
        }
      });
  }
}

__device__ __forceinline__ void phase_moe2(const Params& p, int layer, LAS unsigned char* lds, int* est) {
  const int G = gridDim.x, bid = blockIdx.x;
  const unsigned* cnt = reinterpret_cast<const unsigned*>(p.ws + WS_CTL) + CW_CNT + layer * 32;
  const int total = moe_tables(cnt, est, 4);
  const bf16_t* ACT = reinterpret_cast<const bf16_t*>(p.ws + WS_ACT);
  bf16_t* YB = reinterpret_cast<bf16_t*>(p.ws + WS_YB);
  for (int L = bid; L < total; L += G) {
    int e, cnte, pmt, pnt; moe_unit(est, total, L, e, cnte, pmt, pnt);
    const int m0 = pmt * 256, br0 = pnt * 256; const int tz = opaque_tid();
    const int arow0 = est[e] + m0;
    const bf16_t* Bt = reinterpret_cast<const bf16_t*>(p.ws + WS_WDN) + (size_t)(layer * NEXP + e) * 1024 * 1024;
    const float* bd = p.b_dn + (size_t)(layer * NEXP + e) * 1024 + br0;
    gemm_tile(lds, (const char*)(ACT + (size_t)arow0 * 1024), (const char*)(ACT + (size_t)(arow0 + 128) * 1024), stage_voff(tz, 0, 1024), stage_voff(tz, 1, 1024), stage_voff(tz, 0, 1024), stage_voff(tz, 1, 1024),
              (const char*)(Bt + (size_t)br0 * 1024), (const char*)(Bt + (size_t)(br0 + 128) * 1024), stage_voff(tz, 0, 1024), stage_voff(tz, 1, 1024), 16, tz,
      [&](int r, int c, f32x4 v0, f32x4 v1) {
        if (m0 + r < cnte) {
          const float4 b0 = *reinterpret_cast<const float4*>(bd + c); const float4 b1 = *reinterpret_cast<const float4*>(bd + 128 + c);
          bf16_t* o = YB + (size_t)(arow0 + r) * 1024 + br0 + c;
          st_bf4(o, v0[0] + b0.x, v0[1] + b0.y, v0[2] + b0.z, v0[3] + b0.w);
          st_bf4(o + 128, v1[0] + b1.x, v1[1] + b1.y, v1[2] + b1.z, v1[3] + b1.w);
        }
      });
  }
}

__device__ __forceinline__ void phase_prologue(const Params& p, float* ldsf) {
  const int tid_ = opaque_tid();
  const int G = gridDim.x, bid = blockIdx.x;
  conv_mats<0>(p.w_in, reinterpret_cast<bf16_t*>(p.ws + WS_WIN), DEPTH, 1024, INW, ldsf, tid_);
  conv_mats<0>(p.w_glu, reinterpret_cast<bf16_t*>(p.ws + WS_WGLU), DEPTH, 512, 512, ldsf, tid_);
  conv_mats<0>(p.w_branch, reinterpret_cast<bf16_t*>(p.ws + WS_WBR), DEPTH * 3, 512, 1024, ldsf, tid_);
  conv_mats<0>(p.w_out, reinterpret_cast<bf16_t*>(p.ws + WS_WOUT), DEPTH, 1024, 1024, ldsf, tid_);
  conv_mats<1>(p.w_gu, reinterpret_cast<bf16_t*>(p.ws + WS_WGU), DEPTH * NEXP, 1024, 2048, ldsf, tid_);
  conv_mats<0>(p.w_dn, reinterpret_cast<bf16_t*>(p.ws + WS_WDN), DEPTH * NEXP, 1024, 1024, ldsf, tid_);
  mod_phase(p, ldsf);
  const float4* xs = reinterpret_cast<const float4*>(p.x); float4* xo = reinterpret_cast<float4*>(p.out);
  for (size_t i = (size_t)bid * NTHR + tid_; i < (size_t)NLAT * D / 4; i += (size_t)G * NTHR) xo[i] = xs[i];
  const float4* cs = reinterpret_cast<const float4*>(p.ctx); float4* co = reinterpret_cast<float4*>(p.ws + WS_CX);
  for (size_t i = (size_t)bid * NTHR + tid_; i < (size_t)NCTX * D / 4; i += (size_t)G * NTHR) co[i] = cs[i];
}

#ifndef ONLY
#define ONLY -1
#endif
#ifndef REP_PRO
#define REP_PRO 1
#endif
#ifndef REP_GEMM
#define REP_GEMM 1
#endif
#ifndef REP_PC
#define REP_PC 1
#endif
#ifndef REP_MOE
#define REP_MOE 1
#endif
#define PH_ON(idx, k) ((ONLY < 0 || ONLY == (k)) && p.ph_lo <= (idx) && (idx) < p.ph_hi)
#define PH_END(idx) do { if ((idx) + 1 < p.ph_hi) xcd_barrier(bar); } while (0)

__global__ void __launch_bounds__(512, 2) fwd(Params p) {
  extern __shared__ __attribute__((aligned(16))) unsigned char lds_raw[];
  LAS unsigned char* shm = (LAS unsigned char*)lds_raw;
  unsigned* misc_u = reinterpret_cast<unsigned*>(lds_raw + LDS_MISC);
  int* misc_i = reinterpret_cast<int*>(lds_raw + LDS_MISC + 64);
  unsigned* ctl = reinterpret_cast<unsigned*>(p.ws + WS_CTL);
  if (threadIdx.x < 4) misc_u[threadIdx.x] = 0u;
  __syncthreads();
  XcdBarrier bar = xcd_barrier_post(ctl + CW_BAR, (volatile LAS unsigned*)misc_u);

  if (PH_ON(0, 10)) { for (int rep = 0; rep < REP_PRO; ++rep) phase_prologue(p, reinterpret_cast<float*>(lds_raw)); PH_END(0); }

  for (int layer = 0; layer < DEPTH; ++layer) {
    const int pb = 1 + layer * 10;
    const bool need_ctx = layer < DEPTH - 1;
    const int mrows = need_ctx ? NTOK : NLAT;
    if (PH_ON(pb + 0, 0)) { norm_phase(p, layer, layer > 0, misc_i); PH_END(pb + 0); }
    if (PH_ON(pb + 1, 1)) { for (int rep = 0; rep < REP_GEMM; ++rep) phase_inproj(p, layer, shm); PH_END(pb + 1); }
    if (PH_ON(pb + 2, 2)) { qknorm_phase(p, layer); PH_END(pb + 2); }
    if (PH_ON(pb + 3, 3)) { for (int rep = 0; rep < REP_PC; ++rep) phase_mixers(p, layer, need_ctx, misc_i, lds_raw, rep); PH_END(pb + 3); }
    if (PH_ON(pb + 4, 4)) { for (int rep = 0; rep < REP_GEMM; ++rep) phase_glu(p, layer, mrows, shm); PH_END(pb + 4); }
    if (PH_ON(pb + 5, 5)) { for (int rep = 0; rep < REP_GEMM; ++rep) phase_merge1(p, layer, mrows, shm); PH_END(pb + 5); }
    if (PH_ON(pb + 6, 6)) { phase_merge2(p, layer, mrows, shm); PH_END(pb + 6); }
    if (PH_ON(pb + 7, 7)) { route_phase(p, layer, mrows, reinterpret_cast<float*>(lds_raw)); PH_END(pb + 7); }
    if (PH_ON(pb + 8, 8)) { for (int rep = 0; rep < REP_MOE; ++rep) phase_moe1(p, layer, shm, misc_i); PH_END(pb + 8); }
    if (PH_ON(pb + 9, 9)) { for (int rep = 0; rep < REP_MOE; ++rep) phase_moe2(p, layer, shm, misc_i); PH_END(pb + 9); }
  }
  if (PH_ON(41, 11)) { final_combine(p, misc_i); }
}

extern "C" void kernel_launch(void* const* d_in, const int* in_sizes, int n_in, void* d_out, int out_size, void* d_ws, size_t ws_size, hipStream_t stream) {
  static int grid = 0;
  if (grid == 0) {
    if (n_in != 32 || out_size != NLAT * D || ws_size < WS_END) { fprintf(stderr, "kernel_launch: unexpected shapes (n_in %d out %d ws %zu need %zu)\n", n_in, out_size, ws_size, (size_t)WS_END); grid = -1; return; }
    int dev = 0, cus = 0, per_cu = 0;
    if (hipGetDevice(&dev) != hipSuccess || hipDeviceGetAttribute(&cus, hipDeviceAttributeMultiprocessorCount, dev) != hipSuccess) { grid = -1; return; }
    if (hipFuncSetAttribute((const void*)fwd, hipFuncAttributeMaxDynamicSharedMemorySize, LDS_BYTES) != hipSuccess) { fprintf(stderr, "kernel_launch: hipFuncSetAttribute failed\n"); grid = -1; return; }
    if (hipOccupancyMaxActiveBlocksPerMultiprocessor(&per_cu, (const void*)fwd, NTHR, LDS_BYTES) != hipSuccess || per_cu < 1) fprintf(stderr, "kernel_launch: occupancy query reports %d\n", per_cu);
    (void)hipGetLastError();
    grid = cus;
  }
  if (grid < 0) return;
  (void)hipMemsetAsync((char*)d_ws + WS_CTL, 0, CTL_BYTES, stream);
  Params p{};
  const float** f = reinterpret_cast<const float**>(&p);
  for (int i = 0; i < 32; ++i) f[i] = (const float*)d_in[i];
  p.out = (float*)d_out; p.ws = (unsigned char*)d_ws; p.ph_lo = 0; p.ph_hi = 42;
  hipLaunchKernelGGL(fwd, dim3(grid), dim3(NTHR), LDS_BYTES, stream, p);
}
```

```cpp
#include <hip/hip_runtime.h>
#include <stdint.h>
#include <stdio.h>

typedef unsigned short bf16_t;
typedef short bf16x8 __attribute__((ext_vector_type(8)));
typedef float f32x4 __attribute__((ext_vector_type(4)));
#define LAS __attribute__((address_space(3)))

constexpr int D = 1024, NB = 8, SEQ = 2048, DEPTH = 4, CTXL = 256;
constexpr int NLAT = NB * SEQ, NCTX = NB * CTXL, NTOK = NLAT + NCTX;
constexpr int INW = 5888;
constexpr int C_U = 0, C_WQ = 512, C_WK = 1024, C_WV = 1152, C_NQ = 1280, C_NK = 1792, C_NV = 2304, C_GATE = 2816;
constexpr int NEXP = 32, TOPK = 4, DFF = 1024;
constexpr int NTHR = 512;

constexpr size_t al256(size_t x) { return (x + 255) & ~(size_t)255; }
constexpr size_t WS_CTL   = 0;
constexpr size_t CTL_BYTES = 65536;
constexpr size_t WS_MOD   = WS_CTL + CTL_BYTES;
constexpr size_t WS_WIN   = al256(WS_MOD + (size_t)DEPTH * 9 * 6144 * 4);
constexpr size_t WS_WGLU  = al256(WS_WIN + (size_t)DEPTH * INW * 1024 * 2);
constexpr size_t WS_WBR   = al256(WS_WGLU + (size_t)DEPTH * 512 * 512 * 2);
constexpr size_t WS_WOUT  = al256(WS_WBR + (size_t)DEPTH * 3 * 1024 * 512 * 2);
constexpr size_t WS_WGU   = al256(WS_WOUT + (size_t)DEPTH * 1024 * 1024 * 2);
constexpr size_t WS_WDN   = al256(WS_WGU + (size_t)DEPTH * NEXP * 2048 * 1024 * 2);
constexpr size_t WS_CX    = al256(WS_WDN + (size_t)DEPTH * NEXP * 1024 * 1024 * 2);
constexpr size_t WS_H     = al256(WS_CX + (size_t)NCTX * D * 4);
constexpr size_t WS_P     = al256(WS_H + (size_t)NTOK * D * 2);
constexpr size_t WS_YD    = al256(WS_P + (size_t)NTOK * INW * 2);
constexpr size_t WS_G     = al256(WS_YD + (size_t)2 * NTOK * 512 * 4);
constexpr size_t WS_Y     = al256(WS_G + (size_t)NTOK * 512 * 2);
constexpr size_t WS_S     = al256(WS_Y + (size_t)NTOK * 1536 * 2);
constexpr size_t WS_SB    = al256(WS_S + (size_t)NTOK * D * 4);
constexpr size_t WS_TKE   = al256(WS_SB + (size_t)NTOK * D * 2);
constexpr size_t WS_TKP   = al256(WS_TKE + (size_t)NTOK * 4 * 4);
constexpr size_t WS_TKG   = al256(WS_TKP + (size_t)NTOK * 4 * 4);
constexpr size_t WS_TLIST = al256(WS_TKG + (size_t)NTOK * 4 * 4);
constexpr size_t WS_ACT   = al256(WS_TLIST + (size_t)NEXP * NTOK * 4);
constexpr size_t WS_YB    = al256(WS_ACT + (size_t)(NTOK * 4 + 256) * 1024 * 2);
constexpr size_t WS_VT    = al256(WS_YB + (size_t)(NTOK * 4 + 256) * 1024 * 2);
constexpr size_t WS_ROPE  = al256(WS_VT + (size_t)NB * 10 * 64 * (CTXL + SEQ) * 2);
constexpr size_t WS_END   = al256(WS_ROPE + 2 * 64 * 16 * 4);

constexpr int CW_BAR = 0;
constexpr int CW_WQ = 4096;
constexpr int CW_CNT = 8192;

__device__ __forceinline__ bf16_t f2bf(float f) { unsigned u = __float_as_uint(f); u += 0x7fffu + ((u >> 16) & 1u); return (bf16_t)(u >> 16); }
__device__ __forceinline__ float bf2f(bf16_t h) { return __uint_as_float(((unsigned)h) << 16); }
__device__ __forceinline__ unsigned pack2(float a, float b) { return (unsigned)f2bf(a) | ((unsigned)f2bf(b) << 16); }
__device__ __forceinline__ float sigmoidf(float x) { return 1.0f / (1.0f + __expf(-x)); }
__device__ __forceinline__ int opaque_tid() { int tz = threadIdx.x; asm volatile("" : "+v"(tz)); return tz; }
__device__ __forceinline__ float shx(float v, int o, int lane) { return __int_as_float(__builtin_amdgcn_ds_bpermute((lane ^ o) << 2, __float_as_int(v))); }
__device__ __forceinline__ int shx(int v, int o, int lane) { return __builtin_amdgcn_ds_bpermute((lane ^ o) << 2, v); }
__device__ __forceinline__ float wave_sum(float v, int lane) {
#pragma unroll
  for (int o = 32; o >= 1; o >>= 1) v += shx(v, o, lane);
  return v;
}
__device__ __forceinline__ float wave_max(float v, int lane) {
#pragma unroll
  for (int o = 32; o >= 1; o >>= 1) v = fmaxf(v, shx(v, o, lane));
  return v;
}

#define XB_TMO      128
#define XB_XCNT(j)  (256  + 64 * (j))
#define XB_XSUB(j)  (1280 + 64 * (j))
#define XB_XGEN(j)  (2304 + 64 * (j))
#define XB_TOP      3328
#define XB_TOPGEN   3392
#define XCD_BAR_WORDS 3456
#define XB_SPIN_CAP (1u << 20)

__device__ __forceinline__ unsigned xb_ld(unsigned* p)              { return __hip_atomic_load(p, __ATOMIC_RELAXED, __HIP_MEMORY_SCOPE_AGENT); }
__device__ __forceinline__ unsigned xb_add(unsigned* p, unsigned v) { return __hip_atomic_fetch_add(p, v, __ATOMIC_RELAXED, __HIP_MEMORY_SCOPE_AGENT); }
__device__ __forceinline__ unsigned xb_xcc_id() { return (unsigned)__builtin_amdgcn_s_getreg((3 << 11) | 20) & 0xFu; }
#define XB_SPIN(cond, bar) do { unsigned _sp = 0; while (cond) { __builtin_amdgcn_s_sleep(1); \
    if ((++_sp & 255u) == 0u) { if (xb_ld(&(bar)[XB_TMO])) break; if (_sp > XB_SPIN_CAP) { atomicAdd(&(bar)[XB_TMO], 1u); break; } } } } while (0)

struct XcdBarrier { unsigned* bar; unsigned x; volatile LAS unsigned* st; };

__device__ __forceinline__ XcdBarrier xcd_barrier_post(unsigned* bar, volatile LAS unsigned* st) {
    XcdBarrier b; b.bar = bar; b.x = xb_xcc_id(); b.st = st;
    if (threadIdx.x == 0) (void)xb_add(&bar[XB_XCNT(b.x)], 1u);
    return b;
}
__device__ __forceinline__ void xcd_barrier_complete(unsigned* bar, unsigned x, unsigned& nloc, unsigned& nx) {
    const unsigned G = gridDim.x * gridDim.y * gridDim.z;
    unsigned sum, cnt, mine, sp = 0u;
    for (;;) {
        sum = 0u; cnt = 0u; mine = 0u;
#pragma unroll
        for (unsigned j = 0; j < 16; ++j) { const unsigned c = xb_ld(&bar[XB_XCNT(j)]); sum += c; cnt += (c > 0u) ? 1u : 0u; mine = (j == x) ? c : mine; }
        if (sum == G) break;
        __builtin_amdgcn_s_sleep(1);
        if ((++sp & 255u) == 0u) { if (xb_ld(&bar[XB_TMO])) break; if (sp > XB_SPIN_CAP) { atomicAdd(&bar[XB_TMO], 1u); break; } }
    }
    nloc = mine > 0u ? mine : 1u; nx = cnt > 0u ? cnt : 1u;
}
__device__ __forceinline__ void xcd_barrier(const XcdBarrier& b) {
    asm volatile("s_waitcnt vmcnt(0)" ::: "memory");
    __syncthreads();
    if (threadIdx.x == 0) {
        unsigned* bar = b.bar;
        __builtin_amdgcn_s_waitcnt(0);
        unsigned nloc = b.st[0], nx = b.st[1];
        if (nloc == 0u) { xcd_barrier_complete(bar, b.x, nloc, nx); b.st[0] = nloc; b.st[1] = nx; }
        const unsigned old = xb_add(&bar[XB_XSUB(b.x)], 1u);
        const unsigned gen = old / nloc;
        if (old + 1u == (gen + 1u) * nloc) {
            __builtin_amdgcn_fence(__ATOMIC_RELEASE, "agent");
            asm volatile("s_waitcnt vmcnt(0)" ::: "memory");
            const unsigned og = xb_add(&bar[XB_TOP], 1u);
            const unsigned tg = og / nx;
            if (og + 1u == (tg + 1u) * nx) xb_add(&bar[XB_TOPGEN], 1u);
            else XB_SPIN(xb_ld(&bar[XB_TOPGEN]) == tg, bar);
            __builtin_amdgcn_fence(__ATOMIC_ACQUIRE, "agent");
            xb_add(&bar[XB_XGEN(b.x)], 1u);
            asm volatile("s_waitcnt vmcnt(0)" ::: "memory");
        } else {
            XB_SPIN(xb_ld(&bar[XB_XGEN(b.x)]) == gen, bar);
            __builtin_amdgcn_fence(__ATOMIC_ACQUIRE, "agent");
            asm volatile("s_waitcnt vmcnt(0)" ::: "memory");
        }
    }
    __syncthreads();
}

struct Params {
  const float *x, *c, *ctx, *c_ctx, *w_mod, *b_mod, *norm_mix, *norm_ffn, *w_in, *lam_re, *lam_im, *log_dt,
              *b_re, *b_im, *c_re, *c_im, *ssm_d, *w_glu, *win_qn, *win_kn, *win_sink, *na_qn, *na_kn, *na_rpb,
              *w_branch, *w_out, *router_w, *router_b, *w_gu, *b_gu, *w_dn, *b_dn;
  float* out;
  unsigned char* ws;
  int ph_lo, ph_hi;
};

constexpr int LDS_MISC = 131072;
constexpr int LDS_BYTES = 131072 + 8192;

constexpr int HT = 128 * 64;
__device__ __forceinline__ int lds_byte(int r, int c) {
  int st = (r >> 4) * 2 + (c >> 5), rr = r & 15, cc = c & 31, ob = rr * 64 + cc * 2;
  return st * 1024 + (ob ^ (((ob >> 9) & 1) << 5));
}
__device__ __forceinline__ void stage_rc(int b, int& R, int& C) {
  int st = b / 1024, sb = b % 1024, swz = sb ^ (((sb >> 9) & 1) << 5);
  R = (st >> 1) * 16 + swz / 64; C = (st & 1) * 32 + (swz % 64) / 2;
}

#define G_SA(b, h) (((b) * 2 + (h)) * 16384)
#define G_SB(b, h) ((4 + (b) * 2 + (h)) * 16384)
#define G_STAGE(bufoff, gbase, v0, v1) do { \
    __builtin_amdgcn_global_load_lds((const unsigned*)((gbase) + (v0)), (LAS unsigned*)(lds + (bufoff) + ldsw), 16, 0, 0); \
    __builtin_amdgcn_global_load_lds((const unsigned*)((gbase) + (v1)), (LAS unsigned*)(lds + (bufoff) + ldsw + 8192), 16, 0, 0); } while (0)
#define G_LDA(dst, b, h) do { _Pragma("unroll") for (int m = 0; m < 4; ++m) _Pragma("unroll") for (int k = 0; k < 2; ++k) dst[m][k] = *(const LAS bf16x8*)(lds + G_SA(b, h) + aoff + m * 2048 + k * 1024); } while (0)
#define G_LDB(dst, b, h) do { _Pragma("unroll") for (int n = 0; n < 2; ++n) _Pragma("unroll") for (int k = 0; k < 2; ++k) dst[n][k] = *(const LAS bf16x8*)(lds + G_SB(b, h) + boff + n * 2048 + k * 1024); } while (0)
#define G_MMA(ai, bj, At, Bx) do { __builtin_amdgcn_s_setprio(1); \
    _Pragma("unroll") for (int m = 0; m < 4; ++m) _Pragma("unroll") for (int n = 0; n < 2; ++n) _Pragma("unroll") for (int k = 0; k < 2; ++k) \
      acc[ai][bj][m][n] = __builtin_amdgcn_mfma_f32_16x16x32_bf16(Bx[n][k], At[m][k], acc[ai][bj][m][n], 0, 0, 0); \
    __builtin_amdgcn_s_setprio(0); } while (0)
#define WAIT_V(n) asm volatile("s_waitcnt vmcnt(" #n ")" ::: "memory")
#define WAIT_L(n) asm volatile("s_waitcnt lgkmcnt(" #n ")" ::: "memory")
#define BAR __builtin_amdgcn_s_barrier()
#define SCHED __builtin_amdgcn_sched_barrier(0)

template <class Epi>
__device__ __forceinline__ void gemm_tile(LAS unsigned char* lds, const char* a0, const char* a1, unsigned va00, unsigned va01, unsigned va10, unsigned va11,
                                          const char* b0, const char* b1, unsigned vb0, unsigned vb1, int nt, int tid, Epi epi)
{
  asm volatile("s_waitcnt vmcnt(0)" ::: "memory");
  __syncthreads();
  const int wid = __builtin_amdgcn_readfirstlane(tid >> 6), lane = tid & 63, wr = wid >> 2, wc = wid & 3, fr = lane & 15, fq = lane >> 4;
  const unsigned ldsw = (unsigned)wid * 1024u;
  const int aoff = lds_byte(wr * 64 + fr, fq * 8), boff = lds_byte(wc * 32 + fr, fq * 8);
  f32x4 acc[2][2][4][2];
#pragma unroll
  for (int a = 0; a < 2; ++a)
#pragma unroll
    for (int b = 0; b < 2; ++b)
#pragma unroll
      for (int m = 0; m < 4; ++m)
#pragma unroll
        for (int n = 0; n < 2; ++n) acc[a][b][m][n] = f32x4{0.f, 0.f, 0.f, 0.f};
  bf16x8 At[4][2], B0[2][2], B1[2][2];
  G_STAGE(G_SB(0, 0), b0, vb0, vb1); G_STAGE(G_SA(0, 0), a0, va00, va01);
  G_STAGE(G_SB(0, 1), b1, vb0, vb1); G_STAGE(G_SA(0, 1), a1, va10, va11);
  if (wr == 1) BAR;
  WAIT_V(4); BAR;
  G_STAGE(G_SB(1, 0), b0 + 128, vb0, vb1); G_STAGE(G_SA(1, 0), a0 + 128, va00, va01); G_STAGE(G_SB(1, 1), b1 + 128, vb0, vb1);
  WAIT_V(6); BAR;
  for (int t = 0; t < nt - 2; t += 2) {
    const char* a0t = a0 + (size_t)t * 128; const char* a1t = a1 + (size_t)t * 128; const char* b0t = b0 + (size_t)t * 128; const char* b1t = b1 + (size_t)t * 128;
    G_LDB(B0, 0, 0); SCHED; G_LDA(At, 0, 0); G_STAGE(G_SA(1, 1), a1t + 128, va10, va11);
    WAIT_L(8); BAR; WAIT_L(0); G_MMA(0, 0, At, B0); BAR; SCHED;
    G_LDB(B1, 0, 1); G_STAGE(G_SB(0, 0), b0t + 256, vb0, vb1);
    BAR; WAIT_L(0); G_MMA(0, 1, At, B1); BAR;
    G_LDA(At, 0, 1); G_STAGE(G_SA(0, 0), a0t + 256, va00, va01);
    BAR; WAIT_L(0); G_MMA(1, 0, At, B0); BAR; SCHED;
    G_STAGE(G_SB(0, 1), b1t + 256, vb0, vb1);
    WAIT_V(6); BAR; G_MMA(1, 1, At, B1); BAR;
    G_LDB(B0, 1, 0); SCHED; G_LDA(At, 1, 0); G_STAGE(G_SA(0, 1), a1t + 256, va10, va11);
    WAIT_L(8); BAR; WAIT_L(0); G_MMA(0, 0, At, B0); BAR; SCHED;
    G_LDB(B1, 1, 1); G_STAGE(G_SB(1, 0), b0t + 384, vb0, vb1);
    BAR; WAIT_L(0); G_MMA(0, 1, At, B1); BAR;
    G_LDA(At, 1, 1); G_STAGE(G_SA(1, 0), a0t + 384, va00, va01);
    BAR; WAIT_L(0); G_MMA(1, 0, At, B0); BAR; SCHED;
    G_STAGE(G_SB(1, 1), b1t + 384, vb0, vb1);
    WAIT_V(6); BAR; G_MMA(1, 1, At, B1); BAR;
  }
  { G_LDB(B0, 0, 0); WAIT_V(0); G_LDA(At, 0, 0); G_STAGE(G_SA(1, 1), a1 + (size_t)(nt - 1) * 128, va10, va11);
    BAR; WAIT_L(0); G_MMA(0, 0, At, B0); BAR;
    G_LDB(B1, 0, 1); BAR; WAIT_L(0); G_MMA(0, 1, At, B1); BAR;
    G_LDA(At, 0, 1); WAIT_V(4); BAR; WAIT_L(0); G_MMA(1, 0, At, B0); G_MMA(1, 1, At, B1); BAR; }
  { G_LDB(B0, 1, 0); G_LDA(At, 1, 0); WAIT_V(2); BAR; WAIT_L(0); G_MMA(0, 0, At, B0); BAR;
    G_LDB(B1, 1, 1); WAIT_V(0); BAR; WAIT_L(0); G_MMA(0, 1, At, B1); BAR;
    G_LDA(At, 1, 1); BAR; WAIT_L(0); G_MMA(1, 0, At, B0); G_MMA(1, 1, At, B1); BAR; }
  if (wr == 0) BAR;
#pragma unroll
  for (int ai = 0; ai < 2; ++ai)
#pragma unroll
    for (int m = 0; m < 4; ++m)
      epi(ai * 128 + wr * 64 + m * 16 + fr, wc * 32 + fq * 4, acc[ai][0][m][0], acc[ai][0][m][1], acc[ai][1][m][0], acc[ai][1][m][1]);
}
template <class F> struct Epi2 {
  F f;
  __device__ __forceinline__ void operator()(int row, int cq, f32x4 c00, f32x4 c01, f32x4 c10, f32x4 c11) const { f(row, cq, c00, c10); f(row, cq + 16, c01, c11); }
};
template <class F> __device__ __forceinline__ Epi2<F> epi2(F f) { return Epi2<F>{f}; }

__device__ __forceinline__ unsigned stage_voff(int tid, int i, int ld) { int R, C; stage_rc(tid * 16 + i * 8192, R, C); return (unsigned)(R * ld + C) * 2u; }


__device__ __forceinline__ bool unit_next(int L, int nM, int nN, int& pm, int& pn) {
  const int nwg = nM * nN; if (L >= nwg) return false;
  int wgid = L; { const int q = nwg / 8, r = nwg % 8, xcd = wgid % 8, off = wgid / 8; wgid = (xcd < r ? xcd * (q + 1) : r * (q + 1) + (xcd - r) * q) + off; }
  const int nig = 8 * nN, gid = wgid / nig, fm = gid * 8, gsz = (nM - fm) < 8 ? (nM - fm) : 8;
  pm = fm + ((wgid % nig) % gsz); pn = (wgid % nig) / gsz; return true;
}

__device__ __forceinline__ void st_bf4(bf16_t* p, float a, float b, float c, float d) {
  uint2 v; v.x = pack2(a, b); v.y = pack2(c, d); *reinterpret_cast<uint2*>(p) = v;
}
__device__ __forceinline__ void ld_bf4(const bf16_t* p, float& a, float& b, float& c, float& d) {
  uint2 v = *reinterpret_cast<const uint2*>(p);
  a = __uint_as_float(v.x << 16); b = __uint_as_float(v.x & 0xffff0000u); c = __uint_as_float(v.y << 16); d = __uint_as_float(v.y & 0xffff0000u);
}

template <int PERM>
__device__ __forceinline__ int conv_srccol(int p) {
  if (PERM == 1) { const int t256 = p >> 8, w = p & 255; return (w < 128) ? (t256 * 128 + w) : (1024 + t256 * 128 + (w - 128)); }
  if (PERM == 2) { if (p < C_WQ || p >= C_GATE) return p; const int tile = p >> 8, pin = p & 255, cp = pin >> 5, r = pin & 31, bj = cp >> 2, wc = cp & 3; return tile * 256 + (wc * 2 + bj) * 32 + r; }
  return p;
}
template <int PERM>
__device__ __forceinline__ void conv_mats(const float* __restrict__ src, bf16_t* __restrict__ dst, int nmat, int K, int N, float* lds, int tid_) {
  const int tK = K / 64, tN = N / 64, per = tK * tN, total = nmat * per;
  const int t = tid_;
  for (int tile = blockIdx.x; tile < total; tile += gridDim.x) {
    const int mat = tile / per, rem = tile % per, kt = rem / tN, ntl = rem % tN;
    const int p0 = ntl * 64;
    __syncthreads();
    { const int c = t & 63, r = t >> 6;
      const int sc = conv_srccol<PERM>(p0 + (c & 32)) + (c & 31);
      const float* S = src + (size_t)mat * K * N + (size_t)(kt * 64) * N + sc;
#pragma unroll
      for (int i = 0; i < 8; ++i) { const int k = r + 8 * i; lds[k * 65 + c] = S[(size_t)k * N]; } }
    __syncthreads();
    { const int n = t >> 3, kc = (t & 7) * 8;
      uint4 v;
      v.x = pack2(lds[(kc + 0) * 65 + n], lds[(kc + 1) * 65 + n]);
      v.y = pack2(lds[(kc + 2) * 65 + n], lds[(kc + 3) * 65 + n]);
      v.z = pack2(lds[(kc + 4) * 65 + n], lds[(kc + 5) * 65 + n]);
      v.w = pack2(lds[(kc + 6) * 65 + n], lds[(kc + 7) * 65 + n]);
      *reinterpret_cast<uint4*>(dst + (size_t)mat * N * K + (size_t)(p0 + n) * K + kt * 64 + kc) = v; }
  }
}

__device__ __forceinline__ float siluf(float x) { return x / (1.0f + __expf(-x)); }
__device__ __forceinline__ float gelu_tanh(float x) {
  const float u = 0.7978845608028654f * (x + 0.044715f * x * x * x);
  return 0.5f * x * (1.0f + tanhf(u));
}

__device__ __forceinline__ void mod_phase(const Params& p, float* lds) {
  const int tid_ = opaque_tid();
  float* sc = lds;
  float* red = lds + 9 * 1024;
  const int t = tid_;
  __syncthreads();
  for (int i = t; i < 9 * 1024; i += NTHR) { const int r = i >> 10, k = i & 1023; const float v = (r < 8) ? p.c[r * 1024 + k] : p.c_ctx[k]; sc[i] = siluf(v); }
  __syncthreads();
  float* mod = reinterpret_cast<float*>(p.ws + WS_MOD);
  for (int u = blockIdx.x; u < DEPTH * 48; u += gridDim.x) {
    const int l = u / 48, col0 = (u % 48) * 128;
    const int col = t & 127, kq = t >> 7;
    float a[9];
#pragma unroll
    for (int r = 0; r < 9; ++r) a[r] = 0.f;
    const float* W = p.w_mod + (size_t)l * 1024 * 6144 + col0 + col;
    for (int k = kq * 256; k < kq * 256 + 256; ++k) {
      const float w = W[(size_t)k * 6144];
#pragma unroll
      for (int r = 0; r < 9; ++r) a[r] += sc[r * 1024 + k] * w;
    }
#pragma unroll
    for (int r = 0; r < 9; ++r) red[(kq * 9 + r) * 128 + col] = a[r];
    __syncthreads();
    for (int i = t; i < 9 * 128; i += NTHR) {
      const int r = i >> 7, cc = i & 127;
      const float v = red[(0 * 9 + r) * 128 + cc] + red[(1 * 9 + r) * 128 + cc] + red[(2 * 9 + r) * 128 + cc] + red[(3 * 9 + r) * 128 + cc];
      mod[((size_t)l * 9 + r) * 6144 + col0 + cc] = v + p.b_mod[l * 6144 + col0 + cc];
    }
    __syncthreads();
  }
}

__device__ __forceinline__ float* stream_row(const Params& p, int row) {
  return (row < NLAT) ? (p.out + (size_t)row * D) : (reinterpret_cast<float*>(p.ws + WS_CX) + (size_t)(row - NLAT) * D);
}
__device__ __forceinline__ int row_modidx(int row) { return (row < NLAT) ? (row >> 11) : 8; }

__device__ __forceinline__ void expert_starts(const unsigned* cnt, int* st) {
  if (threadIdx.x == 0) { int s = 0; for (int e = 0; e < NEXP; ++e) { st[e] = s; s += (int)cnt[e]; } st[NEXP] = s; }
  __syncthreads();
}

__device__ __forceinline__ void norm_phase(const Params& p, int layer, bool combine, int* lds_i) {
  const int tid_ = opaque_tid();
  const float* mod = reinterpret_cast<const float*>(p.ws + WS_MOD);
  bf16_t* H = reinterpret_cast<bf16_t*>(p.ws + WS_H);
  const int* tke = reinterpret_cast<const int*>(p.ws + WS_TKE);
  const int* tkp = reinterpret_cast<const int*>(p.ws + WS_TKP);
  const float* tkg = reinterpret_cast<const float*>(p.ws + WS_TKG);
  const bf16_t* YB = reinterpret_cast<const bf16_t*>(p.ws + WS_YB);
  const unsigned* ctl = reinterpret_cast<const unsigned*>(p.ws + WS_CTL);
  if (combine) expert_starts(ctl + CW_CNT + (layer - 1) * 32, lds_i);
  const int lane = tid_ & 63, wv = tid_ >> 6;
  const float* gw = p.norm_mix + layer * D;
  for (int row = blockIdx.x * 8 + wv; row < NTOK; row += gridDim.x * 8) {
    float* xr = stream_row(p, row);
    const int mi = row_modidx(row);
    float v[16];
#pragma unroll
    for (int i = 0; i < 4; ++i) { const float4 q = *reinterpret_cast<const float4*>(xr + i * 256 + lane * 4); v[4 * i] = q.x; v[4 * i + 1] = q.y; v[4 * i + 2] = q.z; v[4 * i + 3] = q.w; }
    if (combine) {
      const float* m5 = mod + ((size_t)(layer - 1) * 9 + mi) * 6144 + 5 * 1024;
      float a[16];
#pragma unroll
      for (int i = 0; i < 16; ++i) a[i] = 0.f;
#pragma unroll
      for (int k = 0; k < 4; ++k) {
        const int e = tke[row * 4 + k]; const int pos = tkp[row * 4 + k]; const float g = tkg[row * 4 + k];
        const bf16_t* yr = YB + (size_t)(lds_i[e] + pos) * D;
#pragma unroll
        for (int i = 0; i < 4; ++i) { float a0, a1, a2, a3; ld_bf4(yr + i * 256 + lane * 4, a0, a1, a2, a3); a[4 * i] += g * a0; a[4 * i + 1] += g * a1; a[4 * i + 2] += g * a2; a[4 * i + 3] += g * a3; }
      }
#pragma unroll
      for (int i = 0; i < 4; ++i) {
        const float4 mm = *reinterpret_cast<const float4*>(m5 + i * 256 + lane * 4);
        v[4 * i] += mm.x * a[4 * i]; v[4 * i + 1] += mm.y * a[4 * i + 1]; v[4 * i + 2] += mm.z * a[4 * i + 2]; v[4 * i + 3] += mm.w * a[4 * i + 3];
        *reinterpret_cast<float4*>(xr + i * 256 + lane * 4) = float4{v[4 * i], v[4 * i + 1], v[4 * i + 2], v[4 * i + 3]};
      }
    }
    float ss = 0.f;
#pragma unroll
    for (int i = 0; i < 16; ++i) ss += v[i] * v[i];
    ss = wave_sum(ss, lane);
    const float rinv = rsqrtf(ss * (1.0f / D) + 1e-6f);
    const float* msh = mod + ((size_t)layer * 9 + mi) * 6144;
#pragma unroll
    for (int i = 0; i < 4; ++i) {
      const int c = i * 256 + lane * 4;
      const float4 g = *reinterpret_cast<const float4*>(gw + c);
      const float4 sh = *reinterpret_cast<const float4*>(msh + c);
      const float4 sc = *reinterpret_cast<const float4*>(msh + 1024 + c);
      st_bf4(H + (size_t)row * D + c, v[4 * i] * rinv * g.x * (1.f + sc.x) + sh.x, v[4 * i + 1] * rinv * g.y * (1.f + sc.y) + sh.y,
             v[4 * i + 2] * rinv * g.z * (1.f + sc.z) + sh.z, v[4 * i + 3] * rinv * g.w * (1.f + sc.w) + sh.w);
    }
  }
}

__device__ __forceinline__ void final_combine(const Params& p, int* lds_i) {
  const int tid_ = opaque_tid();
  const float* mod = reinterpret_cast<const float*>(p.ws + WS_MOD);
  const int* tke = reinterpret_cast<const int*>(p.ws + WS_TKE);
  const int* tkp = reinterpret_cast<const int*>(p.ws + WS_TKP);
  const float* tkg = reinterpret_cast<const float*>(p.ws + WS_TKG);
  const bf16_t* YB = reinterpret_cast<const bf16_t*>(p.ws + WS_YB);
  const unsigned* ctl = reinterpret_cast<const unsigned*>(p.ws + WS_CTL);
  expert_starts(ctl + CW_CNT + (DEPTH - 1) * 32, lds_i);
  const int lane = tid_ & 63, wv = tid_ >> 6;
  for (int row = blockIdx.x * 8 + wv; row < NLAT; row += gridDim.x * 8) {
    float* xr = p.out + (size_t)row * D;
    const int mi = row >> 11;
    const float* m5 = mod + ((size_t)(DEPTH - 1) * 9 + mi) * 6144 + 5 * 1024;
    float a[16];
#pragma unroll
    for (int i = 0; i < 16; ++i) a[i] = 0.f;
#pragma unroll
    for (int k = 0; k < 4; ++k) {
      const int e = tke[row * 4 + k]; const int pos = tkp[row * 4 + k]; const float g = tkg[row * 4 + k];
      const bf16_t* yr = YB + (size_t)(lds_i[e] + pos) * D;
#pragma unroll
      for (int i = 0; i < 4; ++i) { float a0, a1, a2, a3; ld_bf4(yr + i * 256 + lane * 4, a0, a1, a2, a3); a[4 * i] += g * a0; a[4 * i + 1] += g * a1; a[4 * i + 2] += g * a2; a[4 * i + 3] += g * a3; }
    }
#pragma unroll
    for (int i = 0; i < 4; ++i) {
      const float4 mm = *reinterpret_cast<const float4*>(m5 + i * 256 + lane * 4);
      float4 q = *reinterpret_cast<const float4*>(xr + i * 256 + lane * 4);
      q.x += mm.x * a[4 * i]; q.y += mm.y * a[4 * i + 1]; q.z += mm.z * a[4 * i + 2]; q.w += mm.w * a[4 * i + 3];
      *reinterpret_cast<float4*>(xr + i * 256 + lane * 4) = q;
    }
  }
}

__device__ __forceinline__ void qknorm_phase(const Params& p, int layer) {
  const int tid_ = opaque_tid();
  bf16_t* P = reinterpret_cast<bf16_t*>(p.ws + WS_P);
  const int lane = tid_ & 63, wv = tid_ >> 6;
  const float wqn = p.win_qn[layer * 64 + lane], wkn = p.win_kn[layer * 64 + lane];
  const float nqn = p.na_qn[layer * 64 + lane], nkn = p.na_kn[layer * 64 + lane];
  const int fi = lane & 15;
  const float inv_freq = powf(10000.0f, -(float)fi / 16.0f);
  for (int row = blockIdx.x * 8 + wv; row < NTOK; row += gridDim.x * 8) {
    bf16_t* pr = P + (size_t)row * INW;
    const bool lat = row < NLAT;
    float cs = 1.f, sn = 0.f;
    if (lat) { const int t = row & 2047; const int pos = (lane < 32) ? (t >> 6) : (t & 63); const float ang = (float)pos * inv_freq; cs = cosf(ang); sn = sinf(ang); }
    for (int hd = 0; hd < 26; ++hd) {
      int col; float w; bool rope;
      if (hd < 8) { col = C_WQ + hd * 64; w = wqn; rope = lat; }
      else if (hd < 10) { col = C_WK + (hd - 8) * 64; w = wkn; rope = lat; }
      else if (hd < 18) { col = C_NQ + (hd - 10) * 64; w = nqn; rope = false; }
      else { col = C_NK + (hd - 18) * 64; w = nkn; rope = false; }
      const float v = bf2f(pr[col + lane]);
      const float ss = wave_sum(v * v, lane);
      float y = v * rsqrtf(ss * (1.0f / 64.0f) + 1e-6f) * w;
      if (rope) {
        const float o = shx(y, 16, lane);
        y = ((lane & 16) == 0) ? (y * cs - o * sn) : (o * sn + y * cs);
      }
      pr[col + lane] = f2bf(y);
    }
    {
      bf16_t* VT = reinterpret_cast<bf16_t*>(p.ws + WS_VT);
      const int bb = lat ? (row >> 11) : ((row - NLAT) >> 8);
      const int tpos = lat ? (CTXL + (row & 2047)) : ((row - NLAT) & 255);
#pragma unroll
      for (int hv = 0; hv < 10; ++hv) {
        const int col = (hv < 2) ? (C_WV + hv * 64) : (C_NV + (hv - 2) * 64);
        VT[((size_t)(bb * 10 + hv) * 64 + lane) * (CTXL + SEQ) + tpos] = pr[col + lane];
      }
    }
  }
}

__device__ __forceinline__ int ssm_row(int b, int dir, int tau) {
  if (tau < CTXL) return NLAT + b * CTXL + (dir ? (CTXL - 1 - tau) : tau);
  const int t = tau - CTXL;
  return b * SEQ + (dir ? (SEQ - 1 - t) : t);
}

__device__ __forceinline__ void ssm_item_naive(const Params& p, int layer, int item) {
  const int tid_ = opaque_tid();
  const int b = item >> 3, gq = item & 7;
  const int lane = tid_ & 63, wv = tid_ >> 6;
  const int dir = wv & 1, g = gq * 4 + (wv >> 1);
  const bf16_t* P = reinterpret_cast<const bf16_t*>(p.ws + WS_P);
  float* YD = reinterpret_cast<float*>(p.ws + WS_YD) + (size_t)dir * NTOK * 512;
  {
    const int n = lane;
    const size_t pg = ((size_t)(layer * 2 + dir) * 32 + g);
    const float lr = p.lam_re[pg * 64 + n], li = p.lam_im[pg * 64 + n];
    const float dt = expf(p.log_dt[pg]);
    const float mag = expf(lr * dt);
    const float ar = mag * cosf(li * dt), ai = mag * sinf(li * dt);
    const float den = lr * lr + li * li;
    const float fr = ((ar - 1.0f) * lr + ai * li) / den;
    const float fi = (ai * lr - (ar - 1.0f) * li) / den;
    float bbr[16], bbi[16], cr[16], ci[16];
#pragma unroll
    for (int q = 0; q < 16; ++q) {
      const float br = p.b_re[(pg * 64 + n) * 16 + q], bi = p.b_im[(pg * 64 + n) * 16 + q];
      bbr[q] = fr * br - fi * bi; bbi[q] = fr * bi + fi * br;
      cr[q] = p.c_re[(pg * 16 + q) * 64 + n]; ci[q] = p.c_im[(pg * 16 + q) * 64 + n];
    }
    float hr = 0.f, hi = 0.f;
    for (int tau = 0; tau < CTXL + SEQ; ++tau) {
      const int row = ssm_row(b, dir, tau);
      const uint4* up = reinterpret_cast<const uint4*>(P + (size_t)row * INW + C_U + g * 16);
      const uint4 u0 = up[0], u1 = up[1];
      float u[16];
      u[0] = __uint_as_float(u0.x << 16); u[1] = __uint_as_float(u0.x & 0xffff0000u); u[2] = __uint_as_float(u0.y << 16); u[3] = __uint_as_float(u0.y & 0xffff0000u);
      u[4] = __uint_as_float(u0.z << 16); u[5] = __uint_as_float(u0.z & 0xffff0000u); u[6] = __uint_as_float(u0.w << 16); u[7] = __uint_as_float(u0.w & 0xffff0000u);
      u[8] = __uint_as_float(u1.x << 16); u[9] = __uint_as_float(u1.x & 0xffff0000u); u[10] = __uint_as_float(u1.y << 16); u[11] = __uint_as_float(u1.y & 0xffff0000u);
      u[12] = __uint_as_float(u1.z << 16); u[13] = __uint_as_float(u1.z & 0xffff0000u); u[14] = __uint_as_float(u1.w << 16); u[15] = __uint_as_float(u1.w & 0xffff0000u);
      float xr = 0.f, xi = 0.f;
#pragma unroll
      for (int q = 0; q < 16; ++q) { xr += bbr[q] * u[q]; xi += bbi[q] * u[q]; }
      const float nhr = ar * hr - ai * hi + xr;
      const float nhi = ar * hi + ai * hr + xi;
      hr = nhr; hi = nhi;
      float v[16];
#pragma unroll
      for (int q = 0; q < 16; ++q) v[q] = hr * cr[q] - hi * ci[q];
#pragma unroll
      for (int i = 0; i < 8; ++i) { const bool up_ = (lane & 32) != 0; const float send = up_ ? v[i] : v[i + 8]; const float keep = up_ ? v[i + 8] : v[i]; v[i] = keep + shx(send, 32, lane); }
#pragma unroll
      for (int i = 0; i < 4; ++i) { const bool up_ = (lane & 16) != 0; const float send = up_ ? v[i] : v[i + 4]; const float keep = up_ ? v[i + 4] : v[i]; v[i] = keep + shx(send, 16, lane); }
#pragma unroll
      for (int i = 0; i < 2; ++i) { const bool up_ = (lane & 8) != 0; const float send = up_ ? v[i] : v[i + 2]; const float keep = up_ ? v[i + 2] : v[i]; v[i] = keep + shx(send, 8, lane); }
      { const bool up_ = (lane & 4) != 0; const float send = up_ ? v[0] : v[1]; const float keep = up_ ? v[1] : v[0]; v[0] = keep + shx(send, 4, lane); }
      v[0] += shx(v[0], 2, lane);
      v[0] += shx(v[0], 1, lane);
      if ((lane & 3) == 0) YD[(size_t)row * 512 + g * 16 + (lane >> 2)] = v[0];
    }
  }
  asm volatile("s_waitcnt vmcnt(0)" ::: "memory");
  __threadfence();
  __syncthreads();
  {
    const float* Y0 = reinterpret_cast<const float*>(p.ws + WS_YD);
    const float* Y1 = Y0 + (size_t)NTOK * 512;
    bf16_t* G = reinterpret_cast<bf16_t*>(p.ws + WS_G);
    const int ch = gq * 64 + (tid_ & 63);
    const float dsk = p.ssm_d[layer * 512 + ch];
    for (int i = tid_ >> 6; i < CTXL + SEQ; i += 8) {
      const int row = (i < CTXL) ? (NLAT + b * CTXL + i) : (b * SEQ + i - CTXL);
      const float y = Y0[(size_t)row * 512 + ch] + Y1[(size_t)row * 512 + ch] + dsk * bf2f(P[(size_t)row * INW + C_U + ch]);
      G[(size_t)row * 512 + ch] = f2bf(gelu_tanh(y));
    }
  }
}


typedef float f32x16 __attribute__((ext_vector_type(16)));
__device__ __forceinline__ bf16x8 pack8(const float* v) {
  union { unsigned u[4]; bf16x8 b; } t;
  t.u[0] = pack2(v[0], v[1]); t.u[1] = pack2(v[2], v[3]); t.u[2] = pack2(v[4], v[5]); t.u[3] = pack2(v[6], v[7]);
  return t.b;
}
constexpr int SSM_PITCH = 272;
__device__ __forceinline__ void ssm_item(const Params& p, int layer, int item, unsigned char* lds_raw) {
  const int tid_ = opaque_tid();
  const int b = item >> 3, gq = item & 7;
  const int lane = tid_ & 63, wv = tid_ >> 6;
  const int dir = wv & 1, g = gq * 4 + (wv >> 1);
  const bf16_t* P = reinterpret_cast<const bf16_t*>(p.ws + WS_P);
  float* YD = reinterpret_cast<float*>(p.ws + WS_YD) + (size_t)dir * NTOK * 512;
  unsigned char* hl = lds_raw + wv * (32 * SSM_PITCH);
  {
    const int n0 = lane & 31, hh = lane >> 5;
    const size_t pg = ((size_t)(layer * 2 + dir) * 32 + g);
    const float dt = expf(p.log_dt[pg]);
    float pwr[2][4], pwi[2][4];
    bf16x8 Bop[4];
#pragma unroll
    for (int sb = 0; sb < 2; ++sb) {
      const int n = n0 + 32 * sb;
      const float lr = p.lam_re[pg * 64 + n], li = p.lam_im[pg * 64 + n];
      const float mag = expf(lr * dt);
      const float ar = mag * cosf(li * dt), ai = mag * sinf(li * dt);
      const float den = lr * lr + li * li;
      const float fr = ((ar - 1.0f) * lr + ai * li) / den;
      const float fi = (ai * lr - (ar - 1.0f) * li) / den;
      float vr[8], vi[8];
#pragma unroll
      for (int j = 0; j < 8; ++j) {
        const int q = 8 * hh + j;
        const float br = p.b_re[(pg * 64 + n) * 16 + q], bi = p.b_im[(pg * 64 + n) * 16 + q];
        vr[j] = fr * br - fi * bi; vi[j] = fr * bi + fi * br;
      }
      Bop[sb * 2 + 0] = pack8(vr); Bop[sb * 2 + 1] = pack8(vi);
      pwr[sb][0] = ar; pwi[sb][0] = ai;
      pwr[sb][1] = ar * ar - ai * ai; pwi[sb][1] = 2.0f * ar * ai;
      pwr[sb][2] = pwr[sb][1] * ar - pwi[sb][1] * ai; pwi[sb][2] = pwr[sb][1] * ai + pwi[sb][1] * ar;
      pwr[sb][3] = pwr[sb][1] * pwr[sb][1] - pwi[sb][1] * pwi[sb][1]; pwi[sb][3] = 2.0f * pwr[sb][1] * pwi[sb][1];
    }
    bf16x8 Cop[4];
    {
      const int pch = lane & 15, q4 = lane >> 4;
#pragma unroll
      for (int kb = 0; kb < 4; ++kb) {
        float v[8];
#pragma unroll
        for (int j = 0; j < 8; ++j) {
          const int n = 8 * kb + 2 * q4 + (j >> 2), c = j & 3, nn = n + 32 * (c >> 1);
          v[j] = (c & 1) ? -p.c_im[(pg * 16 + pch) * 64 + nn] : p.c_re[(pg * 16 + pch) * 64 + nn];
        }
        Cop[kb] = pack8(v);
      }
    }
    float hpr[2] = {0.f, 0.f}, hpi[2] = {0.f, 0.f};
    const int ucol = C_U + g * 16 + 8 * hh;
    auto chunk_base = [&](int c, int& base, int& sgn) {
      sgn = dir ? -1 : 1;
      if (c < 8) base = NLAT + b * CTXL + (dir ? (CTXL - 1 - c * 32) : c * 32);
      else base = b * SEQ + (dir ? (SEQ - 1 - (c - 8) * 32) : (c - 8) * 32);
    };
    uint4 unext;
    { int base, sgn; chunk_base(0, base, sgn); unext = *reinterpret_cast<const uint4*>(P + (size_t)(base + sgn * n0) * INW + ucol); }
    for (int c = 0; c < 72; ++c) {
      int base, sgn; chunk_base(c, base, sgn);
      union { uint4 u; bf16x8 b; } ua; ua.u = unext;
      if (c + 1 < 72) { int nb, ns; chunk_base(c + 1, nb, ns); unext = *reinterpret_cast<const uint4*>(P + (size_t)(nb + ns * n0) * INW + ucol); }
      f32x16 X[4];
#pragma unroll
      for (int k = 0; k < 4; ++k) {
        f32x16 z;
#pragma unroll
        for (int r = 0; r < 16; ++r) z[r] = 0.f;
        X[k] = __builtin_amdgcn_mfma_f32_32x32x16_bf16(ua.b, Bop[k], z, 0, 0, 0);
      }
#pragma unroll
      for (int sb = 0; sb < 2; ++sb) {
        f32x16& xr = X[sb * 2]; f32x16& xi = X[sb * 2 + 1];
        const float ar = pwr[sb][0], ai = pwi[sb][0], a4r = pwr[sb][3], a4i = pwi[sb][3];
        float Er[4], Ei[4], Or[4], Oi[4], mcr[4], mci[4];
#pragma unroll
        for (int q = 0; q < 4; ++q) {
#pragma unroll
          for (int i = 1; i < 4; ++i) {
            const int r = 4 * q + i;
            const float nr = ar * xr[r - 1] - ai * xi[r - 1] + xr[r];
            const float ni = ar * xi[r - 1] + ai * xr[r - 1] + xi[r];
            xr[r] = nr; xi[r] = ni;
          }
          Er[q] = xr[4 * q + 3]; Ei[q] = xi[4 * q + 3];
        }
#pragma unroll
        for (int q = 0; q < 4; ++q) { Or[q] = shx(Er[q], 32, lane); Oi[q] = shx(Ei[q], 32, lane); }
        float cr = hpr[sb], ci = hpi[sb];
#pragma unroll
        for (int q = 0; q < 4; ++q) {
          const float cer = cr, cei = ci;
          const float eer = hh ? Or[q] : Er[q], eei = hh ? Oi[q] : Ei[q];
          float tr = a4r * cr - a4i * ci + eer, ti = a4r * ci + a4i * cr + eei;
          cr = tr; ci = ti;
          const float cor = cr, coi = ci;
          const float eor = hh ? Er[q] : Or[q], eoi = hh ? Ei[q] : Oi[q];
          tr = a4r * cr - a4i * ci + eor; ti = a4r * ci + a4i * cr + eoi;
          cr = tr; ci = ti;
          mcr[q] = hh ? cor : cer; mci[q] = hh ? coi : cei;
        }
        hpr[sb] = cr; hpi[sb] = ci;
#pragma unroll
        for (int q = 0; q < 4; ++q)
#pragma unroll
          for (int i = 0; i < 4; ++i) {
            const int r = 4 * q + i;
            xr[r] += pwr[sb][i] * mcr[q] - pwi[sb][i] * mci[q];
            xi[r] += pwr[sb][i] * mci[q] + pwi[sb][i] * mcr[q];
          }
      }
#pragma unroll
      for (int q = 0; q < 4; ++q)
#pragma unroll
        for (int i = 0; i < 4; ++i) {
          const int r = 4 * q + i, tok = 8 * q + 4 * hh + i;
          uint2 w; w.x = pack2(X[0][r], X[1][r]); w.y = pack2(X[2][r], X[3][r]);
          *reinterpret_cast<uint2*>(hl + tok * SSM_PITCH + n0 * 8) = w;
        }
#pragma unroll
      for (int th = 0; th < 2; ++th) {
        f32x4 acc = f32x4{0.f, 0.f, 0.f, 0.f};
        const int tok = 16 * th + (lane & 15);
#pragma unroll
        for (int kb = 0; kb < 4; ++kb) {
          const bf16x8 hb = *reinterpret_cast<const bf16x8*>(hl + tok * SSM_PITCH + kb * 64 + (lane >> 4) * 16);
          acc = __builtin_amdgcn_mfma_f32_16x16x32_bf16(Cop[kb], hb, acc, 0, 0, 0);
        }
        const int row = base + sgn * tok;
        *reinterpret_cast<float4*>(YD + (size_t)row * 512 + g * 16 + 4 * (lane >> 4)) = float4{acc[0], acc[1], acc[2], acc[3]};
      }
    }
  }
  asm volatile("s_waitcnt vmcnt(0)" ::: "memory");
  __threadfence();
  __syncthreads();
  {
    const float* Y0 = reinterpret_cast<const float*>(p.ws + WS_YD);
    const float* Y1 = Y0 + (size_t)NTOK * 512;
    bf16_t* G = reinterpret_cast<bf16_t*>(p.ws + WS_G);
    const int ch = gq * 64 + (tid_ & 63);
    const float dsk = p.ssm_d[layer * 512 + ch];
    for (int i = tid_ >> 6; i < CTXL + SEQ; i += 8) {
      const int row = (i < CTXL) ? (NLAT + b * CTXL + i) : (b * SEQ + i - CTXL);
      const float y = Y0[(size_t)row * 512 + ch] + Y1[(size_t)row * 512 + ch] + dsk * bf2f(P[(size_t)row * INW + C_U + ch]);
      G[(size_t)row * 512 + ch] = f2bf(gelu_tanh(y));
    }
  }
}

template <int NBT, class KF>
__device__ __forceinline__ void attn_query(const bf16_t* qptr, const bf16_t* P, int kcol, int vcol, bool has_sink, float sink, bf16_t* optr, int lane, KF kf) {
  float q[64];
  {
    const uint4* qp = reinterpret_cast<const uint4*>(qptr);
#pragma unroll
    for (int i = 0; i < 8; ++i) {
      const uint4 w = qp[i];
      q[8 * i + 0] = __uint_as_float(w.x << 16); q[8 * i + 1] = __uint_as_float(w.x & 0xffff0000u);
      q[8 * i + 2] = __uint_as_float(w.y << 16); q[8 * i + 3] = __uint_as_float(w.y & 0xffff0000u);
      q[8 * i + 4] = __uint_as_float(w.z << 16); q[8 * i + 5] = __uint_as_float(w.z & 0xffff0000u);
      q[8 * i + 6] = __uint_as_float(w.w << 16); q[8 * i + 7] = __uint_as_float(w.w & 0xffff0000u);
    }
  }
  float s[NBT]; int kr[NBT];
  float mx = has_sink ? sink : -1e30f;
#pragma unroll
  for (int j = 0; j < NBT; ++j) {
    int krow; float bias;
    const bool valid = kf(j, lane, krow, bias);
    kr[j] = valid ? krow : -1;
    float dot = 0.f;
    if (valid) {
      const uint4* kp = reinterpret_cast<const uint4*>(P + (size_t)krow * INW + kcol);
#pragma unroll
      for (int i = 0; i < 8; ++i) {
        const uint4 w = kp[i];
        dot += q[8 * i + 0] * __uint_as_float(w.x << 16) + q[8 * i + 1] * __uint_as_float(w.x & 0xffff0000u)
             + q[8 * i + 2] * __uint_as_float(w.y << 16) + q[8 * i + 3] * __uint_as_float(w.y & 0xffff0000u)
             + q[8 * i + 4] * __uint_as_float(w.z << 16) + q[8 * i + 5] * __uint_as_float(w.z & 0xffff0000u)
             + q[8 * i + 6] * __uint_as_float(w.w << 16) + q[8 * i + 7] * __uint_as_float(w.w & 0xffff0000u);
      }
    }
    s[j] = valid ? (dot * 0.125f + bias) : -1e30f;
    mx = fmaxf(mx, s[j]);
  }
  mx = wave_max(mx, lane);
  float l = 0.f;
#pragma unroll
  for (int j = 0; j < NBT; ++j) { s[j] = (kr[j] >= 0) ? __expf(s[j] - mx) : 0.f; l += s[j]; }
  l = wave_sum(l, lane);
  if (has_sink) l += __expf(sink - mx);
  float o[64];
#pragma unroll
  for (int i = 0; i < 64; ++i) o[i] = 0.f;
#pragma unroll
  for (int j = 0; j < NBT; ++j) {
    if (kr[j] >= 0) {
      const uint4* vp = reinterpret_cast<const uint4*>(P + (size_t)kr[j] * INW + vcol);
      const float pj = s[j];
#pragma unroll
      for (int i = 0; i < 8; ++i) {
        const uint4 w = vp[i];
        o[8 * i + 0] += pj * __uint_as_float(w.x << 16); o[8 * i + 1] += pj * __uint_as_float(w.x & 0xffff0000u);
        o[8 * i + 2] += pj * __uint_as_float(w.y << 16); o[8 * i + 3] += pj * __uint_as_float(w.y & 0xffff0000u);
        o[8 * i + 4] += pj * __uint_as_float(w.z << 16); o[8 * i + 5] += pj * __uint_as_float(w.z & 0xffff0000u);
        o[8 * i + 6] += pj * __uint_as_float(w.w << 16); o[8 * i + 7] += pj * __uint_as_float(w.w & 0xffff0000u);
      }
    }
  }
#pragma unroll
  for (int i = 0; i < 32; ++i) { const bool up_ = (lane & 32) != 0; const float send = up_ ? o[i] : o[i + 32]; const float keep = up_ ? o[i + 32] : o[i]; o[i] = keep + shx(send, 32, lane); }
#pragma unroll
  for (int i = 0; i < 16; ++i) { const bool up_ = (lane & 16) != 0; const float send = up_ ? o[i] : o[i + 16]; const float keep = up_ ? o[i + 16] : o[i]; o[i] = keep + shx(send, 16, lane); }
#pragma unroll
  for (int i = 0; i < 8; ++i) { const bool up_ = (lane & 8) != 0; const float send = up_ ? o[i] : o[i + 8]; const float keep = up_ ? o[i + 8] : o[i]; o[i] = keep + shx(send, 8, lane); }
#pragma unroll
  for (int i = 0; i < 4; ++i) { const bool up_ = (lane & 4) != 0; const float send = up_ ? o[i] : o[i + 4]; const float keep = up_ ? o[i + 4] : o[i]; o[i] = keep + shx(send, 4, lane); }
#pragma unroll
  for (int i = 0; i < 2; ++i) { const bool up_ = (lane & 2) != 0; const float send = up_ ? o[i] : o[i + 2]; const float keep = up_ ? o[i + 2] : o[i]; o[i] = keep + shx(send, 2, lane); }
  { const bool up_ = (lane & 1) != 0; const float send = up_ ? o[0] : o[1]; const float keep = up_ ? o[1] : o[0]; o[0] = keep + shx(send, 1, lane); }
  optr[lane] = f2bf(o[0] / l);
}

__device__ __forceinline__ void mixer_item_naive(const Params& p, int layer, int item, bool need_ctx, unsigned char* lds_raw) {
  const int tid_ = opaque_tid();
  const bf16_t* P = reinterpret_cast<const bf16_t*>(p.ws + WS_P);
  bf16_t* Y = reinterpret_cast<bf16_t*>(p.ws + WS_Y);
  const int wv = tid_ >> 6;
  if (item < 64) { ssm_item(p, layer, item, lds_raw); return; }
  if (item < 320) {
    const int it = item - 64; const int b = it >> 5, blk = (it >> 1) & 15, hk = it & 1;
    const int hq = hk * 4 + (wv >> 1), half = wv & 1;
    const float sink = p.win_sink[layer * 8 + hq];
    for (int qi = 0; qi < 64; ++qi) {
      const int t = blk * 128 + half * 64 + qi;
      const int row = b * SEQ + t;
      attn_query<9>(P + (size_t)row * INW + C_WQ + hq * 64, P, C_WK + hk * 64, C_WV + hk * 64, true, sink, Y + (size_t)row * 1536 + 512 + hq * 64, tid_ & 63,
        [&](int j, int lane, int& krow, float& bias) -> bool {
          bias = 0.f;
          if (j < 5) { const int kp = t - 128 + j * 64 + lane; krow = b * SEQ + kp; return kp >= 0 && kp < SEQ && kp <= t + 128; }
          krow = NLAT + b * CTXL + (j - 5) * 64 + lane; return true;
        });
    }
    return;
  }
  if (item < 576) {
    const int it = item - 320; const int b = it >> 5, h = (it >> 2) & 7, rg = it & 3;
    const int r = rg * 8 + wv;
    int rs = r - 4; rs = rs < 0 ? 0 : (rs > 24 ? 24 : rs);
    const float* rpb = p.na_rpb + ((size_t)layer * 8 + h) * 15 * 31;
    for (int c = 0; c < 64; ++c) {
      const int row = b * SEQ + r * 64 + c;
      int cs = c - 8; cs = cs < 0 ? 0 : (cs > 48 ? 48 : cs);
      attn_query<6>(P + (size_t)row * INW + C_NQ + h * 64, P, C_NK + h * 64, C_NV + h * 64, false, 0.f, Y + (size_t)row * 1536 + 1024 + h * 64, tid_ & 63,
        [&](int j, int lane, int& krow, float& bias) -> bool {
          if (j < 2) {
            const int i = j * 64 + lane; const int kr_ = rs + (i >> 4), kc = cs + (i & 15);
            krow = b * SEQ + kr_ * 64 + kc;
            int dc = kc - c; dc = dc < -15 ? -15 : (dc > 15 ? 15 : dc);
            bias = rpb[(kr_ - r + 7) * 31 + dc + 15];
            return true;
          }
          bias = 0.f; krow = NLAT + b * CTXL + (j - 2) * 64 + lane; return true;
        });
    }
    return;
  }
  if (!need_ctx) return;
  if (item < 608) {
    const int it = item - 576; const int b = it >> 2, qb = it & 3;
    const int hq = wv, hk = hq >> 2;
    const float sink = p.win_sink[layer * 8 + hq];
    for (int qi = 0; qi < 64; ++qi) {
      const int row = NLAT + b * CTXL + qb * 64 + qi;
      attn_query<4>(P + (size_t)row * INW + C_WQ + hq * 64, P, C_WK + hk * 64, C_WV + hk * 64, true, sink, Y + (size_t)row * 1536 + 512 + hq * 64, tid_ & 63,
        [&](int j, int lane, int& krow, float& bias) -> bool { bias = 0.f; krow = NLAT + b * CTXL + j * 64 + lane; return true; });
    }
    return;
  }
  {
    const int it = item - 608; const int b = it >> 2, qb = it & 3;
    const int h = wv;
    for (int qi = 0; qi < 64; ++qi) {
      const int row = NLAT + b * CTXL + qb * 64 + qi;
      attn_query<4>(P + (size_t)row * INW + C_NQ + h * 64, P, C_NK + h * 64, C_NV + h * 64, false, 0.f, Y + (size_t)row * 1536 + 1024 + h * 64, tid_ & 63,
        [&](int j, int lane, int& krow, float& bias) -> bool { bias = 0.f; krow = NLAT + b * CTXL + j * 64 + lane; return true; });
    }
  }
}


constexpr int VT_TOK = CTXL + SEQ;
template <class TileFn, class ScoreFn>
__device__ __forceinline__ void attn_wave(const bf16_t* qrow0, int ntiles, TileFn tilefn, ScoreFn scorefn, float m_init, float l_init, bf16_t* orow0, int lane) {
  const int l31 = lane & 31, hh = lane >> 5;
  bf16x8 Qop[2][4];
#pragma unroll
  for (int qb = 0; qb < 2; ++qb)
#pragma unroll
    for (int s = 0; s < 4; ++s) Qop[qb][s] = *reinterpret_cast<const bf16x8*>(qrow0 + (size_t)(32 * qb + l31) * INW + 32 * hh + 8 * s);
  f32x16 O[2][2];
#pragma unroll
  for (int a = 0; a < 2; ++a)
#pragma unroll
    for (int b2 = 0; b2 < 2; ++b2)
#pragma unroll
      for (int r = 0; r < 16; ++r) O[a][b2][r] = 0.f;
  float m[2] = {m_init, m_init};
  float l[2]; l[0] = hh ? 0.f : l_init; l[1] = l[0];
  const unsigned kvo = (unsigned)(l31 * INW + 32 * hh) * 2u;
  const unsigned vvo = (unsigned)(l31 * VT_TOK + 4 * hh) * 2u;
  const bf16_t* kp; const bf16_t* vp; int info;
  tilefn(0, kp, vp, info);
  bf16x8 Kc[4]; uint2 Vc[2][2][2];
#pragma unroll
  for (int s = 0; s < 4; ++s) Kc[s] = *reinterpret_cast<const bf16x8*>(reinterpret_cast<const char*>(kp) + kvo + 16 * s);
#pragma unroll
  for (int db = 0; db < 2; ++db)
#pragma unroll
    for (int s = 0; s < 2; ++s)
#pragma unroll
      for (int pc = 0; pc < 2; ++pc) Vc[db][s][pc] = *reinterpret_cast<const uint2*>(reinterpret_cast<const char*>(vp) + vvo + (size_t)db * 32 * VT_TOK * 2 + (16 * s + 8 * pc) * 2);
  for (int t = 0; t < ntiles; ++t) {
    const int info_c = info;
    const int tn = (t + 1 < ntiles) ? (t + 1) : t;
    tilefn(tn, kp, vp, info);
    f32x16 S[2];
#pragma unroll
    for (int qb = 0; qb < 2; ++qb) {
#pragma unroll
      for (int r = 0; r < 16; ++r) S[qb][r] = 0.f;
#pragma unroll
      for (int s = 0; s < 4; ++s) S[qb] = __builtin_amdgcn_mfma_f32_32x32x16_bf16(Kc[s], Qop[qb][s], S[qb], 0, 0, 0);
    }
#pragma unroll
    for (int s = 0; s < 4; ++s) Kc[s] = *reinterpret_cast<const bf16x8*>(reinterpret_cast<const char*>(kp) + kvo + 16 * s);
    bf16x8 Pop[2][2];
#pragma unroll
    for (int qb = 0; qb < 2; ++qb) {
      scorefn(info_c, qb, S[qb]);
      float mt = S[qb][0];
#pragma unroll
      for (int r = 1; r < 16; ++r) mt = fmaxf(mt, S[qb][r]);
      mt = fmaxf(mt, shx(mt, 32, lane));
      const float mnew = fmaxf(m[qb], mt);
      const float alpha = __expf(m[qb] - mnew);
      m[qb] = mnew;
      float ls = 0.f;
#pragma unroll
      for (int r = 0; r < 16; ++r) { const float pv = __expf(S[qb][r] - mnew); S[qb][r] = pv; ls += pv; }
      l[qb] = l[qb] * alpha + ls;
#pragma unroll
      for (int db = 0; db < 2; ++db)
#pragma unroll
        for (int r = 0; r < 16; ++r) O[db][qb][r] *= alpha;
#pragma unroll
      for (int s = 0; s < 2; ++s) {
        union { unsigned u[4]; bf16x8 b; } pk;
#pragma unroll
        for (int j = 0; j < 4; ++j) pk.u[j] = pack2(S[qb][8 * s + 2 * j], S[qb][8 * s + 2 * j + 1]);
        Pop[qb][s] = pk.b;
      }
    }
#pragma unroll
    for (int db = 0; db < 2; ++db)
#pragma unroll
      for (int s = 0; s < 2; ++s) {
        union { uint2 u[2]; bf16x8 b; } va; va.u[0] = Vc[db][s][0]; va.u[1] = Vc[db][s][1];
#pragma unroll
        for (int qb = 0; qb < 2; ++qb) O[db][qb] = __builtin_amdgcn_mfma_f32_32x32x16_bf16(va.b, Pop[qb][s], O[db][qb], 0, 0, 0);
      }
#pragma unroll
    for (int db = 0; db < 2; ++db)
#pragma unroll
      for (int s = 0; s < 2; ++s)
#pragma unroll
        for (int pc = 0; pc < 2; ++pc) Vc[db][s][pc] = *reinterpret_cast<const uint2*>(reinterpret_cast<const char*>(vp) + vvo + (size_t)db * 32 * VT_TOK * 2 + (16 * s + 8 * pc) * 2);
  }
#pragma unroll
  for (int qb = 0; qb < 2; ++qb) {
    const float lt = l[qb] + shx(l[qb], 32, lane);
    const float inv = 1.0f / lt;
    bf16_t* orow = orow0 + (size_t)(32 * qb + l31) * 1536;
#pragma unroll
    for (int db = 0; db < 2; ++db)
#pragma unroll
      for (int gq = 0; gq < 4; ++gq)
        st_bf4(orow + 32 * db + 8 * gq + 4 * hh, O[db][qb][4 * gq] * inv, O[db][qb][4 * gq + 1] * inv, O[db][qb][4 * gq + 2] * inv, O[db][qb][4 * gq + 3] * inv);
  }
}

__device__ __forceinline__ void mixer_item(const Params& p, int layer, int item, bool need_ctx, unsigned char* lds_raw) {
  const int tid_ = opaque_tid();
  const bf16_t* P = reinterpret_cast<const bf16_t*>(p.ws + WS_P);
  const bf16_t* VT = reinterpret_cast<const bf16_t*>(p.ws + WS_VT);
  bf16_t* Y = reinterpret_cast<bf16_t*>(p.ws + WS_Y);
  const int wv = tid_ >> 6, lane = tid_ & 63;
  if (item < 64) { ssm_item(p, layer, item, lds_raw); return; }
  if (item < 320) {
    const int it = item - 64; const int b = it >> 5, blk = (it >> 1) & 15, hk = it & 1;
    const int hq = hk * 4 + (wv >> 1), half = wv & 1;
    const float sink = p.win_sink[layer * 8 + hq];
    const int t0 = blk * 128 + half * 64;
    int ilo = 0, ihi = 10;
    if (t0 - 128 < 0) ilo = (128 - t0) >> 5;
    if (t0 + 192 > SEQ) ihi = 10 - ((t0 + 192 - SEQ) >> 5);
    const bf16_t* kctx = P + (size_t)(NLAT + b * CTXL) * INW + C_WK + hk * 64;
    const bf16_t* klat = P + (size_t)(b * SEQ) * INW + C_WK + hk * 64;
    const bf16_t* vth = VT + (size_t)(b * 10 + hk) * 64 * VT_TOK;
    const int qrow0 = b * SEQ + t0;
    attn_wave(P + (size_t)qrow0 * INW + C_WQ + hq * 64, 8 + (ihi - ilo),
      [&](int i, const bf16_t*& kp, const bf16_t*& vp, int& info) {
        if (i < 8) { kp = kctx + (size_t)(32 * i) * INW; vp = vth + 32 * i; info = -100000; }
        else { const int key0 = t0 - 128 + 32 * (i - 8 + ilo); kp = klat + (size_t)key0 * INW; vp = vth + CTXL + key0; info = key0; }
      },
      [&](int info, int qb, f32x16& S) {
        if (info == -100000) {
#pragma unroll
          for (int r = 0; r < 16; ++r) S[r] *= 0.125f;
        } else {
          const int d0 = info + 4 * (lane >> 5) - (t0 + 32 * qb + (lane & 31));
#pragma unroll
          for (int r = 0; r < 16; ++r) { const int d = d0 + (r & 3) + 8 * (r >> 2); S[r] = (d >= -128 && d <= 128) ? S[r] * 0.125f : -1e30f; }
        }
      }, sink, 1.0f, Y + (size_t)qrow0 * 1536 + 512 + hq * 64, lane);
    return;
  }
  if (item < 576) {
    const int it = item - 320; const int b = it >> 5, h = (it >> 2) & 7, rg = it & 3;
    const int r = rg * 8 + wv;
    int rs = r - 4; rs = rs < 0 ? 0 : (rs > 24 ? 24 : rs);
    float* tbl = reinterpret_cast<float*>(lds_raw);
    __syncthreads();
    { const float* rpb = p.na_rpb + ((size_t)layer * 8 + h) * 15 * 31; for (int i = tid_; i < 15 * 31 + 128; i += NTHR) { const int j = i - 64; tbl[i] = (j >= 0 && j < 15 * 31) ? rpb[j] : 0.f; } }
    __syncthreads();
    const bf16_t* kctx = P + (size_t)(NLAT + b * CTXL) * INW + C_NK + h * 64;
    const bf16_t* klat = P + (size_t)(b * SEQ) * INW + C_NK + h * 64;
    const bf16_t* vth = VT + (size_t)(b * 10 + 2 + h) * 64 * VT_TOK;
    const int qrow0 = b * SEQ + r * 64;
    attn_wave(P + (size_t)qrow0 * INW + C_NQ + h * 64, 8 + 16,
      [&](int i, const bf16_t*& kp, const bf16_t*& vp, int& info) {
        if (i < 8) { kp = kctx + (size_t)(32 * i) * INW; vp = vth + 32 * i; info = -1; }
        else { const int j = i - 8; const int key0 = rs * 64 + 32 * j; kp = klat + (size_t)key0 * INW; vp = vth + CTXL + key0; info = j; }
      },
      [&](int info, int qb, f32x16& S) {
        if (info < 0) {
#pragma unroll
          for (int r2 = 0; r2 < 16; ++r2) S[r2] *= 0.125f;
        } else {
          const int kr = rs + (info >> 1), jh = info & 1;
          const int qc = 32 * qb + (lane & 31);
          int cs = qc - 8; cs = cs < 0 ? 0 : (cs > 48 ? 48 : cs);
          const int kc0 = jh * 32 + 4 * (lane >> 5);
          const float* tb = tbl + 64 + (kr - r + 7) * 31 + kc0 - qc + 15;
#pragma unroll
          for (int r2 = 0; r2 < 16; ++r2) {
            const int ko = (r2 & 3) + 8 * (r2 >> 2);
            const int kc = kc0 + ko;
            S[r2] = (kc >= cs && kc < cs + 16) ? (S[r2] * 0.125f + tb[ko]) : -1e30f;
          }
        }
      }, -1e30f, 0.0f, Y + (size_t)qrow0 * 1536 + 1024 + h * 64, lane);
    return;
  }
  if (!need_ctx) return;
  if (item < 608) {
    const int it = item - 576; const int b = it >> 2, qb4 = it & 3;
    const int hq = wv, hk = hq >> 2;
    const float sink = p.win_sink[layer * 8 + hq];
    const bf16_t* kctx = P + (size_t)(NLAT + b * CTXL) * INW + C_WK + hk * 64;
    const bf16_t* vth = VT + (size_t)(b * 10 + hk) * 64 * VT_TOK;
    const int qrow0 = NLAT + b * CTXL + qb4 * 64;
    attn_wave(P + (size_t)qrow0 * INW + C_WQ + hq * 64, 8,
      [&](int i, const bf16_t*& kp, const bf16_t*& vp, int& info) { kp = kctx + (size_t)(32 * i) * INW; vp = vth + 32 * i; info = 0; },
      [&](int info, int qb, f32x16& S) {
#pragma unroll
        for (int r2 = 0; r2 < 16; ++r2) S[r2] *= 0.125f;
      }, sink, 1.0f, Y + (size_t)qrow0 * 1536 + 512 + hq * 64, lane);
    return;
  }
  {
    const int it = item - 608; const int b = it >> 2, qb4 = it & 3;
    const int h = wv;
    const bf16_t* kctx = P + (size_t)(NLAT + b * CTXL) * INW + C_NK + h * 64;
    const bf16_t* vth = VT + (size_t)(b * 10 + 2 + h) * 64 * VT_TOK;
    const int qrow0 = NLAT + b * CTXL + qb4 * 64;
    attn_wave(P + (size_t)qrow0 * INW + C_NQ + h * 64, 8,
      [&](int i, const bf16_t*& kp, const bf16_t*& vp, int& info) { kp = kctx + (size_t)(32 * i) * INW; vp = vth + 32 * i; info = 0; },
      [&](int info, int qb, f32x16& S) {
#pragma unroll
        for (int r2 = 0; r2 < 16; ++r2) S[r2] *= 0.125f;
      }, -1e30f, 0.0f, Y + (size_t)qrow0 * 1536 + 1024 + h * 64, lane);
  }
}

__device__ __forceinline__ void route_phase(const Params& p, int layer, int ntok, float* lds_f) {
  const int tid_ = opaque_tid();
  const float* mod = reinterpret_cast<const float*>(p.ws + WS_MOD);
  bf16_t* F = reinterpret_cast<bf16_t*>(p.ws + WS_H);
  int* tke = reinterpret_cast<int*>(p.ws + WS_TKE);
  int* tkp = reinterpret_cast<int*>(p.ws + WS_TKP);
  float* tkg = reinterpret_cast<float*>(p.ws + WS_TKG);
  int* tlist = reinterpret_cast<int*>(p.ws + WS_TLIST);
  unsigned* cnt = reinterpret_cast<unsigned*>(p.ws + WS_CTL) + CW_CNT + layer * 32;
  const int lane = tid_ & 63, wv = tid_ >> 6;
  float* frow = lds_f;
  float* part = lds_f + 8 * 1024;
  const float* gw = p.norm_ffn + layer * D;
  const float* rw = p.router_w + (size_t)layer * D * NEXP;
  const float rb = p.router_b[layer * NEXP + (lane & 31)];
  const int e = tid_ & 31, ks = tid_ >> 5;
  float rwreg[64];
#pragma unroll
  for (int i = 0; i < 64; ++i) rwreg[i] = rw[(size_t)(ks * 64 + i) * NEXP + e];
  const int ngroups = ntok >> 3;
  for (int grp = blockIdx.x; grp < ngroups; grp += gridDim.x) {
    const int row = grp * 8 + wv;
    {
      const float* xr = stream_row(p, row);
      const int mi = row_modidx(row);
      float v[16];
#pragma unroll
      for (int i = 0; i < 4; ++i) { const float4 q = *reinterpret_cast<const float4*>(xr + i * 256 + lane * 4); v[4 * i] = q.x; v[4 * i + 1] = q.y; v[4 * i + 2] = q.z; v[4 * i + 3] = q.w; }
      float ss = 0.f;
#pragma unroll
      for (int i = 0; i < 16; ++i) ss += v[i] * v[i];
      ss = wave_sum(ss, lane);
      const float rinv = rsqrtf(ss * (1.0f / D) + 1e-6f);
      const float* msh = mod + ((size_t)layer * 9 + mi) * 6144 + 3 * 1024;
#pragma unroll
      for (int i = 0; i < 4; ++i) {
        const int c = i * 256 + lane * 4;
        const float4 g = *reinterpret_cast<const float4*>(gw + c);
        const float4 sh = *reinterpret_cast<const float4*>(msh + c);
        const float4 sc = *reinterpret_cast<const float4*>(msh + 1024 + c);
        const float f0 = v[4 * i] * rinv * g.x * (1.f + sc.x) + sh.x, f1 = v[4 * i + 1] * rinv * g.y * (1.f + sc.y) + sh.y;
        const float f2 = v[4 * i + 2] * rinv * g.z * (1.f + sc.z) + sh.z, f3 = v[4 * i + 3] * rinv * g.w * (1.f + sc.w) + sh.w;
        st_bf4(F + (size_t)row * D + c, f0, f1, f2, f3);
        *reinterpret_cast<float4*>(frow + wv * 1024 + c) = float4{f0, f1, f2, f3};
      }
    }
    __syncthreads();
#pragma unroll
    for (int j = 0; j < 8; ++j) {
      const float* fp = frow + j * 1024 + ks * 64;
      float a0 = 0.f, a1 = 0.f;
#pragma unroll
      for (int i = 0; i < 64; i += 4) {
        const float4 f4 = *reinterpret_cast<const float4*>(fp + i);
        a0 += f4.x * rwreg[i]; a1 += f4.y * rwreg[i + 1]; a0 += f4.z * rwreg[i + 2]; a1 += f4.w * rwreg[i + 3];
      }
      part[(j * 16 + ks) * 32 + e] = a0 + a1;
    }
    __syncthreads();
    {
      const int ee = lane & 31;
      float acc = 0.f;
#pragma unroll
      for (int k2 = 0; k2 < 16; ++k2) acc += part[(wv * 16 + k2) * 32 + ee];
      const float logit = acc + rb;
      int sel_e[4]; float sel_v[4];
      float cur = logit;
#pragma unroll
      for (int k = 0; k < 4; ++k) {
        float bv = cur; int bi = ee;
#pragma unroll
        for (int o = 16; o >= 1; o >>= 1) {
          const float ov = shx(bv, o, lane); const int oi = shx(bi, o, lane);
          if (ov > bv || (ov == bv && oi < bi)) { bv = ov; bi = oi; }
        }
        sel_e[k] = bi; sel_v[k] = bv;
        if (ee == bi) cur = -3.0e38f;
      }
      const float m0 = sel_v[0];
      const float e0 = 1.f, e1 = __expf(sel_v[1] - m0), e2 = __expf(sel_v[2] - m0), e3 = __expf(sel_v[3] - m0);
      const float inv = 1.f / (e0 + e1 + e2 + e3);
      if (lane < 4) {
        const int ex = (lane == 0) ? sel_e[0] : (lane == 1) ? sel_e[1] : (lane == 2) ? sel_e[2] : sel_e[3];
        const float gg = ((lane == 0) ? e0 : (lane == 1) ? e1 : (lane == 2) ? e2 : e3) * inv;
        const unsigned pos = __hip_atomic_fetch_add(&cnt[ex], 1u, __ATOMIC_RELAXED, __HIP_MEMORY_SCOPE_AGENT);
        tke[row * 4 + lane] = ex; tkp[row * 4 + lane] = (int)pos; tkg[row * 4 + lane] = gg;
        tlist[(size_t)ex * NTOK + pos] = row;
      }
    }
  }
}

__device__ __forceinline__ void phase_inproj(const Params& p, int layer, LAS unsigned char* lds) {
  const int G = gridDim.x, bid = blockIdx.x;
  const bf16_t* A = reinterpret_cast<const bf16_t*>(p.ws + WS_H);
  const bf16_t* Bt = reinterpret_cast<const bf16_t*>(p.ws + WS_WIN) + (size_t)layer * INW * 1024;
  bf16_t* P = reinterpret_cast<bf16_t*>(p.ws + WS_P);
  bf16_t* VT = reinterpret_cast<bf16_t*>(p.ws + WS_VT);
  const float* ropec = reinterpret_cast<const float*>(p.ws + WS_ROPE);
  for (int i = 0;; ++i) {
    int pm, pn; if (!unit_next(i * G + bid, NTOK / 256, INW / 256, pm, pn)) break;
    const int ar0 = pm * 256, br0 = pn * 256; const int tz = opaque_tid();
    const int wcz = (tz >> 6) & 3, fqz = (tz & 63) >> 4;
    const int hidx = (pn - 2) * 4 + wcz;
    const bool is_head = (pn >= 2 && pn < 11);
    const bool is_v = is_head && ((hidx >= 10 && hidx < 12) || hidx >= 28);
    const bool has_rope = is_head && hidx < 10;
    const float* nw = (hidx < 8) ? (p.win_qn + layer * 64) : (hidx < 10) ? (p.win_kn + layer * 64) : (hidx < 20) ? (p.na_qn + layer * 64) : (p.na_kn + layer * 64);
    float4 w00 = float4{1.f, 1.f, 1.f, 1.f}, w01 = w00, w10 = w00, w11 = w00;
    if (is_head && !is_v) { w00 = *reinterpret_cast<const float4*>(nw + fqz * 4); w01 = *reinterpret_cast<const float4*>(nw + 16 + fqz * 4);
                            w10 = *reinterpret_cast<const float4*>(nw + 32 + fqz * 4); w11 = *reinterpret_cast<const float4*>(nw + 48 + fqz * 4); }
    const int hv = (hidx < 12) ? (hidx - 10) : (2 + hidx - 28);
    gemm_tile(lds, (const char*)(A + (size_t)ar0 * 1024), (const char*)(A + (size_t)(ar0 + 128) * 1024), stage_voff(tz, 0, 1024), stage_voff(tz, 1, 1024), stage_voff(tz, 0, 1024), stage_voff(tz, 1, 1024),
              (const char*)(Bt + (size_t)br0 * 1024), (const char*)(Bt + (size_t)(br0 + 128) * 1024), stage_voff(tz, 0, 1024), stage_voff(tz, 1, 1024), 16, tz,
      [&](int r, int cq, f32x4 c00, f32x4 c01, f32x4 c10, f32x4 c11) {
        const int grow = ar0 + r;
        if (!is_head) {
          bf16_t* o = P + (size_t)grow * INW + br0 + cq;
          if (br0 >= C_GATE) {
            st_bf4(o, sigmoidf(c00[0]), sigmoidf(c00[1]), sigmoidf(c00[2]), sigmoidf(c00[3])); st_bf4(o + 16, sigmoidf(c01[0]), sigmoidf(c01[1]), sigmoidf(c01[2]), sigmoidf(c01[3]));
            st_bf4(o + 128, sigmoidf(c10[0]), sigmoidf(c10[1]), sigmoidf(c10[2]), sigmoidf(c10[3])); st_bf4(o + 144, sigmoidf(c11[0]), sigmoidf(c11[1]), sigmoidf(c11[2]), sigmoidf(c11[3]));
          } else {
            st_bf4(o, c00[0], c00[1], c00[2], c00[3]); st_bf4(o + 16, c01[0], c01[1], c01[2], c01[3]);
            st_bf4(o + 128, c10[0], c10[1], c10[2], c10[3]); st_bf4(o + 144, c11[0], c11[1], c11[2], c11[3]);
          }
          return;
        }
        const bool lat = grow < NLAT;
        if (is_v) {
          const int bb = lat ? (grow >> 11) : ((grow - NLAT) >> 8);
          const int tpos = lat ? (CTXL + (grow & 2047)) : ((grow - NLAT) & 255);
          bf16_t* vt = VT + ((size_t)(bb * 10 + hv) * 64 + fqz * 4) * VT_TOK + tpos;
#pragma unroll
          for (int j = 0; j < 4; ++j) {
            vt[(size_t)(j) * VT_TOK] = f2bf(c00[j]); vt[(size_t)(16 + j) * VT_TOK] = f2bf(c01[j]);
            vt[(size_t)(32 + j) * VT_TOK] = f2bf(c10[j]); vt[(size_t)(48 + j) * VT_TOK] = f2bf(c11[j]);
          }
          return;
        }
        float ss = 0.f;
#pragma unroll
        for (int j = 0; j < 4; ++j) ss += c00[j] * c00[j] + c01[j] * c01[j] + c10[j] * c10[j] + c11[j] * c11[j];
        ss += shx(ss, 16, tz & 63); ss += shx(ss, 32, tz & 63);
        const float rinv = rsqrtf(ss * (1.0f / 64.0f) + 1e-6f);
        float y00[4], y01[4], y10[4], y11[4];
        y00[0] = c00[0] * rinv * w00.x; y00[1] = c00[1] * rinv * w00.y; y00[2] = c00[2] * rinv * w00.z; y00[3] = c00[3] * rinv * w00.w;
        y01[0] = c01[0] * rinv * w01.x; y01[1] = c01[1] * rinv * w01.y; y01[2] = c01[2] * rinv * w01.z; y01[3] = c01[3] * rinv * w01.w;
        y10[0] = c10[0] * rinv * w10.x; y10[1] = c10[1] * rinv * w10.y; y10[2] = c10[2] * rinv * w10.z; y10[3] = c10[3] * rinv * w10.w;
        y11[0] = c11[0] * rinv * w11.x; y11[1] = c11[1] * rinv * w11.y; y11[2] = c11[2] * rinv * w11.z; y11[3] = c11[3] * rinv * w11.w;
        if (has_rope && lat) {
          const int t = grow & 2047;
          const float4 cr = *reinterpret_cast<const float4*>(ropec + (t >> 6) * 16 + fqz * 4), sr = *reinterpret_cast<const float4*>(ropec + 1024 + (t >> 6) * 16 + fqz * 4);
          const float4 cc = *reinterpret_cast<const float4*>(ropec + (t & 63) * 16 + fqz * 4), sc2 = *reinterpret_cast<const float4*>(ropec + 1024 + (t & 63) * 16 + fqz * 4);
          const float crv[4] = {cr.x, cr.y, cr.z, cr.w}, srv[4] = {sr.x, sr.y, sr.z, sr.w}, ccv[4] = {cc.x, cc.y, cc.z, cc.w}, scv[4] = {sc2.x, sc2.y, sc2.z, sc2.w};
#pragma unroll
          for (int j = 0; j < 4; ++j) {
            const float a1 = y00[j], a2 = y01[j]; y00[j] = a1 * crv[j] - a2 * srv[j]; y01[j] = a1 * srv[j] + a2 * crv[j];
            const float b1 = y10[j], b2 = y11[j]; y10[j] = b1 * ccv[j] - b2 * scv[j]; y11[j] = b1 * scv[j] + b2 * ccv[j];
          }
        }
        bf16_t* o = P + (size_t)grow * INW + C_WQ + hidx * 64 + fqz * 4;
        st_bf4(o, y00[0], y00[1], y00[2], y00[3]); st_bf4(o + 16, y01[0], y01[1], y01[2], y01[3]);
        st_bf4(o + 32, y10[0], y10[1], y10[2], y10[3]); st_bf4(o + 48, y11[0], y11[1], y11[2], y11[3]);
      });
  }
}

__device__ __forceinline__ void phase_mixers(const Params& p, int layer, bool need_ctx, int* misc_i, unsigned char* lds_raw, int rep) {
  unsigned* head = reinterpret_cast<unsigned*>(p.ws + WS_CTL) + CW_WQ + layer * 64 + rep * 16;
  for (;;) {
    __syncthreads();
    if (threadIdx.x == 0) misc_i[40] = (int)__hip_atomic_fetch_add(head, 1u, __ATOMIC_RELAXED, __HIP_MEMORY_SCOPE_AGENT);
    __syncthreads();
    const int item = misc_i[40];
    if (item >= 640) break;
    mixer_item(p, layer, item, need_ctx, lds_raw);
  }
}

__device__ __forceinline__ void phase_glu(const Params& p, int layer, int mrows, LAS unsigned char* lds) {
  const int G = gridDim.x, bid = blockIdx.x;
  const bf16_t* A = reinterpret_cast<const bf16_t*>(p.ws + WS_G);
  const bf16_t* Bt = reinterpret_cast<const bf16_t*>(p.ws + WS_WGLU) + (size_t)layer * 512 * 512;
  bf16_t* Y = reinterpret_cast<bf16_t*>(p.ws + WS_Y);
  for (int i = 0;; ++i) {
    int pm, pn; if (!unit_next(i * G + bid, mrows / 256, 2, pm, pn)) break;
    const int ar0 = pm * 256, br0 = pn * 256; const int tz = opaque_tid();
    gemm_tile(lds, (const char*)(A + (size_t)ar0 * 512), (const char*)(A + (size_t)(ar0 + 128) * 512), stage_voff(tz, 0, 512), stage_voff(tz, 1, 512), stage_voff(tz, 0, 512), stage_voff(tz, 1, 512),
              (const char*)(Bt + (size_t)br0 * 512), (const char*)(Bt + (size_t)(br0 + 128) * 512), stage_voff(tz, 0, 512), stage_voff(tz, 1, 512), 8, tz,
      epi2([&](int r, int c, f32x4 v0, f32x4 v1) {
        const bf16_t* gi = A + (size_t)(ar0 + r) * 512 + br0 + c;
        bf16_t* o = Y + (size_t)(ar0 + r) * 1536 + br0 + c;
        float g0, g1, g2, g3;
        ld_bf4(gi, g0, g1, g2, g3); st_bf4(o, g0 * sigmoidf(v0[0]), g1 * sigmoidf(v0[1]), g2 * sigmoidf(v0[2]), g3 * sigmoidf(v0[3]));
        ld_bf4(gi + 128, g0, g1, g2, g3); st_bf4(o + 128, g0 * sigmoidf(v1[0]), g1 * sigmoidf(v1[1]), g2 * sigmoidf(v1[2]), g3 * sigmoidf(v1[3]));
      }));
  }
}

__device__ __forceinline__ void phase_merge1(const Params& p, int layer, int mrows, LAS unsigned char* lds) {
  const int G = gridDim.x, bid = blockIdx.x;
  const bf16_t* Yb = reinterpret_cast<const bf16_t*>(p.ws + WS_Y);
  const bf16_t* P = reinterpret_cast<const bf16_t*>(p.ws + WS_P);
  float* S = reinterpret_cast<float*>(p.ws + WS_S);
  bf16_t* SB = reinterpret_cast<bf16_t*>(p.ws + WS_SB);
  for (int i = 0;; ++i) {
    int pm, pn; if (!unit_next(i * G + bid, mrows / 256, 4, pm, pn)) break;
    const int ar0 = pm * 256, br0 = pn * 256; const int tz = opaque_tid();
    for (int br = 0; br < 3; ++br) {
      const bf16_t* A = Yb + br * 512;
      const bf16_t* Bt = reinterpret_cast<const bf16_t*>(p.ws + WS_WBR) + (size_t)(layer * 3 + br) * 1024 * 512;
      gemm_tile(lds, (const char*)(A + (size_t)ar0 * 1536), (const char*)(A + (size_t)(ar0 + 128) * 1536), stage_voff(tz, 0, 1536), stage_voff(tz, 1, 1536), stage_voff(tz, 0, 1536), stage_voff(tz, 1, 1536),
                (const char*)(Bt + (size_t)br0 * 512), (const char*)(Bt + (size_t)(br0 + 128) * 512), stage_voff(tz, 0, 512), stage_voff(tz, 1, 512), 8, tz,
        epi2([&](int r, int c, f32x4 v0, f32x4 v1) {
          const size_t ro = (size_t)(ar0 + r);
          const bf16_t* gp = P + ro * INW + C_GATE + br * 1024 + br0 + c;
          float* sp = S + ro * D + br0 + c;
          float g0, g1, g2, g3;
          ld_bf4(gp, g0, g1, g2, g3);
          float4 a = float4{g0 * v0[0], g1 * v0[1], g2 * v0[2], g3 * v0[3]};
          ld_bf4(gp + 128, g0, g1, g2, g3);
          float4 b = float4{g0 * v1[0], g1 * v1[1], g2 * v1[2], g3 * v1[3]};
          if (br > 0) { const float4 pa = *reinterpret_cast<const float4*>(sp); const float4 pb2 = *reinterpret_cast<const float4*>(sp + 128);
                        a.x += pa.x; a.y += pa.y; a.z += pa.z; a.w += pa.w; b.x += pb2.x; b.y += pb2.y; b.z += pb2.z; b.w += pb2.w; }
          if (br < 2) { *reinterpret_cast<float4*>(sp) = a; *reinterpret_cast<float4*>(sp + 128) = b; }
          else { bf16_t* o = SB + ro * D + br0 + c; st_bf4(o, a.x, a.y, a.z, a.w); st_bf4(o + 128, b.x, b.y, b.z, b.w); }
        }));
    }
  }
}

__device__ __forceinline__ void phase_merge2(const Params& p, int layer, int mrows, LAS unsigned char* lds) {
  const int G = gridDim.x, bid = blockIdx.x;
  const bf16_t* A = reinterpret_cast<const bf16_t*>(p.ws + WS_SB);
  const bf16_t* Bt = reinterpret_cast<const bf16_t*>(p.ws + WS_WOUT) + (size_t)layer * 1024 * 1024;
  const float* mod = reinterpret_cast<const float*>(p.ws + WS_MOD);
  for (int i = 0;; ++i) {
    int pm, pn; if (!unit_next(i * G + bid, mrows / 256, 4, pm, pn)) break;
    const int ar0 = pm * 256, br0 = pn * 256; const int tz = opaque_tid();
    gemm_tile(lds, (const char*)(A + (size_t)ar0 * 1024), (const char*)(A + (size_t)(ar0 + 128) * 1024), stage_voff(tz, 0, 1024), stage_voff(tz, 1, 1024), stage_voff(tz, 0, 1024), stage_voff(tz, 1, 1024),
              (const char*)(Bt + (size_t)br0 * 1024), (const char*)(Bt + (size_t)(br0 + 128) * 1024), stage_voff(tz, 0, 1024), stage_voff(tz, 1, 1024), 16, tz,
      epi2([&](int r, int c, f32x4 v0, f32x4 v1) {
        const int row = ar0 + r;
        float* xr = stream_row(p, row) + br0 + c;
        const float* m2 = mod + ((size_t)layer * 9 + row_modidx(row)) * 6144 + 2 * 1024 + br0 + c;
        float4 a = *reinterpret_cast<const float4*>(xr); const float4 ma = *reinterpret_cast<const float4*>(m2);
        a.x += ma.x * v0[0]; a.y += ma.y * v0[1]; a.z += ma.z * v0[2]; a.w += ma.w * v0[3];
        *reinterpret_cast<float4*>(xr) = a;
        float4 b = *reinterpret_cast<const float4*>(xr + 128); const float4 mb = *reinterpret_cast<const float4*>(m2 + 128);
        b.x += mb.x * v1[0]; b.y += mb.y * v1[1]; b.z += mb.z * v1[2]; b.w += mb.w * v1[3];
        *reinterpret_cast<float4*>(xr + 128) = b;
      }));
  }
}

__device__ __forceinline__ int moe_tables(const unsigned* cnt, int* est, int ntn) {
  __syncthreads();
  if (threadIdx.x == 0) { int s = 0, u = 0; for (int e = 0; e < NEXP; ++e) { est[e] = s; est[64 + e] = u; const int c = (int)cnt[e]; s += c; u += ((c + 255) >> 8) * ntn; } est[NEXP] = s; est[64 + NEXP] = u; }
  __syncthreads();
  return est[64 + NEXP];
}
__device__ __forceinline__ void moe_unit(const int* est, int total, int L, int& e, int& cnte, int& pmt, int& pnt) {
  int wgid = L; { const int q = total / 8, r = total % 8, xcd = wgid % 8, off = wgid / 8; wgid = (xcd < r ? xcd * (q + 1) : r * (q + 1) + (xcd - r) * q) + off; }
  e = 0; while (est[64 + e + 1] <= wgid) ++e;
  const int idx = wgid - est[64 + e]; cnte = est[e + 1] - est[e]; const int tm = (cnte + 255) >> 8;
  pmt = idx % tm; pnt = idx / tm;
}

__device__ __forceinline__ void phase_moe1(const Params& p, int layer, LAS unsigned char* lds, int* est) {
  const int G = gridDim.x, bid = blockIdx.x;
  const unsigned* cnt = reinterpret_cast<const unsigned*>(p.ws + WS_CTL) + CW_CNT + layer * 32;
  const int total = moe_tables(cnt, est, 8);
  const bf16_t* F = reinterpret_cast<const bf16_t*>(p.ws + WS_H);
  const int* tlist = reinterpret_cast<const int*>(p.ws + WS_TLIST);
  bf16_t* ACT = reinterpret_cast<bf16_t*>(p.ws + WS_ACT);
  for (int L = bid; L < total; L += G) {
    int e, cnte, pmt, pnt; moe_unit(est, total, L, e, cnte, pmt, pnt);
    const int m0 = pmt * 256, br0 = pnt * 256; const int tz = opaque_tid();
    const int* tl = tlist + (size_t)e * NTOK;
    int R0, C0, R1, C1; stage_rc(tz * 16, R0, C0); stage_rc(tz * 16 + 8192, R1, C1);
    const int r00 = m0 + R0, r01 = m0 + R1, r10 = m0 + 128 + R0, r11 = m0 + 128 + R1;
    const int t00 = ((r00 < cnte) ? tl[r00] : 0) * 1024, t01 = ((r01 < cnte) ? tl[r01] : 0) * 1024, t10 = ((r10 < cnte) ? tl[r10] : 0) * 1024, t11 = ((r11 < cnte) ? tl[r11] : 0) * 1024;
    const bf16_t* Bt = reinterpret_cast<const bf16_t*>(p.ws + WS_WGU) + (size_t)(layer * NEXP + e) * 2048 * 1024;
    const float* bg = p.b_gu + (size_t)(layer * NEXP + e) * 2048 + pnt * 128;
    const int arow0 = est[e] + m0;
    gemm_tile(lds, (const char*)F, (const char*)F, (unsigned)(t00 + C0) * 2u, (unsigned)(t01 + C1) * 2u, (unsigned)(t10 + C0) * 2u, (unsigned)(t11 + C1) * 2u,
              (const char*)(Bt + (size_t)br0 * 1024), (const char*)(Bt + (size_t)(br0 + 128) * 1024), stage_voff(tz, 0, 1024), stage_voff(tz, 1, 1024), 16, tz,
      epi2([&](int r, int c, f32x4 v0, f32x4 v1) {
        if (m0 + r < cnte) {
          const float4 b0 = *reinterpret_cast<const float4*>(bg + c); const float4 b1 = *reinterpret_cast<const float4*>(bg + 1024 + c);
          float o[4];
          const float gg[4] = {v0[0] + b0.x, v0[1] + b0.y, v0[2] + b0.z, v0[3] + b0.w};
          const float uu[4] = {v1[0] + b1.x, v1[1] + b1.y, v1[2] + b1.z, v1[3] + b1.w};
#pragma unroll
          for (int j = 0; j < 4; ++j) { const float g = fminf(gg[j], 7.0f); const float u = fminf(fmaxf(uu[j], -7.0f), 7.0f); o[j] = (u + 1.0f) * (g * sigmoidf(1.702f * g)); }
          st_bf4(ACT + (size_t)(arow0 + r) * 1024 + pnt * 128 + c, o[0], o[1], o[2], o[3]);
        }
      }));
  }
}

__device__ __forceinline__ void phase_moe2(const Params& p, int layer, LAS unsigned char* lds, int* est) {
  const int G = gridDim.x, bid = blockIdx.x;
  const unsigned* cnt = reinterpret_cast<const unsigned*>(p.ws + WS_CTL) + CW_CNT + layer * 32;
  const int total = moe_tables(cnt, est, 4);
  const bf16_t* ACT = reinterpret_cast<const bf16_t*>(p.ws + WS_ACT);
  bf16_t* YB = reinterpret_cast<bf16_t*>(p.ws + WS_YB);
  for (int L = bid; L < total; L += G) {
    int e, cnte, pmt, pnt; moe_unit(est, total, L, e, cnte, pmt, pnt);
    const int m0 = pmt * 256, br0 = pnt * 256; const int tz = opaque_tid();
    const int arow0 = est[e] + m0;
    const bf16_t* Bt = reinterpret_cast<const bf16_t*>(p.ws + WS_WDN) + (size_t)(layer * NEXP + e) * 1024 * 1024;
    const float* bd = p.b_dn + (size_t)(layer * NEXP + e) * 1024 + br0;
    gemm_tile(lds, (const char*)(ACT + (size_t)arow0 * 1024), (const char*)(ACT + (size_t)(arow0 + 128) * 1024), stage_voff(tz, 0, 1024), stage_voff(tz, 1, 1024), stage_voff(tz, 0, 1024), stage_voff(tz, 1, 1024),
              (const char*)(Bt + (size_t)br0 * 1024), (const char*)(Bt + (size_t)(br0 + 128) * 1024), stage_voff(tz, 0, 1024), stage_voff(tz, 1, 1024), 16, tz,
      epi2([&](int r, int c, f32x4 v0, f32x4 v1) {
        if (m0 + r < cnte) {
          const float4 b0 = *reinterpret_cast<const float4*>(bd + c); const float4 b1 = *reinterpret_cast<const float4*>(bd + 128 + c);
          bf16_t* o = YB + (size_t)(arow0 + r) * 1024 + br0 + c;
          st_bf4(o, v0[0] + b0.x, v0[1] + b0.y, v0[2] + b0.z, v0[3] + b0.w);
          st_bf4(o + 128, v1[0] + b1.x, v1[1] + b1.y, v1[2] + b1.z, v1[3] + b1.w);
        }
      }));
  }
}

__device__ __forceinline__ void phase_prologue(const Params& p, float* ldsf) {
  const int tid_ = opaque_tid();
  const int G = gridDim.x, bid = blockIdx.x;
  conv_mats<2>(p.w_in, reinterpret_cast<bf16_t*>(p.ws + WS_WIN), DEPTH, 1024, INW, ldsf, tid_);
  conv_mats<0>(p.w_glu, reinterpret_cast<bf16_t*>(p.ws + WS_WGLU), DEPTH, 512, 512, ldsf, tid_);
  conv_mats<0>(p.w_branch, reinterpret_cast<bf16_t*>(p.ws + WS_WBR), DEPTH * 3, 512, 1024, ldsf, tid_);
  conv_mats<0>(p.w_out, reinterpret_cast<bf16_t*>(p.ws + WS_WOUT), DEPTH, 1024, 1024, ldsf, tid_);
  conv_mats<1>(p.w_gu, reinterpret_cast<bf16_t*>(p.ws + WS_WGU), DEPTH * NEXP, 1024, 2048, ldsf, tid_);
  conv_mats<0>(p.w_dn, reinterpret_cast<bf16_t*>(p.ws + WS_WDN), DEPTH * NEXP, 1024, 1024, ldsf, tid_);
  mod_phase(p, ldsf);
  if (bid == 0) {
    float* rt = reinterpret_cast<float*>(p.ws + WS_ROPE);
    for (int i = tid_; i < 1024; i += NTHR) { const float ang = (float)(i >> 4) * powf(10000.0f, -(float)(i & 15) / 16.0f); rt[i] = cosf(ang); rt[1024 + i] = sinf(ang); }
  }
  const float4* xs = reinterpret_cast<const float4*>(p.x); float4* xo = reinterpret_cast<float4*>(p.out);
  for (size_t i = (size_t)bid * NTHR + tid_; i < (size_t)NLAT * D / 4; i += (size_t)G * NTHR) xo[i] = xs[i];
  const float4* cs = reinterpret_cast<const float4*>(p.ctx); float4* co = reinterpret_cast<float4*>(p.ws + WS_CX);
  for (size_t i = (size_t)bid * NTHR + tid_; i < (size_t)NCTX * D / 4; i += (size_t)G * NTHR) co[i] = cs[i];
}

#ifndef ONLY
#define ONLY -1
#endif
#ifndef REP_PRO
#define REP_PRO 1
#endif
#ifndef REP_GEMM
#define REP_GEMM 1
#endif
#ifndef REP_PC
#define REP_PC 1
#endif
#ifndef REP_MOE
#define REP_MOE 1
#endif
#define PH_ON(idx, k) ((ONLY < 0 || ONLY == (k)) && p.ph_lo <= (idx) && (idx) < p.ph_hi)
#define PH_END(idx) do { if ((idx) + 1 < p.ph_hi) xcd_barrier(bar); } while (0)

__global__ void __launch_bounds__(512, 2) fwd(Params p) {
  extern __shared__ __attribute__((aligned(16))) unsigned char lds_raw[];
  LAS unsigned char* shm = (LAS unsigned char*)lds_raw;
  unsigned* misc_u = reinterpret_cast<unsigned*>(lds_raw + LDS_MISC);
  int* misc_i = reinterpret_cast<int*>(lds_raw + LDS_MISC + 64);
  unsigned* ctl = reinterpret_cast<unsigned*>(p.ws + WS_CTL);
  if (threadIdx.x < 4) misc_u[threadIdx.x] = 0u;
  __syncthreads();
  XcdBarrier bar = xcd_barrier_post(ctl + CW_BAR, (volatile LAS unsigned*)misc_u);

  if (PH_ON(0, 10)) { for (int rep = 0; rep < REP_PRO; ++rep) phase_prologue(p, reinterpret_cast<float*>(lds_raw)); PH_END(0); }

  for (int layer = 0; layer < DEPTH; ++layer) {
    const int pb = 1 + layer * 10;
    const bool need_ctx = layer < DEPTH - 1;
    const int mrows = need_ctx ? NTOK : NLAT;
    if (PH_ON(pb + 0, 0)) { norm_phase(p, layer, layer > 0, misc_i); PH_END(pb + 0); }
    if (PH_ON(pb + 1, 1)) { for (int rep = 0; rep < REP_GEMM; ++rep) phase_inproj(p, layer, shm); PH_END(pb + 1); }
    if (PH_ON(pb + 3, 3)) { for (int rep = 0; rep < REP_PC; ++rep) phase_mixers(p, layer, need_ctx, misc_i, lds_raw, rep); PH_END(pb + 3); }
    if (PH_ON(pb + 4, 4)) { for (int rep = 0; rep < REP_GEMM; ++rep) phase_glu(p, layer, mrows, shm); PH_END(pb + 4); }
    if (PH_ON(pb + 5, 5)) { for (int rep = 0; rep < REP_GEMM; ++rep) phase_merge1(p, layer, mrows, shm); PH_END(pb + 5); }
    if (PH_ON(pb + 6, 6)) { phase_merge2(p, layer, mrows, shm); PH_END(pb + 6); }
    if (PH_ON(pb + 7, 7)) { route_phase(p, layer, mrows, reinterpret_cast<float*>(lds_raw)); PH_END(pb + 7); }
    if (PH_ON(pb + 8, 8)) { for (int rep = 0; rep < REP_MOE; ++rep) phase_moe1(p, layer, shm, misc_i); PH_END(pb + 8); }
    if (PH_ON(pb + 9, 9)) { for (int rep = 0; rep < REP_MOE; ++rep) phase_moe2(p, layer, shm, misc_i); PH_END(pb + 9); }
  }
  if (PH_ON(41, 11)) { final_combine(p, misc_i); }
}

extern "C" void kernel_launch(void* const* d_in, const int* in_sizes, int n_in, void* d_out, int out_size, void* d_ws, size_t ws_size, hipStream_t stream) {
  static int grid = 0;
  if (grid == 0) {
    if (n_in != 32 || out_size != NLAT * D || ws_size < WS_END) { fprintf(stderr, "kernel_launch: unexpected shapes (n_in %d out %d ws %zu need %zu)\n", n_in, out_size, ws_size, (size_t)WS_END); grid = -1; return; }
    int dev = 0, cus = 0, per_cu = 0;
    if (hipGetDevice(&dev) != hipSuccess || hipDeviceGetAttribute(&cus, hipDeviceAttributeMultiprocessorCount, dev) != hipSuccess) { grid = -1; return; }
    if (hipFuncSetAttribute((const void*)fwd, hipFuncAttributeMaxDynamicSharedMemorySize, LDS_BYTES) != hipSuccess) { fprintf(stderr, "kernel_launch: hipFuncSetAttribute failed\n"); grid = -1; return; }
    if (hipOccupancyMaxActiveBlocksPerMultiprocessor(&per_cu, (const void*)fwd, NTHR, LDS_BYTES) != hipSuccess || per_cu < 1) fprintf(stderr, "kernel_launch: occupancy query reports %d\n", per_cu);
    (void)hipGetLastError();
    grid = cus;
  }
  if (grid < 0) return;
  (void)hipMemsetAsync((char*)d_ws + WS_CTL, 0, CTL_BYTES, stream);
  Params p{};
  const float** f = reinterpret_cast<const float**>(&p);
  for (int i = 0; i < 32; ++i) f[i] = (const float*)d_in[i];
  p.out = (float*)d_out; p.ws = (unsigned char*)d_ws; p.ph_lo = 0; p.ph_hi = 42;
  hipLaunchKernelGGL(fwd, dim3(grid), dim3(NTHR), LDS_BYTES, stream, p);
}
```

```cpp
#include <hip/hip_runtime.h>
#include <stdint.h>
#include <stdio.h>

typedef unsigned short bf16_t;
typedef short bf16x8 __attribute__((ext_vector_type(8)));
typedef float f32x4 __attribute__((ext_vector_type(4)));
#define LAS __attribute__((address_space(3)))

constexpr int D = 1024, NB = 8, SEQ = 2048, DEPTH = 4, CTXL = 256;
constexpr int NLAT = NB * SEQ, NCTX = NB * CTXL, NTOK = NLAT + NCTX;
constexpr int INW = 5888;
constexpr int C_U = 0, C_WQ = 512, C_WK = 1024, C_WV = 1152, C_NQ = 1280, C_NK = 1792, C_NV = 2304, C_GATE = 2816;
constexpr int NEXP = 32, TOPK = 4, DFF = 1024;
constexpr int NTHR = 512;

constexpr size_t al256(size_t x) { return (x + 255) & ~(size_t)255; }
constexpr size_t WS_CTL   = 0;
constexpr size_t CTL_BYTES = 65536;
constexpr size_t WS_MOD   = WS_CTL + CTL_BYTES;
constexpr size_t WS_WIN   = al256(WS_MOD + (size_t)DEPTH * 9 * 6144 * 4);
constexpr size_t WS_WGLU  = al256(WS_WIN + (size_t)DEPTH * INW * 1024 * 2);
constexpr size_t WS_WBR   = al256(WS_WGLU + (size_t)DEPTH * 512 * 512 * 2);
constexpr size_t WS_WOUT  = al256(WS_WBR + (size_t)DEPTH * 3 * 1024 * 512 * 2);
constexpr size_t WS_WGU   = al256(WS_WOUT + (size_t)DEPTH * 1024 * 1024 * 2);
constexpr size_t WS_WDN   = al256(WS_WGU + (size_t)DEPTH * NEXP * 2048 * 1024 * 2);
constexpr size_t WS_CX    = al256(WS_WDN + (size_t)DEPTH * NEXP * 1024 * 1024 * 2);
constexpr size_t WS_H     = al256(WS_CX + (size_t)NCTX * D * 4);
constexpr size_t WS_P     = al256(WS_H + (size_t)NTOK * D * 2);
constexpr size_t WS_YD    = al256(WS_P + (size_t)NTOK * INW * 2);
constexpr size_t WS_G     = al256(WS_YD + (size_t)2 * NTOK * 512 * 4);
constexpr size_t WS_Y     = al256(WS_G + (size_t)NTOK * 512 * 2);
constexpr size_t WS_S     = al256(WS_Y + (size_t)NTOK * 1536 * 2);
constexpr size_t WS_SB    = al256(WS_S + (size_t)NTOK * D * 4);
constexpr size_t WS_TKE   = al256(WS_SB + (size_t)NTOK * D * 2);
constexpr size_t WS_TKP   = al256(WS_TKE + (size_t)NTOK * 4 * 4);
constexpr size_t WS_TKG   = al256(WS_TKP + (size_t)NTOK * 4 * 4);
constexpr size_t WS_TLIST = al256(WS_TKG + (size_t)NTOK * 4 * 4);
constexpr size_t WS_ACT   = al256(WS_TLIST + (size_t)NEXP * NTOK * 4);
constexpr size_t WS_YB    = al256(WS_ACT + (size_t)(NTOK * 4 + 256) * 1024 * 2);
constexpr size_t WS_VT    = al256(WS_YB + (size_t)(NTOK * 4 + 256) * 1024 * 2);
constexpr size_t WS_ROPE  = al256(WS_VT + (size_t)NB * 10 * 64 * (CTXL + SEQ) * 2);
constexpr size_t WS_END   = al256(WS_ROPE + 2 * 64 * 16 * 4);

constexpr int CW_BAR = 0;
constexpr int CW_WQ = 4096;
constexpr int CW_CNT = 8192;

__device__ __forceinline__ bf16_t f2bf(float f) { unsigned u = __float_as_uint(f); u += 0x7fffu + ((u >> 16) & 1u); return (bf16_t)(u >> 16); }
__device__ __forceinline__ float bf2f(bf16_t h) { return __uint_as_float(((unsigned)h) << 16); }
__device__ __forceinline__ unsigned pack2(float a, float b) { return (unsigned)f2bf(a) | ((unsigned)f2bf(b) << 16); }
__device__ __forceinline__ float sigmoidf(float x) { return 1.0f / (1.0f + __expf(-x)); }
__device__ __forceinline__ int opaque_tid() { int tz = threadIdx.x; asm volatile("" : "+v"(tz)); return tz; }
__device__ __forceinline__ float shx(float v, int o, int lane) { return __int_as_float(__builtin_amdgcn_ds_bpermute((lane ^ o) << 2, __float_as_int(v))); }
__device__ __forceinline__ int shx(int v, int o, int lane) { return __builtin_amdgcn_ds_bpermute((lane ^ o) << 2, v); }
__device__ __forceinline__ float wave_sum(float v, int lane) {
#pragma unroll
  for (int o = 32; o >= 1; o >>= 1) v += shx(v, o, lane);
  return v;
}
__device__ __forceinline__ float wave_max(float v, int lane) {
#pragma unroll
  for (int o = 32; o >= 1; o >>= 1) v = fmaxf(v, shx(v, o, lane));
  return v;
}

#define XB_TMO      128
#define XB_XCNT(j)  (256  + 64 * (j))
#define XB_XSUB(j)  (1280 + 64 * (j))
#define XB_XGEN(j)  (2304 + 64 * (j))
#define XB_TOP      3328
#define XB_TOPGEN   3392
#define XCD_BAR_WORDS 3456
#define XB_SPIN_CAP (1u << 20)

__device__ __forceinline__ unsigned xb_ld(unsigned* p)              { return __hip_atomic_load(p, __ATOMIC_RELAXED, __HIP_MEMORY_SCOPE_AGENT); }
__device__ __forceinline__ unsigned xb_add(unsigned* p, unsigned v) { return __hip_atomic_fetch_add(p, v, __ATOMIC_RELAXED, __HIP_MEMORY_SCOPE_AGENT); }
__device__ __forceinline__ unsigned xb_xcc_id() { return (unsigned)__builtin_amdgcn_s_getreg((3 << 11) | 20) & 0xFu; }
#define XB_SPIN(cond, bar) do { unsigned _sp = 0; while (cond) { __builtin_amdgcn_s_sleep(1); \
    if ((++_sp & 255u) == 0u) { if (xb_ld(&(bar)[XB_TMO])) break; if (_sp > XB_SPIN_CAP) { atomicAdd(&(bar)[XB_TMO], 1u); break; } } } } while (0)

struct XcdBarrier { unsigned* bar; unsigned x; volatile LAS unsigned* st; };

__device__ __forceinline__ XcdBarrier xcd_barrier_post(unsigned* bar, volatile LAS unsigned* st) {
    XcdBarrier b; b.bar = bar; b.x = xb_xcc_id(); b.st = st;
    if (threadIdx.x == 0) (void)xb_add(&bar[XB_XCNT(b.x)], 1u);
    return b;
}
__device__ __forceinline__ void xcd_barrier_complete(unsigned* bar, unsigned x, unsigned& nloc, unsigned& nx) {
    const unsigned G = gridDim.x * gridDim.y * gridDim.z;
    unsigned sum, cnt, mine, sp = 0u;
    for (;;) {
        sum = 0u; cnt = 0u; mine = 0u;
#pragma unroll
        for (unsigned j = 0; j < 16; ++j) { const unsigned c = xb_ld(&bar[XB_XCNT(j)]); sum += c; cnt += (c > 0u) ? 1u : 0u; mine = (j == x) ? c : mine; }
        if (sum == G) break;
        __builtin_amdgcn_s_sleep(1);
        if ((++sp & 255u) == 0u) { if (xb_ld(&bar[XB_TMO])) break; if (sp > XB_SPIN_CAP) { atomicAdd(&bar[XB_TMO], 1u); break; } }
    }
    nloc = mine > 0u ? mine : 1u; nx = cnt > 0u ? cnt : 1u;
}
__device__ __forceinline__ void xcd_barrier(const XcdBarrier& b) {
    asm volatile("s_waitcnt vmcnt(0)" ::: "memory");
    __syncthreads();
    if (threadIdx.x == 0) {
        unsigned* bar = b.bar;
        __builtin_amdgcn_s_waitcnt(0);
        unsigned nloc = b.st[0], nx = b.st[1];
        if (nloc == 0u) { xcd_barrier_complete(bar, b.x, nloc, nx); b.st[0] = nloc; b.st[1] = nx; }
        const unsigned old = xb_add(&bar[XB_XSUB(b.x)], 1u);
        const unsigned gen = old / nloc;
        if (old + 1u == (gen + 1u) * nloc) {
            __builtin_amdgcn_fence(__ATOMIC_RELEASE, "agent");
            asm volatile("s_waitcnt vmcnt(0)" ::: "memory");
            const unsigned og = xb_add(&bar[XB_TOP], 1u);
            const unsigned tg = og / nx;
            if (og + 1u == (tg + 1u) * nx) xb_add(&bar[XB_TOPGEN], 1u);
            else XB_SPIN(xb_ld(&bar[XB_TOPGEN]) == tg, bar);
            __builtin_amdgcn_fence(__ATOMIC_ACQUIRE, "agent");
            xb_add(&bar[XB_XGEN(b.x)], 1u);
            asm volatile("s_waitcnt vmcnt(0)" ::: "memory");
        } else {
            XB_SPIN(xb_ld(&bar[XB_XGEN(b.x)]) == gen, bar);
            __builtin_amdgcn_fence(__ATOMIC_ACQUIRE, "agent");
            asm volatile("s_waitcnt vmcnt(0)" ::: "memory");
        }
    }
    __syncthreads();
}

struct Params {
  const float *x, *c, *ctx, *c_ctx, *w_mod, *b_mod, *norm_mix, *norm_ffn, *w_in, *lam_re, *lam_im, *log_dt,
              *b_re, *b_im, *c_re, *c_im, *ssm_d, *w_glu, *win_qn, *win_kn, *win_sink, *na_qn, *na_kn, *na_rpb,
              *w_branch, *w_out, *router_w, *router_b, *w_gu, *b_gu, *w_dn, *b_dn;
  float* out;
  unsigned char* ws;
  int ph_lo, ph_hi;
};

constexpr int LDS_MISC = 131072;
constexpr int LDS_TAB = 131072 + 4096;
constexpr int LDS_BYTES = 131072 + 16384;

constexpr int HT = 128 * 64;
__device__ __forceinline__ int lds_byte(int r, int c) {
  int st = (r >> 4) * 2 + (c >> 5), rr = r & 15, cc = c & 31, ob = rr * 64 + cc * 2;
  return st * 1024 + (ob ^ (((ob >> 9) & 1) << 5));
}
__device__ __forceinline__ void stage_rc(int b, int& R, int& C) {
  int st = b / 1024, sb = b % 1024, swz = sb ^ (((sb >> 9) & 1) << 5);
  R = (st >> 1) * 16 + swz / 64; C = (st & 1) * 32 + (swz % 64) / 2;
}

#define G_SA(b, h) (((b) * 2 + (h)) * 16384)
#define G_SB(b, h) ((4 + (b) * 2 + (h)) * 16384)
#define G_STAGE(bufoff, gbase, v0, v1) do { \
    __builtin_amdgcn_global_load_lds((const unsigned*)((gbase) + (v0)), (LAS unsigned*)(lds + (bufoff) + ldsw), 16, 0, 0); \
    __builtin_amdgcn_global_load_lds((const unsigned*)((gbase) + (v1)), (LAS unsigned*)(lds + (bufoff) + ldsw + 8192), 16, 0, 0); } while (0)
#define G_LDA(dst, b, h) do { _Pragma("unroll") for (int m = 0; m < 4; ++m) _Pragma("unroll") for (int k = 0; k < 2; ++k) dst[m][k] = *(const LAS bf16x8*)(lds + G_SA(b, h) + aoff + m * 2048 + k * 1024); } while (0)
#define G_LDB(dst, b, h) do { _Pragma("unroll") for (int n = 0; n < 2; ++n) _Pragma("unroll") for (int k = 0; k < 2; ++k) dst[n][k] = *(const LAS bf16x8*)(lds + G_SB(b, h) + boff + n * 2048 + k * 1024); } while (0)
#define G_MMA(ai, bj, At, Bx) do { __builtin_amdgcn_s_setprio(1); \
    _Pragma("unroll") for (int m = 0; m < 4; ++m) _Pragma("unroll") for (int n = 0; n < 2; ++n) _Pragma("unroll") for (int k = 0; k < 2; ++k) \
      acc[ai][bj][m][n] = __builtin_amdgcn_mfma_f32_16x16x32_bf16(Bx[n][k], At[m][k], acc[ai][bj][m][n], 0, 0, 0); \
    __builtin_amdgcn_s_setprio(0); } while (0)
#define WAIT_V(n) asm volatile("s_waitcnt vmcnt(" #n ")" ::: "memory")
#define WAIT_L(n) asm volatile("s_waitcnt lgkmcnt(" #n ")" ::: "memory")
#define BAR __builtin_amdgcn_s_barrier()
#define SCHED __builtin_amdgcn_sched_barrier(0)

template <class Epi>
__device__ __forceinline__ void gemm_tile(LAS unsigned char* lds, const char* a0, const char* a1, unsigned va00, unsigned va01, unsigned va10, unsigned va11,
                                          const char* b0, const char* b1, unsigned vb0, unsigned vb1, int nt, int tid, Epi epi)
{
  asm volatile("s_waitcnt vmcnt(0)" ::: "memory");
  __syncthreads();
  const int wid = __builtin_amdgcn_readfirstlane(tid >> 6), lane = tid & 63, wr = wid >> 2, wc = wid & 3, fr = lane & 15, fq = lane >> 4;
  const unsigned ldsw = (unsigned)wid * 1024u;
  const int aoff = lds_byte(wr * 64 + fr, fq * 8), boff = lds_byte(wc * 32 + fr, fq * 8);
  f32x4 acc[2][2][4][2];
#pragma unroll
  for (int a = 0; a < 2; ++a)
#pragma unroll
    for (int b = 0; b < 2; ++b)
#pragma unroll
      for (int m = 0; m < 4; ++m)
#pragma unroll
        for (int n = 0; n < 2; ++n) acc[a][b][m][n] = f32x4{0.f, 0.f, 0.f, 0.f};
  bf16x8 At[4][2], B0[2][2], B1[2][2];
  G_STAGE(G_SB(0, 0), b0, vb0, vb1); G_STAGE(G_SA(0, 0), a0, va00, va01);
  G_STAGE(G_SB(0, 1), b1, vb0, vb1); G_STAGE(G_SA(0, 1), a1, va10, va11);
  if (wr == 1) BAR;
  WAIT_V(4); BAR;
  G_STAGE(G_SB(1, 0), b0 + 128, vb0, vb1); G_STAGE(G_SA(1, 0), a0 + 128, va00, va01); G_STAGE(G_SB(1, 1), b1 + 128, vb0, vb1);
  WAIT_V(6); BAR;
  for (int t = 0; t < nt - 2; t += 2) {
    const char* a0t = a0 + (size_t)t * 128; const char* a1t = a1 + (size_t)t * 128; const char* b0t = b0 + (size_t)t * 128; const char* b1t = b1 + (size_t)t * 128;
    G_LDB(B0, 0, 0); SCHED; G_LDA(At, 0, 0); G_STAGE(G_SA(1, 1), a1t + 128, va10, va11);
    WAIT_L(8); BAR; WAIT_L(0); G_MMA(0, 0, At, B0); BAR; SCHED;
    G_LDB(B1, 0, 1); G_STAGE(G_SB(0, 0), b0t + 256, vb0, vb1);
    BAR; WAIT_L(0); G_MMA(0, 1, At, B1); BAR;
    G_LDA(At, 0, 1); G_STAGE(G_SA(0, 0), a0t + 256, va00, va01);
    BAR; WAIT_L(0); G_MMA(1, 0, At, B0); BAR; SCHED;
    G_STAGE(G_SB(0, 1), b1t + 256, vb0, vb1);
    WAIT_V(6); BAR; G_MMA(1, 1, At, B1); BAR;
    G_LDB(B0, 1, 0); SCHED; G_LDA(At, 1, 0); G_STAGE(G_SA(0, 1), a1t + 256, va10, va11);
    WAIT_L(8); BAR; WAIT_L(0); G_MMA(0, 0, At, B0); BAR; SCHED;
    G_LDB(B1, 1, 1); G_STAGE(G_SB(1, 0), b0t + 384, vb0, vb1);
    BAR; WAIT_L(0); G_MMA(0, 1, At, B1); BAR;
    G_LDA(At, 1, 1); G_STAGE(G_SA(1, 0), a0t + 384, va00, va01);
    BAR; WAIT_L(0); G_MMA(1, 0, At, B0); BAR; SCHED;
    G_STAGE(G_SB(1, 1), b1t + 384, vb0, vb1);
    WAIT_V(6); BAR; G_MMA(1, 1, At, B1); BAR;
  }
  { G_LDB(B0, 0, 0); WAIT_V(0); G_LDA(At, 0, 0); G_STAGE(G_SA(1, 1), a1 + (size_t)(nt - 1) * 128, va10, va11);
    BAR; WAIT_L(0); G_MMA(0, 0, At, B0); BAR;
    G_LDB(B1, 0, 1); BAR; WAIT_L(0); G_MMA(0, 1, At, B1); BAR;
    G_LDA(At, 0, 1); WAIT_V(4); BAR; WAIT_L(0); G_MMA(1, 0, At, B0); G_MMA(1, 1, At, B1); BAR; }
  { G_LDB(B0, 1, 0); G_LDA(At, 1, 0); WAIT_V(2); BAR; WAIT_L(0); G_MMA(0, 0, At, B0); BAR;
    G_LDB(B1, 1, 1); WAIT_V(0); BAR; WAIT_L(0); G_MMA(0, 1, At, B1); BAR;
    G_LDA(At, 1, 1); BAR; WAIT_L(0); G_MMA(1, 0, At, B0); G_MMA(1, 1, At, B1); BAR; }
  if (wr == 0) BAR;
#pragma unroll
  for (int ai = 0; ai < 2; ++ai)
#pragma unroll
    for (int m = 0; m < 4; ++m)
      epi(ai * 128 + wr * 64 + m * 16 + fr, wc * 32 + fq * 4, acc[ai][0][m][0], acc[ai][0][m][1], acc[ai][1][m][0], acc[ai][1][m][1]);
}
struct GUnit {
  const char* a0; const char* a1; const char* b0; const char* b1;
  unsigned va00, va01, va10, va11;
  int i0, i1, i2, i3;
};
template <class NextFn, class EpiFn>
__device__ __forceinline__ void gemm_stream(LAS unsigned char* lds, int nt, int tid, unsigned vb0, unsigned vb1, NextFn next, EpiFn epi)
{
  GUnit cur, nxt;
  if (!next(0, cur)) return;
  asm volatile("s_waitcnt vmcnt(0)" ::: "memory");
  __syncthreads();
  const int wid = __builtin_amdgcn_readfirstlane(tid >> 6), lane = tid & 63, wr = wid >> 2, wc = wid & 3, fr = lane & 15, fq = lane >> 4;
  const unsigned ldsw = (unsigned)wid * 1024u;
  const int aoff = lds_byte(wr * 64 + fr, fq * 8), boff = lds_byte(wc * 32 + fr, fq * 8);
  f32x4 acc[2][2][4][2];
#pragma unroll
  for (int a = 0; a < 2; ++a)
#pragma unroll
    for (int b = 0; b < 2; ++b)
#pragma unroll
      for (int m = 0; m < 4; ++m)
#pragma unroll
        for (int n = 0; n < 2; ++n) acc[a][b][m][n] = f32x4{0.f, 0.f, 0.f, 0.f};
  bf16x8 At[4][2], B0[2][2], B1[2][2];
  G_STAGE(G_SB(0, 0), cur.b0, vb0, vb1); G_STAGE(G_SA(0, 0), cur.a0, cur.va00, cur.va01);
  G_STAGE(G_SB(0, 1), cur.b1, vb0, vb1); G_STAGE(G_SA(0, 1), cur.a1, cur.va10, cur.va11);
  if (wr == 1) BAR;
  WAIT_V(4); BAR;
  G_STAGE(G_SB(1, 0), cur.b0 + 128, vb0, vb1); G_STAGE(G_SA(1, 0), cur.a0 + 128, cur.va00, cur.va01); G_STAGE(G_SB(1, 1), cur.b1 + 128, vb0, vb1);
  WAIT_V(6); BAR;
  for (int ui = 0;; ++ui) {
    const bool has_next = next(ui + 1, nxt);
    if (!has_next) nxt = cur;
    for (int t = 0; t < nt; t += 2) {
      const bool last = (t == nt - 2);
      const char* a1_1 = cur.a1 + (size_t)(t + 1) * 128;
      const char* a0_2 = last ? nxt.a0 : cur.a0 + (size_t)(t + 2) * 128; const char* a1_2 = last ? nxt.a1 : cur.a1 + (size_t)(t + 2) * 128;
      const char* b0_2 = last ? nxt.b0 : cur.b0 + (size_t)(t + 2) * 128; const char* b1_2 = last ? nxt.b1 : cur.b1 + (size_t)(t + 2) * 128;
      const unsigned w00 = last ? nxt.va00 : cur.va00, w01 = last ? nxt.va01 : cur.va01, w10 = last ? nxt.va10 : cur.va10, w11 = last ? nxt.va11 : cur.va11;
      G_LDB(B0, 0, 0); SCHED; G_LDA(At, 0, 0); G_STAGE(G_SA(1, 1), a1_1, cur.va10, cur.va11);
      WAIT_L(8); BAR; WAIT_L(0); G_MMA(0, 0, At, B0); BAR; SCHED;
      G_LDB(B1, 0, 1); G_STAGE(G_SB(0, 0), b0_2, vb0, vb1);
      BAR; WAIT_L(0); G_MMA(0, 1, At, B1); BAR;
      G_LDA(At, 0, 1); G_STAGE(G_SA(0, 0), a0_2, w00, w01);
      BAR; WAIT_L(0); G_MMA(1, 0, At, B0); BAR; SCHED;
      G_STAGE(G_SB(0, 1), b1_2, vb0, vb1);
      WAIT_V(6); BAR; G_MMA(1, 1, At, B1); BAR;
      G_LDB(B0, 1, 0); SCHED; G_LDA(At, 1, 0); G_STAGE(G_SA(0, 1), a1_2, w10, w11);
      WAIT_L(8); BAR; WAIT_L(0); G_MMA(0, 0, At, B0); BAR; SCHED;
      G_LDB(B1, 1, 1); G_STAGE(G_SB(1, 0), b0_2 + 128, vb0, vb1);
      BAR; WAIT_L(0); G_MMA(0, 1, At, B1); BAR;
      G_LDA(At, 1, 1); G_STAGE(G_SA(1, 0), a0_2 + 128, w00, w01);
      BAR; WAIT_L(0); G_MMA(1, 0, At, B0); BAR; SCHED;
      G_STAGE(G_SB(1, 1), b1_2 + 128, vb0, vb1);
      WAIT_V(6); BAR; G_MMA(1, 1, At, B1); BAR;
    }
    { int frz = fr, fqz = fq; asm volatile("" : "+v"(frz), "+v"(fqz));
      epi(cur, acc, wr, wc, frz, fqz); }
    if (!has_next) break;
#pragma unroll
    for (int a = 0; a < 2; ++a)
#pragma unroll
      for (int b = 0; b < 2; ++b)
#pragma unroll
        for (int m = 0; m < 4; ++m)
#pragma unroll
          for (int n = 0; n < 2; ++n) acc[a][b][m][n] = f32x4{0.f, 0.f, 0.f, 0.f};
    cur = nxt;
  }
  WAIT_V(0);
  if (wr == 0) BAR;
  BAR;
}

template <class F> struct Epi2 {
  F f;
  __device__ __forceinline__ void operator()(int row, int cq, f32x4 c00, f32x4 c01, f32x4 c10, f32x4 c11) const { f(row, cq, c00, c10); f(row, cq + 16, c01, c11); }
};
template <class F> __device__ __forceinline__ Epi2<F> epi2(F f) { return Epi2<F>{f}; }

__device__ __forceinline__ unsigned stage_voff(int tid, int i, int ld) { int R, C; stage_rc(tid * 16 + i * 8192, R, C); return (unsigned)(R * ld + C) * 2u; }


__device__ __forceinline__ bool unit_next(int L, int nM, int nN, int& pm, int& pn) {
  const int nwg = nM * nN; if (L >= nwg) return false;
  int wgid = L; { const int q = nwg / 8, r = nwg % 8, xcd = wgid % 8, off = wgid / 8; wgid = (xcd < r ? xcd * (q + 1) : r * (q + 1) + (xcd - r) * q) + off; }
  const int nig = 8 * nN, gid = wgid / nig, fm = gid * 8, gsz = (nM - fm) < 8 ? (nM - fm) : 8;
  pm = fm + ((wgid % nig) % gsz); pn = (wgid % nig) / gsz; return true;
}

__device__ __forceinline__ void st_bf4(bf16_t* p, float a, float b, float c, float d) {
  uint2 v; v.x = pack2(a, b); v.y = pack2(c, d); *reinterpret_cast<uint2*>(p) = v;
}
__device__ __forceinline__ void ld_bf4(const bf16_t* p, float& a, float& b, float& c, float& d) {
  uint2 v = *reinterpret_cast<const uint2*>(p);
  a = __uint_as_float(v.x << 16); b = __uint_as_float(v.x & 0xffff0000u); c = __uint_as_float(v.y << 16); d = __uint_as_float(v.y & 0xffff0000u);
}

template <class T> __device__ __forceinline__ T ldg(const void* base, unsigned off) { return *reinterpret_cast<const T*>(reinterpret_cast<const char*>(base) + off); }
template <class T> __device__ __forceinline__ void stg(void* base, unsigned off, T v) { *reinterpret_cast<T*>(reinterpret_cast<char*>(base) + off) = v; }
__device__ __forceinline__ void stg_bf4(void* base, unsigned off, float a, float b, float c, float d) { uint2 v; v.x = pack2(a, b); v.y = pack2(c, d); stg<uint2>(base, off, v); }

template <int PERM>
__device__ __forceinline__ int conv_srccol(int p) {
  if (PERM == 1) { const int t256 = p >> 8, w = p & 255; return (w < 128) ? (t256 * 128 + w) : (1024 + t256 * 128 + (w - 128)); }
  if (PERM == 2) { if (p < C_WQ || p >= C_GATE) return p; const int tile = p >> 8, pin = p & 255, cp = pin >> 5, r = pin & 31, bj = cp >> 2, wc = cp & 3; return tile * 256 + (wc * 2 + bj) * 32 + r; }
  return p;
}
template <int PERM>
__device__ __forceinline__ void conv_mats(const float* __restrict__ src, bf16_t* __restrict__ dst, int nmat, int K, int N, float* lds, int tid_) {
  const int tK = K / 64, tN = N / 64, per = tK * tN, total = nmat * per;
  const int t = tid_;
  for (int tile = blockIdx.x; tile < total; tile += gridDim.x) {
    const int mat = tile / per, rem = tile % per, kt = rem / tN, ntl = rem % tN;
    const int p0 = ntl * 64;
    __syncthreads();
    { const int c = t & 63, r = t >> 6;
      const int sc = conv_srccol<PERM>(p0 + (c & 32)) + (c & 31);
      const float* S = src + (size_t)mat * K * N + (size_t)(kt * 64) * N + sc;
#pragma unroll
      for (int i = 0; i < 8; ++i) { const int k = r + 8 * i; lds[k * 65 + c] = S[(size_t)k * N]; } }
    __syncthreads();
    { const int n = t >> 3, kc = (t & 7) * 8;
      uint4 v;
      v.x = pack2(lds[(kc + 0) * 65 + n], lds[(kc + 1) * 65 + n]);
      v.y = pack2(lds[(kc + 2) * 65 + n], lds[(kc + 3) * 65 + n]);
      v.z = pack2(lds[(kc + 4) * 65 + n], lds[(kc + 5) * 65 + n]);
      v.w = pack2(lds[(kc + 6) * 65 + n], lds[(kc + 7) * 65 + n]);
      *reinterpret_cast<uint4*>(dst + (size_t)mat * N * K + (size_t)(p0 + n) * K + kt * 64 + kc) = v; }
  }
}

__device__ __forceinline__ float siluf(float x) { return x / (1.0f + __expf(-x)); }
__device__ __forceinline__ float gelu_tanh(float x) {
  const float u = 0.7978845608028654f * (x + 0.044715f * x * x * x);
  return 0.5f * x * (1.0f + tanhf(u));
}

__device__ __forceinline__ void mod_phase(const Params& p, float* lds) {
  const int tid_ = opaque_tid();
  float* sc = lds;
  float* red = lds + 9 * 1024;
  const int t = tid_;
  __syncthreads();
  for (int i = t; i < 9 * 1024; i += NTHR) { const int r = i >> 10, k = i & 1023; const float v = (r < 8) ? p.c[r * 1024 + k] : p.c_ctx[k]; sc[i] = siluf(v); }
  __syncthreads();
  float* mod = reinterpret_cast<float*>(p.ws + WS_MOD);
  for (int u = blockIdx.x; u < DEPTH * 48; u += gridDim.x) {
    const int l = u / 48, col0 = (u % 48) * 128;
    const int col = t & 127, kq = t >> 7;
    float a[9];
#pragma unroll
    for (int r = 0; r < 9; ++r) a[r] = 0.f;
    const float* W = p.w_mod + (size_t)l * 1024 * 6144 + col0 + col;
    for (int k = kq * 256; k < kq * 256 + 256; ++k) {
      const float w = W[(size_t)k * 6144];
#pragma unroll
      for (int r = 0; r < 9; ++r) a[r] += sc[r * 1024 + k] * w;
    }
#pragma unroll
    for (int r = 0; r < 9; ++r) red[(kq * 9 + r) * 128 + col] = a[r];
    __syncthreads();
    for (int i = t; i < 9 * 128; i += NTHR) {
      const int r = i >> 7, cc = i & 127;
      const float v = red[(0 * 9 + r) * 128 + cc] + red[(1 * 9 + r) * 128 + cc] + red[(2 * 9 + r) * 128 + cc] + red[(3 * 9 + r) * 128 + cc];
      mod[((size_t)l * 9 + r) * 6144 + col0 + cc] = v + p.b_mod[l * 6144 + col0 + cc];
    }
    __syncthreads();
  }
}

__device__ __forceinline__ float* stream_row(const Params& p, int row) {
  return (row < NLAT) ? (p.out + (size_t)row * D) : (reinterpret_cast<float*>(p.ws + WS_CX) + (size_t)(row - NLAT) * D);
}
__device__ __forceinline__ int row_modidx(int row) { return (row < NLAT) ? (row >> 11) : 8; }

__device__ __forceinline__ void expert_starts(const unsigned* cnt, int* st) {
  if (threadIdx.x == 0) { int s = 0; for (int e = 0; e < NEXP; ++e) { st[e] = s; s += (int)cnt[e]; } st[NEXP] = s; }
  __syncthreads();
}

__device__ __forceinline__ void norm_phase(const Params& p, int layer, bool combine, int* lds_i) {
  const int tid_ = opaque_tid();
  const float* mod = reinterpret_cast<const float*>(p.ws + WS_MOD);
  bf16_t* H = reinterpret_cast<bf16_t*>(p.ws + WS_H);
  const int* tke = reinterpret_cast<const int*>(p.ws + WS_TKE);
  const int* tkp = reinterpret_cast<const int*>(p.ws + WS_TKP);
  const float* tkg = reinterpret_cast<const float*>(p.ws + WS_TKG);
  const bf16_t* YB = reinterpret_cast<const bf16_t*>(p.ws + WS_YB);
  const unsigned* ctl = reinterpret_cast<const unsigned*>(p.ws + WS_CTL);
  if (combine) expert_starts(ctl + CW_CNT + (layer - 1) * 32, lds_i);
  const int lane = tid_ & 63, wv = tid_ >> 6;
  const float* gw = p.norm_mix + layer * D;
  for (int row = blockIdx.x * 8 + wv; row < NTOK; row += gridDim.x * 8) {
    float* xr = stream_row(p, row);
    const int mi = row_modidx(row);
    float v[16];
#pragma unroll
    for (int i = 0; i < 4; ++i) { const float4 q = *reinterpret_cast<const float4*>(xr + i * 256 + lane * 4); v[4 * i] = q.x; v[4 * i + 1] = q.y; v[4 * i + 2] = q.z; v[4 * i + 3] = q.w; }
    if (combine) {
      const float* m5 = mod + ((size_t)(layer - 1) * 9 + mi) * 6144 + 5 * 1024;
      float a[16];
#pragma unroll
      for (int i = 0; i < 16; ++i) a[i] = 0.f;
#pragma unroll
      for (int k = 0; k < 4; ++k) {
        const int e = tke[row * 4 + k]; const int pos = tkp[row * 4 + k]; const float g = tkg[row * 4 + k];
        const bf16_t* yr = YB + (size_t)(lds_i[e] + pos) * D;
#pragma unroll
        for (int i = 0; i < 4; ++i) { float a0, a1, a2, a3; ld_bf4(yr + i * 256 + lane * 4, a0, a1, a2, a3); a[4 * i] += g * a0; a[4 * i + 1] += g * a1; a[4 * i + 2] += g * a2; a[4 * i + 3] += g * a3; }
      }
#pragma unroll
      for (int i = 0; i < 4; ++i) {
        const float4 mm = *reinterpret_cast<const float4*>(m5 + i * 256 + lane * 4);
        v[4 * i] += mm.x * a[4 * i]; v[4 * i + 1] += mm.y * a[4 * i + 1]; v[4 * i + 2] += mm.z * a[4 * i + 2]; v[4 * i + 3] += mm.w * a[4 * i + 3];
        *reinterpret_cast<float4*>(xr + i * 256 + lane * 4) = float4{v[4 * i], v[4 * i + 1], v[4 * i + 2], v[4 * i + 3]};
      }
    }
    float ss = 0.f;
#pragma unroll
    for (int i = 0; i < 16; ++i) ss += v[i] * v[i];
    ss = wave_sum(ss, lane);
    const float rinv = rsqrtf(ss * (1.0f / D) + 1e-6f);
    const float* msh = mod + ((size_t)layer * 9 + mi) * 6144;
#pragma unroll
    for (int i = 0; i < 4; ++i) {
      const int c = i * 256 + lane * 4;
      const float4 g = *reinterpret_cast<const float4*>(gw + c);
      const float4 sh = *reinterpret_cast<const float4*>(msh + c);
      const float4 sc = *reinterpret_cast<const float4*>(msh + 1024 + c);
      st_bf4(H + (size_t)row * D + c, v[4 * i] * rinv * g.x * (1.f + sc.x) + sh.x, v[4 * i + 1] * rinv * g.y * (1.f + sc.y) + sh.y,
             v[4 * i + 2] * rinv * g.z * (1.f + sc.z) + sh.z, v[4 * i + 3] * rinv * g.w * (1.f + sc.w) + sh.w);
    }
  }
}

__device__ __forceinline__ void final_combine(const Params& p, int* lds_i) {
  const int tid_ = opaque_tid();
  const float* mod = reinterpret_cast<const float*>(p.ws + WS_MOD);
  const int* tke = reinterpret_cast<const int*>(p.ws + WS_TKE);
  const int* tkp = reinterpret_cast<const int*>(p.ws + WS_TKP);
  const float* tkg = reinterpret_cast<const float*>(p.ws + WS_TKG);
  const bf16_t* YB = reinterpret_cast<const bf16_t*>(p.ws + WS_YB);
  const unsigned* ctl = reinterpret_cast<const unsigned*>(p.ws + WS_CTL);
  expert_starts(ctl + CW_CNT + (DEPTH - 1) * 32, lds_i);
  const int lane = tid_ & 63, wv = tid_ >> 6;
  for (int row = blockIdx.x * 8 + wv; row < NLAT; row += gridDim.x * 8) {
    float* xr = p.out + (size_t)row * D;
    const int mi = row >> 11;
    const float* m5 = mod + ((size_t)(DEPTH - 1) * 9 + mi) * 6144 + 5 * 1024;
    float a[16];
#pragma unroll
    for (int i = 0; i < 16; ++i) a[i] = 0.f;
#pragma unroll
    for (int k = 0; k < 4; ++k) {
      const int e = tke[row * 4 + k]; const int pos = tkp[row * 4 + k]; const float g = tkg[row * 4 + k];
      const bf16_t* yr = YB + (size_t)(lds_i[e] + pos) * D;
#pragma unroll
      for (int i = 0; i < 4; ++i) { float a0, a1, a2, a3; ld_bf4(yr + i * 256 + lane * 4, a0, a1, a2, a3); a[4 * i] += g * a0; a[4 * i + 1] += g * a1; a[4 * i + 2] += g * a2; a[4 * i + 3] += g * a3; }
    }
#pragma unroll
    for (int i = 0; i < 4; ++i) {
      const float4 mm = *reinterpret_cast<const float4*>(m5 + i * 256 + lane * 4);
      float4 q = *reinterpret_cast<const float4*>(xr + i * 256 + lane * 4);
      q.x += mm.x * a[4 * i]; q.y += mm.y * a[4 * i + 1]; q.z += mm.z * a[4 * i + 2]; q.w += mm.w * a[4 * i + 3];
      *reinterpret_cast<float4*>(xr + i * 256 + lane * 4) = q;
    }
  }
}

__device__ __forceinline__ void qknorm_phase(const Params& p, int layer) {
  const int tid_ = opaque_tid();
  bf16_t* P = reinterpret_cast<bf16_t*>(p.ws + WS_P);
  const int lane = tid_ & 63, wv = tid_ >> 6;
  const float wqn = p.win_qn[layer * 64 + lane], wkn = p.win_kn[layer * 64 + lane];
  const float nqn = p.na_qn[layer * 64 + lane], nkn = p.na_kn[layer * 64 + lane];
  const int fi = lane & 15;
  const float inv_freq = powf(10000.0f, -(float)fi / 16.0f);
  for (int row = blockIdx.x * 8 + wv; row < NTOK; row += gridDim.x * 8) {
    bf16_t* pr = P + (size_t)row * INW;
    const bool lat = row < NLAT;
    float cs = 1.f, sn = 0.f;
    if (lat) { const int t = row & 2047; const int pos = (lane < 32) ? (t >> 6) : (t & 63); const float ang = (float)pos * inv_freq; cs = cosf(ang); sn = sinf(ang); }
    for (int hd = 0; hd < 26; ++hd) {
      int col; float w; bool rope;
      if (hd < 8) { col = C_WQ + hd * 64; w = wqn; rope = lat; }
      else if (hd < 10) { col = C_WK + (hd - 8) * 64; w = wkn; rope = lat; }
      else if (hd < 18) { col = C_NQ + (hd - 10) * 64; w = nqn; rope = false; }
      else { col = C_NK + (hd - 18) * 64; w = nkn; rope = false; }
      const float v = bf2f(pr[col + lane]);
      const float ss = wave_sum(v * v, lane);
      float y = v * rsqrtf(ss * (1.0f / 64.0f) + 1e-6f) * w;
      if (rope) {
        const float o = shx(y, 16, lane);
        y = ((lane & 16) == 0) ? (y * cs - o * sn) : (o * sn + y * cs);
      }
      pr[col + lane] = f2bf(y);
    }
    {
      bf16_t* VT = reinterpret_cast<bf16_t*>(p.ws + WS_VT);
      const int bb = lat ? (row >> 11) : ((row - NLAT) >> 8);
      const int tpos = lat ? (CTXL + (row & 2047)) : ((row - NLAT) & 255);
#pragma unroll
      for (int hv = 0; hv < 10; ++hv) {
        const int col = (hv < 2) ? (C_WV + hv * 64) : (C_NV + (hv - 2) * 64);
        VT[((size_t)(bb * 10 + hv) * 64 + lane) * (CTXL + SEQ) + tpos] = pr[col + lane];
      }
    }
  }
}

__device__ __forceinline__ int ssm_row(int b, int dir, int tau) {
  if (tau < CTXL) return NLAT + b * CTXL + (dir ? (CTXL - 1 - tau) : tau);
  const int t = tau - CTXL;
  return b * SEQ + (dir ? (SEQ - 1 - t) : t);
}

__device__ __forceinline__ void ssm_item_naive(const Params& p, int layer, int item) {
  const int tid_ = opaque_tid();
  const int b = item >> 3, gq = item & 7;
  const int lane = tid_ & 63, wv = tid_ >> 6;
  const int dir = wv & 1, g = gq * 4 + (wv >> 1);
  const bf16_t* P = reinterpret_cast<const bf16_t*>(p.ws + WS_P);
  float* YD = reinterpret_cast<float*>(p.ws + WS_YD) + (size_t)dir * NTOK * 512;
  {
    const int n = lane;
    const size_t pg = ((size_t)(layer * 2 + dir) * 32 + g);
    const float lr = p.lam_re[pg * 64 + n], li = p.lam_im[pg * 64 + n];
    const float dt = expf(p.log_dt[pg]);
    const float mag = expf(lr * dt);
    const float ar = mag * cosf(li * dt), ai = mag * sinf(li * dt);
    const float den = lr * lr + li * li;
    const float fr = ((ar - 1.0f) * lr + ai * li) / den;
    const float fi = (ai * lr - (ar - 1.0f) * li) / den;
    float bbr[16], bbi[16], cr[16], ci[16];
#pragma unroll
    for (int q = 0; q < 16; ++q) {
      const float br = p.b_re[(pg * 64 + n) * 16 + q], bi = p.b_im[(pg * 64 + n) * 16 + q];
      bbr[q] = fr * br - fi * bi; bbi[q] = fr * bi + fi * br;
      cr[q] = p.c_re[(pg * 16 + q) * 64 + n]; ci[q] = p.c_im[(pg * 16 + q) * 64 + n];
    }
    float hr = 0.f, hi = 0.f;
    for (int tau = 0; tau < CTXL + SEQ; ++tau) {
      const int row = ssm_row(b, dir, tau);
      const uint4* up = reinterpret_cast<const uint4*>(P + (size_t)row * INW + C_U + g * 16);
      const uint4 u0 = up[0], u1 = up[1];
      float u[16];
      u[0] = __uint_as_float(u0.x << 16); u[1] = __uint_as_float(u0.x & 0xffff0000u); u[2] = __uint_as_float(u0.y << 16); u[3] = __uint_as_float(u0.y & 0xffff0000u);
      u[4] = __uint_as_float(u0.z << 16); u[5] = __uint_as_float(u0.z & 0xffff0000u); u[6] = __uint_as_float(u0.w << 16); u[7] = __uint_as_float(u0.w & 0xffff0000u);
      u[8] = __uint_as_float(u1.x << 16); u[9] = __uint_as_float(u1.x & 0xffff0000u); u[10] = __uint_as_float(u1.y << 16); u[11] = __uint_as_float(u1.y & 0xffff0000u);
      u[12] = __uint_as_float(u1.z << 16); u[13] = __uint_as_float(u1.z & 0xffff0000u); u[14] = __uint_as_float(u1.w << 16); u[15] = __uint_as_float(u1.w & 0xffff0000u);
      float xr = 0.f, xi = 0.f;
#pragma unroll
      for (int q = 0; q < 16; ++q) { xr += bbr[q] * u[q]; xi += bbi[q] * u[q]; }
      const float nhr = ar * hr - ai * hi + xr;
      const float nhi = ar * hi + ai * hr + xi;
      hr = nhr; hi = nhi;
      float v[16];
#pragma unroll
      for (int q = 0; q < 16; ++q) v[q] = hr * cr[q] - hi * ci[q];
#pragma unroll
      for (int i = 0; i < 8; ++i) { const bool up_ = (lane & 32) != 0; const float send = up_ ? v[i] : v[i + 8]; const float keep = up_ ? v[i + 8] : v[i]; v[i] = keep + shx(send, 32, lane); }
#pragma unroll
      for (int i = 0; i < 4; ++i) { const bool up_ = (lane & 16) != 0; const float send = up_ ? v[i] : v[i + 4]; const float keep = up_ ? v[i + 4] : v[i]; v[i] = keep + shx(send, 16, lane); }
#pragma unroll
      for (int i = 0; i < 2; ++i) { const bool up_ = (lane & 8) != 0; const float send = up_ ? v[i] : v[i + 2]; const float keep = up_ ? v[i + 2] : v[i]; v[i] = keep + shx(send, 8, lane); }
      { const bool up_ = (lane & 4) != 0; const float send = up_ ? v[0] : v[1]; const float keep = up_ ? v[1] : v[0]; v[0] = keep + shx(send, 4, lane); }
      v[0] += shx(v[0], 2, lane);
      v[0] += shx(v[0], 1, lane);
      if ((lane & 3) == 0) YD[(size_t)row * 512 + g * 16 + (lane >> 2)] = v[0];
    }
  }
  asm volatile("s_waitcnt vmcnt(0)" ::: "memory");
  __threadfence();
  __syncthreads();
  {
    const float* Y0 = reinterpret_cast<const float*>(p.ws + WS_YD);
    const float* Y1 = Y0 + (size_t)NTOK * 512;
    bf16_t* G = reinterpret_cast<bf16_t*>(p.ws + WS_G);
    const int ch = gq * 64 + (tid_ & 63);
    const float dsk = p.ssm_d[layer * 512 + ch];
    for (int i = tid_ >> 6; i < CTXL + SEQ; i += 8) {
      const int row = (i < CTXL) ? (NLAT + b * CTXL + i) : (b * SEQ + i - CTXL);
      const float y = Y0[(size_t)row * 512 + ch] + Y1[(size_t)row * 512 + ch] + dsk * bf2f(P[(size_t)row * INW + C_U + ch]);
      G[(size_t)row * 512 + ch] = f2bf(gelu_tanh(y));
    }
  }
}


typedef float f32x16 __attribute__((ext_vector_type(16)));
__device__ __forceinline__ bf16x8 pack8(const float* v) {
  union { unsigned u[4]; bf16x8 b; } t;
  t.u[0] = pack2(v[0], v[1]); t.u[1] = pack2(v[2], v[3]); t.u[2] = pack2(v[4], v[5]); t.u[3] = pack2(v[6], v[7]);
  return t.b;
}
constexpr int SSM_PITCH = 272;
__device__ __forceinline__ void ssm_item(const Params& p, int layer, int item, unsigned char* lds_raw) {
  const int tid_ = opaque_tid();
  const int b = item >> 3, gq = item & 7;
  const int lane = tid_ & 63, wv = tid_ >> 6;
  const int dir = wv & 1, g = gq * 4 + (wv >> 1);
  const bf16_t* P = reinterpret_cast<const bf16_t*>(p.ws + WS_P);
  float* YD = reinterpret_cast<float*>(p.ws + WS_YD) + (size_t)dir * NTOK * 512;
  unsigned char* hl = lds_raw + wv * (32 * SSM_PITCH);
  {
    const int n0 = lane & 31, hh = lane >> 5;
    const size_t pg = ((size_t)(layer * 2 + dir) * 32 + g);
    const float dt = expf(p.log_dt[pg]);
    float pwr[2][4], pwi[2][4];
    bf16x8 Bop[4];
#pragma unroll
    for (int sb = 0; sb < 2; ++sb) {
      const int n = n0 + 32 * sb;
      const float lr = p.lam_re[pg * 64 + n], li = p.lam_im[pg * 64 + n];
      const float mag = expf(lr * dt);
      const float ar = mag * cosf(li * dt), ai = mag * sinf(li * dt);
      const float den = lr * lr + li * li;
      const float fr = ((ar - 1.0f) * lr + ai * li) / den;
      const float fi = (ai * lr - (ar - 1.0f) * li) / den;
      float vr[8], vi[8];
#pragma unroll
      for (int j = 0; j < 8; ++j) {
        const int q = 8 * hh + j;
        const float br = p.b_re[(pg * 64 + n) * 16 + q], bi = p.b_im[(pg * 64 + n) * 16 + q];
        vr[j] = fr * br - fi * bi; vi[j] = fr * bi + fi * br;
      }
      Bop[sb * 2 + 0] = pack8(vr); Bop[sb * 2 + 1] = pack8(vi);
      pwr[sb][0] = ar; pwi[sb][0] = ai;
      pwr[sb][1] = ar * ar - ai * ai; pwi[sb][1] = 2.0f * ar * ai;
      pwr[sb][2] = pwr[sb][1] * ar - pwi[sb][1] * ai; pwi[sb][2] = pwr[sb][1] * ai + pwi[sb][1] * ar;
      pwr[sb][3] = pwr[sb][1] * pwr[sb][1] - pwi[sb][1] * pwi[sb][1]; pwi[sb][3] = 2.0f * pwr[sb][1] * pwi[sb][1];
    }
    bf16x8 Cop[4];
    {
      const int pch = lane & 15, q4 = lane >> 4;
#pragma unroll
      for (int kb = 0; kb < 4; ++kb) {
        float v[8];
#pragma unroll
        for (int j = 0; j < 8; ++j) {
          const int n = 8 * kb + 2 * q4 + (j >> 2), c = j & 3, nn = n + 32 * (c >> 1);
          v[j] = (c & 1) ? -p.c_im[(pg * 16 + pch) * 64 + nn] : p.c_re[(pg * 16 + pch) * 64 + nn];
        }
        Cop[kb] = pack8(v);
      }
    }
    float hpr[2] = {0.f, 0.f}, hpi[2] = {0.f, 0.f};
    const int ucol = C_U + g * 16 + 8 * hh;
    auto chunk_base = [&](int c, int& base, int& sgn) {
      sgn = dir ? -1 : 1;
      if (c < 8) base = NLAT + b * CTXL + (dir ? (CTXL - 1 - c * 32) : c * 32);
      else base = b * SEQ + (dir ? (SEQ - 1 - (c - 8) * 32) : (c - 8) * 32);
    };
    uint4 unext;
    { int base, sgn; chunk_base(0, base, sgn); unext = *reinterpret_cast<const uint4*>(P + (size_t)(base + sgn * n0) * INW + ucol); }
    for (int c = 0; c < 72; ++c) {
      int base, sgn; chunk_base(c, base, sgn);
      union { uint4 u; bf16x8 b; } ua; ua.u = unext;
      if (c + 1 < 72) { int nb, ns; chunk_base(c + 1, nb, ns); unext = *reinterpret_cast<const uint4*>(P + (size_t)(nb + ns * n0) * INW + ucol); }
      f32x16 X[4];
#pragma unroll
      for (int k = 0; k < 4; ++k) {
        f32x16 z;
#pragma unroll
        for (int r = 0; r < 16; ++r) z[r] = 0.f;
        X[k] = __builtin_amdgcn_mfma_f32_32x32x16_bf16(ua.b, Bop[k], z, 0, 0, 0);
      }
#pragma unroll
      for (int sb = 0; sb < 2; ++sb) {
        f32x16& xr = X[sb * 2]; f32x16& xi = X[sb * 2 + 1];
        const float ar = pwr[sb][0], ai = pwi[sb][0], a4r = pwr[sb][3], a4i = pwi[sb][3];
        float Er[4], Ei[4], Or[4], Oi[4], mcr[4], mci[4];
#pragma unroll
        for (int q = 0; q < 4; ++q) {
#pragma unroll
          for (int i = 1; i < 4; ++i) {
            const int r = 4 * q + i;
            const float nr = ar * xr[r - 1] - ai * xi[r - 1] + xr[r];
            const float ni = ar * xi[r - 1] + ai * xr[r - 1] + xi[r];
            xr[r] = nr; xi[r] = ni;
          }
          Er[q] = xr[4 * q + 3]; Ei[q] = xi[4 * q + 3];
        }
#pragma unroll
        for (int q = 0; q < 4; ++q) { Or[q] = shx(Er[q], 32, lane); Oi[q] = shx(Ei[q], 32, lane); }
        float cr = hpr[sb], ci = hpi[sb];
#pragma unroll
        for (int q = 0; q < 4; ++q) {
          const float cer = cr, cei = ci;
          const float eer = hh ? Or[q] : Er[q], eei = hh ? Oi[q] : Ei[q];
          float tr = a4r * cr - a4i * ci + eer, ti = a4r * ci + a4i * cr + eei;
          cr = tr; ci = ti;
          const float cor = cr, coi = ci;
          const float eor = hh ? Er[q] : Or[q], eoi = hh ? Ei[q] : Oi[q];
          tr = a4r * cr - a4i * ci + eor; ti = a4r * ci + a4i * cr + eoi;
          cr = tr; ci = ti;
          mcr[q] = hh ? cor : cer; mci[q] = hh ? coi : cei;
        }
        hpr[sb] = cr; hpi[sb] = ci;
#pragma unroll
        for (int q = 0; q < 4; ++q)
#pragma unroll
          for (int i = 0; i < 4; ++i) {
            const int r = 4 * q + i;
            xr[r] += pwr[sb][i] * mcr[q] - pwi[sb][i] * mci[q];
            xi[r] += pwr[sb][i] * mci[q] + pwi[sb][i] * mcr[q];
          }
      }
#pragma unroll
      for (int q = 0; q < 4; ++q)
#pragma unroll
        for (int i = 0; i < 4; ++i) {
          const int r = 4 * q + i, tok = 8 * q + 4 * hh + i;
          uint2 w; w.x = pack2(X[0][r], X[1][r]); w.y = pack2(X[2][r], X[3][r]);
          *reinterpret_cast<uint2*>(hl + tok * SSM_PITCH + n0 * 8) = w;
        }
#pragma unroll
      for (int th = 0; th < 2; ++th) {
        f32x4 acc = f32x4{0.f, 0.f, 0.f, 0.f};
        const int tok = 16 * th + (lane & 15);
#pragma unroll
        for (int kb = 0; kb < 4; ++kb) {
          const bf16x8 hb = *reinterpret_cast<const bf16x8*>(hl + tok * SSM_PITCH + kb * 64 + (lane >> 4) * 16);
          acc = __builtin_amdgcn_mfma_f32_16x16x32_bf16(Cop[kb], hb, acc, 0, 0, 0);
        }
        const int row = base + sgn * tok;
        *reinterpret_cast<float4*>(YD + (size_t)row * 512 + g * 16 + 4 * (lane >> 4)) = float4{acc[0], acc[1], acc[2], acc[3]};
      }
    }
  }
  asm volatile("s_waitcnt vmcnt(0)" ::: "memory");
  __threadfence();
  __syncthreads();
  {
    const float* Y0 = reinterpret_cast<const float*>(p.ws + WS_YD);
    const float* Y1 = Y0 + (size_t)NTOK * 512;
    bf16_t* G = reinterpret_cast<bf16_t*>(p.ws + WS_G);
    const int ch = gq * 64 + (tid_ & 63);
    const float dsk = p.ssm_d[layer * 512 + ch];
    for (int i = tid_ >> 6; i < CTXL + SEQ; i += 8) {
      const int row = (i < CTXL) ? (NLAT + b * CTXL + i) : (b * SEQ + i - CTXL);
      const float y = Y0[(size_t)row * 512 + ch] + Y1[(size_t)row * 512 + ch] + dsk * bf2f(P[(size_t)row * INW + C_U + ch]);
      G[(size_t)row * 512 + ch] = f2bf(gelu_tanh(y));
    }
  }
}

template <int NBT, class KF>
__device__ __forceinline__ void attn_query(const bf16_t* qptr, const bf16_t* P, int kcol, int vcol, bool has_sink, float sink, bf16_t* optr, int lane, KF kf) {
  float q[64];
  {
    const uint4* qp = reinterpret_cast<const uint4*>(qptr);
#pragma unroll
    for (int i = 0; i < 8; ++i) {
      const uint4 w = qp[i];
      q[8 * i + 0] = __uint_as_float(w.x << 16); q[8 * i + 1] = __uint_as_float(w.x & 0xffff0000u);
      q[8 * i + 2] = __uint_as_float(w.y << 16); q[8 * i + 3] = __uint_as_float(w.y & 0xffff0000u);
      q[8 * i + 4] = __uint_as_float(w.z << 16); q[8 * i + 5] = __uint_as_float(w.z & 0xffff0000u);
      q[8 * i + 6] = __uint_as_float(w.w << 16); q[8 * i + 7] = __uint_as_float(w.w & 0xffff0000u);
    }
  }
  float s[NBT]; int kr[NBT];
  float mx = has_sink ? sink : -1e30f;
#pragma unroll
  for (int j = 0; j < NBT; ++j) {
    int krow; float bias;
    const bool valid = kf(j, lane, krow, bias);
    kr[j] = valid ? krow : -1;
    float dot = 0.f;
    if (valid) {
      const uint4* kp = reinterpret_cast<const uint4*>(P + (size_t)krow * INW + kcol);
#pragma unroll
      for (int i = 0; i < 8; ++i) {
        const uint4 w = kp[i];
        dot += q[8 * i + 0] * __uint_as_float(w.x << 16) + q[8 * i + 1] * __uint_as_float(w.x & 0xffff0000u)
             + q[8 * i + 2] * __uint_as_float(w.y << 16) + q[8 * i + 3] * __uint_as_float(w.y & 0xffff0000u)
             + q[8 * i + 4] * __uint_as_float(w.z << 16) + q[8 * i + 5] * __uint_as_float(w.z & 0xffff0000u)
             + q[8 * i + 6] * __uint_as_float(w.w << 16) + q[8 * i + 7] * __uint_as_float(w.w & 0xffff0000u);
      }
    }
    s[j] = valid ? (dot * 0.125f + bias) : -1e30f;
    mx = fmaxf(mx, s[j]);
  }
  mx = wave_max(mx, lane);
  float l = 0.f;
#pragma unroll
  for (int j = 0; j < NBT; ++j) { s[j] = (kr[j] >= 0) ? __expf(s[j] - mx) : 0.f; l += s[j]; }
  l = wave_sum(l, lane);
  if (has_sink) l += __expf(sink - mx);
  float o[64];
#pragma unroll
  for (int i = 0; i < 64; ++i) o[i] = 0.f;
#pragma unroll
  for (int j = 0; j < NBT; ++j) {
    if (kr[j] >= 0) {
      const uint4* vp = reinterpret_cast<const uint4*>(P + (size_t)kr[j] * INW + vcol);
      const float pj = s[j];
#pragma unroll
      for (int i = 0; i < 8; ++i) {
        const uint4 w = vp[i];
        o[8 * i + 0] += pj * __uint_as_float(w.x << 16); o[8 * i + 1] += pj * __uint_as_float(w.x & 0xffff0000u);
        o[8 * i + 2] += pj * __uint_as_float(w.y << 16); o[8 * i + 3] += pj * __uint_as_float(w.y & 0xffff0000u);
        o[8 * i + 4] += pj * __uint_as_float(w.z << 16); o[8 * i + 5] += pj * __uint_as_float(w.z & 0xffff0000u);
        o[8 * i + 6] += pj * __uint_as_float(w.w << 16); o[8 * i + 7] += pj * __uint_as_float(w.w & 0xffff0000u);
      }
    }
  }
#pragma unroll
  for (int i = 0; i < 32; ++i) { const bool up_ = (lane & 32) != 0; const float send = up_ ? o[i] : o[i + 32]; const float keep = up_ ? o[i + 32] : o[i]; o[i] = keep + shx(send, 32, lane); }
#pragma unroll
  for (int i = 0; i < 16; ++i) { const bool up_ = (lane & 16) != 0; const float send = up_ ? o[i] : o[i + 16]; const float keep = up_ ? o[i + 16] : o[i]; o[i] = keep + shx(send, 16, lane); }
#pragma unroll
  for (int i = 0; i < 8; ++i) { const bool up_ = (lane & 8) != 0; const float send = up_ ? o[i] : o[i + 8]; const float keep = up_ ? o[i + 8] : o[i]; o[i] = keep + shx(send, 8, lane); }
#pragma unroll
  for (int i = 0; i < 4; ++i) { const bool up_ = (lane & 4) != 0; const float send = up_ ? o[i] : o[i + 4]; const float keep = up_ ? o[i + 4] : o[i]; o[i] = keep + shx(send, 4, lane); }
#pragma unroll
  for (int i = 0; i < 2; ++i) { const bool up_ = (lane & 2) != 0; const float send = up_ ? o[i] : o[i + 2]; const float keep = up_ ? o[i + 2] : o[i]; o[i] = keep + shx(send, 2, lane); }
  { const bool up_ = (lane & 1) != 0; const float send = up_ ? o[0] : o[1]; const float keep = up_ ? o[1] : o[0]; o[0] = keep + shx(send, 1, lane); }
  optr[lane] = f2bf(o[0] / l);
}

__device__ __forceinline__ void mixer_item_naive(const Params& p, int layer, int item, bool need_ctx, unsigned char* lds_raw) {
  const int tid_ = opaque_tid();
  const bf16_t* P = reinterpret_cast<const bf16_t*>(p.ws + WS_P);
  bf16_t* Y = reinterpret_cast<bf16_t*>(p.ws + WS_Y);
  const int wv = tid_ >> 6;
  if (item < 64) { ssm_item(p, layer, item, lds_raw); return; }
  if (item < 320) {
    const int it = item - 64; const int b = it >> 5, blk = (it >> 1) & 15, hk = it & 1;
    const int hq = hk * 4 + (wv >> 1), half = wv & 1;
    const float sink = p.win_sink[layer * 8 + hq];
    for (int qi = 0; qi < 64; ++qi) {
      const int t = blk * 128 + half * 64 + qi;
      const int row = b * SEQ + t;
      attn_query<9>(P + (size_t)row * INW + C_WQ + hq * 64, P, C_WK + hk * 64, C_WV + hk * 64, true, sink, Y + (size_t)row * 1536 + 512 + hq * 64, tid_ & 63,
        [&](int j, int lane, int& krow, float& bias) -> bool {
          bias = 0.f;
          if (j < 5) { const int kp = t - 128 + j * 64 + lane; krow = b * SEQ + kp; return kp >= 0 && kp < SEQ && kp <= t + 128; }
          krow = NLAT + b * CTXL + (j - 5) * 64 + lane; return true;
        });
    }
    return;
  }
  if (item < 576) {
    const int it = item - 320; const int b = it >> 5, h = (it >> 2) & 7, rg = it & 3;
    const int r = rg * 8 + wv;
    int rs = r - 4; rs = rs < 0 ? 0 : (rs > 24 ? 24 : rs);
    const float* rpb = p.na_rpb + ((size_t)layer * 8 + h) * 15 * 31;
    for (int c = 0; c < 64; ++c) {
      const int row = b * SEQ + r * 64 + c;
      int cs = c - 8; cs = cs < 0 ? 0 : (cs > 48 ? 48 : cs);
      attn_query<6>(P + (size_t)row * INW + C_NQ + h * 64, P, C_NK + h * 64, C_NV + h * 64, false, 0.f, Y + (size_t)row * 1536 + 1024 + h * 64, tid_ & 63,
        [&](int j, int lane, int& krow, float& bias) -> bool {
          if (j < 2) {
            const int i = j * 64 + lane; const int kr_ = rs + (i >> 4), kc = cs + (i & 15);
            krow = b * SEQ + kr_ * 64 + kc;
            int dc = kc - c; dc = dc < -15 ? -15 : (dc > 15 ? 15 : dc);
            bias = rpb[(kr_ - r + 7) * 31 + dc + 15];
            return true;
          }
          bias = 0.f; krow = NLAT + b * CTXL + (j - 2) * 64 + lane; return true;
        });
    }
    return;
  }
  if (!need_ctx) return;
  if (item < 608) {
    const int it = item - 576; const int b = it >> 2, qb = it & 3;
    const int hq = wv, hk = hq >> 2;
    const float sink = p.win_sink[layer * 8 + hq];
    for (int qi = 0; qi < 64; ++qi) {
      const int row = NLAT + b * CTXL + qb * 64 + qi;
      attn_query<4>(P + (size_t)row * INW + C_WQ + hq * 64, P, C_WK + hk * 64, C_WV + hk * 64, true, sink, Y + (size_t)row * 1536 + 512 + hq * 64, tid_ & 63,
        [&](int j, int lane, int& krow, float& bias) -> bool { bias = 0.f; krow = NLAT + b * CTXL + j * 64 + lane; return true; });
    }
    return;
  }
  {
    const int it = item - 608; const int b = it >> 2, qb = it & 3;
    const int h = wv;
    for (int qi = 0; qi < 64; ++qi) {
      const int row = NLAT + b * CTXL + qb * 64 + qi;
      attn_query<4>(P + (size_t)row * INW + C_NQ + h * 64, P, C_NK + h * 64, C_NV + h * 64, false, 0.f, Y + (size_t)row * 1536 + 1024 + h * 64, tid_ & 63,
        [&](int j, int lane, int& krow, float& bias) -> bool { bias = 0.f; krow = NLAT + b * CTXL + j * 64 + lane; return true; });
    }
  }
}


constexpr int VT_TOK = CTXL + SEQ;
template <class TileFn, class ScoreFn>
__device__ __forceinline__ void attn_wave(const bf16_t* qrow0, int ntiles, TileFn tilefn, ScoreFn scorefn, float m_init, float l_init, bf16_t* orow0, int lane) {
  const int l31 = lane & 31, hh = lane >> 5;
  bf16x8 Qop[2][4];
#pragma unroll
  for (int qb = 0; qb < 2; ++qb)
#pragma unroll
    for (int s = 0; s < 4; ++s) Qop[qb][s] = *reinterpret_cast<const bf16x8*>(qrow0 + (size_t)(32 * qb + l31) * INW + 32 * hh + 8 * s);
  f32x16 O[2][2];
#pragma unroll
  for (int a = 0; a < 2; ++a)
#pragma unroll
    for (int b2 = 0; b2 < 2; ++b2)
#pragma unroll
      for (int r = 0; r < 16; ++r) O[a][b2][r] = 0.f;
  float m[2] = {m_init, m_init};
  float l[2]; l[0] = hh ? 0.f : l_init; l[1] = l[0];
  const unsigned kvo = (unsigned)(l31 * INW + 32 * hh) * 2u;
  const unsigned vvo = (unsigned)(l31 * VT_TOK + 4 * hh) * 2u;
  const bf16_t* kp; const bf16_t* vp; int info;
  tilefn(0, kp, vp, info);
  bf16x8 Kc[4]; uint2 Vc[2][2][2];
#pragma unroll
  for (int s = 0; s < 4; ++s) Kc[s] = *reinterpret_cast<const bf16x8*>(reinterpret_cast<const char*>(kp) + kvo + 16 * s);
#pragma unroll
  for (int db = 0; db < 2; ++db)
#pragma unroll
    for (int s = 0; s < 2; ++s)
#pragma unroll
      for (int pc = 0; pc < 2; ++pc) Vc[db][s][pc] = *reinterpret_cast<const uint2*>(reinterpret_cast<const char*>(vp) + vvo + (size_t)db * 32 * VT_TOK * 2 + (16 * s + 8 * pc) * 2);
  for (int t = 0; t < ntiles; ++t) {
    const int info_c = info;
    const int tn = (t + 1 < ntiles) ? (t + 1) : t;
    tilefn(tn, kp, vp, info);
    f32x16 S[2];
#pragma unroll
    for (int qb = 0; qb < 2; ++qb) {
#pragma unroll
      for (int r = 0; r < 16; ++r) S[qb][r] = 0.f;
#pragma unroll
      for (int s = 0; s < 4; ++s) S[qb] = __builtin_amdgcn_mfma_f32_32x32x16_bf16(Kc[s], Qop[qb][s], S[qb], 0, 0, 0);
    }
#pragma unroll
    for (int s = 0; s < 4; ++s) Kc[s] = *reinterpret_cast<const bf16x8*>(reinterpret_cast<const char*>(kp) + kvo + 16 * s);
    bf16x8 Pop[2][2];
#pragma unroll
    for (int qb = 0; qb < 2; ++qb) {
      scorefn(info_c, qb, S[qb]);
      float mt = S[qb][0];
#pragma unroll
      for (int r = 1; r < 16; ++r) mt = fmaxf(mt, S[qb][r]);
      mt = fmaxf(mt, shx(mt, 32, lane));
      const float mnew = fmaxf(m[qb], mt);
      const float alpha = __expf(m[qb] - mnew);
      m[qb] = mnew;
      float ls = 0.f;
#pragma unroll
      for (int r = 0; r < 16; ++r) { const float pv = __expf(S[qb][r] - mnew); S[qb][r] = pv; ls += pv; }
      l[qb] = l[qb] * alpha + ls;
#pragma unroll
      for (int db = 0; db < 2; ++db)
#pragma unroll
        for (int r = 0; r < 16; ++r) O[db][qb][r] *= alpha;
#pragma unroll
      for (int s = 0; s < 2; ++s) {
        union { unsigned u[4]; bf16x8 b; } pk;
#pragma unroll
        for (int j = 0; j < 4; ++j) pk.u[j] = pack2(S[qb][8 * s + 2 * j], S[qb][8 * s + 2 * j + 1]);
        Pop[qb][s] = pk.b;
      }
    }
#pragma unroll
    for (int db = 0; db < 2; ++db)
#pragma unroll
      for (int s = 0; s < 2; ++s) {
        union { uint2 u[2]; bf16x8 b; } va; va.u[0] = Vc[db][s][0]; va.u[1] = Vc[db][s][1];
#pragma unroll
        for (int qb = 0; qb < 2; ++qb) O[db][qb] = __builtin_amdgcn_mfma_f32_32x32x16_bf16(va.b, Pop[qb][s], O[db][qb], 0, 0, 0);
      }
#pragma unroll
    for (int db = 0; db < 2; ++db)
#pragma unroll
      for (int s = 0; s < 2; ++s)
#pragma unroll
        for (int pc = 0; pc < 2; ++pc) Vc[db][s][pc] = *reinterpret_cast<const uint2*>(reinterpret_cast<const char*>(vp) + vvo + (size_t)db * 32 * VT_TOK * 2 + (16 * s + 8 * pc) * 2);
  }
#pragma unroll
  for (int qb = 0; qb < 2; ++qb) {
    const float lt = l[qb] + shx(l[qb], 32, lane);
    const float inv = 1.0f / lt;
    bf16_t* orow = orow0 + (size_t)(32 * qb + l31) * 1536;
#pragma unroll
    for (int db = 0; db < 2; ++db)
#pragma unroll
      for (int gq = 0; gq < 4; ++gq)
        st_bf4(orow + 32 * db + 8 * gq + 4 * hh, O[db][qb][4 * gq] * inv, O[db][qb][4 * gq + 1] * inv, O[db][qb][4 * gq + 2] * inv, O[db][qb][4 * gq + 3] * inv);
  }
}

__device__ __forceinline__ void mixer_item(const Params& p, int layer, int item, bool need_ctx, unsigned char* lds_raw) {
  const int tid_ = opaque_tid();
  const bf16_t* P = reinterpret_cast<const bf16_t*>(p.ws + WS_P);
  const bf16_t* VT = reinterpret_cast<const bf16_t*>(p.ws + WS_VT);
  bf16_t* Y = reinterpret_cast<bf16_t*>(p.ws + WS_Y);
  const int wv = tid_ >> 6, lane = tid_ & 63;
  if (item < 64) { ssm_item(p, layer, item, lds_raw); return; }
  if (item < 320) {
    const int it = item - 64; const int b = it >> 5, blk = (it >> 1) & 15, hk = it & 1;
    const int hq = hk * 4 + (wv >> 1), half = wv & 1;
    const float sink = p.win_sink[layer * 8 + hq];
    const int t0 = blk * 128 + half * 64;
    int ilo = 0, ihi = 10;
    if (t0 - 128 < 0) ilo = (128 - t0) >> 5;
    if (t0 + 192 > SEQ) ihi = 10 - ((t0 + 192 - SEQ) >> 5);
    const bf16_t* kctx = P + (size_t)(NLAT + b * CTXL) * INW + C_WK + hk * 64;
    const bf16_t* klat = P + (size_t)(b * SEQ) * INW + C_WK + hk * 64;
    const bf16_t* vth = VT + (size_t)(b * 10 + hk) * 64 * VT_TOK;
    const int qrow0 = b * SEQ + t0;
    attn_wave(P + (size_t)qrow0 * INW + C_WQ + hq * 64, 8 + (ihi - ilo),
      [&](int i, const bf16_t*& kp, const bf16_t*& vp, int& info) {
        if (i < 8) { kp = kctx + (size_t)(32 * i) * INW; vp = vth + 32 * i; info = -100000; }
        else { const int key0 = t0 - 128 + 32 * (i - 8 + ilo); kp = klat + (size_t)key0 * INW; vp = vth + CTXL + key0; info = key0; }
      },
      [&](int info, int qb, f32x16& S) {
        if (info == -100000) {
#pragma unroll
          for (int r = 0; r < 16; ++r) S[r] *= 0.125f;
        } else {
          const int d0 = info + 4 * (lane >> 5) - (t0 + 32 * qb + (lane & 31));
#pragma unroll
          for (int r = 0; r < 16; ++r) { const int d = d0 + (r & 3) + 8 * (r >> 2); S[r] = (d >= -128 && d <= 128) ? S[r] * 0.125f : -1e30f; }
        }
      }, sink, 1.0f, Y + (size_t)qrow0 * 1536 + 512 + hq * 64, lane);
    return;
  }
  if (item < 576) {
    const int it = item - 320; const int b = it >> 5, h = (it >> 2) & 7, rg = it & 3;
    const int r = rg * 8 + wv;
    int rs = r - 4; rs = rs < 0 ? 0 : (rs > 24 ? 24 : rs);
    float* tbl = reinterpret_cast<float*>(lds_raw);
    __syncthreads();
    { const float* rpb = p.na_rpb + ((size_t)layer * 8 + h) * 15 * 31; for (int i = tid_; i < 15 * 31 + 128; i += NTHR) { const int j = i - 64; tbl[i] = (j >= 0 && j < 15 * 31) ? rpb[j] : 0.f; } }
    __syncthreads();
    const bf16_t* kctx = P + (size_t)(NLAT + b * CTXL) * INW + C_NK + h * 64;
    const bf16_t* klat = P + (size_t)(b * SEQ) * INW + C_NK + h * 64;
    const bf16_t* vth = VT + (size_t)(b * 10 + 2 + h) * 64 * VT_TOK;
    const int qrow0 = b * SEQ + r * 64;
    attn_wave(P + (size_t)qrow0 * INW + C_NQ + h * 64, 8 + 16,
      [&](int i, const bf16_t*& kp, const bf16_t*& vp, int& info) {
        if (i < 8) { kp = kctx + (size_t)(32 * i) * INW; vp = vth + 32 * i; info = -1; }
        else { const int j = i - 8; const int key0 = rs * 64 + 32 * j; kp = klat + (size_t)key0 * INW; vp = vth + CTXL + key0; info = j; }
      },
      [&](int info, int qb, f32x16& S) {
        if (info < 0) {
#pragma unroll
          for (int r2 = 0; r2 < 16; ++r2) S[r2] *= 0.125f;
        } else {
          const int kr = rs + (info >> 1), jh = info & 1;
          const int qc = 32 * qb + (lane & 31);
          int cs = qc - 8; cs = cs < 0 ? 0 : (cs > 48 ? 48 : cs);
          const int kc0 = jh * 32 + 4 * (lane >> 5);
          const float* tb = tbl + 64 + (kr - r + 7) * 31 + kc0 - qc + 15;
#pragma unroll
          for (int r2 = 0; r2 < 16; ++r2) {
            const int ko = (r2 & 3) + 8 * (r2 >> 2);
            const int kc = kc0 + ko;
            S[r2] = (kc >= cs && kc < cs + 16) ? (S[r2] * 0.125f + tb[ko]) : -1e30f;
          }
        }
      }, -1e30f, 0.0f, Y + (size_t)qrow0 * 1536 + 1024 + h * 64, lane);
    return;
  }
  if (!need_ctx) return;
  if (item < 608) {
    const int it = item - 576; const int b = it >> 2, qb4 = it & 3;
    const int hq = wv, hk = hq >> 2;
    const float sink = p.win_sink[layer * 8 + hq];
    const bf16_t* kctx = P + (size_t)(NLAT + b * CTXL) * INW + C_WK + hk * 64;
    const bf16_t* vth = VT + (size_t)(b * 10 + hk) * 64 * VT_TOK;
    const int qrow0 = NLAT + b * CTXL + qb4 * 64;
    attn_wave(P + (size_t)qrow0 * INW + C_WQ + hq * 64, 8,
      [&](int i, const bf16_t*& kp, const bf16_t*& vp, int& info) { kp = kctx + (size_t)(32 * i) * INW; vp = vth + 32 * i; info = 0; },
      [&](int info, int qb, f32x16& S) {
#pragma unroll
        for (int r2 = 0; r2 < 16; ++r2) S[r2] *= 0.125f;
      }, sink, 1.0f, Y + (size_t)qrow0 * 1536 + 512 + hq * 64, lane);
    return;
  }
  {
    const int it = item - 608; const int b = it >> 2, qb4 = it & 3;
    const int h = wv;
    const bf16_t* kctx = P + (size_t)(NLAT + b * CTXL) * INW + C_NK + h * 64;
    const bf16_t* vth = VT + (size_t)(b * 10 + 2 + h) * 64 * VT_TOK;
    const int qrow0 = NLAT + b * CTXL + qb4 * 64;
    attn_wave(P + (size_t)qrow0 * INW + C_NQ + h * 64, 8,
      [&](int i, const bf16_t*& kp, const bf16_t*& vp, int& info) { kp = kctx + (size_t)(32 * i) * INW; vp = vth + 32 * i; info = 0; },
      [&](int info, int qb, f32x16& S) {
#pragma unroll
        for (int r2 = 0; r2 < 16; ++r2) S[r2] *= 0.125f;
      }, -1e30f, 0.0f, Y + (size_t)qrow0 * 1536 + 1024 + h * 64, lane);
  }
}

__device__ __forceinline__ void route_phase(const Params& p, int layer, int ntok, float* lds_f) {
  const int tid_ = opaque_tid();
  const float* mod = reinterpret_cast<const float*>(p.ws + WS_MOD);
  bf16_t* F = reinterpret_cast<bf16_t*>(p.ws + WS_H);
  int* tke = reinterpret_cast<int*>(p.ws + WS_TKE);
  int* tkp = reinterpret_cast<int*>(p.ws + WS_TKP);
  float* tkg = reinterpret_cast<float*>(p.ws + WS_TKG);
  int* tlist = reinterpret_cast<int*>(p.ws + WS_TLIST);
  unsigned* cnt = reinterpret_cast<unsigned*>(p.ws + WS_CTL) + CW_CNT + layer * 32;
  const int lane = tid_ & 63, wv = tid_ >> 6;
  float* frow = lds_f;
  float* part = lds_f + 8 * 1024;
  const float* gw = p.norm_ffn + layer * D;
  const float* rw = p.router_w + (size_t)layer * D * NEXP;
  const float rb = p.router_b[layer * NEXP + (lane & 31)];
  const int e = tid_ & 31, ks = tid_ >> 5;
  float rwreg[64];
#pragma unroll
  for (int i = 0; i < 64; ++i) rwreg[i] = rw[(size_t)(ks * 64 + i) * NEXP + e];
  const int ngroups = ntok >> 3;
  for (int grp = blockIdx.x; grp < ngroups; grp += gridDim.x) {
    const int row = grp * 8 + wv;
    {
      float* xr = stream_row(p, row);
      const int mi = row_modidx(row);
      float v[16];
      {
        const bf16_t* mr = reinterpret_cast<const bf16_t*>(p.ws + WS_S) + (size_t)NTOK * D + (size_t)row * D;
        const float* m2 = mod + ((size_t)layer * 9 + mi) * 6144 + 2 * 1024;
#pragma unroll
        for (int i = 0; i < 4; ++i) {
          const int c = i * 256 + lane * 4;
          float4 q = *reinterpret_cast<const float4*>(xr + c); const float4 g2 = *reinterpret_cast<const float4*>(m2 + c);
          float a0, a1, a2, a3; ld_bf4(mr + c, a0, a1, a2, a3);
          q.x += g2.x * a0; q.y += g2.y * a1; q.z += g2.z * a2; q.w += g2.w * a3;
          *reinterpret_cast<float4*>(xr + c) = q;
          v[4 * i] = q.x; v[4 * i + 1] = q.y; v[4 * i + 2] = q.z; v[4 * i + 3] = q.w;
        }
      }
      float ss = 0.f;
#pragma unroll
      for (int i = 0; i < 16; ++i) ss += v[i] * v[i];
      ss = wave_sum(ss, lane);
      const float rinv = rsqrtf(ss * (1.0f / D) + 1e-6f);
      const float* msh = mod + ((size_t)layer * 9 + mi) * 6144 + 3 * 1024;
#pragma unroll
      for (int i = 0; i < 4; ++i) {
        const int c = i * 256 + lane * 4;
        const float4 g = *reinterpret_cast<const float4*>(gw + c);
        const float4 sh = *reinterpret_cast<const float4*>(msh + c);
        const float4 sc = *reinterpret_cast<const float4*>(msh + 1024 + c);
        const float f0 = v[4 * i] * rinv * g.x * (1.f + sc.x) + sh.x, f1 = v[4 * i + 1] * rinv * g.y * (1.f + sc.y) + sh.y;
        const float f2 = v[4 * i + 2] * rinv * g.z * (1.f + sc.z) + sh.z, f3 = v[4 * i + 3] * rinv * g.w * (1.f + sc.w) + sh.w;
        st_bf4(F + (size_t)row * D + c, f0, f1, f2, f3);
        *reinterpret_cast<float4*>(frow + wv * 1024 + c) = float4{f0, f1, f2, f3};
      }
    }
    __syncthreads();
#pragma unroll
    for (int j = 0; j < 8; ++j) {
      const float* fp = frow + j * 1024 + ks * 64;
      float a0 = 0.f, a1 = 0.f;
#pragma unroll
      for (int i = 0; i < 64; i += 4) {
        const float4 f4 = *reinterpret_cast<const float4*>(fp + i);
        a0 += f4.x * rwreg[i]; a1 += f4.y * rwreg[i + 1]; a0 += f4.z * rwreg[i + 2]; a1 += f4.w * rwreg[i + 3];
      }
      part[(j * 16 + ks) * 32 + e] = a0 + a1;
    }
    __syncthreads();
    {
      const int ee = lane & 31;
      float acc = 0.f;
#pragma unroll
      for (int k2 = 0; k2 < 16; ++k2) acc += part[(wv * 16 + k2) * 32 + ee];
      const float logit = acc + rb;
      int sel_e[4]; float sel_v[4];
      float cur = logit;
#pragma unroll
      for (int k = 0; k < 4; ++k) {
        float bv = cur; int bi = ee;
#pragma unroll
        for (int o = 16; o >= 1; o >>= 1) {
          const float ov = shx(bv, o, lane); const int oi = shx(bi, o, lane);
          if (ov > bv || (ov == bv && oi < bi)) { bv = ov; bi = oi; }
        }
        sel_e[k] = bi; sel_v[k] = bv;
        if (ee == bi) cur = -3.0e38f;
      }
      const float m0 = sel_v[0];
      const float e0 = 1.f, e1 = __expf(sel_v[1] - m0), e2 = __expf(sel_v[2] - m0), e3 = __expf(sel_v[3] - m0);
      const float inv = 1.f / (e0 + e1 + e2 + e3);
      if (lane < 4) {
        const int ex = (lane == 0) ? sel_e[0] : (lane == 1) ? sel_e[1] : (lane == 2) ? sel_e[2] : sel_e[3];
        const float gg = ((lane == 0) ? e0 : (lane == 1) ? e1 : (lane == 2) ? e2 : e3) * inv;
        const unsigned pos = __hip_atomic_fetch_add(&cnt[ex], 1u, __ATOMIC_RELAXED, __HIP_MEMORY_SCOPE_AGENT);
        tke[row * 4 + lane] = ex; tkp[row * 4 + lane] = (int)pos; tkg[row * 4 + lane] = gg;
        tlist[(size_t)ex * NTOK + pos] = row;
      }
    }
  }
}

__device__ __forceinline__ void dense_unit(GUnit& u, const bf16_t* A, int lda, int ar0, const bf16_t* Bt, int ldb, int br0, int tz) {
  u.a0 = (const char*)(A + (size_t)ar0 * lda); u.a1 = (const char*)(A + (size_t)(ar0 + 128) * lda);
  u.b0 = (const char*)(Bt + (size_t)br0 * ldb); u.b1 = (const char*)(Bt + (size_t)(br0 + 128) * ldb);
  u.va00 = stage_voff(tz, 0, lda); u.va01 = stage_voff(tz, 1, lda); u.va10 = u.va00; u.va11 = u.va01;
}

__device__ __forceinline__ void phase_inproj(const Params& p, int layer, LAS unsigned char* lds) {
  const int G = gridDim.x, bid = blockIdx.x;
  const bf16_t* A = reinterpret_cast<const bf16_t*>(p.ws + WS_H);
  const bf16_t* Bt = reinterpret_cast<const bf16_t*>(p.ws + WS_WIN) + (size_t)layer * INW * 1024;
  bf16_t* P = reinterpret_cast<bf16_t*>(p.ws + WS_P);
  bf16_t* VT = reinterpret_cast<bf16_t*>(p.ws + WS_VT);
  const int tz = opaque_tid();
  LAS float* tab = (LAS float*)(lds + LDS_TAB);
  __syncthreads();
  { const float* ropec = reinterpret_cast<const float*>(p.ws + WS_ROPE);
    for (int i = tz; i < 2048; i += NTHR) tab[i] = ropec[i];
    if (tz < 256) { const int w = tz >> 6, d = tz & 63; const float* src = (w == 0) ? p.win_qn : (w == 1) ? p.win_kn : (w == 2) ? p.na_qn : p.na_kn; tab[2048 + tz] = src[layer * 64 + d]; } }
  __syncthreads();
  gemm_stream(lds, 16, tz, stage_voff(tz, 0, 1024), stage_voff(tz, 1, 1024),
    [&](int idx, GUnit& u) -> bool {
      int pm, pn; if (!unit_next(idx * G + bid, NTOK / 256, INW / 256, pm, pn)) return false;
      dense_unit(u, A, 1024, pm * 256, Bt, 1024, pn * 256, tz); u.i0 = pm; u.i1 = pn; u.i2 = 0; u.i3 = 0; return true;
    },
    [&](const GUnit& u, f32x4 (&acc)[2][2][4][2], int wr, int wc, int fr, int fq) {
      const int pn = u.i1, br0 = pn * 256, row0 = u.i0 * 256 + wr * 64 + fr, cq = wc * 32 + fq * 4;
      const bool is_head = (pn >= 2 && pn < 11);
      if (!is_head) {
        const bool gate = br0 >= C_GATE;
#pragma unroll
        for (int ai = 0; ai < 2; ++ai)
#pragma unroll
          for (int m = 0; m < 4; ++m) {
            const unsigned ro = ((unsigned)(row0 + ai * 128 + m * 16) * INW + br0 + cq) * 2u;
#pragma unroll
            for (int bj = 0; bj < 2; ++bj)
#pragma unroll
              for (int n = 0; n < 2; ++n) {
                const f32x4 c = acc[ai][bj][m][n];
                if (gate) stg_bf4(P, ro + (bj * 128 + n * 16) * 2, sigmoidf(c[0]), sigmoidf(c[1]), sigmoidf(c[2]), sigmoidf(c[3]));
                else stg_bf4(P, ro + (bj * 128 + n * 16) * 2, c[0], c[1], c[2], c[3]);
              }
          }
        return;
      }
      const int hidx = (pn - 2) * 4 + wc;
      const bool is_v = (hidx >= 10 && hidx < 12) || hidx >= 28;
      const bool lat = row0 < NLAT;
      if (is_v) {
        const int hv = (hidx < 12) ? (hidx - 10) : (2 + hidx - 28);
#pragma unroll
        for (int ai = 0; ai < 2; ++ai)
#pragma unroll
          for (int m = 0; m < 4; ++m) {
            const int grow = row0 + ai * 128 + m * 16;
            const int bb = lat ? (grow >> 11) : ((grow - NLAT) >> 8);
            const int tpos = lat ? (CTXL + (grow & 2047)) : ((grow - NLAT) & 255);
            const unsigned vo = (((unsigned)(bb * 10 + hv) * 64 + fq * 4) * VT_TOK + tpos) * 2u;
#pragma unroll
            for (int bj = 0; bj < 2; ++bj)
#pragma unroll
              for (int n = 0; n < 2; ++n)
#pragma unroll
                for (int j = 0; j < 4; ++j) stg<bf16_t>(VT, vo + (unsigned)(bj * 32 + n * 16 + j) * VT_TOK * 2u, f2bf(acc[ai][bj][m][n][j]));
          }
        return;
      }
      const int wsel = (hidx < 8) ? 0 : (hidx < 10) ? 1 : (hidx < 20) ? 2 : 3;
      f32x4 wv[2][2];
#pragma unroll
      for (int bj = 0; bj < 2; ++bj)
#pragma unroll
        for (int n = 0; n < 2; ++n) wv[bj][n] = *(const LAS f32x4*)(tab + 2048 + wsel * 64 + bj * 32 + n * 16 + fq * 4);
      const bool rope = (hidx < 10) && lat;
      const int lane = fq * 16 + fr;
#pragma unroll
      for (int ai = 0; ai < 2; ++ai)
#pragma unroll
        for (int m = 0; m < 4; ++m) {
          const int grow = row0 + ai * 128 + m * 16;
          float ss = 0.f;
#pragma unroll
          for (int bj = 0; bj < 2; ++bj)
#pragma unroll
            for (int n = 0; n < 2; ++n)
#pragma unroll
              for (int j = 0; j < 4; ++j) ss += acc[ai][bj][m][n][j] * acc[ai][bj][m][n][j];
          ss += shx(ss, 16, lane); ss += shx(ss, 32, lane);
          const float rinv = rsqrtf(ss * (1.0f / 64.0f) + 1e-6f);
          f32x4 y[2][2];
#pragma unroll
          for (int bj = 0; bj < 2; ++bj)
#pragma unroll
            for (int n = 0; n < 2; ++n) y[bj][n] = acc[ai][bj][m][n] * rinv * wv[bj][n];
          if (rope) {
            const int t = grow & 2047;
#pragma unroll
            for (int bj = 0; bj < 2; ++bj) {
              const int pos = bj ? (t & 63) : (t >> 6);
              const f32x4 cs = *(const LAS f32x4*)(tab + pos * 16 + fq * 4), sn = *(const LAS f32x4*)(tab + 1024 + pos * 16 + fq * 4);
              const f32x4 t1 = y[bj][0], t2 = y[bj][1];
              y[bj][0] = t1 * cs - t2 * sn; y[bj][1] = t1 * sn + t2 * cs;
            }
          }
          const unsigned ro = ((unsigned)grow * INW + C_WQ + hidx * 64 + fq * 4) * 2u;
#pragma unroll
          for (int bj = 0; bj < 2; ++bj)
#pragma unroll
            for (int n = 0; n < 2; ++n) stg_bf4(P, ro + (bj * 32 + n * 16) * 2, y[bj][n][0], y[bj][n][1], y[bj][n][2], y[bj][n][3]);
        }
    });
}

__device__ __forceinline__ void phase_mixers(const Params& p, int layer, bool need_ctx, int* misc_i, unsigned char* lds_raw, int rep) {
  unsigned* head = reinterpret_cast<unsigned*>(p.ws + WS_CTL) + CW_WQ + layer * 64 + rep * 16;
  for (;;) {
    __syncthreads();
    if (threadIdx.x == 0) misc_i[40] = (int)__hip_atomic_fetch_add(head, 1u, __ATOMIC_RELAXED, __HIP_MEMORY_SCOPE_AGENT);
    __syncthreads();
    const int item = misc_i[40];
    if (item >= 640) break;
    mixer_item(p, layer, item, need_ctx, lds_raw);
  }
}

__device__ __forceinline__ void phase_glu(const Params& p, int layer, int mrows, LAS unsigned char* lds) {
  const int G = gridDim.x, bid = blockIdx.x;
  const bf16_t* A = reinterpret_cast<const bf16_t*>(p.ws + WS_G);
  const bf16_t* Bt = reinterpret_cast<const bf16_t*>(p.ws + WS_WGLU) + (size_t)layer * 512 * 512;
  bf16_t* Y = reinterpret_cast<bf16_t*>(p.ws + WS_Y);
  const int tz = opaque_tid();
  gemm_stream(lds, 8, tz, stage_voff(tz, 0, 512), stage_voff(tz, 1, 512),
    [&](int idx, GUnit& u) -> bool {
      int pm, pn; if (!unit_next(idx * G + bid, mrows / 256, 2, pm, pn)) return false;
      dense_unit(u, A, 512, pm * 256, Bt, 512, pn * 256, tz); u.i0 = pm; u.i1 = pn; u.i2 = 0; u.i3 = 0; return true;
    },
    [&](const GUnit& u, f32x4 (&acc)[2][2][4][2], int wr, int wc, int fr, int fq) {
      const int row0 = u.i0 * 256 + wr * 64 + fr, col = u.i1 * 256 + wc * 32 + fq * 4;
      uint2 gv[2][4][2][2];
#pragma unroll
      for (int ai = 0; ai < 2; ++ai)
#pragma unroll
        for (int m = 0; m < 4; ++m) {
          const unsigned ro = ((unsigned)(row0 + ai * 128 + m * 16) * 512 + col) * 2u;
#pragma unroll
          for (int bj = 0; bj < 2; ++bj)
#pragma unroll
            for (int n = 0; n < 2; ++n) gv[ai][m][bj][n] = ldg<uint2>(A, ro + (bj * 128 + n * 16) * 2);
        }
#pragma unroll
      for (int ai = 0; ai < 2; ++ai)
#pragma unroll
        for (int m = 0; m < 4; ++m) {
          const unsigned ro = ((unsigned)(row0 + ai * 128 + m * 16) * 1536 + col) * 2u;
#pragma unroll
          for (int bj = 0; bj < 2; ++bj)
#pragma unroll
            for (int n = 0; n < 2; ++n) {
              const uint2 g = gv[ai][m][bj][n]; const f32x4 c = acc[ai][bj][m][n];
              stg_bf4(Y, ro + (bj * 128 + n * 16) * 2,
                      __uint_as_float(g.x << 16) * sigmoidf(c[0]), __uint_as_float(g.x & 0xffff0000u) * sigmoidf(c[1]),
                      __uint_as_float(g.y << 16) * sigmoidf(c[2]), __uint_as_float(g.y & 0xffff0000u) * sigmoidf(c[3]));
            }
        }
    });
}

__device__ __forceinline__ void phase_merge1(const Params& p, int layer, int mrows, LAS unsigned char* lds) {
  const int G = gridDim.x, bid = blockIdx.x;
  const bf16_t* Yb = reinterpret_cast<const bf16_t*>(p.ws + WS_Y);
  const bf16_t* P = reinterpret_cast<const bf16_t*>(p.ws + WS_P);
  const bf16_t* WB = reinterpret_cast<const bf16_t*>(p.ws + WS_WBR) + (size_t)(layer * 3) * 1024 * 512;
  bf16_t* SP = reinterpret_cast<bf16_t*>(p.ws + WS_S);
  bf16_t* SB = reinterpret_cast<bf16_t*>(p.ws + WS_SB);
  const int tz = opaque_tid();
  gemm_stream(lds, 8, tz, stage_voff(tz, 0, 512), stage_voff(tz, 1, 512),
    [&](int idx, GUnit& u) -> bool {
      const int ti = idx / 3, br = idx - ti * 3;
      int pm, pn; if (!unit_next(ti * G + bid, mrows / 256, 4, pm, pn)) return false;
      dense_unit(u, Yb + br * 512, 1536, pm * 256, WB + (size_t)br * 1024 * 512, 512, pn * 256, tz); u.i0 = pm; u.i1 = pn; u.i2 = br; u.i3 = 0; return true;
    },
    [&](const GUnit& u, f32x4 (&acc)[2][2][4][2], int wr, int wc, int fr, int fq) {
      const int row0 = u.i0 * 256 + wr * 64 + fr, col = u.i1 * 256 + wc * 32 + fq * 4, br = u.i2;
      bf16_t* O = (br < 2) ? SP : SB;
#pragma unroll
      for (int ai = 0; ai < 2; ++ai)
#pragma unroll
        for (int mp = 0; mp < 2; ++mp) {
          uint2 gv[2][2][2], pv[2][2][2];
#pragma unroll
          for (int mm = 0; mm < 2; ++mm) {
            const unsigned go = ((unsigned)(row0 + ai * 128 + (mp * 2 + mm) * 16) * INW + C_GATE + br * 1024 + col) * 2u;
#pragma unroll
            for (int bj = 0; bj < 2; ++bj)
#pragma unroll
              for (int n = 0; n < 2; ++n) { gv[mm][bj][n] = ldg<uint2>(P, go + (bj * 128 + n * 16) * 2); pv[mm][bj][n] = uint2{0u, 0u}; }
          }
          if (br > 0) {
#pragma unroll
            for (int mm = 0; mm < 2; ++mm) {
              const unsigned so = ((unsigned)(row0 + ai * 128 + (mp * 2 + mm) * 16) * D + col) * 2u;
#pragma unroll
              for (int bj = 0; bj < 2; ++bj)
#pragma unroll
                for (int n = 0; n < 2; ++n) pv[mm][bj][n] = ldg<uint2>(SP, so + (bj * 128 + n * 16) * 2);
            }
          }
#pragma unroll
          for (int mm = 0; mm < 2; ++mm) {
            const unsigned so = ((unsigned)(row0 + ai * 128 + (mp * 2 + mm) * 16) * D + col) * 2u;
#pragma unroll
            for (int bj = 0; bj < 2; ++bj)
#pragma unroll
              for (int n = 0; n < 2; ++n) {
                const uint2 g = gv[mm][bj][n], q = pv[mm][bj][n]; const f32x4 c = acc[ai][bj][mp * 2 + mm][n];
                stg_bf4(O, so + (bj * 128 + n * 16) * 2,
                        __uint_as_float(q.x << 16) + __uint_as_float(g.x << 16) * c[0], __uint_as_float(q.x & 0xffff0000u) + __uint_as_float(g.x & 0xffff0000u) * c[1],
                        __uint_as_float(q.y << 16) + __uint_as_float(g.y << 16) * c[2], __uint_as_float(q.y & 0xffff0000u) + __uint_as_float(g.y & 0xffff0000u) * c[3]);
              }
          }
        }
    });
}

__device__ __forceinline__ void phase_merge2(const Params& p, int layer, int mrows, LAS unsigned char* lds) {
  const int G = gridDim.x, bid = blockIdx.x;
  const bf16_t* A = reinterpret_cast<const bf16_t*>(p.ws + WS_SB);
  const bf16_t* Bt = reinterpret_cast<const bf16_t*>(p.ws + WS_WOUT) + (size_t)layer * 1024 * 1024;
  bf16_t* MB = reinterpret_cast<bf16_t*>(p.ws + WS_S) + (size_t)NTOK * D;
  const int tz = opaque_tid();
  gemm_stream(lds, 16, tz, stage_voff(tz, 0, 1024), stage_voff(tz, 1, 1024),
    [&](int idx, GUnit& u) -> bool {
      int pm, pn; if (!unit_next(idx * G + bid, mrows / 256, 4, pm, pn)) return false;
      dense_unit(u, A, 1024, pm * 256, Bt, 1024, pn * 256, tz); u.i0 = pm; u.i1 = pn; u.i2 = 0; u.i3 = 0; return true;
    },
    [&](const GUnit& u, f32x4 (&acc)[2][2][4][2], int wr, int wc, int fr, int fq) {
      const int row0 = u.i0 * 256 + wr * 64 + fr, col = u.i1 * 256 + wc * 32 + fq * 4;
#pragma unroll
      for (int ai = 0; ai < 2; ++ai)
#pragma unroll
        for (int m = 0; m < 4; ++m) {
          const unsigned so = ((unsigned)(row0 + ai * 128 + m * 16) * D + col) * 2u;
#pragma unroll
          for (int bj = 0; bj < 2; ++bj)
#pragma unroll
            for (int n = 0; n < 2; ++n) { const f32x4 c = acc[ai][bj][m][n]; stg_bf4(MB, so + (bj * 128 + n * 16) * 2, c[0], c[1], c[2], c[3]); }
        }
    });
}

__device__ __forceinline__ int moe_tables(const unsigned* cnt, int* est, int ntn) {
  __syncthreads();
  if (threadIdx.x == 0) { int s = 0, u = 0; for (int e = 0; e < NEXP; ++e) { est[e] = s; est[64 + e] = u; const int c = (int)cnt[e]; s += c; u += ((c + 255) >> 8) * ntn; } est[NEXP] = s; est[64 + NEXP] = u; }
  __syncthreads();
  return est[64 + NEXP];
}
__device__ __forceinline__ void moe_unit(const int* est, int total, int L, int& e, int& cnte, int& pmt, int& pnt) {
  int wgid = L; { const int q = total / 8, r = total % 8, xcd = wgid % 8, off = wgid / 8; wgid = (xcd < r ? xcd * (q + 1) : r * (q + 1) + (xcd - r) * q) + off; }
  e = 0; while (est[64 + e + 1] <= wgid) ++e;
  const int idx = wgid - est[64 + e]; cnte = est[e + 1] - est[e]; const int tm = (cnte + 255) >> 8;
  pmt = idx % tm; pnt = idx / tm;
}

__device__ __forceinline__ void phase_moe1(const Params& p, int layer, LAS unsigned char* lds, int* est) {
  const int G = gridDim.x, bid = blockIdx.x;
  const unsigned* cnt = reinterpret_cast<const unsigned*>(p.ws + WS_CTL) + CW_CNT + layer * 32;
  const int total = moe_tables(cnt, est, 8);
  const bf16_t* F = reinterpret_cast<const bf16_t*>(p.ws + WS_H);
  const int* tlist = reinterpret_cast<const int*>(p.ws + WS_TLIST);
  const bf16_t* WG = reinterpret_cast<const bf16_t*>(p.ws + WS_WGU) + (size_t)(layer * NEXP) * 2048 * 1024;
  bf16_t* ACT = reinterpret_cast<bf16_t*>(p.ws + WS_ACT);
  const int tz = opaque_tid();
  int R0, C0, R1, C1; stage_rc(tz * 16, R0, C0); stage_rc(tz * 16 + 8192, R1, C1);
  gemm_stream(lds, 16, tz, stage_voff(tz, 0, 1024), stage_voff(tz, 1, 1024),
    [&](int idx, GUnit& u) -> bool {
      const int L = bid + idx * G; if (L >= total) return false;
      int e, cnte, pmt, pnt; moe_unit(est, total, L, e, cnte, pmt, pnt);
      const int m0 = pmt * 256;
      const int* tl = tlist + (size_t)e * NTOK;
      const int r00 = m0 + R0, r01 = m0 + R1, r10 = m0 + 128 + R0, r11 = m0 + 128 + R1;
      const int t00 = (r00 < cnte) ? tl[r00] : 0, t01 = (r01 < cnte) ? tl[r01] : 0, t10 = (r10 < cnte) ? tl[r10] : 0, t11 = (r11 < cnte) ? tl[r11] : 0;
      u.a0 = (const char*)F; u.a1 = (const char*)F;
      u.va00 = (unsigned)(t00 * 1024 + C0) * 2u; u.va01 = (unsigned)(t01 * 1024 + C1) * 2u; u.va10 = (unsigned)(t10 * 1024 + C0) * 2u; u.va11 = (unsigned)(t11 * 1024 + C1) * 2u;
      const bf16_t* Bt = WG + (size_t)e * 2048 * 1024 + (size_t)(pnt * 256) * 1024;
      u.b0 = (const char*)Bt; u.b1 = (const char*)(Bt + (size_t)128 * 1024);
      u.i0 = e; u.i1 = cnte - m0; u.i2 = est[e] + m0; u.i3 = pnt; return true;
    },
    [&](const GUnit& u, f32x4 (&acc)[2][2][4][2], int wr, int wc, int fr, int fq) {
      const int cq = wc * 32 + fq * 4, r0 = wr * 64 + fr;
      const float* bg = p.b_gu + (size_t)(layer * NEXP + u.i0) * 2048 + u.i3 * 128 + cq;
      float4 bgv[2], buv[2];
#pragma unroll
      for (int n = 0; n < 2; ++n) { bgv[n] = *reinterpret_cast<const float4*>(bg + n * 16); buv[n] = *reinterpret_cast<const float4*>(bg + 1024 + n * 16); }
#pragma unroll
      for (int ai = 0; ai < 2; ++ai)
#pragma unroll
        for (int m = 0; m < 4; ++m) {
          const int r = r0 + ai * 128 + m * 16;
          if (r < u.i1) {
            const unsigned oo = ((unsigned)(u.i2 + r) * 1024 + u.i3 * 128 + cq) * 2u;
#pragma unroll
            for (int n = 0; n < 2; ++n) {
              const f32x4 gc = acc[ai][0][m][n], uc4 = acc[ai][1][m][n];
              const float gg[4] = {gc[0] + bgv[n].x, gc[1] + bgv[n].y, gc[2] + bgv[n].z, gc[3] + bgv[n].w};
              const float uu[4] = {uc4[0] + buv[n].x, uc4[1] + buv[n].y, uc4[2] + buv[n].z, uc4[3] + buv[n].w};
              float ov[4];
#pragma unroll
              for (int j = 0; j < 4; ++j) { const float g = fminf(gg[j], 7.0f); const float uc = fminf(fmaxf(uu[j], -7.0f), 7.0f); ov[j] = (uc + 1.0f) * (g * sigmoidf(1.702f * g)); }
              stg_bf4(ACT, oo + n * 32, ov[0], ov[1], ov[2], ov[3]);
            }
          }
        }
    });
}

__device__ __forceinline__ void phase_moe2(const Params& p, int layer, LAS unsigned char* lds, int* est) {
  const int G = gridDim.x, bid = blockIdx.x;
  const unsigned* cnt = reinterpret_cast<const unsigned*>(p.ws + WS_CTL) + CW_CNT + layer * 32;
  const int total = moe_tables(cnt, est, 4);
  const bf16_t* ACT = reinterpret_cast<const bf16_t*>(p.ws + WS_ACT);
  const bf16_t* WD = reinterpret_cast<const bf16_t*>(p.ws + WS_WDN) + (size_t)(layer * NEXP) * 1024 * 1024;
  bf16_t* YB = reinterpret_cast<bf16_t*>(p.ws + WS_YB);
  const int tz = opaque_tid();
  gemm_stream(lds, 16, tz, stage_voff(tz, 0, 1024), stage_voff(tz, 1, 1024),
    [&](int idx, GUnit& u) -> bool {
      const int L = bid + idx * G; if (L >= total) return false;
      int e, cnte, pmt, pnt; moe_unit(est, total, L, e, cnte, pmt, pnt);
      const int m0 = pmt * 256, arow0 = est[e] + m0;
      dense_unit(u, ACT, 1024, arow0, WD + (size_t)e * 1024 * 1024, 1024, pnt * 256, tz);
      u.i0 = e; u.i1 = cnte - m0; u.i2 = arow0; u.i3 = pnt; return true;
    },
    [&](const GUnit& u, f32x4 (&acc)[2][2][4][2], int wr, int wc, int fr, int fq) {
      const int cq = wc * 32 + fq * 4, r0 = wr * 64 + fr;
      const float* bd = p.b_dn + (size_t)(layer * NEXP + u.i0) * 1024 + u.i3 * 256 + cq;
      float4 bv[2][2];
#pragma unroll
      for (int bj = 0; bj < 2; ++bj)
#pragma unroll
        for (int n = 0; n < 2; ++n) bv[bj][n] = *reinterpret_cast<const float4*>(bd + bj * 128 + n * 16);
#pragma unroll
      for (int ai = 0; ai < 2; ++ai)
#pragma unroll
        for (int m = 0; m < 4; ++m) {
          const int r = r0 + ai * 128 + m * 16;
          if (r < u.i1) {
            const unsigned oo = ((unsigned)(u.i2 + r) * 1024 + u.i3 * 256 + cq) * 2u;
#pragma unroll
            for (int bj = 0; bj < 2; ++bj)
#pragma unroll
              for (int n = 0; n < 2; ++n) { const f32x4 c = acc[ai][bj][m][n]; stg_bf4(YB, oo + (bj * 128 + n * 16) * 2, c[0] + bv[bj][n].x, c[1] + bv[bj][n].y, c[2] + bv[bj][n].z, c[3] + bv[bj][n].w); }
          }
        }
    });
}

__device__ __forceinline__ void phase_prologue(const Params& p, float* ldsf) {
  const int tid_ = opaque_tid();
  const int G = gridDim.x, bid = blockIdx.x;
  conv_mats<2>(p.w_in, reinterpret_cast<bf16_t*>(p.ws + WS_WIN), DEPTH, 1024, INW, ldsf, tid_);
  conv_mats<0>(p.w_glu, reinterpret_cast<bf16_t*>(p.ws + WS_WGLU), DEPTH, 512, 512, ldsf, tid_);
  conv_mats<0>(p.w_branch, reinterpret_cast<bf16_t*>(p.ws + WS_WBR), DEPTH * 3, 512, 1024, ldsf, tid_);
  conv_mats<0>(p.w_out, reinterpret_cast<bf16_t*>(p.ws + WS_WOUT), DEPTH, 1024, 1024, ldsf, tid_);
  conv_mats<1>(p.w_gu, reinterpret_cast<bf16_t*>(p.ws + WS_WGU), DEPTH * NEXP, 1024, 2048, ldsf, tid_);
  conv_mats<0>(p.w_dn, reinterpret_cast<bf16_t*>(p.ws + WS_WDN), DEPTH * NEXP, 1024, 1024, ldsf, tid_);
  mod_phase(p, ldsf);
  if (bid == 0) {
    float* rt = reinterpret_cast<float*>(p.ws + WS_ROPE);
    for (int i = tid_; i < 1024; i += NTHR) { const float ang = (float)(i >> 4) * powf(10000.0f, -(float)(i & 15) / 16.0f); rt[i] = cosf(ang); rt[1024 + i] = sinf(ang); }
  }
  const float4* xs = reinterpret_cast<const float4*>(p.x); float4* xo = reinterpret_cast<float4*>(p.out);
  for (size_t i = (size_t)bid * NTHR + tid_; i < (size_t)NLAT * D / 4; i += (size_t)G * NTHR) xo[i] = xs[i];
  const float4* cs = reinterpret_cast<const float4*>(p.ctx); float4* co = reinterpret_cast<float4*>(p.ws + WS_CX);
  for (size_t i = (size_t)bid * NTHR + tid_; i < (size_t)NCTX * D / 4; i += (size_t)G * NTHR) co[i] = cs[i];
}

#ifndef ONLY
#define ONLY -1
#endif
#ifndef REP_PRO
#define REP_PRO 1
#endif
#ifndef REP_GEMM
#define REP_GEMM 1
#endif
#ifndef REP_PC
#define REP_PC 1
#endif
#ifndef REP_MOE
#define REP_MOE 1
#endif
#define PH_ON(idx, k) ((ONLY < 0 || ONLY == (k)) && p.ph_lo <= (idx) && (idx) < p.ph_hi)
#ifndef REP_BAR
#define REP_BAR 1
#endif
#ifndef REP_NORM
#define REP_NORM 1
#endif
#define PH_END(idx) do { if ((idx) + 1 < p.ph_hi) { for (int rb_ = 0; rb_ < REP_BAR; ++rb_) xcd_barrier(bar); } } while (0)

__global__ void __launch_bounds__(512, 2) fwd(Params p) {
  extern __shared__ __attribute__((aligned(16))) unsigned char lds_raw[];
  LAS unsigned char* shm = (LAS unsigned char*)lds_raw;
  unsigned* misc_u = reinterpret_cast<unsigned*>(lds_raw + LDS_MISC);
  int* misc_i = reinterpret_cast<int*>(lds_raw + LDS_MISC + 64);
  unsigned* ctl = reinterpret_cast<unsigned*>(p.ws + WS_CTL);
  if (threadIdx.x < 4) misc_u[threadIdx.x] = 0u;
  __syncthreads();
  XcdBarrier bar = xcd_barrier_post(ctl + CW_BAR, (volatile LAS unsigned*)misc_u);

  if (PH_ON(0, 10)) { for (int rep = 0; rep < REP_PRO; ++rep) phase_prologue(p, reinterpret_cast<float*>(lds_raw)); PH_END(0); }

  for (int layer = 0; layer < DEPTH; ++layer) {
    const int pb = 1 + layer * 10;
    const bool need_ctx = layer < DEPTH - 1;
    const int mrows = need_ctx ? NTOK : NLAT;
    if (PH_ON(pb + 0, 0)) { norm_phase(p, layer, layer > 0, misc_i); for (int rep = 1; rep < REP_NORM; ++rep) norm_phase(p, layer, false, misc_i); PH_END(pb + 0); }
    if (PH_ON(pb + 1, 1)) { for (int rep = 0; rep < REP_GEMM; ++rep) phase_inproj(p, layer, shm); PH_END(pb + 1); }
    if (PH_ON(pb + 3, 3)) { for (int rep = 0; rep < REP_PC; ++rep) phase_mixers(p, layer, need_ctx, misc_i, lds_raw, rep); PH_END(pb + 3); }
    if (PH_ON(pb + 4, 4)) { for (int rep = 0; rep < REP_GEMM; ++rep) phase_glu(p, layer, mrows, shm); PH_END(pb + 4); }
    if (PH_ON(pb + 5, 5)) { for (int rep = 0; rep < REP_GEMM; ++rep) phase_merge1(p, layer, mrows, shm); PH_END(pb + 5); }
    if (PH_ON(pb + 6, 6)) { phase_merge2(p, layer, mrows, shm); PH_END(pb + 6); }
    if (PH_ON(pb + 7, 7)) { route_phase(p, layer, mrows, reinterpret_cast<float*>(lds_raw)); PH_END(pb + 7); }
    if (PH_ON(pb + 8, 8)) { for (int rep = 0; rep < REP_MOE; ++rep) phase_moe1(p, layer, shm, misc_i); PH_END(pb + 8); }
    if (PH_ON(pb + 9, 9)) { for (int rep = 0; rep < REP_MOE; ++rep) phase_moe2(p, layer, shm, misc_i); PH_END(pb + 9); }
  }
  if (PH_ON(41, 11)) { final_combine(p, misc_i); }
}

extern "C" void kernel_launch(void* const* d_in, const int* in_sizes, int n_in, void* d_out, int out_size, void* d_ws, size_t ws_size, hipStream_t stream) {
  static int grid = 0;
  if (grid == 0) {
    if (n_in != 32 || out_size != NLAT * D || ws_size < WS_END) { fprintf(stderr, "kernel_launch: unexpected shapes (n_in %d out %d ws %zu need %zu)\n", n_in, out_size, ws_size, (size_t)WS_END); grid = -1; return; }
    int dev = 0, cus = 0, per_cu = 0;
    if (hipGetDevice(&dev) != hipSuccess || hipDeviceGetAttribute(&cus, hipDeviceAttributeMultiprocessorCount, dev) != hipSuccess) { grid = -1; return; }
    if (hipFuncSetAttribute((const void*)fwd, hipFuncAttributeMaxDynamicSharedMemorySize, LDS_BYTES) != hipSuccess) { fprintf(stderr, "kernel_launch: hipFuncSetAttribute failed\n"); grid = -1; return; }
    if (hipOccupancyMaxActiveBlocksPerMultiprocessor(&per_cu, (const void*)fwd, NTHR, LDS_BYTES) != hipSuccess || per_cu < 1) fprintf(stderr, "kernel_launch: occupancy query reports %d\n", per_cu);
    (void)hipGetLastError();
    grid = cus;
  }
  if (grid < 0) return;
  (void)hipMemsetAsync((char*)d_ws + WS_CTL, 0, CTL_BYTES, stream);
  Params p{};
  const float** f = reinterpret_cast<const float**>(&p);
  for (int i = 0; i < 32; ++i) f[i] = (const float*)d_in[i];
  p.out = (float*)d_out; p.ws = (unsigned char*)d_ws; p.ph_lo = 0; p.ph_hi = 42;
  hipLaunchKernelGGL(fwd, dim3(grid), dim3(NTHR), LDS_BYTES, stream, p);
}
```

```cpp
#include <hip/hip_runtime.h>
#include <stdint.h>
#include <stdio.h>

#ifndef PROBE_PH
#define PROBE_PH -1
#endif

typedef unsigned short bf16_t;
typedef short bf16x8 __attribute__((ext_vector_type(8)));
typedef float f32x4 __attribute__((ext_vector_type(4)));
#define LAS __attribute__((address_space(3)))

constexpr int D = 1024, NB = 8, SEQ = 2048, DEPTH = 4, CTXL = 256;
constexpr int NLAT = NB * SEQ, NCTX = NB * CTXL, NTOK = NLAT + NCTX;
constexpr int INW = 5888;
constexpr int C_U = 0, C_WQ = 512, C_WK = 1024, C_WV = 1152, C_NQ = 1280, C_NK = 1792, C_NV = 2304, C_GATE = 2816;
constexpr int NEXP = 32, TOPK = 4, DFF = 1024;
constexpr int NTHR = 512;

constexpr size_t al256(size_t x) { return (x + 255) & ~(size_t)255; }
constexpr size_t WS_CTL   = 0;
constexpr size_t CTL_BYTES = 65536;
constexpr size_t WS_MOD   = WS_CTL + CTL_BYTES;
constexpr size_t WS_WIN   = al256(WS_MOD + (size_t)DEPTH * 9 * 6144 * 4);
constexpr size_t WS_WGLU  = al256(WS_WIN + (size_t)DEPTH * INW * 1024 * 2);
constexpr size_t WS_WBR   = al256(WS_WGLU + (size_t)DEPTH * 512 * 512 * 2);
constexpr size_t WS_WOUT  = al256(WS_WBR + (size_t)DEPTH * 3 * 1024 * 512 * 2);
constexpr size_t WS_WGU   = al256(WS_WOUT + (size_t)DEPTH * 1024 * 1024 * 2);
constexpr size_t WS_WDN   = al256(WS_WGU + (size_t)DEPTH * NEXP * 2048 * 1024 * 2);
constexpr size_t WS_CX    = al256(WS_WDN + (size_t)DEPTH * NEXP * 1024 * 1024 * 2);
constexpr size_t WS_H     = al256(WS_CX + (size_t)NCTX * D * 4);
constexpr size_t WS_P     = al256(WS_H + (size_t)NTOK * D * 2);
constexpr size_t WS_YD    = al256(WS_P + (size_t)NTOK * INW * 2);
constexpr size_t WS_G     = al256(WS_YD + (size_t)4 * NTOK * 512 * 4);
constexpr size_t WS_Y     = al256(WS_G + (size_t)NTOK * 512 * 2);
constexpr size_t WS_S     = al256(WS_Y + (size_t)NTOK * 1536 * 2);
constexpr size_t WS_KT    = WS_S;
constexpr size_t WS_SB    = al256(WS_S + (size_t)NTOK * D * 4);
constexpr size_t WS_TKE   = al256(WS_SB + (size_t)NTOK * D * 2);
constexpr size_t WS_TKP   = al256(WS_TKE + (size_t)NTOK * 4 * 4);
constexpr size_t WS_TKG   = al256(WS_TKP + (size_t)NTOK * 4 * 4);
constexpr size_t WS_TLIST = al256(WS_TKG + (size_t)NTOK * 4 * 4);
constexpr size_t WS_ACT   = al256(WS_TLIST + (size_t)NEXP * NTOK * 4);
constexpr size_t WS_YB    = al256(WS_ACT + (size_t)(NTOK * 4 + 256) * 1024 * 2);
constexpr size_t WS_VT    = al256(WS_YB + (size_t)(NTOK * 4 + 256) * 1024 * 2);
constexpr size_t WS_ROPE  = al256(WS_VT + (size_t)NB * 10 * 64 * (CTXL + SEQ) * 2);
constexpr size_t WS_END   = al256(WS_ROPE + 2 * 64 * 16 * 4);

constexpr int CW_BAR = 0;
constexpr int CW_WQ = 4096;
constexpr int CW_CNT = 8192;
constexpr int CW_SSMD = 8448;

__device__ __forceinline__ bf16_t f2bf(float f) { unsigned u = __float_as_uint(f); u += 0x7fffu + ((u >> 16) & 1u); return (bf16_t)(u >> 16); }
__device__ __forceinline__ float bf2f(bf16_t h) { return __uint_as_float(((unsigned)h) << 16); }
__device__ __forceinline__ unsigned pack2(float a, float b) { unsigned r; asm("v_cvt_pk_bf16_f32 %0, %1, %2" : "=v"(r) : "v"(a), "v"(b)); return r; }
__device__ __forceinline__ float sigmoidf(float x) { return __builtin_amdgcn_rcpf(1.0f + __expf(-x)); }
__device__ __forceinline__ int opaque_tid() { int tz = threadIdx.x; asm volatile("" : "+v"(tz)); return tz; }
__device__ __forceinline__ float shx(float v, int o, int lane) { return __int_as_float(__builtin_amdgcn_ds_bpermute((lane ^ o) << 2, __float_as_int(v))); }
__device__ __forceinline__ int shx(int v, int o, int lane) { return __builtin_amdgcn_ds_bpermute((lane ^ o) << 2, v); }
__device__ __forceinline__ float shx32(float v, int lane) {
  const auto r = __builtin_amdgcn_permlane32_swap(__float_as_uint(v), __float_as_uint(v), false, false);
  return __uint_as_float(lane < 32 ? r[1] : r[0]);
}
__device__ __forceinline__ float wave_sum(float v, int lane) {
#pragma unroll
  for (int o = 32; o >= 1; o >>= 1) v += shx(v, o, lane);
  return v;
}
__device__ __forceinline__ float wave_max(float v, int lane) {
#pragma unroll
  for (int o = 32; o >= 1; o >>= 1) v = fmaxf(v, shx(v, o, lane));
  return v;
}

#define XB_TMO      128
#define XB_XCNT(j)  (256  + 64 * (j))
#define XB_XSUB(j)  (1280 + 64 * (j))
#define XB_XGEN(j)  (2304 + 64 * (j))
#define XB_TOP      3328
#define XB_TOPGEN   3392
#define XCD_BAR_WORDS 3456
#define XB_SPIN_CAP (1u << 20)

__device__ __forceinline__ unsigned xb_ld(unsigned* p)              { return __hip_atomic_load(p, __ATOMIC_RELAXED, __HIP_MEMORY_SCOPE_AGENT); }
__device__ __forceinline__ unsigned xb_add(unsigned* p, unsigned v) { return __hip_atomic_fetch_add(p, v, __ATOMIC_RELAXED, __HIP_MEMORY_SCOPE_AGENT); }
__device__ __forceinline__ unsigned xb_xcc_id() { return (unsigned)__builtin_amdgcn_s_getreg((3 << 11) | 20) & 0xFu; }
#define XB_SPIN(cond, bar) do { unsigned _sp = 0; while (cond) { __builtin_amdgcn_s_sleep(1); \
    if ((++_sp & 255u) == 0u) { if (xb_ld(&(bar)[XB_TMO])) break; if (_sp > XB_SPIN_CAP) { atomicAdd(&(bar)[XB_TMO], 1u); break; } } } } while (0)

struct XcdBarrier { unsigned* bar; unsigned x; volatile LAS unsigned* st; };

__device__ __forceinline__ XcdBarrier xcd_barrier_post(unsigned* bar, volatile LAS unsigned* st) {
    XcdBarrier b; b.bar = bar; b.x = xb_xcc_id(); b.st = st;
    if (threadIdx.x == 0) (void)xb_add(&bar[XB_XCNT(b.x)], 1u);
    return b;
}
__device__ __forceinline__ void xcd_barrier_complete(unsigned* bar, unsigned x, unsigned& nloc, unsigned& nx) {
    const unsigned G = gridDim.x * gridDim.y * gridDim.z;
    unsigned sum, cnt, mine, sp = 0u;
    for (;;) {
        sum = 0u; cnt = 0u; mine = 0u;
#pragma unroll
        for (unsigned j = 0; j < 16; ++j) { const unsigned c = xb_ld(&bar[XB_XCNT(j)]); sum += c; cnt += (c > 0u) ? 1u : 0u; mine = (j == x) ? c : mine; }
        if (sum == G) break;
        __builtin_amdgcn_s_sleep(1);
        if ((++sp & 255u) == 0u) { if (xb_ld(&bar[XB_TMO])) break; if (sp > XB_SPIN_CAP) { atomicAdd(&bar[XB_TMO], 1u); break; } }
    }
    nloc = mine > 0u ? mine : 1u; nx = cnt > 0u ? cnt : 1u;
}
__device__ __forceinline__ void xcd_barrier(const XcdBarrier& b) {
    asm volatile("s_waitcnt vmcnt(0)" ::: "memory");
    __syncthreads();
    if (threadIdx.x == 0) {
        unsigned* bar = b.bar;
        __builtin_amdgcn_s_waitcnt(0);
        unsigned nloc = b.st[0], nx = b.st[1];
        if (nloc == 0u) { xcd_barrier_complete(bar, b.x, nloc, nx); b.st[0] = nloc; b.st[1] = nx; }
        const unsigned old = xb_add(&bar[XB_XSUB(b.x)], 1u);
        const unsigned gen = old / nloc;
        if (old + 1u == (gen + 1u) * nloc) {
            __builtin_amdgcn_fence(__ATOMIC_RELEASE, "agent");
            asm volatile("s_waitcnt vmcnt(0)" ::: "memory");
            const unsigned og = xb_add(&bar[XB_TOP], 1u);
            const unsigned tg = og / nx;
            if (og + 1u == (tg + 1u) * nx) xb_add(&bar[XB_TOPGEN], 1u);
            else XB_SPIN(xb_ld(&bar[XB_TOPGEN]) == tg, bar);
            __builtin_amdgcn_fence(__ATOMIC_ACQUIRE, "agent");
            xb_add(&bar[XB_XGEN(b.x)], 1u);
            asm volatile("s_waitcnt vmcnt(0)" ::: "memory");
        } else {
            XB_SPIN(xb_ld(&bar[XB_XGEN(b.x)]) == gen, bar);
            __builtin_amdgcn_fence(__ATOMIC_ACQUIRE, "agent");
            asm volatile("s_waitcnt vmcnt(0)" ::: "memory");
        }
    }
    __syncthreads();
}

struct Params {
  const float *x, *c, *ctx, *c_ctx, *w_mod, *b_mod, *norm_mix, *norm_ffn, *w_in, *lam_re, *lam_im, *log_dt,
              *b_re, *b_im, *c_re, *c_im, *ssm_d, *w_glu, *win_qn, *win_kn, *win_sink, *na_qn, *na_kn, *na_rpb,
              *w_branch, *w_out, *router_w, *router_b, *w_gu, *b_gu, *w_dn, *b_dn;
  float* out;
  unsigned char* ws;
  int ph_lo, ph_hi;
};

constexpr int LDS_MISC = 131072;
constexpr int LDS_TAB = 131072 + 4096;
constexpr int LDS_BYTES = 131072 + 16384;

constexpr int HT = 128 * 64;
__device__ __forceinline__ int lds_byte(int r, int c) {
  int st = (r >> 4) * 2 + (c >> 5), rr = r & 15, cc = c & 31, ob = rr * 64 + cc * 2;
  return st * 1024 + (ob ^ (((ob >> 9) & 1) << 5));
}
__device__ __forceinline__ void stage_rc(int b, int& R, int& C) {
  int st = b / 1024, sb = b % 1024, swz = sb ^ (((sb >> 9) & 1) << 5);
  R = (st >> 1) * 16 + swz / 64; C = (st & 1) * 32 + (swz % 64) / 2;
}

#define G_SA(b, h) (((b) * 2 + (h)) * 16384)
#define G_SB(b, h) ((4 + (b) * 2 + (h)) * 16384)
#define G_STAGE(bufoff, gbase, v0, v1) do { \
    __builtin_amdgcn_global_load_lds((const unsigned*)((gbase) + (v0)), (LAS unsigned*)(lds + (bufoff) + ldsw), 16, 0, 0); \
    __builtin_amdgcn_global_load_lds((const unsigned*)((gbase) + (v1)), (LAS unsigned*)(lds + (bufoff) + ldsw + 8192), 16, 0, 0); } while (0)
#define G_LDA(dst, b, h) do { _Pragma("unroll") for (int m = 0; m < 4; ++m) _Pragma("unroll") for (int k = 0; k < 2; ++k) dst[m][k] = *(const LAS bf16x8*)(lds + G_SA(b, h) + aoff + m * 2048 + k * 1024); } while (0)
#define G_LDB(dst, b, h) do { _Pragma("unroll") for (int n = 0; n < 2; ++n) _Pragma("unroll") for (int k = 0; k < 2; ++k) dst[n][k] = *(const LAS bf16x8*)(lds + G_SB(b, h) + boff + n * 2048 + k * 1024); } while (0)
#define G_MMA(ai, bj, At, Bx) do { __builtin_amdgcn_s_setprio(1); \
    _Pragma("unroll") for (int m = 0; m < 4; ++m) _Pragma("unroll") for (int n = 0; n < 2; ++n) _Pragma("unroll") for (int k = 0; k < 2; ++k) \
      acc[ai][bj][m][n] = __builtin_amdgcn_mfma_f32_16x16x32_bf16(Bx[n][k], At[m][k], acc[ai][bj][m][n], 0, 0, 0); \
    __builtin_amdgcn_s_setprio(0); } while (0)
#define WAIT_V(n) asm volatile("s_waitcnt vmcnt(" #n ")" ::: "memory")
#define WAIT_L(n) asm volatile("s_waitcnt lgkmcnt(" #n ")" ::: "memory")
#define BAR __builtin_amdgcn_s_barrier()
#define SCHED __builtin_amdgcn_sched_barrier(0)

template <class Epi>
__device__ __forceinline__ void gemm_tile(LAS unsigned char* lds, const char* a0, const char* a1, unsigned va00, unsigned va01, unsigned va10, unsigned va11,
                                          const char* b0, const char* b1, unsigned vb0, unsigned vb1, int nt, int tid, Epi epi)
{
  asm volatile("s_waitcnt vmcnt(0)" ::: "memory");
  __syncthreads();
  const int wid = __builtin_amdgcn_readfirstlane(tid >> 6), lane = tid & 63, wr = wid >> 2, wc = wid & 3, fr = lane & 15, fq = lane >> 4;
  const unsigned ldsw = (unsigned)wid * 1024u;
  const int aoff = lds_byte(wr * 64 + fr, fq * 8), boff = lds_byte(wc * 32 + fr, fq * 8);
  f32x4 acc[2][2][4][2];
#pragma unroll
  for (int a = 0; a < 2; ++a)
#pragma unroll
    for (int b = 0; b < 2; ++b)
#pragma unroll
      for (int m = 0; m < 4; ++m)
#pragma unroll
        for (int n = 0; n < 2; ++n) acc[a][b][m][n] = f32x4{0.f, 0.f, 0.f, 0.f};
  bf16x8 At[4][2], B0[2][2], B1[2][2];
  G_STAGE(G_SB(0, 0), b0, vb0, vb1); G_STAGE(G_SA(0, 0), a0, va00, va01);
  G_STAGE(G_SB(0, 1), b1, vb0, vb1); G_STAGE(G_SA(0, 1), a1, va10, va11);
  if (wr == 1) BAR;
  WAIT_V(4); BAR;
  G_STAGE(G_SB(1, 0), b0 + 128, vb0, vb1); G_STAGE(G_SA(1, 0), a0 + 128, va00, va01); G_STAGE(G_SB(1, 1), b1 + 128, vb0, vb1);
  WAIT_V(6); BAR;
  for (int t = 0; t < nt - 2; t += 2) {
    const char* a0t = a0 + (size_t)t * 128; const char* a1t = a1 + (size_t)t * 128; const char* b0t = b0 + (size_t)t * 128; const char* b1t = b1 + (size_t)t * 128;
    G_LDB(B0, 0, 0); SCHED; G_LDA(At, 0, 0); G_STAGE(G_SA(1, 1), a1t + 128, va10, va11);
    WAIT_L(8); BAR; WAIT_L(0); G_MMA(0, 0, At, B0); BAR; SCHED;
    G_LDB(B1, 0, 1); G_STAGE(G_SB(0, 0), b0t + 256, vb0, vb1);
    BAR; WAIT_L(0); G_MMA(0, 1, At, B1); BAR;
    G_LDA(At, 0, 1); G_STAGE(G_SA(0, 0), a0t + 256, va00, va01);
    BAR; WAIT_L(0); G_MMA(1, 0, At, B0); BAR; SCHED;
    G_STAGE(G_SB(0, 1), b1t + 256, vb0, vb1);
    WAIT_V(6); BAR; G_MMA(1, 1, At, B1); BAR;
    G_LDB(B0, 1, 0); SCHED; G_LDA(At, 1, 0); G_STAGE(G_SA(0, 1), a1t + 256, va10, va11);
    WAIT_L(8); BAR; WAIT_L(0); G_MMA(0, 0, At, B0); BAR; SCHED;
    G_LDB(B1, 1, 1); G_STAGE(G_SB(1, 0), b0t + 384, vb0, vb1);
    BAR; WAIT_L(0); G_MMA(0, 1, At, B1); BAR;
    G_LDA(At, 1, 1); G_STAGE(G_SA(1, 0), a0t + 384, va00, va01);
    BAR; WAIT_L(0); G_MMA(1, 0, At, B0); BAR; SCHED;
    G_STAGE(G_SB(1, 1), b1t + 384, vb0, vb1);
    WAIT_V(6); BAR; G_MMA(1, 1, At, B1); BAR;
  }
  { G_LDB(B0, 0, 0); WAIT_V(0); G_LDA(At, 0, 0); G_STAGE(G_SA(1, 1), a1 + (size_t)(nt - 1) * 128, va10, va11);
    BAR; WAIT_L(0); G_MMA(0, 0, At, B0); BAR;
    G_LDB(B1, 0, 1); BAR; WAIT_L(0); G_MMA(0, 1, At, B1); BAR;
    G_LDA(At, 0, 1); WAIT_V(4); BAR; WAIT_L(0); G_MMA(1, 0, At, B0); G_MMA(1, 1, At, B1); BAR; }
  { G_LDB(B0, 1, 0); G_LDA(At, 1, 0); WAIT_V(2); BAR; WAIT_L(0); G_MMA(0, 0, At, B0); BAR;
    G_LDB(B1, 1, 1); WAIT_V(0); BAR; WAIT_L(0); G_MMA(0, 1, At, B1); BAR;
    G_LDA(At, 1, 1); BAR; WAIT_L(0); G_MMA(1, 0, At, B0); G_MMA(1, 1, At, B1); BAR; }
  if (wr == 0) BAR;
#pragma unroll
  for (int ai = 0; ai < 2; ++ai)
#pragma unroll
    for (int m = 0; m < 4; ++m)
      epi(ai * 128 + wr * 64 + m * 16 + fr, wc * 32 + fq * 4, acc[ai][0][m][0], acc[ai][0][m][1], acc[ai][1][m][0], acc[ai][1][m][1]);
}
constexpr int GU_KEEP_ACC = 1 << 30;
struct GUnit {
  const char* a0; const char* a1; const char* b0; const char* b1;
  unsigned va00, va01, va10, va11;
  int i0, i1, i2, i3;
};
template <class NextFn, class EpiFn>
__device__ __forceinline__ void gemm_stream(LAS unsigned char* lds, int nt, int tid, unsigned vb0, unsigned vb1, NextFn next, EpiFn epi, unsigned long long* tk = nullptr, unsigned long long* te = nullptr)
{
  GUnit cur, nxt;
  if (!next(0, cur)) return;
  asm volatile("s_waitcnt vmcnt(0)" ::: "memory");
  __syncthreads();
  const int wid = __builtin_amdgcn_readfirstlane(tid >> 6), lane = tid & 63, wr = wid >> 2, wc = wid & 3, fr = lane & 15, fq = lane >> 4;
  const unsigned ldsw = (unsigned)wid * 1024u;
  const int aoff = lds_byte(wr * 64 + fr, fq * 8), boff = lds_byte(wc * 32 + fr, fq * 8);
  f32x4 acc[2][2][4][2];
#pragma unroll
  for (int a = 0; a < 2; ++a)
#pragma unroll
    for (int b = 0; b < 2; ++b)
#pragma unroll
      for (int m = 0; m < 4; ++m)
#pragma unroll
        for (int n = 0; n < 2; ++n) acc[a][b][m][n] = f32x4{0.f, 0.f, 0.f, 0.f};
  bf16x8 At[4][2], B0[2][2], B1[2][2];
  G_STAGE(G_SB(0, 0), cur.b0, vb0, vb1); G_STAGE(G_SA(0, 0), cur.a0, cur.va00, cur.va01);
  G_STAGE(G_SB(0, 1), cur.b1, vb0, vb1); G_STAGE(G_SA(0, 1), cur.a1, cur.va10, cur.va11);
  if (wr == 1) BAR;
  WAIT_V(4); BAR;
  G_STAGE(G_SB(1, 0), cur.b0 + 128, vb0, vb1); G_STAGE(G_SA(1, 0), cur.a0 + 128, cur.va00, cur.va01); G_STAGE(G_SB(1, 1), cur.b1 + 128, vb0, vb1);
  WAIT_V(6); BAR;
  for (int ui = 0;; ++ui) {
    const bool has_next = next(ui + 1, nxt);
    if (!has_next) nxt = cur;
    unsigned long long tq0 = 0; if (tk) tq0 = (PROBE_PH == 18) ? (unsigned long long)clock64() : wall_clock64();
    for (int t = 0; t < nt; t += 2) {
      const bool last = (t == nt - 2);
      const char* a1_1 = cur.a1 + (size_t)(t + 1) * 128;
      const char* a0_2 = last ? nxt.a0 : cur.a0 + (size_t)(t + 2) * 128; const char* a1_2 = last ? nxt.a1 : cur.a1 + (size_t)(t + 2) * 128;
      const char* b0_2 = last ? nxt.b0 : cur.b0 + (size_t)(t + 2) * 128; const char* b1_2 = last ? nxt.b1 : cur.b1 + (size_t)(t + 2) * 128;
      const unsigned w00 = last ? nxt.va00 : cur.va00, w01 = last ? nxt.va01 : cur.va01, w10 = last ? nxt.va10 : cur.va10, w11 = last ? nxt.va11 : cur.va11;
      G_LDB(B0, 0, 0); SCHED; G_LDA(At, 0, 0); G_STAGE(G_SA(1, 1), a1_1, cur.va10, cur.va11);
      WAIT_L(8); BAR; WAIT_L(0); G_MMA(0, 0, At, B0); BAR; SCHED;
      G_LDB(B1, 0, 1); G_STAGE(G_SB(0, 0), b0_2, vb0, vb1);
      BAR; WAIT_L(0); G_MMA(0, 1, At, B1); BAR;
      G_LDA(At, 0, 1); G_STAGE(G_SA(0, 0), a0_2, w00, w01);
      BAR; WAIT_L(0); G_MMA(1, 0, At, B0); BAR; SCHED;
      G_STAGE(G_SB(0, 1), b1_2, vb0, vb1);
      WAIT_V(6); BAR; G_MMA(1, 1, At, B1); BAR;
      G_LDB(B0, 1, 0); SCHED; G_LDA(At, 1, 0); G_STAGE(G_SA(0, 1), a1_2, w10, w11);
      WAIT_L(8); BAR; WAIT_L(0); G_MMA(0, 0, At, B0); BAR; SCHED;
      G_LDB(B1, 1, 1); G_STAGE(G_SB(1, 0), b0_2 + 128, vb0, vb1);
      BAR; WAIT_L(0); G_MMA(0, 1, At, B1); BAR;
      G_LDA(At, 1, 1); G_STAGE(G_SA(1, 0), a0_2 + 128, w00, w01);
      BAR; WAIT_L(0); G_MMA(1, 0, At, B0); BAR; SCHED;
      G_STAGE(G_SB(1, 1), b1_2 + 128, vb0, vb1);
      WAIT_V(6); BAR; G_MMA(1, 1, At, B1); BAR;
    }
    unsigned long long tq1 = 0; if (tk) { if (PROBE_PH == 18) *tk += ((unsigned long long)clock64() - tq0) / 24; else *tk += wall_clock64() - tq0; } if (te) tq1 = wall_clock64();
    { int frz = fr, fqz = fq; asm volatile("" : "+v"(frz), "+v"(fqz));
      epi(cur, acc, wr, wc, frz, fqz); }
    if (te) { asm volatile("s_waitcnt vmcnt(0)" ::: "memory"); *te += wall_clock64() - tq1; }
    if (!has_next) break;
    if (!(nxt.i3 & GU_KEEP_ACC)) {
#pragma unroll
      for (int a = 0; a < 2; ++a)
#pragma unroll
        for (int b = 0; b < 2; ++b)
#pragma unroll
          for (int m = 0; m < 4; ++m)
#pragma unroll
            for (int n = 0; n < 2; ++n) acc[a][b][m][n] = f32x4{0.f, 0.f, 0.f, 0.f};
    }
    cur = nxt;
  }
  WAIT_V(0);
  if (wr == 0) BAR;
  BAR;
}

template <class F> struct Epi2 {
  F f;
  __device__ __forceinline__ void operator()(int row, int cq, f32x4 c00, f32x4 c01, f32x4 c10, f32x4 c11) const { f(row, cq, c00, c10); f(row, cq + 16, c01, c11); }
};
template <class F> __device__ __forceinline__ Epi2<F> epi2(F f) { return Epi2<F>{f}; }

__device__ __forceinline__ unsigned stage_voff(int tid, int i, int ld) { int R, C; stage_rc(tid * 16 + i * 8192, R, C); return (unsigned)(R * ld + C) * 2u; }


__device__ __forceinline__ bool unit_next(int L, int nM, int nN, int& pm, int& pn) {
  const int nwg = nM * nN; if (L >= nwg) return false;
  int wgid = L; { const int q = nwg / 8, r = nwg % 8, xcd = wgid % 8, off = wgid / 8; wgid = (xcd < r ? xcd * (q + 1) : r * (q + 1) + (xcd - r) * q) + off; }
  const int nig = 8 * nN, gid = wgid / nig, fm = gid * 8, gsz = (nM - fm) < 8 ? (nM - fm) : 8;
  pm = fm + ((wgid % nig) % gsz); pn = (wgid % nig) / gsz; return true;
}

__device__ __forceinline__ void st_bf4(bf16_t* p, float a, float b, float c, float d) {
  uint2 v; v.x = pack2(a, b); v.y = pack2(c, d); *reinterpret_cast<uint2*>(p) = v;
}
__device__ __forceinline__ void ld_bf4(const bf16_t* p, float& a, float& b, float& c, float& d) {
  uint2 v = *reinterpret_cast<const uint2*>(p);
  a = __uint_as_float(v.x << 16); b = __uint_as_float(v.x & 0xffff0000u); c = __uint_as_float(v.y << 16); d = __uint_as_float(v.y & 0xffff0000u);
}

template <class T> __device__ __forceinline__ T ldg(const void* base, unsigned off) { return *reinterpret_cast<const T*>(reinterpret_cast<const char*>(base) + off); }
template <class T> __device__ __forceinline__ void stg(void* base, unsigned off, T v) { *reinterpret_cast<T*>(reinterpret_cast<char*>(base) + off) = v; }
__device__ __forceinline__ void stg_bf4(void* base, unsigned off, float a, float b, float c, float d) { uint2 v; v.x = pack2(a, b); v.y = pack2(c, d); stg<uint2>(base, off, v); }
__device__ __forceinline__ void stg_bf8(void* base, unsigned off, f32x4 lo, f32x4 hi) { uint4 v; v.x = pack2(lo[0], lo[1]); v.y = pack2(lo[2], lo[3]); v.z = pack2(hi[0], hi[1]); v.w = pack2(hi[2], hi[3]); stg<uint4>(base, off, v); }
__device__ __forceinline__ void unpack8(uint4 v, f32x4& lo, f32x4& hi) {
  lo = f32x4{__uint_as_float(v.x << 16), __uint_as_float(v.x & 0xffff0000u), __uint_as_float(v.y << 16), __uint_as_float(v.y & 0xffff0000u)};
  hi = f32x4{__uint_as_float(v.z << 16), __uint_as_float(v.z & 0xffff0000u), __uint_as_float(v.w << 16), __uint_as_float(v.w & 0xffff0000u)};
}

template <int PERM>
__device__ __forceinline__ int conv_srccol(int p) {
  if (PERM == 1) { const int t256 = p >> 8, w = p & 255; return (w < 128) ? (t256 * 128 + w) : (1024 + t256 * 128 + (w - 128)); }
  if (PERM == 2) { if (p < C_WQ || p >= C_GATE) return p; const int tile = p >> 8, pin = p & 255, cp = pin >> 5, r = pin & 31, bj = cp >> 2, wc = cp & 3; return tile * 256 + (wc * 2 + bj) * 32 + r; }
  return p;
}
template <int PERM>
__device__ __forceinline__ int conv_dst_slot(int p0, int n) {
  if (PERM == 2 && p0 >= C_WQ && p0 < C_GATE) return n;
  const int l = n & 31;
  return (n & 32) + 16 * ((l >> 2) & 1) + 4 * (l >> 3) + (l & 3);
}
template <int PERM>
__device__ __forceinline__ void conv_mats(const float* __restrict__ src, bf16_t* __restrict__ dst, int nmat, int K, int N, float* lds, int tid_) {
  const int tK = K / 128, tN = N / 64, per = tK * tN, total = nmat * per;
  const int t = tid_;
  const int c4 = (t & 15) * 4, r = t >> 4;
  auto issue = [&](int tile, float4 (&v)[4]) {
    const int mat = tile / per, rem = tile % per, kt = rem / tN, ntl = rem % tN;
    const int sc = conv_srccol<PERM>(ntl * 64 + (c4 & 32)) + (c4 & 31);
    const float* S = src + (size_t)mat * K * N + (size_t)(kt * 128) * N + sc;
#pragma unroll
    for (int i = 0; i < 4; ++i) { const f32x4 t4 = __builtin_nontemporal_load(reinterpret_cast<const f32x4*>(S + (size_t)(r + 32 * i) * N)); v[i] = float4{t4[0], t4[1], t4[2], t4[3]}; }
  };
  float4 cur[4], nxt[4];
  int tile = blockIdx.x;
  if (tile < total) issue(tile, cur);
  for (; tile < total; tile += gridDim.x) {
    const int ntile = tile + gridDim.x;
    if (ntile < total) issue(ntile, nxt);
    const int mat = tile / per, rem = tile % per, kt = rem / tN, ntl = rem % tN;
    const int p0 = ntl * 64;
    __syncthreads();
#pragma unroll
    for (int i = 0; i < 4; ++i) { float* d = lds + (r + 32 * i) * 65 + c4; d[0] = cur[i].x; d[1] = cur[i].y; d[2] = cur[i].z; d[3] = cur[i].w; }
    __syncthreads();
    { const int n = t >> 3, kc = (t & 7) * 16;
      uint4 v0, v1;
      v0.x = pack2(lds[(kc + 0) * 65 + n], lds[(kc + 1) * 65 + n]); v0.y = pack2(lds[(kc + 2) * 65 + n], lds[(kc + 3) * 65 + n]);
      v0.z = pack2(lds[(kc + 4) * 65 + n], lds[(kc + 5) * 65 + n]); v0.w = pack2(lds[(kc + 6) * 65 + n], lds[(kc + 7) * 65 + n]);
      v1.x = pack2(lds[(kc + 8) * 65 + n], lds[(kc + 9) * 65 + n]); v1.y = pack2(lds[(kc + 10) * 65 + n], lds[(kc + 11) * 65 + n]);
      v1.z = pack2(lds[(kc + 12) * 65 + n], lds[(kc + 13) * 65 + n]); v1.w = pack2(lds[(kc + 14) * 65 + n], lds[(kc + 15) * 65 + n]);
      bf16_t* d = dst + (size_t)mat * N * K + (size_t)(p0 + conv_dst_slot<PERM>(p0, n)) * K + kt * 128 + kc;
      { typedef unsigned u32x4v __attribute__((ext_vector_type(4))); __builtin_nontemporal_store(u32x4v{v0.x, v0.y, v0.z, v0.w}, reinterpret_cast<u32x4v*>(d)); __builtin_nontemporal_store(u32x4v{v1.x, v1.y, v1.z, v1.w}, reinterpret_cast<u32x4v*>(d + 8)); } }
#pragma unroll
    for (int i = 0; i < 4; ++i) cur[i] = nxt[i];
  }
}

template <int PERM>
__device__ __forceinline__ void conv_tile128(const float* __restrict__ src, bf16_t* __restrict__ dst, int K, int N, int kt, int ntl, float* lds, int t) {
  const int c4 = (t & 15) * 4, r = t >> 4;
  const int sc = conv_srccol<PERM>(ntl * 64 + (c4 & 32)) + (c4 & 31);
  const float* S = src + (size_t)(kt * 128) * N + sc;
  float4 v[4];
#pragma unroll
  for (int i = 0; i < 4; ++i) { const f32x4 t4 = __builtin_nontemporal_load(reinterpret_cast<const f32x4*>(S + (size_t)(r + 32 * i) * N)); v[i] = float4{t4[0], t4[1], t4[2], t4[3]}; }
  __syncthreads();
#pragma unroll
  for (int i = 0; i < 4; ++i) { float* d = lds + (r + 32 * i) * 65 + c4; d[0] = v[i].x; d[1] = v[i].y; d[2] = v[i].z; d[3] = v[i].w; }
  __syncthreads();
  const int n = t >> 3, kc = (t & 7) * 16;
  uint4 v0, v1;
  v0.x = pack2(lds[(kc + 0) * 65 + n], lds[(kc + 1) * 65 + n]); v0.y = pack2(lds[(kc + 2) * 65 + n], lds[(kc + 3) * 65 + n]);
  v0.z = pack2(lds[(kc + 4) * 65 + n], lds[(kc + 5) * 65 + n]); v0.w = pack2(lds[(kc + 6) * 65 + n], lds[(kc + 7) * 65 + n]);
  v1.x = pack2(lds[(kc + 8) * 65 + n], lds[(kc + 9) * 65 + n]); v1.y = pack2(lds[(kc + 10) * 65 + n], lds[(kc + 11) * 65 + n]);
  v1.z = pack2(lds[(kc + 12) * 65 + n], lds[(kc + 13) * 65 + n]); v1.w = pack2(lds[(kc + 14) * 65 + n], lds[(kc + 15) * 65 + n]);
  bf16_t* d = dst + (size_t)(ntl * 64 + conv_dst_slot<PERM>(ntl * 64, n)) * K + kt * 128 + kc;
  { typedef unsigned u32x4v __attribute__((ext_vector_type(4))); __builtin_nontemporal_store(u32x4v{v0.x, v0.y, v0.z, v0.w}, reinterpret_cast<u32x4v*>(d)); __builtin_nontemporal_store(u32x4v{v1.x, v1.y, v1.z, v1.w}, reinterpret_cast<u32x4v*>(d + 8)); }
}
constexpr int MOE_CT_GU = NEXP * 8 * 32, MOE_CT = MOE_CT_GU + NEXP * 8 * 16;
constexpr int CQ_B = 10, CQ_E = 24, CQ_F = 8, CQ_H = 11, CQ_I = 10;
constexpr int CB_E = 136 * CQ_B, CB_F = CB_E + 224 * CQ_E, CB_REST = CB_F + 224 * CQ_F;
__device__ __forceinline__ void conv_moe_tiles(const Params& p, int L, int t0, int cnt, float* lds) {
  if (L >= DEPTH) return;
  const int tid_ = opaque_tid();
  __syncthreads();
  for (int t = t0; t < t0 + cnt && t < MOE_CT; ++t) {
    if (t < MOE_CT_GU) { const int m = t >> 8, q = t & 255; conv_tile128<1>(p.w_gu + (size_t)(L * NEXP + m) * 1024 * 2048, reinterpret_cast<bf16_t*>(p.ws + WS_WGU) + (size_t)(L * NEXP + m) * 2048 * 1024, 1024, 2048, q >> 5, q & 31, lds, tid_); }
    else { const int r = t - MOE_CT_GU, m = r >> 7, q = r & 127; conv_tile128<0>(p.w_dn + (size_t)(L * NEXP + m) * 1024 * 1024, reinterpret_cast<bf16_t*>(p.ws + WS_WDN) + (size_t)(L * NEXP + m) * 1024 * 1024, 1024, 1024, q >> 4, q & 15, lds, tid_); }
  }
}

__device__ __forceinline__ float siluf(float x) { return x / (1.0f + __expf(-x)); }
__device__ __forceinline__ float gelu_tanh(float x) {
  const float u2 = 1.5957691216057308f * (x + 0.044715f * x * x * x);
  return x * __builtin_amdgcn_rcpf(1.0f + __expf(-u2));
}

__device__ __forceinline__ void mod_phase(const Params& p, float* lds) {
  const int tid_ = opaque_tid();
  float* sc = lds;
  float* red = lds + 9 * 1024;
  const int t = tid_;
  __syncthreads();
  for (int i = t; i < 9 * 1024; i += NTHR) { const int r = i >> 10, k = i & 1023; const float v = (r < 8) ? p.c[r * 1024 + k] : p.c_ctx[k]; sc[i] = siluf(v); }
  __syncthreads();
  float* mod = reinterpret_cast<float*>(p.ws + WS_MOD);
  for (int u = blockIdx.x; u < DEPTH * 48; u += gridDim.x) {
    const int l = u / 48, col0 = (u % 48) * 128;
    const int col = t & 127, kq = t >> 7;
    float a[9];
#pragma unroll
    for (int r = 0; r < 9; ++r) a[r] = 0.f;
    const float* W = p.w_mod + (size_t)l * 1024 * 6144 + col0 + col;
    for (int k = kq * 256; k < kq * 256 + 256; k += 4) {
      float w[4];
#pragma unroll
      for (int j = 0; j < 4; ++j) w[j] = __builtin_nontemporal_load(W + (size_t)(k + j) * 6144);
#pragma unroll
      for (int r = 0; r < 9; ++r) {
        const float4 s4 = *reinterpret_cast<const float4*>(sc + r * 1024 + k);
        a[r] += s4.x * w[0]; a[r] += s4.y * w[1]; a[r] += s4.z * w[2]; a[r] += s4.w * w[3];
      }
    }
#pragma unroll
    for (int r = 0; r < 9; ++r) red[(kq * 9 + r) * 128 + col] = a[r];
    __syncthreads();
    for (int i = t; i < 9 * 128; i += NTHR) {
      const int r = i >> 7, cc = i & 127;
      const float v = red[(0 * 9 + r) * 128 + cc] + red[(1 * 9 + r) * 128 + cc] + red[(2 * 9 + r) * 128 + cc] + red[(3 * 9 + r) * 128 + cc];
      mod[((size_t)l * 9 + r) * 6144 + col0 + cc] = v + p.b_mod[l * 6144 + col0 + cc];
    }
    __syncthreads();
  }
}

__device__ __forceinline__ float* stream_row(const Params& p, int row) {
  return (row < NLAT) ? (p.out + (size_t)row * D) : (reinterpret_cast<float*>(p.ws + WS_CX) + (size_t)(row - NLAT) * D);
}
__device__ __forceinline__ int row_modidx(int row) { return (row < NLAT) ? (row >> 11) : 8; }
__device__ __forceinline__ const float* stream_row_in(const Params& p, int layer, int row) {
  if (layer > 0) return stream_row(p, row);
  return (row < NLAT) ? (p.x + (size_t)row * D) : (p.ctx + (size_t)(row - NLAT) * D);
}

__device__ __forceinline__ void expert_starts(const unsigned* cnt, int* st) {
  if (threadIdx.x == 0) { int s = 0; for (int e = 0; e < NEXP; ++e) { st[e] = s; s += (int)cnt[e]; } st[NEXP] = s; }
  __syncthreads();
}

__device__ __forceinline__ void norm_phase(const Params& p, int layer, bool combine, int* lds_i) {
  const int tid_ = opaque_tid();
  const float* mod = reinterpret_cast<const float*>(p.ws + WS_MOD);
  bf16_t* H = reinterpret_cast<bf16_t*>(p.ws + WS_H);
  const int* tke = reinterpret_cast<const int*>(p.ws + WS_TKE);
  const int* tkp = reinterpret_cast<const int*>(p.ws + WS_TKP);
  const float* tkg = reinterpret_cast<const float*>(p.ws + WS_TKG);
  const bf16_t* YB = reinterpret_cast<const bf16_t*>(p.ws + WS_YB);
  const unsigned* ctl = reinterpret_cast<const unsigned*>(p.ws + WS_CTL);
  if (combine) expert_starts(ctl + CW_CNT + (layer - 1) * 32, lds_i);
  const int lane = tid_ & 63, wv = tid_ >> 6;
  const float* gw = p.norm_mix + layer * D;
  const int stride = gridDim.x * 8;
  for (int row0 = blockIdx.x * 8 + wv; row0 < NTOK; row0 += 2 * stride) {
    float v[2][16]; uint2 yv[2][4][4]; float gk[2][4];
#pragma unroll
    for (int tt = 0; tt < 2; ++tt) {
      const int row = row0 + tt * stride;
      if (row < NTOK) {
        const float* xin = stream_row_in(p, layer, row);
#pragma unroll
        for (int i = 0; i < 4; ++i) { const float4 q = *reinterpret_cast<const float4*>(xin + i * 256 + lane * 4); v[tt][4 * i] = q.x; v[tt][4 * i + 1] = q.y; v[tt][4 * i + 2] = q.z; v[tt][4 * i + 3] = q.w; }
        if (combine) {
#pragma unroll
          for (int k = 0; k < 4; ++k) {
            const int e = tke[row * 4 + k]; const int pos = tkp[row * 4 + k]; gk[tt][k] = tkg[row * 4 + k];
            const bf16_t* yr = YB + (size_t)(lds_i[e] + pos) * D;
#pragma unroll
            for (int i = 0; i < 4; ++i) yv[tt][k][i] = *reinterpret_cast<const uint2*>(yr + i * 256 + lane * 4);
          }
        }
      }
    }
#pragma unroll
    for (int tt = 0; tt < 2; ++tt) {
      const int row = row0 + tt * stride;
      if (row < NTOK) {
        float* xr = stream_row(p, row);
        const int mi = row_modidx(row);
        if (combine) {
          const float* m5 = mod + ((size_t)(layer - 1) * 9 + mi) * 6144 + 5 * 1024;
#pragma unroll
          for (int i = 0; i < 4; ++i) {
            float a0 = 0.f, a1 = 0.f, a2 = 0.f, a3 = 0.f;
#pragma unroll
            for (int k = 0; k < 4; ++k) {
              const uint2 y = yv[tt][k][i]; const float g = gk[tt][k];
              a0 += g * __uint_as_float(y.x << 16); a1 += g * __uint_as_float(y.x & 0xffff0000u); a2 += g * __uint_as_float(y.y << 16); a3 += g * __uint_as_float(y.y & 0xffff0000u);
            }
            const float4 mm = *reinterpret_cast<const float4*>(m5 + i * 256 + lane * 4);
            v[tt][4 * i] += mm.x * a0; v[tt][4 * i + 1] += mm.y * a1; v[tt][4 * i + 2] += mm.z * a2; v[tt][4 * i + 3] += mm.w * a3;
            *reinterpret_cast<float4*>(xr + i * 256 + lane * 4) = float4{v[tt][4 * i], v[tt][4 * i + 1], v[tt][4 * i + 2], v[tt][4 * i + 3]};
          }
        }
        float ss = 0.f;
#pragma unroll
        for (int i = 0; i < 16; ++i) ss += v[tt][i] * v[tt][i];
        ss = wave_sum(ss, lane);
        const float rinv = rsqrtf(ss * (1.0f / D) + 1e-6f);
        const float* msh = mod + ((size_t)layer * 9 + mi) * 6144;
#pragma unroll
        for (int i = 0; i < 4; ++i) {
          const int c = i * 256 + lane * 4;
          const float4 g = *reinterpret_cast<const float4*>(gw + c);
          const float4 sh = *reinterpret_cast<const float4*>(msh + c);
          const float4 sc = *reinterpret_cast<const float4*>(msh + 1024 + c);
          st_bf4(H + (size_t)row * D + c, v[tt][4 * i] * rinv * g.x * (1.f + sc.x) + sh.x, v[tt][4 * i + 1] * rinv * g.y * (1.f + sc.y) + sh.y,
                 v[tt][4 * i + 2] * rinv * g.z * (1.f + sc.z) + sh.z, v[tt][4 * i + 3] * rinv * g.w * (1.f + sc.w) + sh.w);
        }
      }
    }
  }
}

__device__ __forceinline__ void final_combine(const Params& p, int* lds_i) {
  const int tid_ = opaque_tid();
  const float* mod = reinterpret_cast<const float*>(p.ws + WS_MOD);
  const int* tke = reinterpret_cast<const int*>(p.ws + WS_TKE);
  const int* tkp = reinterpret_cast<const int*>(p.ws + WS_TKP);
  const float* tkg = reinterpret_cast<const float*>(p.ws + WS_TKG);
  const bf16_t* YB = reinterpret_cast<const bf16_t*>(p.ws + WS_YB);
  const unsigned* ctl = reinterpret_cast<const unsigned*>(p.ws + WS_CTL);
  expert_starts(ctl + CW_CNT + (DEPTH - 1) * 32, lds_i);
  const int lane = tid_ & 63, wv = tid_ >> 6;
  for (int row = blockIdx.x * 8 + wv; row < NLAT; row += gridDim.x * 8) {
    float* xr = p.out + (size_t)row * D;
    const int mi = row >> 11;
    const float* m5 = mod + ((size_t)(DEPTH - 1) * 9 + mi) * 6144 + 5 * 1024;
    float a[16];
#pragma unroll
    for (int i = 0; i < 16; ++i) a[i] = 0.f;
#pragma unroll
    for (int k = 0; k < 4; ++k) {
      const int e = tke[row * 4 + k]; const int pos = tkp[row * 4 + k]; const float g = tkg[row * 4 + k];
      const bf16_t* yr = YB + (size_t)(lds_i[e] + pos) * D;
#pragma unroll
      for (int i = 0; i < 4; ++i) { float a0, a1, a2, a3; ld_bf4(yr + i * 256 + lane * 4, a0, a1, a2, a3); a[4 * i] += g * a0; a[4 * i + 1] += g * a1; a[4 * i + 2] += g * a2; a[4 * i + 3] += g * a3; }
    }
#pragma unroll
    for (int i = 0; i < 4; ++i) {
      const float4 mm = *reinterpret_cast<const float4*>(m5 + i * 256 + lane * 4);
      float4 q = *reinterpret_cast<const float4*>(xr + i * 256 + lane * 4);
      q.x += mm.x * a[4 * i]; q.y += mm.y * a[4 * i + 1]; q.z += mm.z * a[4 * i + 2]; q.w += mm.w * a[4 * i + 3];
      *reinterpret_cast<float4*>(xr + i * 256 + lane * 4) = q;
    }
  }
}

__device__ __forceinline__ void qknorm_phase(const Params& p, int layer) {
  const int tid_ = opaque_tid();
  bf16_t* P = reinterpret_cast<bf16_t*>(p.ws + WS_P);
  const int lane = tid_ & 63, wv = tid_ >> 6;
  const float wqn = p.win_qn[layer * 64 + lane], wkn = p.win_kn[layer * 64 + lane];
  const float nqn = p.na_qn[layer * 64 + lane], nkn = p.na_kn[layer * 64 + lane];
  const int fi = lane & 15;
  const float inv_freq = powf(10000.0f, -(float)fi / 16.0f);
  for (int row = blockIdx.x * 8 + wv; row < NTOK; row += gridDim.x * 8) {
    bf16_t* pr = P + (size_t)row * INW;
    const bool lat = row < NLAT;
    float cs = 1.f, sn = 0.f;
    if (lat) { const int t = row & 2047; const int pos = (lane < 32) ? (t >> 6) : (t & 63); const float ang = (float)pos * inv_freq; cs = cosf(ang); sn = sinf(ang); }
    for (int hd = 0; hd < 26; ++hd) {
      int col; float w; bool rope;
      if (hd < 8) { col = C_WQ + hd * 64; w = wqn; rope = lat; }
      else if (hd < 10) { col = C_WK + (hd - 8) * 64; w = wkn; rope = lat; }
      else if (hd < 18) { col = C_NQ + (hd - 10) * 64; w = nqn; rope = false; }
      else { col = C_NK + (hd - 18) * 64; w = nkn; rope = false; }
      const float v = bf2f(pr[col + lane]);
      const float ss = wave_sum(v * v, lane);
      float y = v * rsqrtf(ss * (1.0f / 64.0f) + 1e-6f) * w;
      if (rope) {
        const float o = shx(y, 16, lane);
        y = ((lane & 16) == 0) ? (y * cs - o * sn) : (o * sn + y * cs);
      }
      pr[col + lane] = f2bf(y);
    }
    {
      bf16_t* VT = reinterpret_cast<bf16_t*>(p.ws + WS_VT);
      const int bb = lat ? (row >> 11) : ((row - NLAT) >> 8);
      const int tpos = lat ? (CTXL + (row & 2047)) : ((row - NLAT) & 255);
#pragma unroll
      for (int hv = 0; hv < 10; ++hv) {
        const int col = (hv < 2) ? (C_WV + hv * 64) : (C_NV + (hv - 2) * 64);
        VT[((size_t)(bb * 10 + hv) * 64 + lane) * (CTXL + SEQ) + tpos] = pr[col + lane];
      }
    }
  }
}

__device__ __forceinline__ int ssm_row(int b, int dir, int tau) {
  if (tau < CTXL) return NLAT + b * CTXL + (dir ? (CTXL - 1 - tau) : tau);
  const int t = tau - CTXL;
  return b * SEQ + (dir ? (SEQ - 1 - t) : t);
}

__device__ __forceinline__ void ssm_item_naive(const Params& p, int layer, int item) {
  const int tid_ = opaque_tid();
  const int b = item >> 3, gq = item & 7;
  const int lane = tid_ & 63, wv = tid_ >> 6;
  const int dir = wv & 1, g = gq * 4 + (wv >> 1);
  const bf16_t* P = reinterpret_cast<const bf16_t*>(p.ws + WS_P);
  float* YD = reinterpret_cast<float*>(p.ws + WS_YD) + (size_t)dir * NTOK * 512;
  {
    const int n = lane;
    const size_t pg = ((size_t)(layer * 2 + dir) * 32 + g);
    const float lr = p.lam_re[pg * 64 + n], li = p.lam_im[pg * 64 + n];
    const float dt = expf(p.log_dt[pg]);
    const float mag = expf(lr * dt);
    const float ar = mag * cosf(li * dt), ai = mag * sinf(li * dt);
    const float den = lr * lr + li * li;
    const float fr = ((ar - 1.0f) * lr + ai * li) / den;
    const float fi = (ai * lr - (ar - 1.0f) * li) / den;
    float bbr[16], bbi[16], cr[16], ci[16];
#pragma unroll
    for (int q = 0; q < 16; ++q) {
      const float br = p.b_re[(pg * 64 + n) * 16 + q], bi = p.b_im[(pg * 64 + n) * 16 + q];
      bbr[q] = fr * br - fi * bi; bbi[q] = fr * bi + fi * br;
      cr[q] = p.c_re[(pg * 16 + q) * 64 + n]; ci[q] = p.c_im[(pg * 16 + q) * 64 + n];
    }
    float hr = 0.f, hi = 0.f;
    for (int tau = 0; tau < CTXL + SEQ; ++tau) {
      const int row = ssm_row(b, dir, tau);
      const uint4* up = reinterpret_cast<const uint4*>(P + (size_t)row * INW + C_U + g * 16);
      const uint4 u0 = up[0], u1 = up[1];
      float u[16];
      u[0] = __uint_as_float(u0.x << 16); u[1] = __uint_as_float(u0.x & 0xffff0000u); u[2] = __uint_as_float(u0.y << 16); u[3] = __uint_as_float(u0.y & 0xffff0000u);
      u[4] = __uint_as_float(u0.z << 16); u[5] = __uint_as_float(u0.z & 0xffff0000u); u[6] = __uint_as_float(u0.w << 16); u[7] = __uint_as_float(u0.w & 0xffff0000u);
      u[8] = __uint_as_float(u1.x << 16); u[9] = __uint_as_float(u1.x & 0xffff0000u); u[10] = __uint_as_float(u1.y << 16); u[11] = __uint_as_float(u1.y & 0xffff0000u);
      u[12] = __uint_as_float(u1.z << 16); u[13] = __uint_as_float(u1.z & 0xffff0000u); u[14] = __uint_as_float(u1.w << 16); u[15] = __uint_as_float(u1.w & 0xffff0000u);
      float xr = 0.f, xi = 0.f;
#pragma unroll
      for (int q = 0; q < 16; ++q) { xr += bbr[q] * u[q]; xi += bbi[q] * u[q]; }
      const float nhr = ar * hr - ai * hi + xr;
      const float nhi = ar * hi + ai * hr + xi;
      hr = nhr; hi = nhi;
      float v[16];
#pragma unroll
      for (int q = 0; q < 16; ++q) v[q] = hr * cr[q] - hi * ci[q];
#pragma unroll
      for (int i = 0; i < 8; ++i) { const bool up_ = (lane & 32) != 0; const float send = up_ ? v[i] : v[i + 8]; const float keep = up_ ? v[i + 8] : v[i]; v[i] = keep + shx(send, 32, lane); }
#pragma unroll
      for (int i = 0; i < 4; ++i) { const bool up_ = (lane & 16) != 0; const float send = up_ ? v[i] : v[i + 4]; const float keep = up_ ? v[i + 4] : v[i]; v[i] = keep + shx(send, 16, lane); }
#pragma unroll
      for (int i = 0; i < 2; ++i) { const bool up_ = (lane & 8) != 0; const float send = up_ ? v[i] : v[i + 2]; const float keep = up_ ? v[i + 2] : v[i]; v[i] = keep + shx(send, 8, lane); }
      { const bool up_ = (lane & 4) != 0; const float send = up_ ? v[0] : v[1]; const float keep = up_ ? v[1] : v[0]; v[0] = keep + shx(send, 4, lane); }
      v[0] += shx(v[0], 2, lane);
      v[0] += shx(v[0], 1, lane);
      if ((lane & 3) == 0) YD[(size_t)row * 512 + g * 16 + (lane >> 2)] = v[0];
    }
  }
  asm volatile("s_waitcnt vmcnt(0)" ::: "memory");
  __threadfence();
  __syncthreads();
  {
    const float* Y0 = reinterpret_cast<const float*>(p.ws + WS_YD);
    const float* Y1 = Y0 + (size_t)NTOK * 512;
    bf16_t* G = reinterpret_cast<bf16_t*>(p.ws + WS_G);
    const int ch = gq * 64 + (tid_ & 63);
    const float dsk = p.ssm_d[layer * 512 + ch];
    for (int i = tid_ >> 6; i < CTXL + SEQ; i += 8) {
      const int row = (i < CTXL) ? (NLAT + b * CTXL + i) : (b * SEQ + i - CTXL);
      const float y = Y0[(size_t)row * 512 + ch] + Y1[(size_t)row * 512 + ch] + dsk * bf2f(P[(size_t)row * INW + C_U + ch]);
      G[(size_t)row * 512 + ch] = f2bf(gelu_tanh(y));
    }
  }
}


typedef float f32x16 __attribute__((ext_vector_type(16)));
__device__ __forceinline__ bf16x8 pack8(const float* v) {
  union { unsigned u[4]; bf16x8 b; } t;
  t.u[0] = pack2(v[0], v[1]); t.u[1] = pack2(v[2], v[3]); t.u[2] = pack2(v[4], v[5]); t.u[3] = pack2(v[6], v[7]);
  return t.b;
}
constexpr int SSM_PITCH = 144;
__device__ __forceinline__ void ssm_item(const Params& p, int layer, int item, unsigned char* lds_raw) {
  const int tid_ = opaque_tid();
  const int b = item >> 4, gq = item & 15;
  const int lane = tid_ & 63, wv = tid_ >> 6;
  const int dir = wv & 1, sb = (wv >> 1) & 1, g = gq * 2 + (wv >> 2);
  const bf16_t* P = reinterpret_cast<const bf16_t*>(p.ws + WS_P);
  float* YD = reinterpret_cast<float*>(p.ws + WS_YD) + (size_t)(dir * 2 + sb) * NTOK * 512;
  unsigned char* hl = lds_raw + wv * (32 * SSM_PITCH);
  {
    const int n0 = lane & 31, hh = lane >> 5;
    const size_t pg = ((size_t)(layer * 2 + dir) * 32 + g);
    const float dt = expf(p.log_dt[pg]);
    float pwr[4], pwi[4];
    bf16x8 Bop[2];
    {
      const int n = n0 + 32 * sb;
      const float lr = p.lam_re[pg * 64 + n], li = p.lam_im[pg * 64 + n];
      const float mag = expf(lr * dt);
      const float ar = mag * __cosf(li * dt), ai = mag * __sinf(li * dt);
      const float den = lr * lr + li * li;
      const float fr = ((ar - 1.0f) * lr + ai * li) / den;
      const float fi = (ai * lr - (ar - 1.0f) * li) / den;
      float vr[8], vi[8];
#pragma unroll
      for (int j = 0; j < 8; ++j) {
        const int q = 8 * hh + j;
        const float br = p.b_re[(pg * 64 + n) * 16 + q], bi = p.b_im[(pg * 64 + n) * 16 + q];
        vr[j] = fr * br - fi * bi; vi[j] = fr * bi + fi * br;
      }
      Bop[0] = pack8(vr); Bop[1] = pack8(vi);
      pwr[0] = ar; pwi[0] = ai;
      pwr[1] = ar * ar - ai * ai; pwi[1] = 2.0f * ar * ai;
      pwr[2] = pwr[1] * ar - pwi[1] * ai; pwi[2] = pwr[1] * ai + pwi[1] * ar;
      pwr[3] = pwr[1] * pwr[1] - pwi[1] * pwi[1]; pwi[3] = 2.0f * pwr[1] * pwi[1];
    }
    bf16x8 Cop[2];
    {
      const int pch = lane & 15, q4 = lane >> 4;
#pragma unroll
      for (int kb = 0; kb < 2; ++kb) {
        float v[8];
#pragma unroll
        for (int j = 0; j < 8; ++j) {
          const int nn = 32 * sb + kb * 16 + 4 * q4 + (j >> 1);
          v[j] = (j & 1) ? -p.c_im[(pg * 16 + pch) * 64 + nn] : p.c_re[(pg * 16 + pch) * 64 + nn];
        }
        Cop[kb] = pack8(v);
      }
    }
    float hpr = 0.f, hpi = 0.f;
    const int ucol = C_U + g * 16 + 8 * hh;
    auto chunk_base = [&](int c, int& base, int& sgn) {
      sgn = dir ? -1 : 1;
      if (c < 8) base = NLAT + b * CTXL + (dir ? (CTXL - 1 - c * 32) : c * 32);
      else base = b * SEQ + (dir ? (SEQ - 1 - (c - 8) * 32) : (c - 8) * 32);
    };
    uint4 unext;
    { int base, sgn; chunk_base(0, base, sgn); unext = *reinterpret_cast<const uint4*>(P + (size_t)(base + sgn * n0) * INW + ucol); }
    for (int c = 0; c < 72; ++c) {
      int base, sgn; chunk_base(c, base, sgn);
      union { uint4 u; bf16x8 b; } ua; ua.u = unext;
      if (c + 1 < 72) { int nb, ns; chunk_base(c + 1, nb, ns); unext = *reinterpret_cast<const uint4*>(P + (size_t)(nb + ns * n0) * INW + ucol); }
      f32x16 xr, xi;
      {
        f32x16 z;
#pragma unroll
        for (int r = 0; r < 16; ++r) z[r] = 0.f;
        xr = __builtin_amdgcn_mfma_f32_32x32x16_bf16(ua.b, Bop[0], z, 0, 0, 0);
        xi = __builtin_amdgcn_mfma_f32_32x32x16_bf16(ua.b, Bop[1], z, 0, 0, 0);
      }
      {
        const float ar = pwr[0], ai = pwi[0], a4r = pwr[3], a4i = pwi[3];
        float Er[4], Ei[4], Or[4], Oi[4], mcr[4], mci[4];
#pragma unroll
        for (int q = 0; q < 4; ++q) {
#pragma unroll
          for (int i = 1; i < 4; ++i) {
            const int r = 4 * q + i;
            const float nr = ar * xr[r - 1] - ai * xi[r - 1] + xr[r];
            const float ni = ar * xi[r - 1] + ai * xr[r - 1] + xi[r];
            xr[r] = nr; xi[r] = ni;
          }
          Er[q] = xr[4 * q + 3]; Ei[q] = xi[4 * q + 3];
        }
#pragma unroll
        for (int q = 0; q < 4; ++q) { Or[q] = shx32(Er[q], lane); Oi[q] = shx32(Ei[q], lane); }
        float cr = hpr, ci = hpi;
#pragma unroll
        for (int q = 0; q < 4; ++q) {
          const float cer = cr, cei = ci;
          const float eer = hh ? Or[q] : Er[q], eei = hh ? Oi[q] : Ei[q];
          float tr = a4r * cr - a4i * ci + eer, ti = a4r * ci + a4i * cr + eei;
          cr = tr; ci = ti;
          const float cor = cr, coi = ci;
          const float eor = hh ? Er[q] : Or[q], eoi = hh ? Ei[q] : Oi[q];
          tr = a4r * cr - a4i * ci + eor; ti = a4r * ci + a4i * cr + eoi;
          cr = tr; ci = ti;
          mcr[q] = hh ? cor : cer; mci[q] = hh ? coi : cei;
        }
        hpr = cr; hpi = ci;
#pragma unroll
        for (int q = 0; q < 4; ++q)
#pragma unroll
          for (int i = 0; i < 4; ++i) {
            const int r = 4 * q + i;
            xr[r] += pwr[i] * mcr[q] - pwi[i] * mci[q];
            xi[r] += pwr[i] * mci[q] + pwi[i] * mcr[q];
          }
      }
#pragma unroll
      for (int q = 0; q < 4; ++q)
#pragma unroll
        for (int i = 0; i < 4; ++i) {
          const int r = 4 * q + i, tok = 8 * q + 4 * hh + i;
          *reinterpret_cast<unsigned*>(hl + tok * SSM_PITCH + n0 * 4) = pack2(xr[r], xi[r]);
        }
#pragma unroll
      for (int th = 0; th < 2; ++th) {
        f32x4 acc = f32x4{0.f, 0.f, 0.f, 0.f};
        const int tok = 16 * th + (lane & 15);
#pragma unroll
        for (int kb = 0; kb < 2; ++kb) {
          const bf16x8 hb = *reinterpret_cast<const bf16x8*>(hl + tok * SSM_PITCH + kb * 64 + (lane >> 4) * 16);
          acc = __builtin_amdgcn_mfma_f32_16x16x32_bf16(Cop[kb], hb, acc, 0, 0, 0);
        }
        const int row = base + sgn * tok;
        __builtin_nontemporal_store(acc, reinterpret_cast<f32x4*>(YD + (size_t)row * 512 + g * 16 + 4 * (lane >> 4)));
      }
    }
  }
  asm volatile("s_waitcnt vmcnt(0)" ::: "memory");
  __syncthreads();
  {
    const float* Y0 = reinterpret_cast<const float*>(p.ws + WS_YD);
    constexpr size_t YS = (size_t)NTOK * 512;
    bf16_t* G = reinterpret_cast<bf16_t*>(p.ws + WS_G);
    const int ch = gq * 32 + (tid_ & 7) * 4;
    const float4 dv = *reinterpret_cast<const float4*>(p.ssm_d + layer * 512 + ch);
    for (int i0 = tid_ >> 3; i0 < CTXL + SEQ; i0 += 4 * 64) {
      float4 pa[4][4]; uint2 uu[4];
#pragma unroll
      for (int k = 0; k < 4; ++k) {
        const int i = i0 + 64 * k;
        const int row = (i < CTXL) ? (NLAT + b * CTXL + i) : (b * SEQ + i - CTXL);
#pragma unroll
        for (int q = 0; q < 4; ++q) { const f32x4 t4 = __builtin_nontemporal_load(reinterpret_cast<const f32x4*>(Y0 + q * YS + (size_t)row * 512 + ch)); pa[k][q] = float4{t4[0], t4[1], t4[2], t4[3]}; }
        uu[k] = *reinterpret_cast<const uint2*>(P + (size_t)row * INW + C_U + ch);
      }
#pragma unroll
      for (int k = 0; k < 4; ++k) {
        const int i = i0 + 64 * k;
        const int row = (i < CTXL) ? (NLAT + b * CTXL + i) : (b * SEQ + i - CTXL);
        const float y0 = pa[k][0].x + pa[k][1].x + pa[k][2].x + pa[k][3].x + dv.x * __uint_as_float(uu[k].x << 16);
        const float y1 = pa[k][0].y + pa[k][1].y + pa[k][2].y + pa[k][3].y + dv.y * __uint_as_float(uu[k].x & 0xffff0000u);
        const float y2 = pa[k][0].z + pa[k][1].z + pa[k][2].z + pa[k][3].z + dv.z * __uint_as_float(uu[k].y << 16);
        const float y3 = pa[k][0].w + pa[k][1].w + pa[k][2].w + pa[k][3].w + dv.w * __uint_as_float(uu[k].y & 0xffff0000u);
        st_bf4(G + (size_t)row * 512 + ch, gelu_tanh(y0), gelu_tanh(y1), gelu_tanh(y2), gelu_tanh(y3));
      }
    }
  }
  asm volatile("s_waitcnt vmcnt(0)" ::: "memory");
  __syncthreads();
  if (tid_ == 0) {
    __builtin_amdgcn_fence(__ATOMIC_RELEASE, "agent");
    asm volatile("s_waitcnt vmcnt(0)" ::: "memory");
    __hip_atomic_fetch_add(reinterpret_cast<unsigned*>(p.ws + WS_CTL) + CW_SSMD + (layer * 8 + b) * 64, 1u, __ATOMIC_RELAXED, __HIP_MEMORY_SCOPE_AGENT);
  }
}

__device__ __forceinline__ void readout_phase(const Params& p, int layer, int nrows) {
  const int tid_ = opaque_tid();
  const int lane = tid_ & 63, wv = tid_ >> 6;
  const bf16_t* P = reinterpret_cast<const bf16_t*>(p.ws + WS_P);
  const float* Y0 = reinterpret_cast<const float*>(p.ws + WS_YD);
  constexpr size_t YS = (size_t)NTOK * 512;
  bf16_t* G = reinterpret_cast<bf16_t*>(p.ws + WS_G);
  const float4 d0 = *reinterpret_cast<const float4*>(p.ssm_d + layer * 512 + lane * 8), d1 = *reinterpret_cast<const float4*>(p.ssm_d + layer * 512 + lane * 8 + 4);
  const int stride = gridDim.x * 8;
  for (int row0 = blockIdx.x * 8 + wv; row0 < nrows; row0 += 2 * stride) {
    float4 a0[2][4], a1[2][4]; uint4 uu[2];
#pragma unroll
    for (int k = 0; k < 2; ++k) {
      const int row = row0 + k * stride;
      if (row < nrows) {
#pragma unroll
        for (int q = 0; q < 4; ++q) { a0[k][q] = *reinterpret_cast<const float4*>(Y0 + q * YS + (size_t)row * 512 + lane * 8); a1[k][q] = *reinterpret_cast<const float4*>(Y0 + q * YS + (size_t)row * 512 + lane * 8 + 4); }
        uu[k] = *reinterpret_cast<const uint4*>(P + (size_t)row * INW + C_U + lane * 8);
      }
    }
#pragma unroll
    for (int k = 0; k < 2; ++k) {
      const int row = row0 + k * stride;
      if (row < nrows) {
        const uint4 u = uu[k];
        const float4 s0 = float4{a0[k][0].x + a0[k][1].x + a0[k][2].x + a0[k][3].x, a0[k][0].y + a0[k][1].y + a0[k][2].y + a0[k][3].y, a0[k][0].z + a0[k][1].z + a0[k][2].z + a0[k][3].z, a0[k][0].w + a0[k][1].w + a0[k][2].w + a0[k][3].w};
        const float4 s1 = float4{a1[k][0].x + a1[k][1].x + a1[k][2].x + a1[k][3].x, a1[k][0].y + a1[k][1].y + a1[k][2].y + a1[k][3].y, a1[k][0].z + a1[k][1].z + a1[k][2].z + a1[k][3].z, a1[k][0].w + a1[k][1].w + a1[k][2].w + a1[k][3].w};
        const float y0 = s0.x + d0.x * __uint_as_float(u.x << 16), y1 = s0.y + d0.y * __uint_as_float(u.x & 0xffff0000u);
        const float y2 = s0.z + d0.z * __uint_as_float(u.y << 16), y3 = s0.w + d0.w * __uint_as_float(u.y & 0xffff0000u);
        const float y4 = s1.x + d1.x * __uint_as_float(u.z << 16), y5 = s1.y + d1.y * __uint_as_float(u.z & 0xffff0000u);
        const float y6 = s1.z + d1.z * __uint_as_float(u.w << 16), y7 = s1.w + d1.w * __uint_as_float(u.w & 0xffff0000u);
        uint4 o; o.x = pack2(gelu_tanh(y0), gelu_tanh(y1)); o.y = pack2(gelu_tanh(y2), gelu_tanh(y3)); o.z = pack2(gelu_tanh(y4), gelu_tanh(y5)); o.w = pack2(gelu_tanh(y6), gelu_tanh(y7));
        *reinterpret_cast<uint4*>(G + (size_t)row * 512 + lane * 8) = o;
      }
    }
  }
}

template <int NBT, class KF>
__device__ __forceinline__ void attn_query(const bf16_t* qptr, const bf16_t* P, int kcol, int vcol, bool has_sink, float sink, bf16_t* optr, int lane, KF kf) {
  float q[64];
  {
    const uint4* qp = reinterpret_cast<const uint4*>(qptr);
#pragma unroll
    for (int i = 0; i < 8; ++i) {
      const uint4 w = qp[i];
      q[8 * i + 0] = __uint_as_float(w.x << 16); q[8 * i + 1] = __uint_as_float(w.x & 0xffff0000u);
      q[8 * i + 2] = __uint_as_float(w.y << 16); q[8 * i + 3] = __uint_as_float(w.y & 0xffff0000u);
      q[8 * i + 4] = __uint_as_float(w.z << 16); q[8 * i + 5] = __uint_as_float(w.z & 0xffff0000u);
      q[8 * i + 6] = __uint_as_float(w.w << 16); q[8 * i + 7] = __uint_as_float(w.w & 0xffff0000u);
    }
  }
  float s[NBT]; int kr[NBT];
  float mx = has_sink ? sink : -1e30f;
#pragma unroll
  for (int j = 0; j < NBT; ++j) {
    int krow; float bias;
    const bool valid = kf(j, lane, krow, bias);
    kr[j] = valid ? krow : -1;
    float dot = 0.f;
    if (valid) {
      const uint4* kp = reinterpret_cast<const uint4*>(P + (size_t)krow * INW + kcol);
#pragma unroll
      for (int i = 0; i < 8; ++i) {
        const uint4 w = kp[i];
        dot += q[8 * i + 0] * __uint_as_float(w.x << 16) + q[8 * i + 1] * __uint_as_float(w.x & 0xffff0000u)
             + q[8 * i + 2] * __uint_as_float(w.y << 16) + q[8 * i + 3] * __uint_as_float(w.y & 0xffff0000u)
             + q[8 * i + 4] * __uint_as_float(w.z << 16) + q[8 * i + 5] * __uint_as_float(w.z & 0xffff0000u)
             + q[8 * i + 6] * __uint_as_float(w.w << 16) + q[8 * i + 7] * __uint_as_float(w.w & 0xffff0000u);
      }
    }
    s[j] = valid ? (dot * 0.125f + bias) : -1e30f;
    mx = fmaxf(mx, s[j]);
  }
  mx = wave_max(mx, lane);
  float l = 0.f;
#pragma unroll
  for (int j = 0; j < NBT; ++j) { s[j] = (kr[j] >= 0) ? __expf(s[j] - mx) : 0.f; l += s[j]; }
  l = wave_sum(l, lane);
  if (has_sink) l += __expf(sink - mx);
  float o[64];
#pragma unroll
  for (int i = 0; i < 64; ++i) o[i] = 0.f;
#pragma unroll
  for (int j = 0; j < NBT; ++j) {
    if (kr[j] >= 0) {
      const uint4* vp = reinterpret_cast<const uint4*>(P + (size_t)kr[j] * INW + vcol);
      const float pj = s[j];
#pragma unroll
      for (int i = 0; i < 8; ++i) {
        const uint4 w = vp[i];
        o[8 * i + 0] += pj * __uint_as_float(w.x << 16); o[8 * i + 1] += pj * __uint_as_float(w.x & 0xffff0000u);
        o[8 * i + 2] += pj * __uint_as_float(w.y << 16); o[8 * i + 3] += pj * __uint_as_float(w.y & 0xffff0000u);
        o[8 * i + 4] += pj * __uint_as_float(w.z << 16); o[8 * i + 5] += pj * __uint_as_float(w.z & 0xffff0000u);
        o[8 * i + 6] += pj * __uint_as_float(w.w << 16); o[8 * i + 7] += pj * __uint_as_float(w.w & 0xffff0000u);
      }
    }
  }
#pragma unroll
  for (int i = 0; i < 32; ++i) { const bool up_ = (lane & 32) != 0; const float send = up_ ? o[i] : o[i + 32]; const float keep = up_ ? o[i + 32] : o[i]; o[i] = keep + shx(send, 32, lane); }
#pragma unroll
  for (int i = 0; i < 16; ++i) { const bool up_ = (lane & 16) != 0; const float send = up_ ? o[i] : o[i + 16]; const float keep = up_ ? o[i + 16] : o[i]; o[i] = keep + shx(send, 16, lane); }
#pragma unroll
  for (int i = 0; i < 8; ++i) { const bool up_ = (lane & 8) != 0; const float send = up_ ? o[i] : o[i + 8]; const float keep = up_ ? o[i + 8] : o[i]; o[i] = keep + shx(send, 8, lane); }
#pragma unroll
  for (int i = 0; i < 4; ++i) { const bool up_ = (lane & 4) != 0; const float send = up_ ? o[i] : o[i + 4]; const float keep = up_ ? o[i + 4] : o[i]; o[i] = keep + shx(send, 4, lane); }
#pragma unroll
  for (int i = 0; i < 2; ++i) { const bool up_ = (lane & 2) != 0; const float send = up_ ? o[i] : o[i + 2]; const float keep = up_ ? o[i + 2] : o[i]; o[i] = keep + shx(send, 2, lane); }
  { const bool up_ = (lane & 1) != 0; const float send = up_ ? o[0] : o[1]; const float keep = up_ ? o[1] : o[0]; o[0] = keep + shx(send, 1, lane); }
  optr[lane] = f2bf(o[0] / l);
}

__device__ __forceinline__ void mixer_item_naive(const Params& p, int layer, int item, bool need_ctx, unsigned char* lds_raw) {
  const int tid_ = opaque_tid();
  const bf16_t* P = reinterpret_cast<const bf16_t*>(p.ws + WS_P);
  bf16_t* Y = reinterpret_cast<bf16_t*>(p.ws + WS_Y);
  const int wv = tid_ >> 6;
  if (item < 64) {
    unsigned long long ts0 = 0; if (PROBE_PH == 13) ts0 = wall_clock64();
    ssm_item(p, layer, item, lds_raw);
    if (PROBE_PH == 13) { __syncthreads(); if (tid_ == 0) atomicMax(reinterpret_cast<unsigned*>(p.ws + WS_CTL) + 12288 + layer, (unsigned)(wall_clock64() - ts0)); }
    return; }
  if (item < 320) {
    const int it = item - 64; const int b = it >> 5, blk = (it >> 1) & 15, hk = it & 1;
    const int hq = hk * 4 + (wv >> 1), half = wv & 1;
    const float sink = p.win_sink[layer * 8 + hq];
    for (int qi = 0; qi < 64; ++qi) {
      const int t = blk * 128 + half * 64 + qi;
      const int row = b * SEQ + t;
      attn_query<9>(P + (size_t)row * INW + C_WQ + hq * 64, P, C_WK + hk * 64, C_WV + hk * 64, true, sink, Y + (size_t)row * 1536 + 512 + hq * 64, tid_ & 63,
        [&](int j, int lane, int& krow, float& bias) -> bool {
          bias = 0.f;
          if (j < 5) { const int kp = t - 128 + j * 64 + lane; krow = b * SEQ + kp; return kp >= 0 && kp < SEQ && kp <= t + 128; }
          krow = NLAT + b * CTXL + (j - 5) * 64 + lane; return true;
        });
    }
    return;
  }
  if (item < 576) {
    const int it = item - 320; const int b = it >> 5, h = (it >> 2) & 7, rg = it & 3;
    const int r = rg * 8 + wv;
    int rs = r - 4; rs = rs < 0 ? 0 : (rs > 24 ? 24 : rs);
    const float* rpb = p.na_rpb + ((size_t)layer * 8 + h) * 15 * 31;
    for (int c = 0; c < 64; ++c) {
      const int row = b * SEQ + r * 64 + c;
      int cs = c - 8; cs = cs < 0 ? 0 : (cs > 48 ? 48 : cs);
      attn_query<6>(P + (size_t)row * INW + C_NQ + h * 64, P, C_NK + h * 64, C_NV + h * 64, false, 0.f, Y + (size_t)row * 1536 + 1024 + h * 64, tid_ & 63,
        [&](int j, int lane, int& krow, float& bias) -> bool {
          if (j < 2) {
            const int i = j * 64 + lane; const int kr_ = rs + (i >> 4), kc = cs + (i & 15);
            krow = b * SEQ + kr_ * 64 + kc;
            int dc = kc - c; dc = dc < -15 ? -15 : (dc > 15 ? 15 : dc);
            bias = rpb[(kr_ - r + 7) * 31 + dc + 15];
            return true;
          }
          bias = 0.f; krow = NLAT + b * CTXL + (j - 2) * 64 + lane; return true;
        });
    }
    return;
  }
  if (!need_ctx) return;
  if (item < 608) {
    const int it = item - 576; const int b = it >> 2, qb = it & 3;
    const int hq = wv, hk = hq >> 2;
    const float sink = p.win_sink[layer * 8 + hq];
    for (int qi = 0; qi < 64; ++qi) {
      const int row = NLAT + b * CTXL + qb * 64 + qi;
      attn_query<4>(P + (size_t)row * INW + C_WQ + hq * 64, P, C_WK + hk * 64, C_WV + hk * 64, true, sink, Y + (size_t)row * 1536 + 512 + hq * 64, tid_ & 63,
        [&](int j, int lane, int& krow, float& bias) -> bool { bias = 0.f; krow = NLAT + b * CTXL + j * 64 + lane; return true; });
    }
    return;
  }
  {
    const int it = item - 608; const int b = it >> 2, qb = it & 3;
    const int h = wv;
    for (int qi = 0; qi < 64; ++qi) {
      const int row = NLAT + b * CTXL + qb * 64 + qi;
      attn_query<4>(P + (size_t)row * INW + C_NQ + h * 64, P, C_NK + h * 64, C_NV + h * 64, false, 0.f, Y + (size_t)row * 1536 + 1024 + h * 64, tid_ & 63,
        [&](int j, int lane, int& krow, float& bias) -> bool { bias = 0.f; krow = NLAT + b * CTXL + j * 64 + lane; return true; });
    }
  }
}


constexpr int VT_TOK = CTXL + SEQ;
__device__ __forceinline__ int vt_pos(int tpos) { const int k = tpos & 31; return (tpos & ~31) + (((k >> 2) & 1) << 4) + (((k >> 3) << 2) | (k & 3)); }
template <class TileFn, class ScoreFn>
__device__ __forceinline__ void attn_wave_d1(const bf16_t* qrow0, int ntiles, TileFn tilefn, ScoreFn scorefn, float m_init, float l_init, bf16_t* orow0, int lane) {
  const int l31 = lane & 31, hh = lane >> 5;
  bf16x8 Qop[2][4];
#pragma unroll
  for (int qb = 0; qb < 2; ++qb)
#pragma unroll
    for (int s = 0; s < 4; ++s) {
      union { uint4 u; bf16x8 b; } q; q.u = *reinterpret_cast<const uint4*>(qrow0 + (size_t)(32 * qb + l31) * INW + 32 * hh + 8 * s);
      unsigned w[4] = {q.u.x, q.u.y, q.u.z, q.u.w};
#pragma unroll
      for (int j = 0; j < 4; ++j) w[j] = pack2(__uint_as_float(w[j] << 16) * 0.18033688011112042f, __uint_as_float(w[j] & 0xffff0000u) * 0.18033688011112042f);
      q.u = uint4{w[0], w[1], w[2], w[3]}; Qop[qb][s] = q.b;
    }
  f32x16 O[2][2];
#pragma unroll
  for (int a = 0; a < 2; ++a)
#pragma unroll
    for (int b2 = 0; b2 < 2; ++b2)
#pragma unroll
      for (int r = 0; r < 16; ++r) O[a][b2][r] = 0.f;
  float m[2] = {m_init, m_init};
  float l[2]; l[0] = hh ? 0.f : l_init; l[1] = l[0];
  const unsigned kvo = (unsigned)(hh * 32 + l31) * 16u;
  const bf16_t* kp; const bf16_t* vp; int info;
  tilefn(0, kp, vp, info);
  bf16x8 Kc[4]; bf16x8 Vc[2][2];
#pragma unroll
  for (int s = 0; s < 4; ++s) Kc[s] = ldg<bf16x8>(kp, kvo + 1024 * s);
#pragma unroll
  for (int db = 0; db < 2; ++db)
#pragma unroll
    for (int s = 0; s < 2; ++s) Vc[db][s] = ldg<bf16x8>(vp, kvo + (unsigned)((db * 2 + s) * 1024));
  for (int t = 0; t < ntiles; ++t) {
    const int info_c = info;
    const int tn = (t + 1 < ntiles) ? (t + 1) : t;
    tilefn(tn, kp, vp, info);
    bf16x8 Kn[4]; bf16x8 Vn[2][2];
#pragma unroll
    for (int s = 0; s < 4; ++s) Kn[s] = ldg<bf16x8>(kp, kvo + 1024 * s);
#pragma unroll
    for (int db = 0; db < 2; ++db)
#pragma unroll
      for (int s = 0; s < 2; ++s) Vn[db][s] = ldg<bf16x8>(vp, kvo + (unsigned)((db * 2 + s) * 1024));
    f32x16 S[2];
#pragma unroll
    for (int qb = 0; qb < 2; ++qb) {
#pragma unroll
      for (int r = 0; r < 16; ++r) S[qb][r] = 0.f;
#pragma unroll
      for (int s = 0; s < 4; ++s) S[qb] = __builtin_amdgcn_mfma_f32_32x32x16_bf16(Kc[s], Qop[qb][s], S[qb], 0, 0, 0);
    }
    bf16x8 Pop[2][2];
#pragma unroll
    for (int qb = 0; qb < 2; ++qb) {
      scorefn(info_c, qb, S[qb]);
      float mt = S[qb][0];
#pragma unroll
      for (int r = 1; r < 16; ++r) mt = fmaxf(mt, S[qb][r]);
      mt = fmaxf(mt, shx32(mt, lane));
      const float mnew = fmaxf(m[qb], mt);
      if (__any(mnew > m[qb])) {
        const float alpha = __builtin_amdgcn_exp2f(m[qb] - mnew);
        l[qb] *= alpha;
#pragma unroll
        for (int db = 0; db < 2; ++db)
#pragma unroll
          for (int r = 0; r < 16; ++r) O[db][qb][r] *= alpha;
        m[qb] = mnew;
      }
      float ls = 0.f;
#pragma unroll
      for (int r = 0; r < 16; ++r) { const float pv = __builtin_amdgcn_exp2f(S[qb][r] - mnew); S[qb][r] = pv; ls += pv; }
      l[qb] += ls;
#pragma unroll
      for (int s = 0; s < 2; ++s) {
        union { unsigned u[4]; bf16x8 b; } pk;
#pragma unroll
        for (int j = 0; j < 4; ++j) pk.u[j] = pack2(S[qb][8 * s + 2 * j], S[qb][8 * s + 2 * j + 1]);
        Pop[qb][s] = pk.b;
      }
    }
#pragma unroll
    for (int db = 0; db < 2; ++db)
#pragma unroll
      for (int s = 0; s < 2; ++s) {
#pragma unroll
        for (int qb = 0; qb < 2; ++qb) O[db][qb] = __builtin_amdgcn_mfma_f32_32x32x16_bf16(Vc[db][s], Pop[qb][s], O[db][qb], 0, 0, 0);
      }
#pragma unroll
    for (int s = 0; s < 4; ++s) Kc[s] = Kn[s];
#pragma unroll
    for (int db = 0; db < 2; ++db)
#pragma unroll
      for (int s = 0; s < 2; ++s) Vc[db][s] = Vn[db][s];
  }
#pragma unroll
  for (int qb = 0; qb < 2; ++qb) {
    const float lt = l[qb] + shx32(l[qb], lane);
    const float inv = 1.0f / lt;
    bf16_t* orow = orow0 + (size_t)(32 * qb + l31) * 1536;
#pragma unroll
    for (int db = 0; db < 2; ++db)
#pragma unroll
      for (int gq = 0; gq < 4; ++gq)
        st_bf4(orow + 32 * db + 8 * gq + 4 * hh, O[db][qb][4 * gq] * inv, O[db][qb][4 * gq + 1] * inv, O[db][qb][4 * gq + 2] * inv, O[db][qb][4 * gq + 3] * inv);
  }
}

template <class TileFn, class ScoreFn>
__device__ __forceinline__ void attn_wave(const bf16_t* qrow0, int ntiles, TileFn tilefn, ScoreFn scorefn, float m_init, float l_init, bf16_t* orow0, int lane, LAS unsigned char* wq) {
  const int l31 = lane & 31, hh = lane >> 5;
  const unsigned kvo = (unsigned)(hh * 32 + l31) * 16u;
#pragma unroll
  for (int qb = 0; qb < 2; ++qb)
#pragma unroll
    for (int s = 0; s < 4; ++s) {
      union { uint4 u; bf16x8 b; } q; q.u = *reinterpret_cast<const uint4*>(qrow0 + (size_t)(32 * qb + l31) * INW + 32 * hh + 8 * s);
      unsigned w[4] = {q.u.x, q.u.y, q.u.z, q.u.w};
#pragma unroll
      for (int j = 0; j < 4; ++j) w[j] = pack2(__uint_as_float(w[j] << 16) * 0.18033688011112042f, __uint_as_float(w[j] & 0xffff0000u) * 0.18033688011112042f);
      q.u = uint4{w[0], w[1], w[2], w[3]};
      *(LAS bf16x8*)(wq + kvo + (qb * 4 + s) * 1024) = q.b;
    }
  f32x16 O[2][2];
#pragma unroll
  for (int a = 0; a < 2; ++a)
#pragma unroll
    for (int b2 = 0; b2 < 2; ++b2)
#pragma unroll
      for (int r = 0; r < 16; ++r) O[a][b2][r] = 0.f;
  float m[2] = {m_init, m_init};
  float l[2]; l[0] = hh ? 0.f : l_init; l[1] = l[0];
  auto loadk = [&](int i, bf16x8 (&Kd)[4]) __attribute__((always_inline)) {
    const bf16_t* kp; const bf16_t* vp; int inf; tilefn((i < ntiles) ? i : (ntiles - 1), kp, vp, inf); (void)inf; (void)vp;
#pragma unroll
    for (int s = 0; s < 4; ++s) Kd[s] = ldg<bf16x8>(kp, kvo + 1024 * s);
  };
  auto loadv = [&](int i, bf16x8 (&Vd)[2][2]) __attribute__((always_inline)) {
    const bf16_t* kp; const bf16_t* vp; int inf; tilefn((i < ntiles) ? i : (ntiles - 1), kp, vp, inf); (void)inf; (void)kp;
#pragma unroll
    for (int db = 0; db < 2; ++db)
#pragma unroll
      for (int s = 0; s < 2; ++s) Vd[db][s] = ldg<bf16x8>(vp, kvo + (unsigned)((db * 2 + s) * 1024));
  };
  auto body = [&](int t, bf16x8 (&Kc)[4], bf16x8 (&Vc)[2][2], bf16x8 (&Kl)[4], bf16x8 (&Vl)[2][2]) __attribute__((always_inline)) {
    SCHED;
    loadk(t + 2, Kl); loadv(t + 1, Vl);
    int info_c; { const bf16_t* kd; const bf16_t* vd; tilefn(t, kd, vd, info_c); (void)kd; (void)vd; }
    unsigned qo = kvo; asm volatile("" : "+v"(qo));
    f32x16 S[2];
#pragma unroll
    for (int qb = 0; qb < 2; ++qb) {
#pragma unroll
      for (int r = 0; r < 16; ++r) S[qb][r] = 0.f;
#pragma unroll
      for (int s = 0; s < 4; ++s) S[qb] = __builtin_amdgcn_mfma_f32_32x32x16_bf16(Kc[s], *(const LAS bf16x8*)(wq + qo + (qb * 4 + s) * 1024), S[qb], 0, 0, 0);
      if (qb == 0) SCHED;
    }
    bf16x8 Pop[2][2];
#pragma unroll
    for (int qb = 0; qb < 2; ++qb) {
      scorefn(info_c, qb, S[qb]);
      float mt = S[qb][0];
#pragma unroll
      for (int r = 1; r < 16; ++r) mt = fmaxf(mt, S[qb][r]);
      mt = fmaxf(mt, shx32(mt, lane));
      const float mnew = fmaxf(m[qb], mt);
      if (__any(mnew > m[qb])) {
        const float alpha = __builtin_amdgcn_exp2f(m[qb] - mnew);
        l[qb] *= alpha;
#pragma unroll
        for (int db = 0; db < 2; ++db)
#pragma unroll
          for (int r = 0; r < 16; ++r) O[db][qb][r] *= alpha;
        m[qb] = mnew;
      }
      float ls = 0.f;
#pragma unroll
      for (int r = 0; r < 16; ++r) { const float pv = __builtin_amdgcn_exp2f(S[qb][r] - mnew); S[qb][r] = pv; ls += pv; }
      l[qb] += ls;
#pragma unroll
      for (int s = 0; s < 2; ++s) {
        union { unsigned u[4]; bf16x8 b; } pk;
#pragma unroll
        for (int j = 0; j < 4; ++j) pk.u[j] = pack2(S[qb][8 * s + 2 * j], S[qb][8 * s + 2 * j + 1]);
        Pop[qb][s] = pk.b;
      }
    }
#pragma unroll
    for (int db = 0; db < 2; ++db)
#pragma unroll
      for (int s = 0; s < 2; ++s) {
#pragma unroll
        for (int qb = 0; qb < 2; ++qb) O[db][qb] = __builtin_amdgcn_mfma_f32_32x32x16_bf16(Vc[db][s], Pop[qb][s], O[db][qb], 0, 0, 0);
      }
  };
  bf16x8 K0[4], K1[4], K2[4]; bf16x8 V0[2][2], V1[2][2];
  loadk(0, K0); loadv(0, V0); loadk(1, K1);
  for (int t = 0; t < ntiles; t += 6) {
    body(t, K0, V0, K2, V1);
    if (t + 1 < ntiles) body(t + 1, K1, V1, K0, V0);
    if (t + 2 < ntiles) body(t + 2, K2, V0, K1, V1);
    if (t + 3 < ntiles) body(t + 3, K0, V1, K2, V0);
    if (t + 4 < ntiles) body(t + 4, K1, V0, K0, V1);
    if (t + 5 < ntiles) body(t + 5, K2, V1, K1, V0);
  }
#pragma unroll
  for (int qb = 0; qb < 2; ++qb) {
    const float lt = l[qb] + shx32(l[qb], lane);
    const float inv = 1.0f / lt;
    bf16_t* orow = orow0 + (size_t)(32 * qb + l31) * 1536;
#pragma unroll
    for (int db = 0; db < 2; ++db)
#pragma unroll
      for (int gq = 0; gq < 4; ++gq)
        st_bf4(orow + 32 * db + 8 * gq + 4 * hh, O[db][qb][4 * gq] * inv, O[db][qb][4 * gq + 1] * inv, O[db][qb][4 * gq + 2] * inv, O[db][qb][4 * gq + 3] * inv);
  }
}

__device__ __forceinline__ void mixer_item(const Params& p, int layer, int item, bool need_ctx, unsigned char* lds_raw) {
  const int tid_ = opaque_tid();
  const bf16_t* P = reinterpret_cast<const bf16_t*>(p.ws + WS_P);
  const bf16_t* VT = reinterpret_cast<const bf16_t*>(p.ws + WS_VT);
  const bf16_t* KT = reinterpret_cast<const bf16_t*>(p.ws + WS_KT);
  bf16_t* Y = reinterpret_cast<bf16_t*>(p.ws + WS_Y);
  const int wv = tid_ >> 6, lane = tid_ & 63;
  LAS unsigned char* wq = (LAS unsigned char*)lds_raw + wv * 8192;
  if (item < 128) {
    unsigned long long ts0 = 0; if (PROBE_PH == 13) ts0 = wall_clock64();
    ssm_item(p, layer, item, lds_raw);
    if (PROBE_PH == 13) { __syncthreads(); if (tid_ == 0) atomicMax(reinterpret_cast<unsigned*>(p.ws + WS_CTL) + 12288 + layer, (unsigned)(wall_clock64() - ts0)); }
    return; }
  if (item < 384) {
    const int it = item - 128; const int b = it >> 5, blk = (it >> 1) & 15, hk = it & 1;
    const int hq = hk * 4 + (wv >> 1), half = wv & 1;
    const float sink = p.win_sink[layer * 8 + hq] * 1.4426950408889634f;
    const int t0 = blk * 128 + half * 64;
    int ilo = 0, ihi = 10;
    if (t0 - 128 < 0) ilo = (128 - t0) >> 5;
    if (t0 + 192 > SEQ) ihi = 10 - ((t0 + 192 - SEQ) >> 5);
    const bf16_t* kth = KT + (size_t)(b * 10 + hk) * 72 * 2048;
    const bf16_t* vth = VT + (size_t)(b * 10 + hk) * 72 * 2048;
    const int qrow0 = b * SEQ + t0;
    attn_wave(P + (size_t)qrow0 * INW + C_WQ + hq * 64, 8 + (ihi - ilo),
      [&](int i, const bf16_t*& kp, const bf16_t*& vp, int& info) {
        if (i < 8) { kp = kth + i * 2048; vp = vth + i * 2048; info = -100000; }
        else { const int key0 = t0 - 128 + 32 * (i - 8 + ilo); const int tl = 8 + (key0 >> 5); kp = kth + tl * 2048; vp = vth + tl * 2048; info = key0; }
      },
      [&](int info, int qb, f32x16& S) {
        if (info != -100000 && (info < t0 - 64 || info > t0 + 96)) {
          const int d0 = info + 4 * (lane >> 5) - (t0 + 32 * qb + (lane & 31));
#pragma unroll
          for (int r = 0; r < 16; ++r) { const int d = d0 + (r & 3) + 8 * (r >> 2); S[r] = (d >= -128 && d <= 128) ? S[r] : -1e30f; }
        }
      }, sink, 1.0f, Y + (size_t)qrow0 * 1536 + 512 + hq * 64, lane, wq);
    return;
  }
  if (item < 640) {
    const int it = item - 384; const int b = it >> 5, h = (it >> 2) & 7, rg = it & 3;
    const int r = rg * 8 + wv;
    int rs = r - 4; rs = rs < 0 ? 0 : (rs > 24 ? 24 : rs);
    float* tbl = reinterpret_cast<float*>(lds_raw + LDS_TAB);
    __syncthreads();
    { const float* rpb = p.na_rpb + ((size_t)layer * 8 + h) * 15 * 31; for (int i = tid_; i < 15 * 31 + 128; i += NTHR) { const int j = i - 64; tbl[i] = (j >= 0 && j < 15 * 31) ? rpb[j] * 1.4426950408889634f : 0.f; } }
    __syncthreads();
    const bf16_t* kth = KT + (size_t)(b * 10 + 2 + h) * 72 * 2048;
    const bf16_t* vth = VT + (size_t)(b * 10 + 2 + h) * 72 * 2048;
    const int qrow0 = b * SEQ + r * 64;
    attn_wave_d1(P + (size_t)qrow0 * INW + C_NQ + h * 64, 8 + 16,
      [&](int i, const bf16_t*& kp, const bf16_t*& vp, int& info) {
        if (i < 8) { kp = kth + i * 2048; vp = vth + i * 2048; info = -1; }
        else { const int j = i - 8; const int tl = 8 + rs * 2 + j; kp = kth + tl * 2048; vp = vth + tl * 2048; info = j; }
      },
      [&](int info, int qb, f32x16& S) {
        if (info < 0) {
#pragma unroll
          for (int r2 = 0; r2 < 16; ++r2) { }
        } else {
          const int kr = rs + (info >> 1), jh = info & 1;
          const int qc = 32 * qb + (lane & 31);
          int cs = qc - 8; cs = cs < 0 ? 0 : (cs > 48 ? 48 : cs);
          const int kc0 = jh * 32 + 4 * (lane >> 5);
          const float* tb = tbl + 64 + (kr - r + 7) * 31 + kc0 - qc + 15;
          float tv[16];
#pragma unroll
          for (int r2 = 0; r2 < 16; ++r2) tv[r2] = tb[(r2 & 3) + 8 * (r2 >> 2)];
#pragma unroll
          for (int r2 = 0; r2 < 16; ++r2) {
            const int kc = kc0 + (r2 & 3) + 8 * (r2 >> 2);
            S[r2] = (kc >= cs && kc < cs + 16) ? (S[r2] + tv[r2]) : -1e30f;
          }
        }
      }, -1e30f, 0.0f, Y + (size_t)qrow0 * 1536 + 1024 + h * 64, lane);
    return;
  }
  if (!need_ctx) return;
  if (item < 672) {
    const int it = item - 640; const int b = it >> 2, qb4 = it & 3;
    const int hq = wv, hk = hq >> 2;
    const float sink = p.win_sink[layer * 8 + hq] * 1.4426950408889634f;
    const bf16_t* kth = KT + (size_t)(b * 10 + hk) * 72 * 2048;
    const bf16_t* vth = VT + (size_t)(b * 10 + hk) * 72 * 2048;
    const int qrow0 = NLAT + b * CTXL + qb4 * 64;
    attn_wave(P + (size_t)qrow0 * INW + C_WQ + hq * 64, 8,
      [&](int i, const bf16_t*& kp, const bf16_t*& vp, int& info) { kp = kth + i * 2048; vp = vth + i * 2048; info = 0; },
      [&](int info, int qb, f32x16& S) {
#pragma unroll
        for (int r2 = 0; r2 < 16; ++r2) { }
      }, sink, 1.0f, Y + (size_t)qrow0 * 1536 + 512 + hq * 64, lane, wq);
    return;
  }
  {
    const int it = item - 672; const int b = it >> 2, qb4 = it & 3;
    const int h = wv;
    const bf16_t* kth = KT + (size_t)(b * 10 + 2 + h) * 72 * 2048;
    const bf16_t* vth = VT + (size_t)(b * 10 + 2 + h) * 72 * 2048;
    const int qrow0 = NLAT + b * CTXL + qb4 * 64;
    attn_wave(P + (size_t)qrow0 * INW + C_NQ + h * 64, 8,
      [&](int i, const bf16_t*& kp, const bf16_t*& vp, int& info) { kp = kth + i * 2048; vp = vth + i * 2048; info = 0; },
      [&](int info, int qb, f32x16& S) {
#pragma unroll
        for (int r2 = 0; r2 < 16; ++r2) { }
      }, -1e30f, 0.0f, Y + (size_t)qrow0 * 1536 + 1024 + h * 64, lane, wq);
  }
}

__device__ __forceinline__ void split8(const float* v, bf16x8& hi, bf16x8& lo) {
  union { unsigned u[4]; bf16x8 b; } h, l;
#pragma unroll
  for (int i = 0; i < 4; ++i) {
    const unsigned u = pack2(v[2 * i], v[2 * i + 1]);
    h.u[i] = u;
    l.u[i] = pack2(v[2 * i] - __uint_as_float(u << 16), v[2 * i + 1] - __uint_as_float(u & 0xffff0000u));
  }
  hi = h.b; lo = l.b;
}
constexpr int RT_PITCH = 1028;
#define ROUTE_LOAD(xd, md, g_) do { \
    _Pragma("unroll") for (int tt = 0; tt < 2; ++tt) { \
      const int row_ = (g_) * 16 + wv + 8 * tt; const float* xi_ = stream_row_in(p, layer, row_); \
      _Pragma("unroll") for (int i = 0; i < 4; ++i) { xd[tt][i] = *reinterpret_cast<const float4*>(xi_ + i * 256 + lane * 4); md[tt][i] = *reinterpret_cast<const uint2*>(MBp + (size_t)row_ * D + i * 256 + lane * 4); } \
    } } while (0)
#define ROUTE_MODLOAD(g_) do { const float* ms_ = mod + ((size_t)layer * 9 + row_modidx((g_) * 16)) * 6144 + 2 * 1024; \
    mdn0 = *reinterpret_cast<const float4*>(ms_ + tid_ * 4); if (tid_ < 256) mdn1 = *reinterpret_cast<const float4*>(ms_ + 2048 + tid_ * 4); } while (0)
#define ROUTE_MODSTORE(buf_) do { *reinterpret_cast<float4*>((buf_) + tid_ * 4) = mdn0; if (tid_ < 256) *reinterpret_cast<float4*>((buf_) + 2048 + tid_ * 4) = mdn1; } while (0)
__device__ __forceinline__ void route_phase(const Params& p, int layer, int ntok, float* lds_f) {
  const int tid_ = opaque_tid();
  const float* mod = reinterpret_cast<const float*>(p.ws + WS_MOD);
  bf16_t* F = reinterpret_cast<bf16_t*>(p.ws + WS_H);
  int* tke = reinterpret_cast<int*>(p.ws + WS_TKE);
  int* tkp = reinterpret_cast<int*>(p.ws + WS_TKP);
  float* tkg = reinterpret_cast<float*>(p.ws + WS_TKG);
  int* tlist = reinterpret_cast<int*>(p.ws + WS_TLIST);
  unsigned* cnt = reinterpret_cast<unsigned*>(p.ws + WS_CTL) + CW_CNT + layer * 32;
  const bf16_t* MBp = reinterpret_cast<const bf16_t*>(p.ws + WS_S) + (size_t)NTOK * D;
  const int lane = tid_ & 63, wv = tid_ >> 6;
  float* frow = lds_f;
  float* part = lds_f + 16 * RT_PITCH;
  int* hist = reinterpret_cast<int*>(part + 16 * 8 * 32);
  int* sel = hist + 64;
  float* selg = reinterpret_cast<float*>(sel + 8 * 16 * 4);
  float* modb = selg + 8 * 16 * 4;
  float* gwl = modb + 2 * 3072;
  const float* gw = p.norm_ffn + layer * D;
  const float* rw = p.router_w + (size_t)layer * D * NEXP;
  const float rb = p.router_b[layer * NEXP + (lane & 31)];
  const int fr = lane & 15, fq = lane >> 4;
  bf16x8 wh[4][2], wl[4][2];
#pragma unroll
  for (int s = 0; s < 4; ++s)
#pragma unroll
    for (int n = 0; n < 2; ++n) {
      float w8[8];
#pragma unroll
      for (int i = 0; i < 8; ++i) w8[i] = rw[(size_t)(wv * 128 + s * 32 + fq * 8 + i) * NEXP + n * 16 + fr];
      split8(w8, wh[s][n], wl[s][n]);
    }
  if (tid_ < 64) hist[tid_] = 0;
  const int ngroups = ntok >> 4;
  int lg = 0, cur = 0;
  float4 xq[2][4], xn[2][4]; uint2 mq[2][4], mn[2][4];
  float4 mdn0 = {0.f, 0.f, 0.f, 0.f}, mdn1 = {0.f, 0.f, 0.f, 0.f};
  if (tid_ < 256) *reinterpret_cast<float4*>(gwl + tid_ * 4) = *reinterpret_cast<const float4*>(gw + tid_ * 4);
  if ((int)blockIdx.x < ngroups) { ROUTE_MODLOAD((int)blockIdx.x); ROUTE_MODSTORE(modb); ROUTE_LOAD(xq, mq, (int)blockIdx.x); }
  __syncthreads();
  for (int grp = blockIdx.x; grp < ngroups; grp += gridDim.x, ++lg, cur ^= 1) {
    const int ng = grp + (int)gridDim.x; const bool hasn = ng < ngroups;
    if (hasn) { ROUTE_MODLOAD(ng); ROUTE_LOAD(xn, mn, ng); }
    {
      const float* mcur = modb + cur * 3072;
#pragma unroll
      for (int tt = 0; tt < 2; ++tt) {
        const int row = grp * 16 + wv + 8 * tt;
        float* xr = stream_row(p, row);
        float v[16];
#pragma unroll
        for (int i = 0; i < 4; ++i) {
          const int c = i * 256 + lane * 4;
          float4 q = xq[tt][i]; const float4 g2 = *reinterpret_cast<const float4*>(mcur + c); const uint2 mm = mq[tt][i];
          q.x += g2.x * __uint_as_float(mm.x << 16); q.y += g2.y * __uint_as_float(mm.x & 0xffff0000u); q.z += g2.z * __uint_as_float(mm.y << 16); q.w += g2.w * __uint_as_float(mm.y & 0xffff0000u);
          *reinterpret_cast<float4*>(xr + c) = q;
          v[4 * i] = q.x; v[4 * i + 1] = q.y; v[4 * i + 2] = q.z; v[4 * i + 3] = q.w;
        }
        float ss = 0.f;
#pragma unroll
        for (int i = 0; i < 16; ++i) ss += v[i] * v[i];
        ss = wave_sum(ss, lane);
        const float rinv = rsqrtf(ss * (1.0f / D) + 1e-6f);
#pragma unroll
        for (int i = 0; i < 4; ++i) {
          const int c = i * 256 + lane * 4;
          const float4 g = *reinterpret_cast<const float4*>(gwl + c);
          const float4 sh = *reinterpret_cast<const float4*>(mcur + 1024 + c);
          const float4 sc = *reinterpret_cast<const float4*>(mcur + 2048 + c);
          const float f0 = v[4 * i] * rinv * g.x * (1.f + sc.x) + sh.x, f1 = v[4 * i + 1] * rinv * g.y * (1.f + sc.y) + sh.y;
          const float f2 = v[4 * i + 2] * rinv * g.z * (1.f + sc.z) + sh.z, f3 = v[4 * i + 3] * rinv * g.w * (1.f + sc.w) + sh.w;
          st_bf4(F + (size_t)row * D + c, f0, f1, f2, f3);
          *reinterpret_cast<float4*>(frow + (wv + 8 * tt) * RT_PITCH + c) = float4{f0, f1, f2, f3};
        }
      }
    }
    if (hasn) ROUTE_MODSTORE(modb + (cur ^ 1) * 3072);
    __syncthreads();
    {
      f32x4 acc0 = {0.f, 0.f, 0.f, 0.f}, acc1 = {0.f, 0.f, 0.f, 0.f};
#pragma unroll
      for (int s = 0; s < 4; ++s) {
        const float* fp = frow + fr * RT_PITCH + wv * 128 + s * 32 + fq * 8;
        const float4 x0 = *reinterpret_cast<const float4*>(fp), x1 = *reinterpret_cast<const float4*>(fp + 4);
        const float x8[8] = {x0.x, x0.y, x0.z, x0.w, x1.x, x1.y, x1.z, x1.w};
        bf16x8 xh, xl; split8(x8, xh, xl);
        acc0 = __builtin_amdgcn_mfma_f32_16x16x32_bf16(xl, wh[s][0], acc0, 0, 0, 0);
        acc1 = __builtin_amdgcn_mfma_f32_16x16x32_bf16(xl, wh[s][1], acc1, 0, 0, 0);
        acc0 = __builtin_amdgcn_mfma_f32_16x16x32_bf16(xh, wl[s][0], acc0, 0, 0, 0);
        acc1 = __builtin_amdgcn_mfma_f32_16x16x32_bf16(xh, wl[s][1], acc1, 0, 0, 0);
        acc0 = __builtin_amdgcn_mfma_f32_16x16x32_bf16(xh, wh[s][0], acc0, 0, 0, 0);
        acc1 = __builtin_amdgcn_mfma_f32_16x16x32_bf16(xh, wh[s][1], acc1, 0, 0, 0);
      }
#pragma unroll
      for (int r = 0; r < 4; ++r) {
        part[((4 * fq + r) * 8 + wv) * 32 + fr] = acc0[r];
        part[((4 * fq + r) * 8 + wv) * 32 + 16 + fr] = acc1[r];
      }
    }
    __syncthreads();
    {
      const int ee = lane & 31, tsel = wv + 8 * (lane >> 5);
      float acc = 0.f;
#pragma unroll
      for (int k2 = 0; k2 < 8; ++k2) acc += part[(tsel * 8 + k2) * 32 + ee];
      const float logit = acc + rb;
      int sel_e[4]; float sel_v[4];
      float cur = logit;
#pragma unroll
      for (int k = 0; k < 4; ++k) {
        float bv = cur; int bi = ee;
#pragma unroll
        for (int o = 16; o >= 1; o >>= 1) {
          const float ov = shx(bv, o, lane); const int oi = shx(bi, o, lane);
          if (ov > bv || (ov == bv && oi < bi)) { bv = ov; bi = oi; }
        }
        sel_e[k] = bi; sel_v[k] = bv;
        if (ee == bi) cur = -3.0e38f;
      }
      const float m0 = sel_v[0];
      const float e0 = 1.f, e1 = __expf(sel_v[1] - m0), e2 = __expf(sel_v[2] - m0), e3 = __expf(sel_v[3] - m0);
      const float inv = 1.f / (e0 + e1 + e2 + e3);
      if (ee < 4) {
        const int ex = (ee == 0) ? sel_e[0] : (ee == 1) ? sel_e[1] : (ee == 2) ? sel_e[2] : sel_e[3];
        const float gg = ((ee == 0) ? e0 : (ee == 1) ? e1 : (ee == 2) ? e2 : e3) * inv;
        const int lp = atomicAdd(&hist[ex], 1);
        sel[(lg * 16 + tsel) * 4 + ee] = ex | (lp << 8); selg[(lg * 16 + tsel) * 4 + ee] = gg;
      }
    }
#pragma unroll
    for (int tt = 0; tt < 2; ++tt)
#pragma unroll
      for (int i = 0; i < 4; ++i) { xq[tt][i] = xn[tt][i]; mq[tt][i] = mn[tt][i]; }
  }
  __syncthreads();
  if (tid_ < 32) hist[32 + tid_] = (int)__hip_atomic_fetch_add(&cnt[tid_], (unsigned)hist[tid_], __ATOMIC_RELAXED, __HIP_MEMORY_SCOPE_AGENT);
  __syncthreads();
  for (int i = tid_; i < lg * 64; i += NTHR) {
    const int g2 = i >> 6, w2 = (i >> 2) & 15, k2 = i & 3;
    const int row = (blockIdx.x + g2 * gridDim.x) * 16 + w2;
    const int pk = sel[i]; const int ex = pk & 255; const int pos = hist[32 + ex] + (pk >> 8);
    tke[row * 4 + k2] = ex; tkp[row * 4 + k2] = pos; tkg[row * 4 + k2] = selg[i];
    tlist[(size_t)ex * NTOK + pos] = row;
  }
}

__device__ __forceinline__ void dense_unit(GUnit& u, const bf16_t* A, int lda, int ar0, const bf16_t* Bt, int ldb, int br0, int tz) {
  u.a0 = (const char*)(A + (size_t)ar0 * lda); u.a1 = (const char*)(A + (size_t)(ar0 + 128) * lda);
  u.b0 = (const char*)(Bt + (size_t)br0 * ldb); u.b1 = (const char*)(Bt + (size_t)(br0 + 128) * ldb);
  u.va00 = stage_voff(tz, 0, lda); u.va01 = stage_voff(tz, 1, lda); u.va10 = u.va00; u.va11 = u.va01;
}

__device__ __forceinline__ void phase_inproj(const Params& p, int layer, LAS unsigned char* lds, unsigned long long* tk = nullptr, unsigned long long* te = nullptr) {
  const int G = gridDim.x, bid = blockIdx.x;
  const bf16_t* A = reinterpret_cast<const bf16_t*>(p.ws + WS_H);
  const bf16_t* Bt = reinterpret_cast<const bf16_t*>(p.ws + WS_WIN) + (size_t)layer * INW * 1024;
  bf16_t* P = reinterpret_cast<bf16_t*>(p.ws + WS_P);
  bf16_t* VT = reinterpret_cast<bf16_t*>(p.ws + WS_VT);
  bf16_t* KTw = reinterpret_cast<bf16_t*>(p.ws + WS_KT);
  const int tz = opaque_tid();
  LAS float* tab = (LAS float*)(lds + LDS_TAB);
  __syncthreads();
  { const float* ropec = reinterpret_cast<const float*>(p.ws + WS_ROPE);
    for (int i = tz; i < 2048; i += NTHR) tab[i] = ropec[i];
    if (tz < 256) { const int w = tz >> 6, d = tz & 63; const float* src = (w == 0) ? p.win_qn : (w == 1) ? p.win_kn : (w == 2) ? p.na_qn : p.na_kn; tab[2048 + tz] = src[layer * 64 + d]; } }
  __syncthreads();
  gemm_stream(lds, 16, tz, stage_voff(tz, 0, 1024), stage_voff(tz, 1, 1024),
    [&](int idx, GUnit& u) -> bool {
      int pm, pn;
      if (layer < DEPTH - 1) { if (!unit_next(idx * G + bid, NTOK / 256, INW / 256, pm, pn)) return false; }
      else {
        const int L = idx * G + bid;
        if (L < 64 * 23) { unit_next(L, 64, 23, pm, pn); }
        else { const int j = L - 64 * 23; if (j >= 8 * 7) return false; const int c = j % 7; pm = 64 + j / 7; pn = (c < 2) ? c : (c == 2) ? 4 : (c + 4); }
      }
      dense_unit(u, A, 1024, pm * 256, Bt, 1024, pn * 256, tz); u.i0 = pm; u.i1 = pn; u.i2 = 0; u.i3 = 0; return true;
    },
    [&](const GUnit& u, f32x4 (&acc)[2][2][4][2], int wr, int wc, int fr, int fq) {
      const int pn = u.i1, br0 = pn * 256, row0 = u.i0 * 256 + wr * 64 + fr, cq = wc * 32 + fq * 4;
      const bool is_head = (pn >= 2 && pn < 11);
      if (!is_head) {
        const bool gate = br0 >= C_GATE;
        const int c8 = wc * 32 + fq * 8;
#pragma unroll
        for (int ai = 0; ai < 2; ++ai)
#pragma unroll
          for (int m = 0; m < 4; ++m) {
            const unsigned ro = ((unsigned)(row0 + ai * 128 + m * 16) * INW + br0 + c8) * 2u;
#pragma unroll
            for (int bj = 0; bj < 2; ++bj) {
              f32x4 lo = acc[ai][bj][m][0], hi = acc[ai][bj][m][1];
              if (gate) { lo = f32x4{sigmoidf(lo[0]), sigmoidf(lo[1]), sigmoidf(lo[2]), sigmoidf(lo[3])}; hi = f32x4{sigmoidf(hi[0]), sigmoidf(hi[1]), sigmoidf(hi[2]), sigmoidf(hi[3])}; }
              stg_bf8(P, ro + bj * 256, lo, hi);
            }
          }
        return;
      }
      const int hidx = (pn - 2) * 4 + wc;
      const bool is_v = (hidx >= 10 && hidx < 12) || hidx >= 28;
      const bool lat = row0 < NLAT;
      if (is_v) {
        const int hv = (hidx < 12) ? (hidx - 10) : (2 + hidx - 28);
#pragma unroll
        for (int ai = 0; ai < 2; ++ai)
#pragma unroll
          for (int m = 0; m < 4; ++m) {
            const int grow = row0 + ai * 128 + m * 16;
            const int bb = lat ? (grow >> 11) : ((grow - NLAT) >> 8);
            const int tpos = lat ? (CTXL + (grow & 2047)) : ((grow - NLAT) & 255);
            const int pos = vt_pos(tpos & 31);
            const unsigned vo = ((unsigned)(bb * 10 + hv) * 72 + (unsigned)(tpos >> 5)) * 4096u + (unsigned)(((((pos >> 3) & 1) * 2 + (pos >> 4)) * 32 + fq * 4) * 8 + (pos & 7)) * 2u;
#pragma unroll
            for (int bj = 0; bj < 2; ++bj)
#pragma unroll
              for (int n = 0; n < 2; ++n)
#pragma unroll
                for (int j = 0; j < 4; ++j) stg<bf16_t>(VT, vo + (unsigned)(bj * 2048 + (n * 16 + j) * 16), f2bf(acc[ai][bj][m][n][j]));
          }
        return;
      }
      const int wsel = (hidx < 8) ? 0 : (hidx < 10) ? 1 : (hidx < 20) ? 2 : 3;
      f32x4 wv[2][2];
#pragma unroll
      for (int bj = 0; bj < 2; ++bj)
#pragma unroll
        for (int n = 0; n < 2; ++n) wv[bj][n] = *(const LAS f32x4*)(tab + 2048 + wsel * 64 + bj * 32 + n * 16 + fq * 4);
      const bool rope = (hidx < 10) && lat;
      const bool is_k = (wsel & 1) != 0;
      const int hkt = (hidx < 10) ? (hidx - 8) : (2 + hidx - 20);
      const int lane = fq * 16 + fr;
#pragma unroll
      for (int ai = 0; ai < 2; ++ai)
#pragma unroll
        for (int m = 0; m < 4; ++m) {
          const int grow = row0 + ai * 128 + m * 16;
          float ss = 0.f;
#pragma unroll
          for (int bj = 0; bj < 2; ++bj)
#pragma unroll
            for (int n = 0; n < 2; ++n)
#pragma unroll
              for (int j = 0; j < 4; ++j) ss += acc[ai][bj][m][n][j] * acc[ai][bj][m][n][j];
          ss += shx(ss, 16, lane); ss += shx32(ss, lane);
          const float rinv = rsqrtf(ss * (1.0f / 64.0f) + 1e-6f);
          f32x4 y[2][2];
#pragma unroll
          for (int bj = 0; bj < 2; ++bj)
#pragma unroll
            for (int n = 0; n < 2; ++n) y[bj][n] = acc[ai][bj][m][n] * rinv * wv[bj][n];
          if (rope) {
            const int t = grow & 2047;
#pragma unroll
            for (int bj = 0; bj < 2; ++bj) {
              const int pos = bj ? (t & 63) : (t >> 6);
              const f32x4 cs = *(const LAS f32x4*)(tab + pos * 16 + fq * 4), sn = *(const LAS f32x4*)(tab + 1024 + pos * 16 + fq * 4);
              const f32x4 t1 = y[bj][0], t2 = y[bj][1];
              y[bj][0] = t1 * cs - t2 * sn; y[bj][1] = t1 * sn + t2 * cs;
            }
          }
          if (is_k) {
            const int bb = lat ? (grow >> 11) : ((grow - NLAT) >> 8);
            const int tpos = lat ? (CTXL + (grow & 2047)) : ((grow - NLAT) & 255);
            const unsigned ko = ((unsigned)(bb * 10 + hkt) * 72 + (unsigned)(tpos >> 5)) * 4096u + (unsigned)((((fq >> 1) * 2) * 32 + (tpos & 31)) * 8 + (fq & 1) * 4) * 2u;
#pragma unroll
            for (int bj = 0; bj < 2; ++bj)
#pragma unroll
              for (int n = 0; n < 2; ++n) stg_bf4(KTw, ko + (unsigned)((n * 4 + bj) * 512), y[bj][n][0], y[bj][n][1], y[bj][n][2], y[bj][n][3]);
          } else {
            const unsigned ro = ((unsigned)grow * INW + C_WQ + hidx * 64 + fq * 4) * 2u;
#pragma unroll
            for (int bj = 0; bj < 2; ++bj)
#pragma unroll
              for (int n = 0; n < 2; ++n) stg_bf4(P, ro + (bj * 32 + n * 16) * 2, y[bj][n][0], y[bj][n][1], y[bj][n][2], y[bj][n][3]);
          }
        }
    }, tk, te);
}

__device__ __forceinline__ void glu_item(const Params& p, int layer, int pm, int pn, LAS unsigned char* lds) {
  const bf16_t* A = reinterpret_cast<const bf16_t*>(p.ws + WS_G);
  const bf16_t* Bt = reinterpret_cast<const bf16_t*>(p.ws + WS_WGLU) + (size_t)layer * 512 * 512;
  bf16_t* Y = reinterpret_cast<bf16_t*>(p.ws + WS_Y);
  const int tz = opaque_tid();
  if (tz == 0) {
    const int bb = (pm < 64) ? (pm >> 3) : (pm - 64);
    unsigned* cnt = reinterpret_cast<unsigned*>(p.ws + WS_CTL) + CW_SSMD + (layer * 8 + bb) * 64;
    unsigned spins = 0;
    while (__hip_atomic_load(cnt, __ATOMIC_RELAXED, __HIP_MEMORY_SCOPE_AGENT) < 16u) { __builtin_amdgcn_s_sleep(2); if (++spins > (1u << 22)) break; }
    __builtin_amdgcn_fence(__ATOMIC_ACQUIRE, "agent");
    asm volatile("s_waitcnt vmcnt(0)" ::: "memory");
  }
  __syncthreads();
  gemm_stream(lds, 8, tz, stage_voff(tz, 0, 512), stage_voff(tz, 1, 512),
    [&](int idx, GUnit& u) -> bool {
      if (idx > 0) return false;
      dense_unit(u, A, 512, pm * 256, Bt, 512, pn * 256, tz); u.i0 = pm; u.i1 = pn; u.i2 = 0; u.i3 = 0; return true;
    },
    [&](const GUnit& u, f32x4 (&acc)[2][2][4][2], int wr, int wc, int fr, int fq) {
      const int row0 = u.i0 * 256 + wr * 64 + fr, col = u.i1 * 256 + wc * 32 + fq * 8;
      uint4 gv[2][4][2];
#pragma unroll
      for (int ai = 0; ai < 2; ++ai)
#pragma unroll
        for (int m = 0; m < 4; ++m) {
          const unsigned ro = ((unsigned)(row0 + ai * 128 + m * 16) * 512 + col) * 2u;
#pragma unroll
          for (int bj = 0; bj < 2; ++bj) gv[ai][m][bj] = ldg<uint4>(A, ro + bj * 256);
        }
#pragma unroll
      for (int ai = 0; ai < 2; ++ai)
#pragma unroll
        for (int m = 0; m < 4; ++m) {
          const unsigned ro = ((unsigned)(row0 + ai * 128 + m * 16) * 1536 + col) * 2u;
#pragma unroll
          for (int bj = 0; bj < 2; ++bj) {
            f32x4 g0, g1; unpack8(gv[ai][m][bj], g0, g1);
            const f32x4 c0 = acc[ai][bj][m][0], c1 = acc[ai][bj][m][1];
            stg_bf8(Y, ro + bj * 256, f32x4{g0[0] * sigmoidf(c0[0]), g0[1] * sigmoidf(c0[1]), g0[2] * sigmoidf(c0[2]), g0[3] * sigmoidf(c0[3])},
                                      f32x4{g1[0] * sigmoidf(c1[0]), g1[1] * sigmoidf(c1[1]), g1[2] * sigmoidf(c1[2]), g1[3] * sigmoidf(c1[3])});
          }
        }
    });
}

__device__ __forceinline__ void phase_mixers(const Params& p, int layer, bool need_ctx, int* misc_i, unsigned char* lds_raw, LAS unsigned char* lds, int mrows, int rep) {
  unsigned* head = reinterpret_cast<unsigned*>(p.ws + WS_CTL) + CW_WQ + layer * 64 + rep * 16;
  const int nitems = 704 + 2 * (mrows >> 8);
  unsigned long long tph0 = 0; if (PROBE_PH == 20) tph0 = wall_clock64();
  for (;;) {
    __syncthreads();
    if (threadIdx.x == 0) misc_i[40] = (int)__hip_atomic_fetch_add(head, 1u, __ATOMIC_RELAXED, __HIP_MEMORY_SCOPE_AGENT);
    __syncthreads();
    const int qpos = misc_i[40];
    if (qpos >= nitems) break;
    if (qpos >= 704) { glu_item(p, layer, (qpos - 704) >> 1, (qpos - 704) & 1, lds); continue; }
    const int item = (qpos < 128 || qpos >= 640) ? qpos : (qpos < 384 ? qpos + 256 : qpos - 256);
    mixer_item(p, layer, item, need_ctx, lds_raw);
    if (PROBE_PH == 20 && item >= 128) { __syncthreads(); if (threadIdx.x == 0) atomicMax(reinterpret_cast<unsigned*>(p.ws + WS_CTL) + 12288 + layer, (unsigned)(wall_clock64() - tph0)); }
  }
}

__device__ __forceinline__ void phase_merge1(const Params& p, int layer, int mrows, LAS unsigned char* lds) {
  const int G = gridDim.x, bid = blockIdx.x;
  const bf16_t* Yb = reinterpret_cast<const bf16_t*>(p.ws + WS_Y);
  const bf16_t* P = reinterpret_cast<const bf16_t*>(p.ws + WS_P);
  const bf16_t* WB = reinterpret_cast<const bf16_t*>(p.ws + WS_WBR) + (size_t)(layer * 3) * 1024 * 512;
  bf16_t* SB = reinterpret_cast<bf16_t*>(p.ws + WS_SB);
  const int tz = opaque_tid();
  gemm_stream(lds, 8, tz, stage_voff(tz, 0, 512), stage_voff(tz, 1, 512),
    [&](int idx, GUnit& u) -> bool {
      const int ti = idx / 3, br = idx - ti * 3;
      int pm, pn; if (!unit_next(ti * G + bid, mrows / 256, 4, pm, pn)) return false;
      dense_unit(u, Yb + br * 512, 1536, pm * 256, WB + (size_t)br * 1024 * 512, 512, pn * 256, tz); u.i0 = pm; u.i1 = pn; u.i2 = br; u.i3 = (br > 0) ? GU_KEEP_ACC : 0; return true;
    },
    [&](const GUnit& u, f32x4 (&acc)[2][2][4][2], int wr, int wc, int fr, int fq) {
      const int row0 = u.i0 * 256 + wr * 64 + fr, col = u.i1 * 256 + wc * 32 + fq * 8, br = u.i2;
      if (br < 2) {
#pragma unroll
        for (int ai = 0; ai < 2; ++ai) {
          uint4 ga[4][2], gb[4][2];
#pragma unroll
          for (int m = 0; m < 4; ++m) {
            const unsigned go = ((unsigned)(row0 + ai * 128 + m * 16) * INW + C_GATE + br * 1024 + col) * 2u;
#pragma unroll
            for (int bj = 0; bj < 2; ++bj) { ga[m][bj] = ldg<uint4>(P, go + bj * 256); gb[m][bj] = ldg<uint4>(P, go + 2048 + bj * 256); }
          }
#pragma unroll
          for (int m = 0; m < 4; ++m)
#pragma unroll
            for (int bj = 0; bj < 2; ++bj) {
              f32x4 x0, x1, y0, y1; unpack8(ga[m][bj], x0, x1); unpack8(gb[m][bj], y0, y1);
#pragma unroll
              for (int j = 0; j < 4; ++j) {
                acc[ai][bj][m][0][j] *= x0[j] * __builtin_amdgcn_rcpf(fmaxf(y0[j], 1e-20f));
                acc[ai][bj][m][1][j] *= x1[j] * __builtin_amdgcn_rcpf(fmaxf(y1[j], 1e-20f));
              }
            }
        }
        return;
      }
#pragma unroll
      for (int ai = 0; ai < 2; ++ai) {
        uint4 ga[4][2];
#pragma unroll
        for (int m = 0; m < 4; ++m) {
          const unsigned go = ((unsigned)(row0 + ai * 128 + m * 16) * INW + C_GATE + 2 * 1024 + col) * 2u;
#pragma unroll
          for (int bj = 0; bj < 2; ++bj) ga[m][bj] = ldg<uint4>(P, go + bj * 256);
        }
#pragma unroll
        for (int m = 0; m < 4; ++m) {
          const unsigned so = ((unsigned)(row0 + ai * 128 + m * 16) * D + col) * 2u;
#pragma unroll
          for (int bj = 0; bj < 2; ++bj) {
            f32x4 x0, x1; unpack8(ga[m][bj], x0, x1);
            f32x4 c0 = acc[ai][bj][m][0], c1 = acc[ai][bj][m][1];
#pragma unroll
            for (int j = 0; j < 4; ++j) { c0[j] *= fmaxf(x0[j], 1e-20f); c1[j] *= fmaxf(x1[j], 1e-20f); }
            stg_bf8(SB, so + bj * 256, c0, c1);
          }
        }
      }
    });
}

__device__ __forceinline__ void phase_merge2(const Params& p, int layer, int mrows, LAS unsigned char* lds) {
  const int G = gridDim.x, bid = blockIdx.x;
  const bf16_t* A = reinterpret_cast<const bf16_t*>(p.ws + WS_SB);
  const bf16_t* Bt = reinterpret_cast<const bf16_t*>(p.ws + WS_WOUT) + (size_t)layer * 1024 * 1024;
  bf16_t* MB = reinterpret_cast<bf16_t*>(p.ws + WS_S) + (size_t)NTOK * D;
  const int tz = opaque_tid();
  gemm_stream(lds, 16, tz, stage_voff(tz, 0, 1024), stage_voff(tz, 1, 1024),
    [&](int idx, GUnit& u) -> bool {
      int pm, pn; if (!unit_next(idx * G + bid, mrows / 256, 4, pm, pn)) return false;
      dense_unit(u, A, 1024, pm * 256, Bt, 1024, pn * 256, tz); u.i0 = pm; u.i1 = pn; u.i2 = 0; u.i3 = 0; return true;
    },
    [&](const GUnit& u, f32x4 (&acc)[2][2][4][2], int wr, int wc, int fr, int fq) {
      const int row0 = u.i0 * 256 + wr * 64 + fr, col = u.i1 * 256 + wc * 32 + fq * 8;
#pragma unroll
      for (int ai = 0; ai < 2; ++ai)
#pragma unroll
        for (int m = 0; m < 4; ++m) {
          const unsigned so = ((unsigned)(row0 + ai * 128 + m * 16) * D + col) * 2u;
#pragma unroll
          for (int bj = 0; bj < 2; ++bj) stg_bf8(MB, so + bj * 256, acc[ai][bj][m][0], acc[ai][bj][m][1]);
        }
    });
}

__device__ __forceinline__ int moe_tables(const unsigned* cnt, int* est, int ntn) {
  __syncthreads();
  if (threadIdx.x == 0) { int s = 0, u = 0; for (int e = 0; e < NEXP; ++e) { est[e] = s; est[64 + e] = u; const int c = (int)cnt[e]; s += c; u += ((c + 255) >> 8) * ntn; } est[NEXP] = s; est[64 + NEXP] = u; }
  __syncthreads();
  return est[64 + NEXP];
}
__device__ __forceinline__ void moe_unit(const int* est, int total, int L, int& e, int& cnte, int& pmt, int& pnt) {
  int wgid = L; { const int q = total / 8, r = total % 8, xcd = wgid % 8, off = wgid / 8; wgid = (xcd < r ? xcd * (q + 1) : r * (q + 1) + (xcd - r) * q) + off; }
  e = 0; while (est[64 + e + 1] <= wgid) ++e;
  const int idx = wgid - est[64 + e]; cnte = est[e + 1] - est[e]; const int tm = (cnte + 255) >> 8;
  pmt = idx % tm; pnt = idx / tm;
}

__device__ __forceinline__ void phase_moe1(const Params& p, int layer, LAS unsigned char* lds, int* est) {
  const int G = gridDim.x, bid = blockIdx.x;
  const unsigned* cnt = reinterpret_cast<const unsigned*>(p.ws + WS_CTL) + CW_CNT + layer * 32;
  const int total = moe_tables(cnt, est, 8);
  const bf16_t* F = reinterpret_cast<const bf16_t*>(p.ws + WS_H);
  const int* tlist = reinterpret_cast<const int*>(p.ws + WS_TLIST);
  const bf16_t* WG = reinterpret_cast<const bf16_t*>(p.ws + WS_WGU) + (size_t)(layer * NEXP) * 2048 * 1024;
  bf16_t* ACT = reinterpret_cast<bf16_t*>(p.ws + WS_ACT);
  const int tz = opaque_tid();
  int R0, C0, R1, C1; stage_rc(tz * 16, R0, C0); stage_rc(tz * 16 + 8192, R1, C1);
  gemm_stream(lds, 16, tz, stage_voff(tz, 0, 1024), stage_voff(tz, 1, 1024),
    [&](int idx, GUnit& u) -> bool {
      const int L = bid + idx * G; if (L >= total) return false;
      int e, cnte, pmt, pnt; moe_unit(est, total, L, e, cnte, pmt, pnt);
      const int m0 = pmt * 256;
      const int* tl = tlist + (size_t)e * NTOK;
      const int r00 = m0 + R0, r01 = m0 + R1, r10 = m0 + 128 + R0, r11 = m0 + 128 + R1;
      const int t00 = (r00 < cnte) ? tl[r00] : 0, t01 = (r01 < cnte) ? tl[r01] : 0, t10 = (r10 < cnte) ? tl[r10] : 0, t11 = (r11 < cnte) ? tl[r11] : 0;
      u.a0 = (const char*)F; u.a1 = (const char*)F;
      u.va00 = (unsigned)(t00 * 1024 + C0) * 2u; u.va01 = (unsigned)(t01 * 1024 + C1) * 2u; u.va10 = (unsigned)(t10 * 1024 + C0) * 2u; u.va11 = (unsigned)(t11 * 1024 + C1) * 2u;
      const bf16_t* Bt = WG + (size_t)e * 2048 * 1024 + (size_t)(pnt * 256) * 1024;
      u.b0 = (const char*)Bt; u.b1 = (const char*)(Bt + (size_t)128 * 1024);
      u.i0 = e; u.i1 = cnte - m0; u.i2 = est[e] + m0; u.i3 = pnt; return true;
    },
    [&](const GUnit& u, f32x4 (&acc)[2][2][4][2], int wr, int wc, int fr, int fq) {
      const int cq = wc * 32 + fq * 8, r0 = wr * 64 + fr;
      const float* bg = p.b_gu + (size_t)(layer * NEXP + u.i0) * 2048 + u.i3 * 128 + cq;
      float4 bgv[2], buv[2];
#pragma unroll
      for (int n = 0; n < 2; ++n) { bgv[n] = *reinterpret_cast<const float4*>(bg + n * 4); buv[n] = *reinterpret_cast<const float4*>(bg + 1024 + n * 4); }
#pragma unroll
      for (int ai = 0; ai < 2; ++ai)
#pragma unroll
        for (int m = 0; m < 4; ++m) {
          const int r = r0 + ai * 128 + m * 16;
          if (r < u.i1) {
            const unsigned oo = ((unsigned)(u.i2 + r) * 1024 + u.i3 * 128 + cq) * 2u;
            f32x4 ov[2];
#pragma unroll
            for (int n = 0; n < 2; ++n) {
              const f32x4 gc = acc[ai][0][m][n], uc4 = acc[ai][1][m][n];
              const float gg[4] = {gc[0] + bgv[n].x, gc[1] + bgv[n].y, gc[2] + bgv[n].z, gc[3] + bgv[n].w};
              const float uu[4] = {uc4[0] + buv[n].x, uc4[1] + buv[n].y, uc4[2] + buv[n].z, uc4[3] + buv[n].w};
#pragma unroll
              for (int j = 0; j < 4; ++j) { const float g = fminf(gg[j], 7.0f); const float uc = fminf(fmaxf(uu[j], -7.0f), 7.0f); ov[n][j] = (uc + 1.0f) * (g * sigmoidf(1.702f * g)); }
            }
            stg_bf8(ACT, oo, ov[0], ov[1]);
          }
        }
    });
  if (G == 256) { const int rem = total & 255; if (rem && bid >= rem) conv_moe_tiles(p, layer + 1, CB_REST + (bid - rem) * CQ_H, CQ_H, reinterpret_cast<float*>((unsigned char*)lds)); }
}

__device__ __forceinline__ void phase_moe2(const Params& p, int layer, LAS unsigned char* lds, int* est) {
  const int G = gridDim.x, bid = blockIdx.x;
  const unsigned* cnt = reinterpret_cast<const unsigned*>(p.ws + WS_CTL) + CW_CNT + layer * 32;
  const int total = moe_tables(cnt, est, 4);
  const bf16_t* ACT = reinterpret_cast<const bf16_t*>(p.ws + WS_ACT);
  const bf16_t* WD = reinterpret_cast<const bf16_t*>(p.ws + WS_WDN) + (size_t)(layer * NEXP) * 1024 * 1024;
  bf16_t* YB = reinterpret_cast<bf16_t*>(p.ws + WS_YB);
  const int tz = opaque_tid();
  gemm_stream(lds, 16, tz, stage_voff(tz, 0, 1024), stage_voff(tz, 1, 1024),
    [&](int idx, GUnit& u) -> bool {
      const int L = bid + idx * G; if (L >= total) return false;
      int e, cnte, pmt, pnt; moe_unit(est, total, L, e, cnte, pmt, pnt);
      const int m0 = pmt * 256, arow0 = est[e] + m0;
      dense_unit(u, ACT, 1024, arow0, WD + (size_t)e * 1024 * 1024, 1024, pnt * 256, tz);
      u.i0 = e; u.i1 = cnte - m0; u.i2 = arow0; u.i3 = pnt; return true;
    },
    [&](const GUnit& u, f32x4 (&acc)[2][2][4][2], int wr, int wc, int fr, int fq) {
      const int cq = wc * 32 + fq * 8, r0 = wr * 64 + fr;
      const float* bd = p.b_dn + (size_t)(layer * NEXP + u.i0) * 1024 + u.i3 * 256 + cq;
      f32x4 bv[2][2];
#pragma unroll
      for (int bj = 0; bj < 2; ++bj)
#pragma unroll
        for (int n = 0; n < 2; ++n) { const float4 t4 = *reinterpret_cast<const float4*>(bd + bj * 128 + n * 4); bv[bj][n] = f32x4{t4.x, t4.y, t4.z, t4.w}; }
#pragma unroll
      for (int ai = 0; ai < 2; ++ai)
#pragma unroll
        for (int m = 0; m < 4; ++m) {
          const int r = r0 + ai * 128 + m * 16;
          if (r < u.i1) {
            const unsigned oo = ((unsigned)(u.i2 + r) * 1024 + u.i3 * 256 + cq) * 2u;
#pragma unroll
            for (int bj = 0; bj < 2; ++bj) stg_bf8(YB, oo + bj * 256, acc[ai][bj][m][0] + bv[bj][0], acc[ai][bj][m][1] + bv[bj][1]);
          }
        }
    });
  if (G == 256) { const int rem1 = (2 * total) & 255, nid1 = rem1 ? 256 - rem1 : 0, rem = total & 255;
    if (rem && bid >= rem) conv_moe_tiles(p, layer + 1, CB_REST + nid1 * CQ_H + (bid - rem) * CQ_I, CQ_I, reinterpret_cast<float*>((unsigned char*)lds)); }
}

__device__ __forceinline__ void phase_prologue(const Params& p, float* ldsf) {
  const int tid_ = opaque_tid();
  const int G = gridDim.x, bid = blockIdx.x;
  conv_mats<2>(p.w_in, reinterpret_cast<bf16_t*>(p.ws + WS_WIN), DEPTH, 1024, INW, ldsf, tid_);
  conv_mats<0>(p.w_glu, reinterpret_cast<bf16_t*>(p.ws + WS_WGLU), DEPTH, 512, 512, ldsf, tid_);
  conv_mats<0>(p.w_branch, reinterpret_cast<bf16_t*>(p.ws + WS_WBR), DEPTH * 3, 512, 1024, ldsf, tid_);
  conv_mats<0>(p.w_out, reinterpret_cast<bf16_t*>(p.ws + WS_WOUT), DEPTH, 1024, 1024, ldsf, tid_);
  conv_mats<1>(p.w_gu, reinterpret_cast<bf16_t*>(p.ws + WS_WGU), NEXP, 1024, 2048, ldsf, tid_);
  conv_mats<0>(p.w_dn, reinterpret_cast<bf16_t*>(p.ws + WS_WDN), NEXP, 1024, 1024, ldsf, tid_);
  mod_phase(p, ldsf);
  if (bid == 0) {
    float* rt = reinterpret_cast<float*>(p.ws + WS_ROPE);
    for (int i = tid_; i < 1024; i += NTHR) { const float ang = (float)(i >> 4) * powf(10000.0f, -(float)(i & 15) / 16.0f); rt[i] = cosf(ang); rt[1024 + i] = sinf(ang); }
  }
}

#ifndef ONLY
#define ONLY -1
#endif
#ifndef REP_PRO
#define REP_PRO 1
#endif
#ifndef REP_GEMM
#define REP_GEMM 1
#endif
#ifndef REP_PC
#define REP_PC 1
#endif
#ifndef REP_MOE
#define REP_MOE 1
#endif
#define PROBE_K 8
#define PROBE_T0(k) do { if (PROBE_PH == (k)) probe_t0 = wall_clock64(); } while (0)
#define PROBE_T1(k) do { if (PROBE_PH == (k)) probe_acc += wall_clock64() - probe_t0; } while (0)
#define PH_ON(idx, k) ((ONLY < 0 || ONLY == (k)) && p.ph_lo <= (idx) && (idx) < p.ph_hi)
#ifndef REP_BAR
#define REP_BAR 1
#endif
#ifndef REP_NORM
#define REP_NORM 1
#endif
#define PH_END(idx) do { if ((idx) + 1 < p.ph_hi) { for (int rb_ = 0; rb_ < REP_BAR; ++rb_) xcd_barrier(bar); } } while (0)

__global__ void __launch_bounds__(512, 2) fwd(Params p) {
  extern __shared__ __attribute__((aligned(16))) unsigned char lds_raw[];
  LAS unsigned char* shm = (LAS unsigned char*)lds_raw;
  unsigned* misc_u = reinterpret_cast<unsigned*>(lds_raw + LDS_MISC);
  int* misc_i = reinterpret_cast<int*>(lds_raw + LDS_MISC + 64);
  unsigned* ctl = reinterpret_cast<unsigned*>(p.ws + WS_CTL);
  if (threadIdx.x < 4) misc_u[threadIdx.x] = 0u;
  __syncthreads();
  XcdBarrier bar = xcd_barrier_post(ctl + CW_BAR, (volatile LAS unsigned*)misc_u);
  unsigned long long probe_t0 = 0, probe_acc = 0;

  if (PH_ON(0, 10)) { PROBE_T0(10); for (int rep = 0; rep < REP_PRO; ++rep) phase_prologue(p, reinterpret_cast<float*>(lds_raw)); PH_END(0); PROBE_T1(10); }

  for (int layer = 0; layer < DEPTH; ++layer) {
    const int pb = 1 + layer * 10;
    const bool need_ctx = layer < DEPTH - 1;
    const int mrows = need_ctx ? NTOK : NLAT;
    if (PH_ON(pb + 0, 0)) { PROBE_T0(0); if (layer > 0) { const unsigned* pc = ctl + CW_CNT + (layer - 1) * 32; int t2 = 0; for (int e = 0; e < NEXP; ++e) t2 += (((int)pc[e] + 255) >> 8) * 4; const int rem1 = (2 * t2) & 255, rem2 = t2 & 255; const int base = (gridDim.x == 256) ? (CB_REST + (rem1 ? 256 - rem1 : 0) * CQ_H + (rem2 ? 256 - rem2 : 0) * CQ_I) : 0; const int left = MOE_CT - base; if (left > 0) { const int per = (left + (int)gridDim.x - 1) / (int)gridDim.x; conv_moe_tiles(p, layer, base + (int)blockIdx.x * per, per, reinterpret_cast<float*>(lds_raw)); } } norm_phase(p, layer, layer > 0, misc_i); for (int rep = 1; rep < REP_NORM; ++rep) norm_phase(p, layer, false, misc_i); PH_END(pb + 0); PROBE_T1(0); }
    if (PH_ON(pb + 1, 1)) { PROBE_T0(1); for (int rep = 0; rep < REP_GEMM; ++rep) phase_inproj(p, layer, shm, (PROBE_PH == 16 || PROBE_PH == 18) ? &probe_acc : nullptr, (PROBE_PH == 17) ? &probe_acc : nullptr); if (gridDim.x == 256 && (int)blockIdx.x >= 120) conv_moe_tiles(p, layer + 1, ((int)blockIdx.x - 120) * CQ_B, CQ_B, reinterpret_cast<float*>(lds_raw)); PH_END(pb + 1); PROBE_T1(1); }
    if (PH_ON(pb + 3, 3)) { PROBE_T0(3); for (int rep = 0; rep < REP_PC; ++rep) phase_mixers(p, layer, need_ctx, misc_i, lds_raw, shm, mrows, rep); PH_END(pb + 3); PROBE_T1(3); }
    if (PH_ON(pb + 5, 5)) { PROBE_T0(5); for (int rep = 0; rep < REP_GEMM; ++rep) phase_merge1(p, layer, mrows, shm); if (gridDim.x == 256 && (int)blockIdx.x >= 32) conv_moe_tiles(p, layer + 1, CB_E + ((int)blockIdx.x - 32) * CQ_E, CQ_E, reinterpret_cast<float*>(lds_raw)); PH_END(pb + 5); PROBE_T1(5); }
    if (PH_ON(pb + 6, 6)) { PROBE_T0(6); phase_merge2(p, layer, mrows, shm); if (gridDim.x == 256 && (int)blockIdx.x >= 32) conv_moe_tiles(p, layer + 1, CB_F + ((int)blockIdx.x - 32) * CQ_F, CQ_F, reinterpret_cast<float*>(lds_raw)); PH_END(pb + 6); PROBE_T1(6); }
    if (PH_ON(pb + 7, 7)) { PROBE_T0(7); route_phase(p, layer, mrows, reinterpret_cast<float*>(lds_raw)); PH_END(pb + 7); PROBE_T1(7); }
    if (PH_ON(pb + 8, 8)) { PROBE_T0(8); for (int rep = 0; rep < REP_MOE; ++rep) phase_moe1(p, layer, shm, misc_i); PH_END(pb + 8); PROBE_T1(8); }
    if (PH_ON(pb + 9, 9)) { PROBE_T0(9); for (int rep = 0; rep < REP_MOE; ++rep) phase_moe2(p, layer, shm, misc_i); PH_END(pb + 9); PROBE_T1(9); }
  }
  if (PH_ON(41, 11)) { final_combine(p, misc_i); }
  if (PROBE_PH == 13 || PROBE_PH == 20) { const unsigned* w = reinterpret_cast<const unsigned*>(p.ws + WS_CTL) + 12288; probe_acc = (unsigned long long)__hip_atomic_load(w, __ATOMIC_RELAXED, __HIP_MEMORY_SCOPE_AGENT) + __hip_atomic_load(w + 1, __ATOMIC_RELAXED, __HIP_MEMORY_SCOPE_AGENT) + __hip_atomic_load(w + 2, __ATOMIC_RELAXED, __HIP_MEMORY_SCOPE_AGENT) + __hip_atomic_load(w + 3, __ATOMIC_RELAXED, __HIP_MEMORY_SCOPE_AGENT); }
  if (PROBE_PH == 19) probe_acc = (unsigned long long)__hip_atomic_load(reinterpret_cast<const unsigned*>(p.ws + WS_CTL) + 12288 + 8, __ATOMIC_RELAXED, __HIP_MEMORY_SCOPE_AGENT) / 256;
  if (PROBE_PH >= 0 && blockIdx.x == 0) { const unsigned long long te = wall_clock64(); while (wall_clock64() - te < PROBE_K * probe_acc) __builtin_amdgcn_s_sleep(8); }
}

extern "C" void kernel_launch(void* const* d_in, const int* in_sizes, int n_in, void* d_out, int out_size, void* d_ws, size_t ws_size, hipStream_t stream) {
  static int grid = 0;
  if (grid == 0) {
    if (n_in != 32 || out_size != NLAT * D || ws_size < WS_END) { fprintf(stderr, "kernel_launch: unexpected shapes (n_in %d out %d ws %zu need %zu)\n", n_in, out_size, ws_size, (size_t)WS_END); grid = -1; return; }
    int dev = 0, cus = 0, per_cu = 0;
    if (hipGetDevice(&dev) != hipSuccess || hipDeviceGetAttribute(&cus, hipDeviceAttributeMultiprocessorCount, dev) != hipSuccess) { grid = -1; return; }
    if (hipFuncSetAttribute((const void*)fwd, hipFuncAttributeMaxDynamicSharedMemorySize, LDS_BYTES) != hipSuccess) { fprintf(stderr, "kernel_launch: hipFuncSetAttribute failed\n"); grid = -1; return; }
    if (hipOccupancyMaxActiveBlocksPerMultiprocessor(&per_cu, (const void*)fwd, NTHR, LDS_BYTES) != hipSuccess || per_cu < 1) fprintf(stderr, "kernel_launch: occupancy query reports %d\n", per_cu);
    (void)hipGetLastError();
    grid = cus;
  }
  if (grid < 0) return;
  (void)hipMemsetAsync((char*)d_ws + WS_CTL, 0, CTL_BYTES, stream);
  Params p{};
  const float** f = reinterpret_cast<const float**>(&p);
  for (int i = 0; i < 32; ++i) f[i] = (const float*)d_in[i];
  p.out = (float*)d_out; p.ws = (unsigned char*)d_ws; p.ph_lo = 0; p.ph_hi = 42;
  hipLaunchKernelGGL(fwd, dim3(grid), dim3(NTHR), LDS_BYTES, stream, p);
}
```

```cpp
#include <hip/hip_runtime.h>
#include <stdint.h>
#include <stdio.h>

#ifndef PROBE_PH
#define PROBE_PH -1
#endif

typedef unsigned short bf16_t;
typedef short bf16x8 __attribute__((ext_vector_type(8)));
typedef float f32x4 __attribute__((ext_vector_type(4)));
#define LAS __attribute__((address_space(3)))

constexpr int D = 1024, NB = 8, SEQ = 2048, DEPTH = 4, CTXL = 256;
constexpr int NLAT = NB * SEQ, NCTX = NB * CTXL, NTOK = NLAT + NCTX;
constexpr int INW = 5888;
constexpr int C_U = 0, C_WQ = 512, C_WK = 1024, C_WV = 1152, C_NQ = 1280, C_NK = 1792, C_NV = 2304, C_GATE = 2816;
constexpr int NEXP = 32, TOPK = 4, DFF = 1024;
constexpr int NTHR = 512;

constexpr size_t al256(size_t x) { return (x + 255) & ~(size_t)255; }
constexpr size_t WS_CTL   = 0;
constexpr size_t CTL_BYTES = 65536;
constexpr size_t WS_MOD   = WS_CTL + CTL_BYTES;
constexpr size_t WS_WIN   = al256(WS_MOD + (size_t)DEPTH * 9 * 6144 * 4);
constexpr size_t WS_WGLU  = al256(WS_WIN + (size_t)DEPTH * INW * 1024 * 2);
constexpr size_t WS_WBR   = al256(WS_WGLU + (size_t)DEPTH * 512 * 512 * 2);
constexpr size_t WS_WOUT  = al256(WS_WBR + (size_t)DEPTH * 3 * 1024 * 512 * 2);
constexpr size_t WS_WGU   = al256(WS_WOUT + (size_t)DEPTH * 1024 * 1024 * 2);
constexpr size_t WS_WDN   = al256(WS_WGU + (size_t)DEPTH * NEXP * 2048 * 1024 * 2);
constexpr size_t WS_CX    = al256(WS_WDN + (size_t)DEPTH * NEXP * 1024 * 1024 * 2);
constexpr size_t WS_H     = al256(WS_CX + (size_t)NCTX * D * 4);
constexpr size_t WS_P     = al256(WS_H + (size_t)NTOK * D * 2);
constexpr size_t WS_YD    = al256(WS_P + (size_t)NTOK * INW * 2);
constexpr size_t WS_G     = al256(WS_YD + (size_t)4 * NTOK * 512 * 4);
constexpr size_t WS_Y     = al256(WS_G + (size_t)NTOK * 512 * 2);
constexpr size_t WS_S     = al256(WS_Y + (size_t)NTOK * 1536 * 2);
constexpr size_t WS_KT    = WS_S;
constexpr size_t WS_SB    = al256(WS_S + (size_t)NTOK * D * 4);
constexpr size_t WS_TKE   = al256(WS_SB + (size_t)NTOK * D * 2);
constexpr size_t WS_TKP   = al256(WS_TKE + (size_t)NTOK * 4 * 4);
constexpr size_t WS_TKG   = al256(WS_TKP + (size_t)NTOK * 4 * 4);
constexpr size_t WS_TLIST = al256(WS_TKG + (size_t)NTOK * 4 * 4);
constexpr size_t WS_ACT   = al256(WS_TLIST + (size_t)NEXP * NTOK * 4);
constexpr size_t WS_YB    = al256(WS_ACT + (size_t)(NTOK * 4 + 256) * 1024 * 2);
constexpr size_t WS_VT    = al256(WS_YB + (size_t)(NTOK * 4 + 256) * 1024 * 2);
constexpr size_t WS_ROPE  = al256(WS_VT + (size_t)NB * 10 * 64 * (CTXL + SEQ) * 2);
constexpr size_t WS_END   = al256(WS_ROPE + 2 * 64 * 16 * 4);

constexpr int CW_BAR = 0;
constexpr int CW_WQ = 4096;
constexpr int CW_CNT = 8192;
constexpr int CW_SSMD = 8448;

__device__ __forceinline__ bf16_t f2bf(float f) { unsigned u = __float_as_uint(f); u += 0x7fffu + ((u >> 16) & 1u); return (bf16_t)(u >> 16); }
__device__ __forceinline__ float bf2f(bf16_t h) { return __uint_as_float(((unsigned)h) << 16); }
__device__ __forceinline__ unsigned pack2(float a, float b) { unsigned r; asm("v_cvt_pk_bf16_f32 %0, %1, %2" : "=v"(r) : "v"(a), "v"(b)); return r; }
__device__ __forceinline__ float sigmoidf(float x) { return __builtin_amdgcn_rcpf(1.0f + __expf(-x)); }
__device__ __forceinline__ int opaque_tid() { int tz = threadIdx.x; asm volatile("" : "+v"(tz)); return tz; }
__device__ __forceinline__ float shx(float v, int o, int lane) { return __int_as_float(__builtin_amdgcn_ds_bpermute((lane ^ o) << 2, __float_as_int(v))); }
__device__ __forceinline__ int shx(int v, int o, int lane) { return __builtin_amdgcn_ds_bpermute((lane ^ o) << 2, v); }
__device__ __forceinline__ float shx32(float v, int lane) {
  const auto r = __builtin_amdgcn_permlane32_swap(__float_as_uint(v), __float_as_uint(v), false, false);
  return __uint_as_float(lane < 32 ? r[1] : r[0]);
}
__device__ __forceinline__ float wave_sum(float v, int lane) {
#pragma unroll
  for (int o = 32; o >= 1; o >>= 1) v += shx(v, o, lane);
  return v;
}
__device__ __forceinline__ float wave_max(float v, int lane) {
#pragma unroll
  for (int o = 32; o >= 1; o >>= 1) v = fmaxf(v, shx(v, o, lane));
  return v;
}

#define XB_TMO      128
#define XB_XCNT(j)  (256  + 64 * (j))
#define XB_XSUB(j)  (1280 + 64 * (j))
#define XB_XGEN(j)  (2304 + 64 * (j))
#define XB_TOP      3328
#define XB_TOPGEN   3392
#define XCD_BAR_WORDS 3456
#define XB_SPIN_CAP (1u << 20)

__device__ __forceinline__ unsigned xb_ld(unsigned* p)              { return __hip_atomic_load(p, __ATOMIC_RELAXED, __HIP_MEMORY_SCOPE_AGENT); }
__device__ __forceinline__ unsigned xb_add(unsigned* p, unsigned v) { return __hip_atomic_fetch_add(p, v, __ATOMIC_RELAXED, __HIP_MEMORY_SCOPE_AGENT); }
__device__ __forceinline__ unsigned xb_xcc_id() { return (unsigned)__builtin_amdgcn_s_getreg((3 << 11) | 20) & 0xFu; }
#define XB_SPIN(cond, bar) do { unsigned _sp = 0; while (cond) { __builtin_amdgcn_s_sleep(1); \
    if ((++_sp & 255u) == 0u) { if (xb_ld(&(bar)[XB_TMO])) break; if (_sp > XB_SPIN_CAP) { atomicAdd(&(bar)[XB_TMO], 1u); break; } } } } while (0)

struct XcdBarrier { unsigned* bar; unsigned x; volatile LAS unsigned* st; };

__device__ __forceinline__ XcdBarrier xcd_barrier_post(unsigned* bar, volatile LAS unsigned* st) {
    XcdBarrier b; b.bar = bar; b.x = xb_xcc_id(); b.st = st;
    if (threadIdx.x == 0) (void)xb_add(&bar[XB_XCNT(b.x)], 1u);
    return b;
}
__device__ __forceinline__ void xcd_barrier_complete(unsigned* bar, unsigned x, unsigned& nloc, unsigned& nx) {
    const unsigned G = gridDim.x * gridDim.y * gridDim.z;
    unsigned sum, cnt, mine, sp = 0u;
    for (;;) {
        sum = 0u; cnt = 0u; mine = 0u;
#pragma unroll
        for (unsigned j = 0; j < 16; ++j) { const unsigned c = xb_ld(&bar[XB_XCNT(j)]); sum += c; cnt += (c > 0u) ? 1u : 0u; mine = (j == x) ? c : mine; }
        if (sum == G) break;
        __builtin_amdgcn_s_sleep(1);
        if ((++sp & 255u) == 0u) { if (xb_ld(&bar[XB_TMO])) break; if (sp > XB_SPIN_CAP) { atomicAdd(&bar[XB_TMO], 1u); break; } }
    }
    nloc = mine > 0u ? mine : 1u; nx = cnt > 0u ? cnt : 1u;
}
__device__ __forceinline__ void xcd_barrier(const XcdBarrier& b) {
    asm volatile("s_waitcnt vmcnt(0)" ::: "memory");
    __syncthreads();
    if (threadIdx.x == 0) {
        unsigned* bar = b.bar;
        __builtin_amdgcn_s_waitcnt(0);
        unsigned nloc = b.st[0], nx = b.st[1];
        if (nloc == 0u) { xcd_barrier_complete(bar, b.x, nloc, nx); b.st[0] = nloc; b.st[1] = nx; }
        const unsigned old = xb_add(&bar[XB_XSUB(b.x)], 1u);
        const unsigned gen = old / nloc;
        if (old + 1u == (gen + 1u) * nloc) {
            __builtin_amdgcn_fence(__ATOMIC_RELEASE, "agent");
            asm volatile("s_waitcnt vmcnt(0)" ::: "memory");
            const unsigned og = xb_add(&bar[XB_TOP], 1u);
            const unsigned tg = og / nx;
            if (og + 1u == (tg + 1u) * nx) xb_add(&bar[XB_TOPGEN], 1u);
            else XB_SPIN(xb_ld(&bar[XB_TOPGEN]) == tg, bar);
            __builtin_amdgcn_fence(__ATOMIC_ACQUIRE, "agent");
            xb_add(&bar[XB_XGEN(b.x)], 1u);
            asm volatile("s_waitcnt vmcnt(0)" ::: "memory");
        } else {
            XB_SPIN(xb_ld(&bar[XB_XGEN(b.x)]) == gen, bar);
            __builtin_amdgcn_fence(__ATOMIC_ACQUIRE, "agent");
            asm volatile("s_waitcnt vmcnt(0)" ::: "memory");
        }
    }
    __syncthreads();
}

struct Params {
  const float *x, *c, *ctx, *c_ctx, *w_mod, *b_mod, *norm_mix, *norm_ffn, *w_in, *lam_re, *lam_im, *log_dt,
              *b_re, *b_im, *c_re, *c_im, *ssm_d, *w_glu, *win_qn, *win_kn, *win_sink, *na_qn, *na_kn, *na_rpb,
              *w_branch, *w_out, *router_w, *router_b, *w_gu, *b_gu, *w_dn, *b_dn;
  float* out;
  unsigned char* ws;
  int ph_lo, ph_hi;
};

constexpr int LDS_MISC = 131072;
constexpr int LDS_TAB = 131072 + 4096;
constexpr int LDS_BYTES = 131072 + 16384;

constexpr int HT = 128 * 64;
__device__ __forceinline__ int lds_byte(int r, int c) {
  int st = (r >> 4) * 2 + (c >> 5), rr = r & 15, cc = c & 31, ob = rr * 64 + cc * 2;
  return st * 1024 + (ob ^ (((ob >> 9) & 1) << 5));
}
__device__ __forceinline__ void stage_rc(int b, int& R, int& C) {
  int st = b / 1024, sb = b % 1024, swz = sb ^ (((sb >> 9) & 1) << 5);
  R = (st >> 1) * 16 + swz / 64; C = (st & 1) * 32 + (swz % 64) / 2;
}

#define G_SA(b, h) (((b) * 2 + (h)) * 16384)
#define G_SB(b, h) ((4 + (b) * 2 + (h)) * 16384)
#define G_STAGE(bufoff, gbase, v0, v1) do { \
    __builtin_amdgcn_global_load_lds((const unsigned*)((gbase) + (v0)), (LAS unsigned*)(lds + (bufoff) + ldsw), 16, 0, 0); \
    __builtin_amdgcn_global_load_lds((const unsigned*)((gbase) + (v1)), (LAS unsigned*)(lds + (bufoff) + ldsw + 8192), 16, 0, 0); } while (0)
#define G_LDA(dst, b, h) do { _Pragma("unroll") for (int m = 0; m < 4; ++m) _Pragma("unroll") for (int k = 0; k < 2; ++k) dst[m][k] = *(const LAS bf16x8*)(lds + G_SA(b, h) + aoff + m * 2048 + k * 1024); } while (0)
#define G_LDB(dst, b, h) do { _Pragma("unroll") for (int n = 0; n < 2; ++n) _Pragma("unroll") for (int k = 0; k < 2; ++k) dst[n][k] = *(const LAS bf16x8*)(lds + G_SB(b, h) + boff + n * 2048 + k * 1024); } while (0)
#define G_MMA(ai, bj, At, Bx) do { __builtin_amdgcn_s_setprio(1); \
    _Pragma("unroll") for (int m = 0; m < 4; ++m) _Pragma("unroll") for (int n = 0; n < 2; ++n) _Pragma("unroll") for (int k = 0; k < 2; ++k) \
      acc[ai][bj][m][n] = __builtin_amdgcn_mfma_f32_16x16x32_bf16(Bx[n][k], At[m][k], acc[ai][bj][m][n], 0, 0, 0); \
    __builtin_amdgcn_s_setprio(0); } while (0)
#define WAIT_V(n) asm volatile("s_waitcnt vmcnt(" #n ")" ::: "memory")
#define WAIT_L(n) asm volatile("s_waitcnt lgkmcnt(" #n ")" ::: "memory")
#define BAR __builtin_amdgcn_s_barrier()
#define SCHED __builtin_amdgcn_sched_barrier(0)

template <class Epi>
__device__ __forceinline__ void gemm_tile(LAS unsigned char* lds, const char* a0, const char* a1, unsigned va00, unsigned va01, unsigned va10, unsigned va11,
                                          const char* b0, const char* b1, unsigned vb0, unsigned vb1, int nt, int tid, Epi epi)
{
  asm volatile("s_waitcnt vmcnt(0)" ::: "memory");
  __syncthreads();
  const int wid = __builtin_amdgcn_readfirstlane(tid >> 6), lane = tid & 63, wr = wid >> 2, wc = wid & 3, fr = lane & 15, fq = lane >> 4;
  const unsigned ldsw = (unsigned)wid * 1024u;
  const int aoff = lds_byte(wr * 64 + fr, fq * 8), boff = lds_byte(wc * 32 + fr, fq * 8);
  f32x4 acc[2][2][4][2];
#pragma unroll
  for (int a = 0; a < 2; ++a)
#pragma unroll
    for (int b = 0; b < 2; ++b)
#pragma unroll
      for (int m = 0; m < 4; ++m)
#pragma unroll
        for (int n = 0; n < 2; ++n) acc[a][b][m][n] = f32x4{0.f, 0.f, 0.f, 0.f};
  bf16x8 At[4][2], B0[2][2], B1[2][2];
  G_STAGE(G_SB(0, 0), b0, vb0, vb1); G_STAGE(G_SA(0, 0), a0, va00, va01);
  G_STAGE(G_SB(0, 1), b1, vb0, vb1); G_STAGE(G_SA(0, 1), a1, va10, va11);
  if (wr == 1) BAR;
  WAIT_V(4); BAR;
  G_STAGE(G_SB(1, 0), b0 + 128, vb0, vb1); G_STAGE(G_SA(1, 0), a0 + 128, va00, va01); G_STAGE(G_SB(1, 1), b1 + 128, vb0, vb1);
  WAIT_V(6); BAR;
  for (int t = 0; t < nt - 2; t += 2) {
    const char* a0t = a0 + (size_t)t * 128; const char* a1t = a1 + (size_t)t * 128; const char* b0t = b0 + (size_t)t * 128; const char* b1t = b1 + (size_t)t * 128;
    G_LDB(B0, 0, 0); SCHED; G_LDA(At, 0, 0); G_STAGE(G_SA(1, 1), a1t + 128, va10, va11);
    WAIT_L(8); BAR; WAIT_L(0); G_MMA(0, 0, At, B0); BAR; SCHED;
    G_LDB(B1, 0, 1); G_STAGE(G_SB(0, 0), b0t + 256, vb0, vb1);
    BAR; WAIT_L(0); G_MMA(0, 1, At, B1); BAR;
    G_LDA(At, 0, 1); G_STAGE(G_SA(0, 0), a0t + 256, va00, va01);
    BAR; WAIT_L(0); G_MMA(1, 0, At, B0); BAR; SCHED;
    G_STAGE(G_SB(0, 1), b1t + 256, vb0, vb1);
    WAIT_V(6); BAR; G_MMA(1, 1, At, B1); BAR;
    G_LDB(B0, 1, 0); SCHED; G_LDA(At, 1, 0); G_STAGE(G_SA(0, 1), a1t + 256, va10, va11);
    WAIT_L(8); BAR; WAIT_L(0); G_MMA(0, 0, At, B0); BAR; SCHED;
    G_LDB(B1, 1, 1); G_STAGE(G_SB(1, 0), b0t + 384, vb0, vb1);
    BAR; WAIT_L(0); G_MMA(0, 1, At, B1); BAR;
    G_LDA(At, 1, 1); G_STAGE(G_SA(1, 0), a0t + 384, va00, va01);
    BAR; WAIT_L(0); G_MMA(1, 0, At, B0); BAR; SCHED;
    G_STAGE(G_SB(1, 1), b1t + 384, vb0, vb1);
    WAIT_V(6); BAR; G_MMA(1, 1, At, B1); BAR;
  }
  { G_LDB(B0, 0, 0); WAIT_V(0); G_LDA(At, 0, 0); G_STAGE(G_SA(1, 1), a1 + (size_t)(nt - 1) * 128, va10, va11);
    BAR; WAIT_L(0); G_MMA(0, 0, At, B0); BAR;
    G_LDB(B1, 0, 1); BAR; WAIT_L(0); G_MMA(0, 1, At, B1); BAR;
    G_LDA(At, 0, 1); WAIT_V(4); BAR; WAIT_L(0); G_MMA(1, 0, At, B0); G_MMA(1, 1, At, B1); BAR; }
  { G_LDB(B0, 1, 0); G_LDA(At, 1, 0); WAIT_V(2); BAR; WAIT_L(0); G_MMA(0, 0, At, B0); BAR;
    G_LDB(B1, 1, 1); WAIT_V(0); BAR; WAIT_L(0); G_MMA(0, 1, At, B1); BAR;
    G_LDA(At, 1, 1); BAR; WAIT_L(0); G_MMA(1, 0, At, B0); G_MMA(1, 1, At, B1); BAR; }
  if (wr == 0) BAR;
#pragma unroll
  for (int ai = 0; ai < 2; ++ai)
#pragma unroll
    for (int m = 0; m < 4; ++m)
      epi(ai * 128 + wr * 64 + m * 16 + fr, wc * 32 + fq * 4, acc[ai][0][m][0], acc[ai][0][m][1], acc[ai][1][m][0], acc[ai][1][m][1]);
}
constexpr int GU_KEEP_ACC = 1 << 30;
struct GUnit {
  const char* a0; const char* a1; const char* b0; const char* b1;
  unsigned va00, va01, va10, va11;
  int i0, i1, i2, i3;
};
template <class NextFn, class EpiFn>
__device__ __forceinline__ void gemm_stream(LAS unsigned char* lds, int nt, int tid, unsigned vb0, unsigned vb1, NextFn next, EpiFn epi, unsigned long long* tk = nullptr, unsigned long long* te = nullptr)
{
  GUnit cur, nxt;
  if (!next(0, cur)) return;
  asm volatile("s_waitcnt vmcnt(0)" ::: "memory");
  __syncthreads();
  const int wid = __builtin_amdgcn_readfirstlane(tid >> 6), lane = tid & 63, wr = wid >> 2, wc = wid & 3, fr = lane & 15, fq = lane >> 4;
  const unsigned ldsw = (unsigned)wid * 1024u;
  const int aoff = lds_byte(wr * 64 + fr, fq * 8), boff = lds_byte(wc * 32 + fr, fq * 8);
  f32x4 acc[2][2][4][2];
#pragma unroll
  for (int a = 0; a < 2; ++a)
#pragma unroll
    for (int b = 0; b < 2; ++b)
#pragma unroll
      for (int m = 0; m < 4; ++m)
#pragma unroll
        for (int n = 0; n < 2; ++n) acc[a][b][m][n] = f32x4{0.f, 0.f, 0.f, 0.f};
  bf16x8 At[4][2], B0[2][2], B1[2][2];
  G_STAGE(G_SB(0, 0), cur.b0, vb0, vb1); G_STAGE(G_SA(0, 0), cur.a0, cur.va00, cur.va01);
  G_STAGE(G_SB(0, 1), cur.b1, vb0, vb1); G_STAGE(G_SA(0, 1), cur.a1, cur.va10, cur.va11);
  if (wr == 1) BAR;
  WAIT_V(4); BAR;
  G_STAGE(G_SB(1, 0), cur.b0 + 128, vb0, vb1); G_STAGE(G_SA(1, 0), cur.a0 + 128, cur.va00, cur.va01); G_STAGE(G_SB(1, 1), cur.b1 + 128, vb0, vb1);
  WAIT_V(6); BAR;
  for (int ui = 0;; ++ui) {
    const bool has_next = next(ui + 1, nxt);
    if (!has_next) nxt = cur;
    unsigned long long tq0 = 0; if (tk) tq0 = (PROBE_PH == 18) ? (unsigned long long)clock64() : wall_clock64();
    for (int t = 0; t < nt; t += 2) {
      const bool last = (t == nt - 2);
      const char* a1_1 = cur.a1 + (size_t)(t + 1) * 128;
      const char* a0_2 = last ? nxt.a0 : cur.a0 + (size_t)(t + 2) * 128; const char* a1_2 = last ? nxt.a1 : cur.a1 + (size_t)(t + 2) * 128;
      const char* b0_2 = last ? nxt.b0 : cur.b0 + (size_t)(t + 2) * 128; const char* b1_2 = last ? nxt.b1 : cur.b1 + (size_t)(t + 2) * 128;
      const unsigned w00 = last ? nxt.va00 : cur.va00, w01 = last ? nxt.va01 : cur.va01, w10 = last ? nxt.va10 : cur.va10, w11 = last ? nxt.va11 : cur.va11;
      G_LDB(B0, 0, 0); SCHED; G_LDA(At, 0, 0); G_STAGE(G_SA(1, 1), a1_1, cur.va10, cur.va11);
      WAIT_L(8); BAR; WAIT_L(0); G_MMA(0, 0, At, B0); BAR; SCHED;
      G_LDB(B1, 0, 1); G_STAGE(G_SB(0, 0), b0_2, vb0, vb1);
      BAR; WAIT_L(0); G_MMA(0, 1, At, B1); BAR;
      G_LDA(At, 0, 1); G_STAGE(G_SA(0, 0), a0_2, w00, w01);
      BAR; WAIT_L(0); G_MMA(1, 0, At, B0); BAR; SCHED;
      G_STAGE(G_SB(0, 1), b1_2, vb0, vb1);
      WAIT_V(6); BAR; G_MMA(1, 1, At, B1); BAR;
      G_LDB(B0, 1, 0); SCHED; G_LDA(At, 1, 0); G_STAGE(G_SA(0, 1), a1_2, w10, w11);
      WAIT_L(8); BAR; WAIT_L(0); G_MMA(0, 0, At, B0); BAR; SCHED;
      G_LDB(B1, 1, 1); G_STAGE(G_SB(1, 0), b0_2 + 128, vb0, vb1);
      BAR; WAIT_L(0); G_MMA(0, 1, At, B1); BAR;
      G_LDA(At, 1, 1); G_STAGE(G_SA(1, 0), a0_2 + 128, w00, w01);
      BAR; WAIT_L(0); G_MMA(1, 0, At, B0); BAR; SCHED;
      G_STAGE(G_SB(1, 1), b1_2 + 128, vb0, vb1);
      WAIT_V(6); BAR; G_MMA(1, 1, At, B1); BAR;
    }
    unsigned long long tq1 = 0; if (tk) { if (PROBE_PH == 18) *tk += ((unsigned long long)clock64() - tq0) / 24; else *tk += wall_clock64() - tq0; } if (te) tq1 = wall_clock64();
    { int frz = fr, fqz = fq; asm volatile("" : "+v"(frz), "+v"(fqz));
      epi(cur, acc, wr, wc, frz, fqz); }
    if (te) { asm volatile("s_waitcnt vmcnt(0)" ::: "memory"); *te += wall_clock64() - tq1; }
    if (!has_next) break;
    if (!(nxt.i3 & GU_KEEP_ACC)) {
#pragma unroll
      for (int a = 0; a < 2; ++a)
#pragma unroll
        for (int b = 0; b < 2; ++b)
#pragma unroll
          for (int m = 0; m < 4; ++m)
#pragma unroll
            for (int n = 0; n < 2; ++n) acc[a][b][m][n] = f32x4{0.f, 0.f, 0.f, 0.f};
    }
    cur = nxt;
  }
  WAIT_V(0);
  if (wr == 0) BAR;
  BAR;
}

template <class F> struct Epi2 {
  F f;
  __device__ __forceinline__ void operator()(int row, int cq, f32x4 c00, f32x4 c01, f32x4 c10, f32x4 c11) const { f(row, cq, c00, c10); f(row, cq + 16, c01, c11); }
};
template <class F> __device__ __forceinline__ Epi2<F> epi2(F f) { return Epi2<F>{f}; }

__device__ __forceinline__ unsigned stage_voff(int tid, int i, int ld) { int R, C; stage_rc(tid * 16 + i * 8192, R, C); return (unsigned)(R * ld + C) * 2u; }


__device__ __forceinline__ bool unit_next(int L, int nM, int nN, int& pm, int& pn) {
  const int nwg = nM * nN; if (L >= nwg) return false;
  int wgid = L; { const int q = nwg / 8, r = nwg % 8, xcd = wgid % 8, off = wgid / 8; wgid = (xcd < r ? xcd * (q + 1) : r * (q + 1) + (xcd - r) * q) + off; }
  const int nig = 8 * nN, gid = wgid / nig, fm = gid * 8, gsz = (nM - fm) < 8 ? (nM - fm) : 8;
  pm = fm + ((wgid % nig) % gsz); pn = (wgid % nig) / gsz; return true;
}

__device__ __forceinline__ void st_bf4(bf16_t* p, float a, float b, float c, float d) {
  uint2 v; v.x = pack2(a, b); v.y = pack2(c, d); *reinterpret_cast<uint2*>(p) = v;
}
__device__ __forceinline__ void ld_bf4(const bf16_t* p, float& a, float& b, float& c, float& d) {
  uint2 v = *reinterpret_cast<const uint2*>(p);
  a = __uint_as_float(v.x << 16); b = __uint_as_float(v.x & 0xffff0000u); c = __uint_as_float(v.y << 16); d = __uint_as_float(v.y & 0xffff0000u);
}

template <class T> __device__ __forceinline__ T ldg(const void* base, unsigned off) { return *reinterpret_cast<const T*>(reinterpret_cast<const char*>(base) + off); }
template <class T> __device__ __forceinline__ void stg(void* base, unsigned off, T v) { *reinterpret_cast<T*>(reinterpret_cast<char*>(base) + off) = v; }
__device__ __forceinline__ void stg_bf4(void* base, unsigned off, float a, float b, float c, float d) { uint2 v; v.x = pack2(a, b); v.y = pack2(c, d); stg<uint2>(base, off, v); }
__device__ __forceinline__ void stg_bf8(void* base, unsigned off, f32x4 lo, f32x4 hi) { uint4 v; v.x = pack2(lo[0], lo[1]); v.y = pack2(lo[2], lo[3]); v.z = pack2(hi[0], hi[1]); v.w = pack2(hi[2], hi[3]); stg<uint4>(base, off, v); }
__device__ __forceinline__ void unpack8(uint4 v, f32x4& lo, f32x4& hi) {
  lo = f32x4{__uint_as_float(v.x << 16), __uint_as_float(v.x & 0xffff0000u), __uint_as_float(v.y << 16), __uint_as_float(v.y & 0xffff0000u)};
  hi = f32x4{__uint_as_float(v.z << 16), __uint_as_float(v.z & 0xffff0000u), __uint_as_float(v.w << 16), __uint_as_float(v.w & 0xffff0000u)};
}

template <int PERM>
__device__ __forceinline__ int conv_srccol(int p) {
  if (PERM == 1) { const int t256 = p >> 8, w = p & 255; return (w < 128) ? (t256 * 128 + w) : (1024 + t256 * 128 + (w - 128)); }
  if (PERM == 2) { if (p < C_WQ || p >= C_GATE) return p; const int tile = p >> 8, pin = p & 255, cp = pin >> 5, r = pin & 31, bj = cp >> 2, wc = cp & 3; return tile * 256 + (wc * 2 + bj) * 32 + r; }
  return p;
}
template <int PERM>
__device__ __forceinline__ int conv_dst_slot(int p0, int n) {
  if (PERM == 2 && p0 >= C_WQ && p0 < C_GATE) return n;
  const int l = n & 31;
  return (n & 32) + 16 * ((l >> 2) & 1) + 4 * (l >> 3) + (l & 3);
}
template <int PERM>
__device__ __forceinline__ void conv_mats(const float* __restrict__ src, bf16_t* __restrict__ dst, int nmat, int K, int N, float* lds, int tid_) {
  const int tK = K / 128, tN = N / 64, per = tK * tN, total = nmat * per;
  const int t = tid_;
  const int c4 = (t & 15) * 4, r = t >> 4;
  auto issue = [&](int tile, float4 (&v)[4]) {
    const int mat = tile / per, rem = tile % per, kt = rem / tN, ntl = rem % tN;
    const int sc = conv_srccol<PERM>(ntl * 64 + (c4 & 32)) + (c4 & 31);
    const float* S = src + (size_t)mat * K * N + (size_t)(kt * 128) * N + sc;
#pragma unroll
    for (int i = 0; i < 4; ++i) { const f32x4 t4 = __builtin_nontemporal_load(reinterpret_cast<const f32x4*>(S + (size_t)(r + 32 * i) * N)); v[i] = float4{t4[0], t4[1], t4[2], t4[3]}; }
  };
  float4 cur[4], nxt[4];
  int tile = blockIdx.x;
  if (tile < total) issue(tile, cur);
  for (; tile < total; tile += gridDim.x) {
    const int ntile = tile + gridDim.x;
    if (ntile < total) issue(ntile, nxt);
    const int mat = tile / per, rem = tile % per, kt = rem / tN, ntl = rem % tN;
    const int p0 = ntl * 64;
    __syncthreads();
#pragma unroll
    for (int i = 0; i < 4; ++i) { float* d = lds + (r + 32 * i) * 65 + c4; d[0] = cur[i].x; d[1] = cur[i].y; d[2] = cur[i].z; d[3] = cur[i].w; }
    __syncthreads();
    { const int n = t >> 3, kc = (t & 7) * 16;
      uint4 v0, v1;
      v0.x = pack2(lds[(kc + 0) * 65 + n], lds[(kc + 1) * 65 + n]); v0.y = pack2(lds[(kc + 2) * 65 + n], lds[(kc + 3) * 65 + n]);
      v0.z = pack2(lds[(kc + 4) * 65 + n], lds[(kc + 5) * 65 + n]); v0.w = pack2(lds[(kc + 6) * 65 + n], lds[(kc + 7) * 65 + n]);
      v1.x = pack2(lds[(kc + 8) * 65 + n], lds[(kc + 9) * 65 + n]); v1.y = pack2(lds[(kc + 10) * 65 + n], lds[(kc + 11) * 65 + n]);
      v1.z = pack2(lds[(kc + 12) * 65 + n], lds[(kc + 13) * 65 + n]); v1.w = pack2(lds[(kc + 14) * 65 + n], lds[(kc + 15) * 65 + n]);
      bf16_t* d = dst + (size_t)mat * N * K + (size_t)(p0 + conv_dst_slot<PERM>(p0, n)) * K + kt * 128 + kc;
      { typedef unsigned u32x4v __attribute__((ext_vector_type(4))); __builtin_nontemporal_store(u32x4v{v0.x, v0.y, v0.z, v0.w}, reinterpret_cast<u32x4v*>(d)); __builtin_nontemporal_store(u32x4v{v1.x, v1.y, v1.z, v1.w}, reinterpret_cast<u32x4v*>(d + 8)); } }
#pragma unroll
    for (int i = 0; i < 4; ++i) cur[i] = nxt[i];
  }
}

template <int PERM>
__device__ __forceinline__ void conv_tile128(const float* __restrict__ src, bf16_t* __restrict__ dst, int K, int N, int kt, int ntl, float* lds, int t) {
  const int c4 = (t & 15) * 4, r = t >> 4;
  const int sc = conv_srccol<PERM>(ntl * 64 + (c4 & 32)) + (c4 & 31);
  const float* S = src + (size_t)(kt * 128) * N + sc;
  float4 v[4];
#pragma unroll
  for (int i = 0; i < 4; ++i) { const f32x4 t4 = __builtin_nontemporal_load(reinterpret_cast<const f32x4*>(S + (size_t)(r + 32 * i) * N)); v[i] = float4{t4[0], t4[1], t4[2], t4[3]}; }
  __syncthreads();
#pragma unroll
  for (int i = 0; i < 4; ++i) { float* d = lds + (r + 32 * i) * 65 + c4; d[0] = v[i].x; d[1] = v[i].y; d[2] = v[i].z; d[3] = v[i].w; }
  __syncthreads();
  const int n = t >> 3, kc = (t & 7) * 16;
  uint4 v0, v1;
  v0.x = pack2(lds[(kc + 0) * 65 + n], lds[(kc + 1) * 65 + n]); v0.y = pack2(lds[(kc + 2) * 65 + n], lds[(kc + 3) * 65 + n]);
  v0.z = pack2(lds[(kc + 4) * 65 + n], lds[(kc + 5) * 65 + n]); v0.w = pack2(lds[(kc + 6) * 65 + n], lds[(kc + 7) * 65 + n]);
  v1.x = pack2(lds[(kc + 8) * 65 + n], lds[(kc + 9) * 65 + n]); v1.y = pack2(lds[(kc + 10) * 65 + n], lds[(kc + 11) * 65 + n]);
  v1.z = pack2(lds[(kc + 12) * 65 + n], lds[(kc + 13) * 65 + n]); v1.w = pack2(lds[(kc + 14) * 65 + n], lds[(kc + 15) * 65 + n]);
  bf16_t* d = dst + (size_t)(ntl * 64 + conv_dst_slot<PERM>(ntl * 64, n)) * K + kt * 128 + kc;
  { typedef unsigned u32x4v __attribute__((ext_vector_type(4))); __builtin_nontemporal_store(u32x4v{v0.x, v0.y, v0.z, v0.w}, reinterpret_cast<u32x4v*>(d)); __builtin_nontemporal_store(u32x4v{v1.x, v1.y, v1.z, v1.w}, reinterpret_cast<u32x4v*>(d + 8)); }
}
constexpr int MOE_CT_GU = NEXP * 8 * 32, MOE_CT = MOE_CT_GU + NEXP * 8 * 16;
constexpr int CQ_B = 10, CQ_E = 24, CQ_F = 8, CQ_H = 11, CQ_I = 10;
constexpr int CB_E = 136 * CQ_B, CB_F = CB_E + 224 * CQ_E, CB_REST = CB_F + 224 * CQ_F;
__device__ __forceinline__ void conv_moe_tiles(const Params& p, int L, int t0, int cnt, float* lds) {
  if (L >= DEPTH) return;
  const int tid_ = opaque_tid();
  __syncthreads();
  for (int t = t0; t < t0 + cnt && t < MOE_CT; ++t) {
    if (t < MOE_CT_GU) { const int m = t >> 8, q = t & 255; conv_tile128<1>(p.w_gu + (size_t)(L * NEXP + m) * 1024 * 2048, reinterpret_cast<bf16_t*>(p.ws + WS_WGU) + (size_t)(L * NEXP + m) * 2048 * 1024, 1024, 2048, q >> 5, q & 31, lds, tid_); }
    else { const int r = t - MOE_CT_GU, m = r >> 7, q = r & 127; conv_tile128<0>(p.w_dn + (size_t)(L * NEXP + m) * 1024 * 1024, reinterpret_cast<bf16_t*>(p.ws + WS_WDN) + (size_t)(L * NEXP + m) * 1024 * 1024, 1024, 1024, q >> 4, q & 15, lds, tid_); }
  }
}

__device__ __forceinline__ float siluf(float x) { return x / (1.0f + __expf(-x)); }
__device__ __forceinline__ float gelu_tanh(float x) {
  const float u2 = 1.5957691216057308f * (x + 0.044715f * x * x * x);
  return x * __builtin_amdgcn_rcpf(1.0f + __expf(-u2));
}

__device__ __forceinline__ void mod_phase(const Params& p, float* lds) {
  const int tid_ = opaque_tid();
  float* sc = lds;
  float* red = lds + 9 * 1024;
  const int t = tid_;
  __syncthreads();
  for (int i = t; i < 9 * 1024; i += NTHR) { const int r = i >> 10, k = i & 1023; const float v = (r < 8) ? p.c[r * 1024 + k] : p.c_ctx[k]; sc[i] = siluf(v); }
  __syncthreads();
  float* mod = reinterpret_cast<float*>(p.ws + WS_MOD);
  for (int u = blockIdx.x; u < DEPTH * 48; u += gridDim.x) {
    const int l = u / 48, col0 = (u % 48) * 128;
    const int col = t & 127, kq = t >> 7;
    float a[9];
#pragma unroll
    for (int r = 0; r < 9; ++r) a[r] = 0.f;
    const float* W = p.w_mod + (size_t)l * 1024 * 6144 + col0 + col;
    for (int k = kq * 256; k < kq * 256 + 256; k += 4) {
      float w[4];
#pragma unroll
      for (int j = 0; j < 4; ++j) w[j] = __builtin_nontemporal_load(W + (size_t)(k + j) * 6144);
#pragma unroll
      for (int r = 0; r < 9; ++r) {
        const float4 s4 = *reinterpret_cast<const float4*>(sc + r * 1024 + k);
        a[r] += s4.x * w[0]; a[r] += s4.y * w[1]; a[r] += s4.z * w[2]; a[r] += s4.w * w[3];
      }
    }
#pragma unroll
    for (int r = 0; r < 9; ++r) red[(kq * 9 + r) * 128 + col] = a[r];
    __syncthreads();
    for (int i = t; i < 9 * 128; i += NTHR) {
      const int r = i >> 7, cc = i & 127;
      const float v = red[(0 * 9 + r) * 128 + cc] + red[(1 * 9 + r) * 128 + cc] + red[(2 * 9 + r) * 128 + cc] + red[(3 * 9 + r) * 128 + cc];
      mod[((size_t)l * 9 + r) * 6144 + col0 + cc] = v + p.b_mod[l * 6144 + col0 + cc];
    }
    __syncthreads();
  }
}

__device__ __forceinline__ float* stream_row(const Params& p, int row) {
  return (row < NLAT) ? (p.out + (size_t)row * D) : (reinterpret_cast<float*>(p.ws + WS_CX) + (size_t)(row - NLAT) * D);
}
__device__ __forceinline__ int row_modidx(int row) { return (row < NLAT) ? (row >> 11) : 8; }
__device__ __forceinline__ const float* stream_row_in(const Params& p, int layer, int row) {
  if (layer > 0) return stream_row(p, row);
  return (row < NLAT) ? (p.x + (size_t)row * D) : (p.ctx + (size_t)(row - NLAT) * D);
}

__device__ __forceinline__ void expert_starts(const unsigned* cnt, int* st) {
  if (threadIdx.x == 0) { int s = 0; for (int e = 0; e < NEXP; ++e) { st[e] = s; s += (int)cnt[e]; } st[NEXP] = s; }
  __syncthreads();
}

__device__ __forceinline__ void norm_phase(const Params& p, int layer, bool combine, int* lds_i) {
  const int tid_ = opaque_tid();
  const float* mod = reinterpret_cast<const float*>(p.ws + WS_MOD);
  bf16_t* H = reinterpret_cast<bf16_t*>(p.ws + WS_H);
  const int* tke = reinterpret_cast<const int*>(p.ws + WS_TKE);
  const int* tkp = reinterpret_cast<const int*>(p.ws + WS_TKP);
  const float* tkg = reinterpret_cast<const float*>(p.ws + WS_TKG);
  const bf16_t* YB = reinterpret_cast<const bf16_t*>(p.ws + WS_YB);
  const unsigned* ctl = reinterpret_cast<const unsigned*>(p.ws + WS_CTL);
  if (combine) expert_starts(ctl + CW_CNT + (layer - 1) * 32, lds_i);
  const int lane = tid_ & 63, wv = tid_ >> 6;
  const float* gw = p.norm_mix + layer * D;
  const int stride = gridDim.x * 8;
  for (int row0 = blockIdx.x * 8 + wv; row0 < NTOK; row0 += 2 * stride) {
    float v[2][16]; uint2 yv[2][4][4]; float gk[2][4];
#pragma unroll
    for (int tt = 0; tt < 2; ++tt) {
      const int row = row0 + tt * stride;
      if (row < NTOK) {
        const float* xin = stream_row_in(p, layer, row);
#pragma unroll
        for (int i = 0; i < 4; ++i) { const float4 q = *reinterpret_cast<const float4*>(xin + i * 256 + lane * 4); v[tt][4 * i] = q.x; v[tt][4 * i + 1] = q.y; v[tt][4 * i + 2] = q.z; v[tt][4 * i + 3] = q.w; }
        if (combine) {
#pragma unroll
          for (int k = 0; k < 4; ++k) {
            const int e = tke[row * 4 + k]; const int pos = tkp[row * 4 + k]; gk[tt][k] = tkg[row * 4 + k];
            const bf16_t* yr = YB + (size_t)(lds_i[e] + pos) * D;
#pragma unroll
            for (int i = 0; i < 4; ++i) yv[tt][k][i] = *reinterpret_cast<const uint2*>(yr + i * 256 + lane * 4);
          }
        }
      }
    }
#pragma unroll
    for (int tt = 0; tt < 2; ++tt) {
      const int row = row0 + tt * stride;
      if (row < NTOK) {
        float* xr = stream_row(p, row);
        const int mi = row_modidx(row);
        if (combine) {
          const float* m5 = mod + ((size_t)(layer - 1) * 9 + mi) * 6144 + 5 * 1024;
#pragma unroll
          for (int i = 0; i < 4; ++i) {
            float a0 = 0.f, a1 = 0.f, a2 = 0.f, a3 = 0.f;
#pragma unroll
            for (int k = 0; k < 4; ++k) {
              const uint2 y = yv[tt][k][i]; const float g = gk[tt][k];
              a0 += g * __uint_as_float(y.x << 16); a1 += g * __uint_as_float(y.x & 0xffff0000u); a2 += g * __uint_as_float(y.y << 16); a3 += g * __uint_as_float(y.y & 0xffff0000u);
            }
            const float4 mm = *reinterpret_cast<const float4*>(m5 + i * 256 + lane * 4);
            v[tt][4 * i] += mm.x * a0; v[tt][4 * i + 1] += mm.y * a1; v[tt][4 * i + 2] += mm.z * a2; v[tt][4 * i + 3] += mm.w * a3;
            *reinterpret_cast<float4*>(xr + i * 256 + lane * 4) = float4{v[tt][4 * i], v[tt][4 * i + 1], v[tt][4 * i + 2], v[tt][4 * i + 3]};
          }
        }
        float ss = 0.f;
#pragma unroll
        for (int i = 0; i < 16; ++i) ss += v[tt][i] * v[tt][i];
        ss = wave_sum(ss, lane);
        const float rinv = rsqrtf(ss * (1.0f / D) + 1e-6f);
        const float* msh = mod + ((size_t)layer * 9 + mi) * 6144;
#pragma unroll
        for (int i = 0; i < 4; ++i) {
          const int c = i * 256 + lane * 4;
          const float4 g = *reinterpret_cast<const float4*>(gw + c);
          const float4 sh = *reinterpret_cast<const float4*>(msh + c);
          const float4 sc = *reinterpret_cast<const float4*>(msh + 1024 + c);
          st_bf4(H + (size_t)row * D + c, v[tt][4 * i] * rinv * g.x * (1.f + sc.x) + sh.x, v[tt][4 * i + 1] * rinv * g.y * (1.f + sc.y) + sh.y,
                 v[tt][4 * i + 2] * rinv * g.z * (1.f + sc.z) + sh.z, v[tt][4 * i + 3] * rinv * g.w * (1.f + sc.w) + sh.w);
        }
      }
    }
  }
}

__device__ __forceinline__ void final_combine(const Params& p, int* lds_i) {
  const int tid_ = opaque_tid();
  const float* mod = reinterpret_cast<const float*>(p.ws + WS_MOD);
  const int* tke = reinterpret_cast<const int*>(p.ws + WS_TKE);
  const int* tkp = reinterpret_cast<const int*>(p.ws + WS_TKP);
  const float* tkg = reinterpret_cast<const float*>(p.ws + WS_TKG);
  const bf16_t* YB = reinterpret_cast<const bf16_t*>(p.ws + WS_YB);
  const unsigned* ctl = reinterpret_cast<const unsigned*>(p.ws + WS_CTL);
  expert_starts(ctl + CW_CNT + (DEPTH - 1) * 32, lds_i);
  const int lane = tid_ & 63, wv = tid_ >> 6;
  for (int row = blockIdx.x * 8 + wv; row < NLAT; row += gridDim.x * 8) {
    float* xr = p.out + (size_t)row * D;
    const int mi = row >> 11;
    const float* m5 = mod + ((size_t)(DEPTH - 1) * 9 + mi) * 6144 + 5 * 1024;
    float a[16];
#pragma unroll
    for (int i = 0; i < 16; ++i) a[i] = 0.f;
#pragma unroll
    for (int k = 0; k < 4; ++k) {
      const int e = tke[row * 4 + k]; const int pos = tkp[row * 4 + k]; const float g = tkg[row * 4 + k];
      const bf16_t* yr = YB + (size_t)(lds_i[e] + pos) * D;
#pragma unroll
      for (int i = 0; i < 4; ++i) { float a0, a1, a2, a3; ld_bf4(yr + i * 256 + lane * 4, a0, a1, a2, a3); a[4 * i] += g * a0; a[4 * i + 1] += g * a1; a[4 * i + 2] += g * a2; a[4 * i + 3] += g * a3; }
    }
#pragma unroll
    for (int i = 0; i < 4; ++i) {
      const float4 mm = *reinterpret_cast<const float4*>(m5 + i * 256 + lane * 4);
      float4 q = *reinterpret_cast<const float4*>(xr + i * 256 + lane * 4);
      q.x += mm.x * a[4 * i]; q.y += mm.y * a[4 * i + 1]; q.z += mm.z * a[4 * i + 2]; q.w += mm.w * a[4 * i + 3];
      *reinterpret_cast<float4*>(xr + i * 256 + lane * 4) = q;
    }
  }
}

__device__ __forceinline__ void qknorm_phase(const Params& p, int layer) {
  const int tid_ = opaque_tid();
  bf16_t* P = reinterpret_cast<bf16_t*>(p.ws + WS_P);
  const int lane = tid_ & 63, wv = tid_ >> 6;
  const float wqn = p.win_qn[layer * 64 + lane], wkn = p.win_kn[layer * 64 + lane];
  const float nqn = p.na_qn[layer * 64 + lane], nkn = p.na_kn[layer * 64 + lane];
  const int fi = lane & 15;
  const float inv_freq = powf(10000.0f, -(float)fi / 16.0f);
  for (int row = blockIdx.x * 8 + wv; row < NTOK; row += gridDim.x * 8) {
    bf16_t* pr = P + (size_t)row * INW;
    const bool lat = row < NLAT;
    float cs = 1.f, sn = 0.f;
    if (lat) { const int t = row & 2047; const int pos = (lane < 32) ? (t >> 6) : (t & 63); const float ang = (float)pos * inv_freq; cs = cosf(ang); sn = sinf(ang); }
    for (int hd = 0; hd < 26; ++hd) {
      int col; float w; bool rope;
      if (hd < 8) { col = C_WQ + hd * 64; w = wqn; rope = lat; }
      else if (hd < 10) { col = C_WK + (hd - 8) * 64; w = wkn; rope = lat; }
      else if (hd < 18) { col = C_NQ + (hd - 10) * 64; w = nqn; rope = false; }
      else { col = C_NK + (hd - 18) * 64; w = nkn; rope = false; }
      const float v = bf2f(pr[col + lane]);
      const float ss = wave_sum(v * v, lane);
      float y = v * rsqrtf(ss * (1.0f / 64.0f) + 1e-6f) * w;
      if (rope) {
        const float o = shx(y, 16, lane);
        y = ((lane & 16) == 0) ? (y * cs - o * sn) : (o * sn + y * cs);
      }
      pr[col + lane] = f2bf(y);
    }
    {
      bf16_t* VT = reinterpret_cast<bf16_t*>(p.ws + WS_VT);
      const int bb = lat ? (row >> 11) : ((row - NLAT) >> 8);
      const int tpos = lat ? (CTXL + (row & 2047)) : ((row - NLAT) & 255);
#pragma unroll
      for (int hv = 0; hv < 10; ++hv) {
        const int col = (hv < 2) ? (C_WV + hv * 64) : (C_NV + (hv - 2) * 64);
        VT[((size_t)(bb * 10 + hv) * 64 + lane) * (CTXL + SEQ) + tpos] = pr[col + lane];
      }
    }
  }
}

__device__ __forceinline__ int ssm_row(int b, int dir, int tau) {
  if (tau < CTXL) return NLAT + b * CTXL + (dir ? (CTXL - 1 - tau) : tau);
  const int t = tau - CTXL;
  return b * SEQ + (dir ? (SEQ - 1 - t) : t);
}

__device__ __forceinline__ void ssm_item_naive(const Params& p, int layer, int item) {
  const int tid_ = opaque_tid();
  const int b = item >> 3, gq = item & 7;
  const int lane = tid_ & 63, wv = tid_ >> 6;
  const int dir = wv & 1, g = gq * 4 + (wv >> 1);
  const bf16_t* P = reinterpret_cast<const bf16_t*>(p.ws + WS_P);
  float* YD = reinterpret_cast<float*>(p.ws + WS_YD) + (size_t)dir * NTOK * 512;
  {
    const int n = lane;
    const size_t pg = ((size_t)(layer * 2 + dir) * 32 + g);
    const float lr = p.lam_re[pg * 64 + n], li = p.lam_im[pg * 64 + n];
    const float dt = expf(p.log_dt[pg]);
    const float mag = expf(lr * dt);
    const float ar = mag * cosf(li * dt), ai = mag * sinf(li * dt);
    const float den = lr * lr + li * li;
    const float fr = ((ar - 1.0f) * lr + ai * li) / den;
    const float fi = (ai * lr - (ar - 1.0f) * li) / den;
    float bbr[16], bbi[16], cr[16], ci[16];
#pragma unroll
    for (int q = 0; q < 16; ++q) {
      const float br = p.b_re[(pg * 64 + n) * 16 + q], bi = p.b_im[(pg * 64 + n) * 16 + q];
      bbr[q] = fr * br - fi * bi; bbi[q] = fr * bi + fi * br;
      cr[q] = p.c_re[(pg * 16 + q) * 64 + n]; ci[q] = p.c_im[(pg * 16 + q) * 64 + n];
    }
    float hr = 0.f, hi = 0.f;
    for (int tau = 0; tau < CTXL + SEQ; ++tau) {
      const int row = ssm_row(b, dir, tau);
      const uint4* up = reinterpret_cast<const uint4*>(P + (size_t)row * INW + C_U + g * 16);
      const uint4 u0 = up[0], u1 = up[1];
      float u[16];
      u[0] = __uint_as_float(u0.x << 16); u[1] = __uint_as_float(u0.x & 0xffff0000u); u[2] = __uint_as_float(u0.y << 16); u[3] = __uint_as_float(u0.y & 0xffff0000u);
      u[4] = __uint_as_float(u0.z << 16); u[5] = __uint_as_float(u0.z & 0xffff0000u); u[6] = __uint_as_float(u0.w << 16); u[7] = __uint_as_float(u0.w & 0xffff0000u);
      u[8] = __uint_as_float(u1.x << 16); u[9] = __uint_as_float(u1.x & 0xffff0000u); u[10] = __uint_as_float(u1.y << 16); u[11] = __uint_as_float(u1.y & 0xffff0000u);
      u[12] = __uint_as_float(u1.z << 16); u[13] = __uint_as_float(u1.z & 0xffff0000u); u[14] = __uint_as_float(u1.w << 16); u[15] = __uint_as_float(u1.w & 0xffff0000u);
      float xr = 0.f, xi = 0.f;
#pragma unroll
      for (int q = 0; q < 16; ++q) { xr += bbr[q] * u[q]; xi += bbi[q] * u[q]; }
      const float nhr = ar * hr - ai * hi + xr;
      const float nhi = ar * hi + ai * hr + xi;
      hr = nhr; hi = nhi;
      float v[16];
#pragma unroll
      for (int q = 0; q < 16; ++q) v[q] = hr * cr[q] - hi * ci[q];
#pragma unroll
      for (int i = 0; i < 8; ++i) { const bool up_ = (lane & 32) != 0; const float send = up_ ? v[i] : v[i + 8]; const float keep = up_ ? v[i + 8] : v[i]; v[i] = keep + shx(send, 32, lane); }
#pragma unroll
      for (int i = 0; i < 4; ++i) { const bool up_ = (lane & 16) != 0; const float send = up_ ? v[i] : v[i + 4]; const float keep = up_ ? v[i + 4] : v[i]; v[i] = keep + shx(send, 16, lane); }
#pragma unroll
      for (int i = 0; i < 2; ++i) { const bool up_ = (lane & 8) != 0; const float send = up_ ? v[i] : v[i + 2]; const float keep = up_ ? v[i + 2] : v[i]; v[i] = keep + shx(send, 8, lane); }
      { const bool up_ = (lane & 4) != 0; const float send = up_ ? v[0] : v[1]; const float keep = up_ ? v[1] : v[0]; v[0] = keep + shx(send, 4, lane); }
      v[0] += shx(v[0], 2, lane);
      v[0] += shx(v[0], 1, lane);
      if ((lane & 3) == 0) YD[(size_t)row * 512 + g * 16 + (lane >> 2)] = v[0];
    }
  }
  asm volatile("s_waitcnt vmcnt(0)" ::: "memory");
  __threadfence();
  __syncthreads();
  {
    const float* Y0 = reinterpret_cast<const float*>(p.ws + WS_YD);
    const float* Y1 = Y0 + (size_t)NTOK * 512;
    bf16_t* G = reinterpret_cast<bf16_t*>(p.ws + WS_G);
    const int ch = gq * 64 + (tid_ & 63);
    const float dsk = p.ssm_d[layer * 512 + ch];
    for (int i = tid_ >> 6; i < CTXL + SEQ; i += 8) {
      const int row = (i < CTXL) ? (NLAT + b * CTXL + i) : (b * SEQ + i - CTXL);
      const float y = Y0[(size_t)row * 512 + ch] + Y1[(size_t)row * 512 + ch] + dsk * bf2f(P[(size_t)row * INW + C_U + ch]);
      G[(size_t)row * 512 + ch] = f2bf(gelu_tanh(y));
    }
  }
}


typedef float f32x16 __attribute__((ext_vector_type(16)));
__device__ __forceinline__ bf16x8 pack8(const float* v) {
  union { unsigned u[4]; bf16x8 b; } t;
  t.u[0] = pack2(v[0], v[1]); t.u[1] = pack2(v[2], v[3]); t.u[2] = pack2(v[4], v[5]); t.u[3] = pack2(v[6], v[7]);
  return t.b;
}
constexpr int SSM_PITCH = 144;
__device__ __forceinline__ void ssm_item(const Params& p, int layer, int item, unsigned char* lds_raw) {
  const int tid_ = opaque_tid();
  const int b = item >> 4, gq = item & 15;
  const int lane = tid_ & 63, wv = tid_ >> 6;
  const int dir = wv & 1, sb = (wv >> 1) & 1, g = gq * 2 + (wv >> 2);
  const bf16_t* P = reinterpret_cast<const bf16_t*>(p.ws + WS_P);
  float* YD = reinterpret_cast<float*>(p.ws + WS_YD) + (size_t)(dir * 2 + sb) * NTOK * 512;
  unsigned char* hl = lds_raw + wv * (32 * SSM_PITCH);
  {
    const int n0 = lane & 31, hh = lane >> 5;
    const size_t pg = ((size_t)(layer * 2 + dir) * 32 + g);
    const float dt = expf(p.log_dt[pg]);
    float pwr[4], pwi[4];
    bf16x8 Bop[2];
    {
      const int n = n0 + 32 * sb;
      const float lr = p.lam_re[pg * 64 + n], li = p.lam_im[pg * 64 + n];
      const float mag = expf(lr * dt);
      const float ar = mag * __cosf(li * dt), ai = mag * __sinf(li * dt);
      const float den = lr * lr + li * li;
      const float fr = ((ar - 1.0f) * lr + ai * li) / den;
      const float fi = (ai * lr - (ar - 1.0f) * li) / den;
      float vr[8], vi[8];
#pragma unroll
      for (int j = 0; j < 8; ++j) {
        const int q = 8 * hh + j;
        const float br = p.b_re[(pg * 64 + n) * 16 + q], bi = p.b_im[(pg * 64 + n) * 16 + q];
        vr[j] = fr * br - fi * bi; vi[j] = fr * bi + fi * br;
      }
      Bop[0] = pack8(vr); Bop[1] = pack8(vi);
      pwr[0] = ar; pwi[0] = ai;
      pwr[1] = ar * ar - ai * ai; pwi[1] = 2.0f * ar * ai;
      pwr[2] = pwr[1] * ar - pwi[1] * ai; pwi[2] = pwr[1] * ai + pwi[1] * ar;
      pwr[3] = pwr[1] * pwr[1] - pwi[1] * pwi[1]; pwi[3] = 2.0f * pwr[1] * pwi[1];
    }
    bf16x8 Cop[2];
    {
      const int pch = lane & 15, q4 = lane >> 4;
#pragma unroll
      for (int kb = 0; kb < 2; ++kb) {
        float v[8];
#pragma unroll
        for (int j = 0; j < 8; ++j) {
          const int nn = 32 * sb + kb * 16 + 4 * q4 + (j >> 1);
          v[j] = (j & 1) ? -p.c_im[(pg * 16 + pch) * 64 + nn] : p.c_re[(pg * 16 + pch) * 64 + nn];
        }
        Cop[kb] = pack8(v);
      }
    }
    float hpr = 0.f, hpi = 0.f;
    const int ucol = C_U + g * 16 + 8 * hh;
    auto chunk_base = [&](int c, int& base, int& sgn) {
      sgn = dir ? -1 : 1;
      if (c < 8) base = NLAT + b * CTXL + (dir ? (CTXL - 1 - c * 32) : c * 32);
      else base = b * SEQ + (dir ? (SEQ - 1 - (c - 8) * 32) : (c - 8) * 32);
    };
    uint4 unext;
    { int base, sgn; chunk_base(0, base, sgn); unext = *reinterpret_cast<const uint4*>(P + (size_t)(base + sgn * n0) * INW + ucol); }
    for (int c = 0; c < 72; ++c) {
      int base, sgn; chunk_base(c, base, sgn);
      union { uint4 u; bf16x8 b; } ua; ua.u = unext;
      if (c + 1 < 72) { int nb, ns; chunk_base(c + 1, nb, ns); unext = *reinterpret_cast<const uint4*>(P + (size_t)(nb + ns * n0) * INW + ucol); }
      f32x16 xr, xi;
      {
        f32x16 z;
#pragma unroll
        for (int r = 0; r < 16; ++r) z[r] = 0.f;
        xr = __builtin_amdgcn_mfma_f32_32x32x16_bf16(ua.b, Bop[0], z, 0, 0, 0);
        xi = __builtin_amdgcn_mfma_f32_32x32x16_bf16(ua.b, Bop[1], z, 0, 0, 0);
      }
      {
        const float ar = pwr[0], ai = pwi[0], a4r = pwr[3], a4i = pwi[3];
        float Er[4], Ei[4], Or[4], Oi[4], mcr[4], mci[4];
#pragma unroll
        for (int q = 0; q < 4; ++q) {
#pragma unroll
          for (int i = 1; i < 4; ++i) {
            const int r = 4 * q + i;
            const float nr = ar * xr[r - 1] - ai * xi[r - 1] + xr[r];
            const float ni = ar * xi[r - 1] + ai * xr[r - 1] + xi[r];
            xr[r] = nr; xi[r] = ni;
          }
          Er[q] = xr[4 * q + 3]; Ei[q] = xi[4 * q + 3];
        }
#pragma unroll
        for (int q = 0; q < 4; ++q) { Or[q] = shx32(Er[q], lane); Oi[q] = shx32(Ei[q], lane); }
        float cr = hpr, ci = hpi;
#pragma unroll
        for (int q = 0; q < 4; ++q) {
          const float cer = cr, cei = ci;
          const float eer = hh ? Or[q] : Er[q], eei = hh ? Oi[q] : Ei[q];
          float tr = a4r * cr - a4i * ci + eer, ti = a4r * ci + a4i * cr + eei;
          cr = tr; ci = ti;
          const float cor = cr, coi = ci;
          const float eor = hh ? Er[q] : Or[q], eoi = hh ? Ei[q] : Oi[q];
          tr = a4r * cr - a4i * ci + eor; ti = a4r * ci + a4i * cr + eoi;
          cr = tr; ci = ti;
          mcr[q] = hh ? cor : cer; mci[q] = hh ? coi : cei;
        }
        hpr = cr; hpi = ci;
#pragma unroll
        for (int q = 0; q < 4; ++q)
#pragma unroll
          for (int i = 0; i < 4; ++i) {
            const int r = 4 * q + i;
            xr[r] += pwr[i] * mcr[q] - pwi[i] * mci[q];
            xi[r] += pwr[i] * mci[q] + pwi[i] * mcr[q];
          }
      }
#pragma unroll
      for (int q = 0; q < 4; ++q)
#pragma unroll
        for (int i = 0; i < 4; ++i) {
          const int r = 4 * q + i, tok = 8 * q + 4 * hh + i;
          *reinterpret_cast<unsigned*>(hl + tok * SSM_PITCH + n0 * 4) = pack2(xr[r], xi[r]);
        }
#pragma unroll
      for (int th = 0; th < 2; ++th) {
        f32x4 acc = f32x4{0.f, 0.f, 0.f, 0.f};
        const int tok = 16 * th + (lane & 15);
#pragma unroll
        for (int kb = 0; kb < 2; ++kb) {
          const bf16x8 hb = *reinterpret_cast<const bf16x8*>(hl + tok * SSM_PITCH + kb * 64 + (lane >> 4) * 16);
          acc = __builtin_amdgcn_mfma_f32_16x16x32_bf16(Cop[kb], hb, acc, 0, 0, 0);
        }
        const int row = base + sgn * tok;
        __builtin_nontemporal_store(acc, reinterpret_cast<f32x4*>(YD + (size_t)row * 512 + g * 16 + 4 * (lane >> 4)));
      }
    }
  }
  asm volatile("s_waitcnt vmcnt(0)" ::: "memory");
  __syncthreads();
  {
    const float* Y0 = reinterpret_cast<const float*>(p.ws + WS_YD);
    constexpr size_t YS = (size_t)NTOK * 512;
    bf16_t* G = reinterpret_cast<bf16_t*>(p.ws + WS_G);
    const int ch = gq * 32 + (tid_ & 7) * 4;
    const float4 dv = *reinterpret_cast<const float4*>(p.ssm_d + layer * 512 + ch);
    for (int i0 = tid_ >> 3; i0 < CTXL + SEQ; i0 += 4 * 64) {
      float4 pa[4][4]; uint2 uu[4];
#pragma unroll
      for (int k = 0; k < 4; ++k) {
        const int i = i0 + 64 * k;
        const int row = (i < CTXL) ? (NLAT + b * CTXL + i) : (b * SEQ + i - CTXL);
#pragma unroll
        for (int q = 0; q < 4; ++q) { const f32x4 t4 = __builtin_nontemporal_load(reinterpret_cast<const f32x4*>(Y0 + q * YS + (size_t)row * 512 + ch)); pa[k][q] = float4{t4[0], t4[1], t4[2], t4[3]}; }
        uu[k] = *reinterpret_cast<const uint2*>(P + (size_t)row * INW + C_U + ch);
      }
#pragma unroll
      for (int k = 0; k < 4; ++k) {
        const int i = i0 + 64 * k;
        const int row = (i < CTXL) ? (NLAT + b * CTXL + i) : (b * SEQ + i - CTXL);
        const float y0 = pa[k][0].x + pa[k][1].x + pa[k][2].x + pa[k][3].x + dv.x * __uint_as_float(uu[k].x << 16);
        const float y1 = pa[k][0].y + pa[k][1].y + pa[k][2].y + pa[k][3].y + dv.y * __uint_as_float(uu[k].x & 0xffff0000u);
        const float y2 = pa[k][0].z + pa[k][1].z + pa[k][2].z + pa[k][3].z + dv.z * __uint_as_float(uu[k].y << 16);
        const float y3 = pa[k][0].w + pa[k][1].w + pa[k][2].w + pa[k][3].w + dv.w * __uint_as_float(uu[k].y & 0xffff0000u);
        st_bf4(G + (size_t)row * 512 + ch, gelu_tanh(y0), gelu_tanh(y1), gelu_tanh(y2), gelu_tanh(y3));
      }
    }
  }
  asm volatile("s_waitcnt vmcnt(0)" ::: "memory");
  __syncthreads();
  if (tid_ == 0) {
    __builtin_amdgcn_fence(__ATOMIC_RELEASE, "agent");
    asm volatile("s_waitcnt vmcnt(0)" ::: "memory");
    __hip_atomic_fetch_add(reinterpret_cast<unsigned*>(p.ws + WS_CTL) + CW_SSMD + (layer * 8 + b) * 64, 1u, __ATOMIC_RELAXED, __HIP_MEMORY_SCOPE_AGENT);
  }
}

__device__ __forceinline__ void readout_phase(const Params& p, int layer, int nrows) {
  const int tid_ = opaque_tid();
  const int lane = tid_ & 63, wv = tid_ >> 6;
  const bf16_t* P = reinterpret_cast<const bf16_t*>(p.ws + WS_P);
  const float* Y0 = reinterpret_cast<const float*>(p.ws + WS_YD);
  constexpr size_t YS = (size_t)NTOK * 512;
  bf16_t* G = reinterpret_cast<bf16_t*>(p.ws + WS_G);
  const float4 d0 = *reinterpret_cast<const float4*>(p.ssm_d + layer * 512 + lane * 8), d1 = *reinterpret_cast<const float4*>(p.ssm_d + layer * 512 + lane * 8 + 4);
  const int stride = gridDim.x * 8;
  for (int row0 = blockIdx.x * 8 + wv; row0 < nrows; row0 += 2 * stride) {
    float4 a0[2][4], a1[2][4]; uint4 uu[2];
#pragma unroll
    for (int k = 0; k < 2; ++k) {
      const int row = row0 + k * stride;
      if (row < nrows) {
#pragma unroll
        for (int q = 0; q < 4; ++q) { a0[k][q] = *reinterpret_cast<const float4*>(Y0 + q * YS + (size_t)row * 512 + lane * 8); a1[k][q] = *reinterpret_cast<const float4*>(Y0 + q * YS + (size_t)row * 512 + lane * 8 + 4); }
        uu[k] = *reinterpret_cast<const uint4*>(P + (size_t)row * INW + C_U + lane * 8);
      }
    }
#pragma unroll
    for (int k = 0; k < 2; ++k) {
      const int row = row0 + k * stride;
      if (row < nrows) {
        const uint4 u = uu[k];
        const float4 s0 = float4{a0[k][0].x + a0[k][1].x + a0[k][2].x + a0[k][3].x, a0[k][0].y + a0[k][1].y + a0[k][2].y + a0[k][3].y, a0[k][0].z + a0[k][1].z + a0[k][2].z + a0[k][3].z, a0[k][0].w + a0[k][1].w + a0[k][2].w + a0[k][3].w};
        const float4 s1 = float4{a1[k][0].x + a1[k][1].x + a1[k][2].x + a1[k][3].x, a1[k][0].y + a1[k][1].y + a1[k][2].y + a1[k][3].y, a1[k][0].z + a1[k][1].z + a1[k][2].z + a1[k][3].z, a1[k][0].w + a1[k][1].w + a1[k][2].w + a1[k][3].w};
        const float y0 = s0.x + d0.x * __uint_as_float(u.x << 16), y1 = s0.y + d0.y * __uint_as_float(u.x & 0xffff0000u);
        const float y2 = s0.z + d0.z * __uint_as_float(u.y << 16), y3 = s0.w + d0.w * __uint_as_float(u.y & 0xffff0000u);
        const float y4 = s1.x + d1.x * __uint_as_float(u.z << 16), y5 = s1.y + d1.y * __uint_as_float(u.z & 0xffff0000u);
        const float y6 = s1.z + d1.z * __uint_as_float(u.w << 16), y7 = s1.w + d1.w * __uint_as_float(u.w & 0xffff0000u);
        uint4 o; o.x = pack2(gelu_tanh(y0), gelu_tanh(y1)); o.y = pack2(gelu_tanh(y2), gelu_tanh(y3)); o.z = pack2(gelu_tanh(y4), gelu_tanh(y5)); o.w = pack2(gelu_tanh(y6), gelu_tanh(y7));
        *reinterpret_cast<uint4*>(G + (size_t)row * 512 + lane * 8) = o;
      }
    }
  }
}

template <int NBT, class KF>
__device__ __forceinline__ void attn_query(const bf16_t* qptr, const bf16_t* P, int kcol, int vcol, bool has_sink, float sink, bf16_t* optr, int lane, KF kf) {
  float q[64];
  {
    const uint4* qp = reinterpret_cast<const uint4*>(qptr);
#pragma unroll
    for (int i = 0; i < 8; ++i) {
      const uint4 w = qp[i];
      q[8 * i + 0] = __uint_as_float(w.x << 16); q[8 * i + 1] = __uint_as_float(w.x & 0xffff0000u);
      q[8 * i + 2] = __uint_as_float(w.y << 16); q[8 * i + 3] = __uint_as_float(w.y & 0xffff0000u);
      q[8 * i + 4] = __uint_as_float(w.z << 16); q[8 * i + 5] = __uint_as_float(w.z & 0xffff0000u);
      q[8 * i + 6] = __uint_as_float(w.w << 16); q[8 * i + 7] = __uint_as_float(w.w & 0xffff0000u);
    }
  }
  float s[NBT]; int kr[NBT];
  float mx = has_sink ? sink : -1e30f;
#pragma unroll
  for (int j = 0; j < NBT; ++j) {
    int krow; float bias;
    const bool valid = kf(j, lane, krow, bias);
    kr[j] = valid ? krow : -1;
    float dot = 0.f;
    if (valid) {
      const uint4* kp = reinterpret_cast<const uint4*>(P + (size_t)krow * INW + kcol);
#pragma unroll
      for (int i = 0; i < 8; ++i) {
        const uint4 w = kp[i];
        dot += q[8 * i + 0] * __uint_as_float(w.x << 16) + q[8 * i + 1] * __uint_as_float(w.x & 0xffff0000u)
             + q[8 * i + 2] * __uint_as_float(w.y << 16) + q[8 * i + 3] * __uint_as_float(w.y & 0xffff0000u)
             + q[8 * i + 4] * __uint_as_float(w.z << 16) + q[8 * i + 5] * __uint_as_float(w.z & 0xffff0000u)
             + q[8 * i + 6] * __uint_as_float(w.w << 16) + q[8 * i + 7] * __uint_as_float(w.w & 0xffff0000u);
      }
    }
    s[j] = valid ? (dot * 0.125f + bias) : -1e30f;
    mx = fmaxf(mx, s[j]);
  }
  mx = wave_max(mx, lane);
  float l = 0.f;
#pragma unroll
  for (int j = 0; j < NBT; ++j) { s[j] = (kr[j] >= 0) ? __expf(s[j] - mx) : 0.f; l += s[j]; }
  l = wave_sum(l, lane);
  if (has_sink) l += __expf(sink - mx);
  float o[64];
#pragma unroll
  for (int i = 0; i < 64; ++i) o[i] = 0.f;
#pragma unroll
  for (int j = 0; j < NBT; ++j) {
    if (kr[j] >= 0) {
      const uint4* vp = reinterpret_cast<const uint4*>(P + (size_t)kr[j] * INW + vcol);
      const float pj = s[j];
#pragma unroll
      for (int i = 0; i < 8; ++i) {
        const uint4 w = vp[i];
        o[8 * i + 0] += pj * __uint_as_float(w.x << 16); o[8 * i + 1] += pj * __uint_as_float(w.x & 0xffff0000u);
        o[8 * i + 2] += pj * __uint_as_float(w.y << 16); o[8 * i + 3] += pj * __uint_as_float(w.y & 0xffff0000u);
        o[8 * i + 4] += pj * __uint_as_float(w.z << 16); o[8 * i + 5] += pj * __uint_as_float(w.z & 0xffff0000u);
        o[8 * i + 6] += pj * __uint_as_float(w.w << 16); o[8 * i + 7] += pj * __uint_as_float(w.w & 0xffff0000u);
      }
    }
  }
#pragma unroll
  for (int i = 0; i < 32; ++i) { const bool up_ = (lane & 32) != 0; const float send = up_ ? o[i] : o[i + 32]; const float keep = up_ ? o[i + 32] : o[i]; o[i] = keep + shx(send, 32, lane); }
#pragma unroll
  for (int i = 0; i < 16; ++i) { const bool up_ = (lane & 16) != 0; const float send = up_ ? o[i] : o[i + 16]; const float keep = up_ ? o[i + 16] : o[i]; o[i] = keep + shx(send, 16, lane); }
#pragma unroll
  for (int i = 0; i < 8; ++i) { const bool up_ = (lane & 8) != 0; const float send = up_ ? o[i] : o[i + 8]; const float keep = up_ ? o[i + 8] : o[i]; o[i] = keep + shx(send, 8, lane); }
#pragma unroll
  for (int i = 0; i < 4; ++i) { const bool up_ = (lane & 4) != 0; const float send = up_ ? o[i] : o[i + 4]; const float keep = up_ ? o[i + 4] : o[i]; o[i] = keep + shx(send, 4, lane); }
#pragma unroll
  for (int i = 0; i < 2; ++i) { const bool up_ = (lane & 2) != 0; const float send = up_ ? o[i] : o[i + 2]; const float keep = up_ ? o[i + 2] : o[i]; o[i] = keep + shx(send, 2, lane); }
  { const bool up_ = (lane & 1) != 0; const float send = up_ ? o[0] : o[1]; const float keep = up_ ? o[1] : o[0]; o[0] = keep + shx(send, 1, lane); }
  optr[lane] = f2bf(o[0] / l);
}

__device__ __forceinline__ void mixer_item_naive(const Params& p, int layer, int item, bool need_ctx, unsigned char* lds_raw) {
  const int tid_ = opaque_tid();
  const bf16_t* P = reinterpret_cast<const bf16_t*>(p.ws + WS_P);
  bf16_t* Y = reinterpret_cast<bf16_t*>(p.ws + WS_Y);
  const int wv = tid_ >> 6;
  if (item < 64) {
    unsigned long long ts0 = 0; if (PROBE_PH == 13) ts0 = wall_clock64();
    ssm_item(p, layer, item, lds_raw);
    if (PROBE_PH == 13) { __syncthreads(); if (tid_ == 0) atomicMax(reinterpret_cast<unsigned*>(p.ws + WS_CTL) + 12288 + layer, (unsigned)(wall_clock64() - ts0)); }
    return; }
  if (item < 320) {
    const int it = item - 64; const int b = it >> 5, blk = (it >> 1) & 15, hk = it & 1;
    const int hq = hk * 4 + (wv >> 1), half = wv & 1;
    const float sink = p.win_sink[layer * 8 + hq];
    for (int qi = 0; qi < 64; ++qi) {
      const int t = blk * 128 + half * 64 + qi;
      const int row = b * SEQ + t;
      attn_query<9>(P + (size_t)row * INW + C_WQ + hq * 64, P, C_WK + hk * 64, C_WV + hk * 64, true, sink, Y + (size_t)row * 1536 + 512 + hq * 64, tid_ & 63,
        [&](int j, int lane, int& krow, float& bias) -> bool {
          bias = 0.f;
          if (j < 5) { const int kp = t - 128 + j * 64 + lane; krow = b * SEQ + kp; return kp >= 0 && kp < SEQ && kp <= t + 128; }
          krow = NLAT + b * CTXL + (j - 5) * 64 + lane; return true;
        });
    }
    return;
  }
  if (item < 576) {
    const int it = item - 320; const int b = it >> 5, h = (it >> 2) & 7, rg = it & 3;
    const int r = rg * 8 + wv;
    int rs = r - 4; rs = rs < 0 ? 0 : (rs > 24 ? 24 : rs);
    const float* rpb = p.na_rpb + ((size_t)layer * 8 + h) * 15 * 31;
    for (int c = 0; c < 64; ++c) {
      const int row = b * SEQ + r * 64 + c;
      int cs = c - 8; cs = cs < 0 ? 0 : (cs > 48 ? 48 : cs);
      attn_query<6>(P + (size_t)row * INW + C_NQ + h * 64, P, C_NK + h * 64, C_NV + h * 64, false, 0.f, Y + (size_t)row * 1536 + 1024 + h * 64, tid_ & 63,
        [&](int j, int lane, int& krow, float& bias) -> bool {
          if (j < 2) {
            const int i = j * 64 + lane; const int kr_ = rs + (i >> 4), kc = cs + (i & 15);
            krow = b * SEQ + kr_ * 64 + kc;
            int dc = kc - c; dc = dc < -15 ? -15 : (dc > 15 ? 15 : dc);
            bias = rpb[(kr_ - r + 7) * 31 + dc + 15];
            return true;
          }
          bias = 0.f; krow = NLAT + b * CTXL + (j - 2) * 64 + lane; return true;
        });
    }
    return;
  }
  if (!need_ctx) return;
  if (item < 608) {
    const int it = item - 576; const int b = it >> 2, qb = it & 3;
    const int hq = wv, hk = hq >> 2;
    const float sink = p.win_sink[layer * 8 + hq];
    for (int qi = 0; qi < 64; ++qi) {
      const int row = NLAT + b * CTXL + qb * 64 + qi;
      attn_query<4>(P + (size_t)row * INW + C_WQ + hq * 64, P, C_WK + hk * 64, C_WV + hk * 64, true, sink, Y + (size_t)row * 1536 + 512 + hq * 64, tid_ & 63,
        [&](int j, int lane, int& krow, float& bias) -> bool { bias = 0.f; krow = NLAT + b * CTXL + j * 64 + lane; return true; });
    }
    return;
  }
  {
    const int it = item - 608; const int b = it >> 2, qb = it & 3;
    const int h = wv;
    for (int qi = 0; qi < 64; ++qi) {
      const int row = NLAT + b * CTXL + qb * 64 + qi;
      attn_query<4>(P + (size_t)row * INW + C_NQ + h * 64, P, C_NK + h * 64, C_NV + h * 64, false, 0.f, Y + (size_t)row * 1536 + 1024 + h * 64, tid_ & 63,
        [&](int j, int lane, int& krow, float& bias) -> bool { bias = 0.f; krow = NLAT + b * CTXL + j * 64 + lane; return true; });
    }
  }
}


constexpr int VT_TOK = CTXL + SEQ;
__device__ __forceinline__ int vt_pos(int tpos) { const int k = tpos & 31; return (tpos & ~31) + (((k >> 2) & 1) << 4) + (((k >> 3) << 2) | (k & 3)); }
template <class TileFn, class ScoreFn>
__device__ __forceinline__ void attn_wave_d1(const bf16_t* qrow0, int ntiles, TileFn tilefn, ScoreFn scorefn, float m_init, float l_init, bf16_t* orow0, int lane) {
  const int l31 = lane & 31, hh = lane >> 5;
  bf16x8 Qop[2][4];
#pragma unroll
  for (int qb = 0; qb < 2; ++qb)
#pragma unroll
    for (int s = 0; s < 4; ++s) {
      union { uint4 u; bf16x8 b; } q; q.u = *reinterpret_cast<const uint4*>(qrow0 + (size_t)(32 * qb + l31) * INW + 32 * hh + 8 * s);
      unsigned w[4] = {q.u.x, q.u.y, q.u.z, q.u.w};
#pragma unroll
      for (int j = 0; j < 4; ++j) w[j] = pack2(__uint_as_float(w[j] << 16) * 0.18033688011112042f, __uint_as_float(w[j] & 0xffff0000u) * 0.18033688011112042f);
      q.u = uint4{w[0], w[1], w[2], w[3]}; Qop[qb][s] = q.b;
    }
  f32x16 O[2][2];
#pragma unroll
  for (int a = 0; a < 2; ++a)
#pragma unroll
    for (int b2 = 0; b2 < 2; ++b2)
#pragma unroll
      for (int r = 0; r < 16; ++r) O[a][b2][r] = 0.f;
  float m[2] = {m_init, m_init};
  float l[2]; l[0] = hh ? 0.f : l_init; l[1] = l[0];
  const unsigned kvo = (unsigned)(hh * 32 + l31) * 16u;
  const bf16_t* kp; const bf16_t* vp; int info;
  tilefn(0, kp, vp, info);
  bf16x8 Kc[4]; bf16x8 Vc[2][2];
#pragma unroll
  for (int s = 0; s < 4; ++s) Kc[s] = ldg<bf16x8>(kp, kvo + 1024 * s);
#pragma unroll
  for (int db = 0; db < 2; ++db)
#pragma unroll
    for (int s = 0; s < 2; ++s) Vc[db][s] = ldg<bf16x8>(vp, kvo + (unsigned)((db * 2 + s) * 1024));
  for (int t = 0; t < ntiles; ++t) {
    const int info_c = info;
    const int tn = (t + 1 < ntiles) ? (t + 1) : t;
    tilefn(tn, kp, vp, info);
    bf16x8 Kn[4]; bf16x8 Vn[2][2];
#pragma unroll
    for (int s = 0; s < 4; ++s) Kn[s] = ldg<bf16x8>(kp, kvo + 1024 * s);
#pragma unroll
    for (int db = 0; db < 2; ++db)
#pragma unroll
      for (int s = 0; s < 2; ++s) Vn[db][s] = ldg<bf16x8>(vp, kvo + (unsigned)((db * 2 + s) * 1024));
    f32x16 S[2];
#pragma unroll
    for (int qb = 0; qb < 2; ++qb) {
#pragma unroll
      for (int r = 0; r < 16; ++r) S[qb][r] = 0.f;
#pragma unroll
      for (int s = 0; s < 4; ++s) S[qb] = __builtin_amdgcn_mfma_f32_32x32x16_bf16(Kc[s], Qop[qb][s], S[qb], 0, 0, 0);
    }
    bf16x8 Pop[2][2];
#pragma unroll
    for (int qb = 0; qb < 2; ++qb) {
      scorefn(info_c, qb, S[qb]);
      float mt = S[qb][0];
#pragma unroll
      for (int r = 1; r < 16; ++r) mt = fmaxf(mt, S[qb][r]);
      mt = fmaxf(mt, shx32(mt, lane));
      const float mnew = fmaxf(m[qb], mt);
      if (__any(mnew > m[qb])) {
        const float alpha = __builtin_amdgcn_exp2f(m[qb] - mnew);
        l[qb] *= alpha;
#pragma unroll
        for (int db = 0; db < 2; ++db)
#pragma unroll
          for (int r = 0; r < 16; ++r) O[db][qb][r] *= alpha;
        m[qb] = mnew;
      }
      float ls = 0.f;
#pragma unroll
      for (int r = 0; r < 16; ++r) { const float pv = __builtin_amdgcn_exp2f(S[qb][r] - mnew); S[qb][r] = pv; ls += pv; }
      l[qb] += ls;
#pragma unroll
      for (int s = 0; s < 2; ++s) {
        union { unsigned u[4]; bf16x8 b; } pk;
#pragma unroll
        for (int j = 0; j < 4; ++j) pk.u[j] = pack2(S[qb][8 * s + 2 * j], S[qb][8 * s + 2 * j + 1]);
        Pop[qb][s] = pk.b;
      }
    }
#pragma unroll
    for (int db = 0; db < 2; ++db)
#pragma unroll
      for (int s = 0; s < 2; ++s) {
#pragma unroll
        for (int qb = 0; qb < 2; ++qb) O[db][qb] = __builtin_amdgcn_mfma_f32_32x32x16_bf16(Vc[db][s], Pop[qb][s], O[db][qb], 0, 0, 0);
      }
#pragma unroll
    for (int s = 0; s < 4; ++s) Kc[s] = Kn[s];
#pragma unroll
    for (int db = 0; db < 2; ++db)
#pragma unroll
      for (int s = 0; s < 2; ++s) Vc[db][s] = Vn[db][s];
  }
#pragma unroll
  for (int qb = 0; qb < 2; ++qb) {
    const float lt = l[qb] + shx32(l[qb], lane);
    const float inv = 1.0f / lt;
    bf16_t* orow = orow0 + (size_t)(32 * qb + l31) * 1536;
#pragma unroll
    for (int db = 0; db < 2; ++db)
#pragma unroll
      for (int gq = 0; gq < 4; ++gq)
        st_bf4(orow + 32 * db + 8 * gq + 4 * hh, O[db][qb][4 * gq] * inv, O[db][qb][4 * gq + 1] * inv, O[db][qb][4 * gq + 2] * inv, O[db][qb][4 * gq + 3] * inv);
  }
}

template <class TileFn, class ScoreFn>
__device__ __forceinline__ void attn_wave(const bf16_t* qrow0, int ntiles, TileFn tilefn, ScoreFn scorefn, float m_init, float l_init, bf16_t* orow0, int lane, LAS unsigned char* wq) {
  const int l31 = lane & 31, hh = lane >> 5;
  const unsigned kvo = (unsigned)(hh * 32 + l31) * 16u;
#pragma unroll
  for (int qb = 0; qb < 2; ++qb)
#pragma unroll
    for (int s = 0; s < 4; ++s) {
      union { uint4 u; bf16x8 b; } q; q.u = *reinterpret_cast<const uint4*>(qrow0 + (size_t)(32 * qb + l31) * INW + 32 * hh + 8 * s);
      unsigned w[4] = {q.u.x, q.u.y, q.u.z, q.u.w};
#pragma unroll
      for (int j = 0; j < 4; ++j) w[j] = pack2(__uint_as_float(w[j] << 16) * 0.18033688011112042f, __uint_as_float(w[j] & 0xffff0000u) * 0.18033688011112042f);
      q.u = uint4{w[0], w[1], w[2], w[3]};
      *(LAS bf16x8*)(wq + kvo + (qb * 4 + s) * 1024) = q.b;
    }
  f32x16 O[2][2];
#pragma unroll
  for (int a = 0; a < 2; ++a)
#pragma unroll
    for (int b2 = 0; b2 < 2; ++b2)
#pragma unroll
      for (int r = 0; r < 16; ++r) O[a][b2][r] = 0.f;
  float m[2] = {m_init, m_init};
  float l[2]; l[0] = hh ? 0.f : l_init; l[1] = l[0];
  auto loadk = [&](int i, bf16x8 (&Kd)[4]) __attribute__((always_inline)) {
    const bf16_t* kp; const bf16_t* vp; int inf; tilefn((i < ntiles) ? i : (ntiles - 1), kp, vp, inf); (void)inf; (void)vp;
#pragma unroll
    for (int s = 0; s < 4; ++s) Kd[s] = ldg<bf16x8>(kp, kvo + 1024 * s);
  };
  auto loadv = [&](int i, bf16x8 (&Vd)[2][2]) __attribute__((always_inline)) {
    const bf16_t* kp; const bf16_t* vp; int inf; tilefn((i < ntiles) ? i : (ntiles - 1), kp, vp, inf); (void)inf; (void)kp;
#pragma unroll
    for (int db = 0; db < 2; ++db)
#pragma unroll
      for (int s = 0; s < 2; ++s) Vd[db][s] = ldg<bf16x8>(vp, kvo + (unsigned)((db * 2 + s) * 1024));
  };
  auto body = [&](int t, bf16x8 (&Kc)[4], bf16x8 (&Vc)[2][2], bf16x8 (&Kl)[4], bf16x8 (&Vl)[2][2]) __attribute__((always_inline)) {
    SCHED;
    loadk(t + 2, Kl); loadv(t + 1, Vl);
    int info_c; { const bf16_t* kd; const bf16_t* vd; tilefn(t, kd, vd, info_c); (void)kd; (void)vd; }
    unsigned qo = kvo; asm volatile("" : "+v"(qo));
    f32x16 S[2];
#pragma unroll
    for (int qb = 0; qb < 2; ++qb) {
#pragma unroll
      for (int r = 0; r < 16; ++r) S[qb][r] = 0.f;
#pragma unroll
      for (int s = 0; s < 4; ++s) S[qb] = __builtin_amdgcn_mfma_f32_32x32x16_bf16(Kc[s], *(const LAS bf16x8*)(wq + qo + (qb * 4 + s) * 1024), S[qb], 0, 0, 0);
      if (qb == 0) SCHED;
    }
    bf16x8 Pop[2][2];
#pragma unroll
    for (int qb = 0; qb < 2; ++qb) {
      scorefn(info_c, qb, S[qb]);
      float mt = S[qb][0];
#pragma unroll
      for (int r = 1; r < 16; ++r) mt = fmaxf(mt, S[qb][r]);
      mt = fmaxf(mt, shx32(mt, lane));
      const float mnew = fmaxf(m[qb], mt);
      if (__any(mnew > m[qb])) {
        const float alpha = __builtin_amdgcn_exp2f(m[qb] - mnew);
        l[qb] *= alpha;
#pragma unroll
        for (int db = 0; db < 2; ++db)
#pragma unroll
          for (int r = 0; r < 16; ++r) O[db][qb][r] *= alpha;
        m[qb] = mnew;
      }
      float ls = 0.f;
#pragma unroll
      for (int r = 0; r < 16; ++r) { const float pv = __builtin_amdgcn_exp2f(S[qb][r] - mnew); S[qb][r] = pv; ls += pv; }
      l[qb] += ls;
#pragma unroll
      for (int s = 0; s < 2; ++s) {
        union { unsigned u[4]; bf16x8 b; } pk;
#pragma unroll
        for (int j = 0; j < 4; ++j) pk.u[j] = pack2(S[qb][8 * s + 2 * j], S[qb][8 * s + 2 * j + 1]);
        Pop[qb][s] = pk.b;
      }
    }
#pragma unroll
    for (int db = 0; db < 2; ++db)
#pragma unroll
      for (int s = 0; s < 2; ++s) {
#pragma unroll
        for (int qb = 0; qb < 2; ++qb) O[db][qb] = __builtin_amdgcn_mfma_f32_32x32x16_bf16(Vc[db][s], Pop[qb][s], O[db][qb], 0, 0, 0);
      }
  };
  bf16x8 K0[4], K1[4], K2[4]; bf16x8 V0[2][2], V1[2][2];
  loadk(0, K0); loadv(0, V0); loadk(1, K1);
  for (int t = 0; t < ntiles; t += 6) {
    body(t, K0, V0, K2, V1);
    if (t + 1 < ntiles) body(t + 1, K1, V1, K0, V0);
    if (t + 2 < ntiles) body(t + 2, K2, V0, K1, V1);
    if (t + 3 < ntiles) body(t + 3, K0, V1, K2, V0);
    if (t + 4 < ntiles) body(t + 4, K1, V0, K0, V1);
    if (t + 5 < ntiles) body(t + 5, K2, V1, K1, V0);
  }
#pragma unroll
  for (int qb = 0; qb < 2; ++qb) {
    const float lt = l[qb] + shx32(l[qb], lane);
    const float inv = 1.0f / lt;
    bf16_t* orow = orow0 + (size_t)(32 * qb + l31) * 1536;
#pragma unroll
    for (int db = 0; db < 2; ++db)
#pragma unroll
      for (int gq = 0; gq < 4; ++gq)
        st_bf4(orow + 32 * db + 8 * gq + 4 * hh, O[db][qb][4 * gq] * inv, O[db][qb][4 * gq + 1] * inv, O[db][qb][4 * gq + 2] * inv, O[db][qb][4 * gq + 3] * inv);
  }
}

__device__ __forceinline__ void mixer_item(const Params& p, int layer, int item, bool need_ctx, unsigned char* lds_raw) {
  const int tid_ = opaque_tid();
  const bf16_t* P = reinterpret_cast<const bf16_t*>(p.ws + WS_P);
  const bf16_t* VT = reinterpret_cast<const bf16_t*>(p.ws + WS_VT);
  const bf16_t* KT = reinterpret_cast<const bf16_t*>(p.ws + WS_KT);
  bf16_t* Y = reinterpret_cast<bf16_t*>(p.ws + WS_Y);
  const int wv = tid_ >> 6, lane = tid_ & 63;
  LAS unsigned char* wq = (LAS unsigned char*)lds_raw + wv * 8192;
  if (item < 128) {
    unsigned long long ts0 = 0; if (PROBE_PH == 13) ts0 = wall_clock64();
    ssm_item(p, layer, item, lds_raw);
    if (PROBE_PH == 13) { __syncthreads(); if (tid_ == 0) atomicMax(reinterpret_cast<unsigned*>(p.ws + WS_CTL) + 12288 + layer, (unsigned)(wall_clock64() - ts0)); }
    return; }
  if (item < 384) {
    const int it = item - 128; const int b = it >> 5, blk = (it >> 1) & 15, hk = it & 1;
    const int hq = hk * 4 + (wv >> 1), half = wv & 1;
    const float sink = p.win_sink[layer * 8 + hq] * 1.4426950408889634f;
    const int t0 = blk * 128 + half * 64;
    int ilo = 0, ihi = 10;
    if (t0 - 128 < 0) ilo = (128 - t0) >> 5;
    if (t0 + 192 > SEQ) ihi = 10 - ((t0 + 192 - SEQ) >> 5);
    const bf16_t* kth = KT + (size_t)(b * 10 + hk) * 72 * 2048;
    const bf16_t* vth = VT + (size_t)(b * 10 + hk) * 72 * 2048;
    const int qrow0 = b * SEQ + t0;
    attn_wave(P + (size_t)qrow0 * INW + C_WQ + hq * 64, 8 + (ihi - ilo),
      [&](int i, const bf16_t*& kp, const bf16_t*& vp, int& info) {
        if (i < 8) { kp = kth + i * 2048; vp = vth + i * 2048; info = -100000; }
        else { const int key0 = t0 - 128 + 32 * (i - 8 + ilo); const int tl = 8 + (key0 >> 5); kp = kth + tl * 2048; vp = vth + tl * 2048; info = key0; }
      },
      [&](int info, int qb, f32x16& S) {
        if (info != -100000 && (info < t0 - 64 || info > t0 + 96)) {
          const int d0 = info + 4 * (lane >> 5) - (t0 + 32 * qb + (lane & 31));
#pragma unroll
          for (int r = 0; r < 16; ++r) { const int d = d0 + (r & 3) + 8 * (r >> 2); S[r] = (d >= -128 && d <= 128) ? S[r] : -1e30f; }
        }
      }, sink, 1.0f, Y + (size_t)qrow0 * 1536 + 512 + hq * 64, lane, wq);
    return;
  }
  if (item < 640) {
    const int it = item - 384; const int b = it >> 5, h = (it >> 2) & 7, rg = it & 3;
    const int r = rg * 8 + wv;
    int rs = r - 4; rs = rs < 0 ? 0 : (rs > 24 ? 24 : rs);
    float* tbl = reinterpret_cast<float*>(lds_raw + LDS_TAB);
    __syncthreads();
    { const float* rpb = p.na_rpb + ((size_t)layer * 8 + h) * 15 * 31; for (int i = tid_; i < 15 * 31 + 128; i += NTHR) { const int j = i - 64; tbl[i] = (j >= 0 && j < 15 * 31) ? rpb[j] * 1.4426950408889634f : 0.f; } }
    __syncthreads();
    const bf16_t* kth = KT + (size_t)(b * 10 + 2 + h) * 72 * 2048;
    const bf16_t* vth = VT + (size_t)(b * 10 + 2 + h) * 72 * 2048;
    const int qrow0 = b * SEQ + r * 64;
    attn_wave_d1(P + (size_t)qrow0 * INW + C_NQ + h * 64, 8 + 16,
      [&](int i, const bf16_t*& kp, const bf16_t*& vp, int& info) {
        if (i < 8) { kp = kth + i * 2048; vp = vth + i * 2048; info = -1; }
        else { const int j = i - 8; const int tl = 8 + rs * 2 + j; kp = kth + tl * 2048; vp = vth + tl * 2048; info = j; }
      },
      [&](int info, int qb, f32x16& S) {
        if (info < 0) {
#pragma unroll
          for (int r2 = 0; r2 < 16; ++r2) { }
        } else {
          const int kr = rs + (info >> 1), jh = info & 1;
          const int qc = 32 * qb + (lane & 31);
          int cs = qc - 8; cs = cs < 0 ? 0 : (cs > 48 ? 48 : cs);
          const int kc0 = jh * 32 + 4 * (lane >> 5);
          const float* tb = tbl + 64 + (kr - r + 7) * 31 + kc0 - qc + 15;
          float tv[16];
#pragma unroll
          for (int r2 = 0; r2 < 16; ++r2) tv[r2] = tb[(r2 & 3) + 8 * (r2 >> 2)];
#pragma unroll
          for (int r2 = 0; r2 < 16; ++r2) {
            const int kc = kc0 + (r2 & 3) + 8 * (r2 >> 2);
            S[r2] = (kc >= cs && kc < cs + 16) ? (S[r2] + tv[r2]) : -1e30f;
          }
        }
      }, -1e30f, 0.0f, Y + (size_t)qrow0 * 1536 + 1024 + h * 64, lane);
    return;
  }
  if (!need_ctx) return;
  if (item < 672) {
    const int it = item - 640; const int b = it >> 2, qb4 = it & 3;
    const int hq = wv, hk = hq >> 2;
    const float sink = p.win_sink[layer * 8 + hq] * 1.4426950408889634f;
    const bf16_t* kth = KT + (size_t)(b * 10 + hk) * 72 * 2048;
    const bf16_t* vth = VT + (size_t)(b * 10 + hk) * 72 * 2048;
    const int qrow0 = NLAT + b * CTXL + qb4 * 64;
    attn_wave(P + (size_t)qrow0 * INW + C_WQ + hq * 64, 8,
      [&](int i, const bf16_t*& kp, const bf16_t*& vp, int& info) { kp = kth + i * 2048; vp = vth + i * 2048; info = 0; },
      [&](int info, int qb, f32x16& S) {
#pragma unroll
        for (int r2 = 0; r2 < 16; ++r2) { }
      }, sink, 1.0f, Y + (size_t)qrow0 * 1536 + 512 + hq * 64, lane, wq);
    return;
  }
  {
    const int it = item - 672; const int b = it >> 2, qb4 = it & 3;
    const int h = wv;
    const bf16_t* kth = KT + (size_t)(b * 10 + 2 + h) * 72 * 2048;
    const bf16_t* vth = VT + (size_t)(b * 10 + 2 + h) * 72 * 2048;
    const int qrow0 = NLAT + b * CTXL + qb4 * 64;
    attn_wave(P + (size_t)qrow0 * INW + C_NQ + h * 64, 8,
      [&](int i, const bf16_t*& kp, const bf16_t*& vp, int& info) { kp = kth + i * 2048; vp = vth + i * 2048; info = 0; },
      [&](int info, int qb, f32x16& S) {
#pragma unroll
        for (int r2 = 0; r2 < 16; ++r2) { }
      }, -1e30f, 0.0f, Y + (size_t)qrow0 * 1536 + 1024 + h * 64, lane, wq);
  }
}

__device__ __forceinline__ void split8(const float* v, bf16x8& hi, bf16x8& lo) {
  union { unsigned u[4]; bf16x8 b; } h, l;
#pragma unroll
  for (int i = 0; i < 4; ++i) {
    const unsigned u = pack2(v[2 * i], v[2 * i + 1]);
    h.u[i] = u;
    l.u[i] = pack2(v[2 * i] - __uint_as_float(u << 16), v[2 * i + 1] - __uint_as_float(u & 0xffff0000u));
  }
  hi = h.b; lo = l.b;
}
constexpr int RT_PITCH = 1028;
#define ROUTE_LOAD(xd, md, g_) do { \
    _Pragma("unroll") for (int tt = 0; tt < 2; ++tt) { \
      const int row_ = (g_) * 16 + wv + 8 * tt; const float* xi_ = stream_row_in(p, layer, row_); \
      _Pragma("unroll") for (int i = 0; i < 4; ++i) { xd[tt][i] = *reinterpret_cast<const float4*>(xi_ + i * 256 + lane * 4); md[tt][i] = *reinterpret_cast<const uint2*>(MBp + (size_t)row_ * D + i * 256 + lane * 4); } \
    } } while (0)
#define ROUTE_MODLOAD(g_) do { const float* ms_ = mod + ((size_t)layer * 9 + row_modidx((g_) * 16)) * 6144 + 2 * 1024; \
    mdn0 = *reinterpret_cast<const float4*>(ms_ + tid_ * 4); if (tid_ < 256) mdn1 = *reinterpret_cast<const float4*>(ms_ + 2048 + tid_ * 4); } while (0)
#define ROUTE_MODSTORE(buf_) do { *reinterpret_cast<float4*>((buf_) + tid_ * 4) = mdn0; if (tid_ < 256) *reinterpret_cast<float4*>((buf_) + 2048 + tid_ * 4) = mdn1; } while (0)
__device__ __forceinline__ void route_phase(const Params& p, int layer, int ntok, float* lds_f) {
  const int tid_ = opaque_tid();
  const float* mod = reinterpret_cast<const float*>(p.ws + WS_MOD);
  bf16_t* F = reinterpret_cast<bf16_t*>(p.ws + WS_H);
  int* tke = reinterpret_cast<int*>(p.ws + WS_TKE);
  int* tkp = reinterpret_cast<int*>(p.ws + WS_TKP);
  float* tkg = reinterpret_cast<float*>(p.ws + WS_TKG);
  int* tlist = reinterpret_cast<int*>(p.ws + WS_TLIST);
  unsigned* cnt = reinterpret_cast<unsigned*>(p.ws + WS_CTL) + CW_CNT + layer * 32;
  const bf16_t* MBp = reinterpret_cast<const bf16_t*>(p.ws + WS_S) + (size_t)NTOK * D;
  const int lane = tid_ & 63, wv = tid_ >> 6;
  float* frow = lds_f;
  float* part = lds_f + 16 * RT_PITCH;
  int* hist = reinterpret_cast<int*>(part + 16 * 8 * 32);
  int* sel = hist + 64;
  float* selg = reinterpret_cast<float*>(sel + 8 * 16 * 4);
  float* modb = selg + 8 * 16 * 4;
  float* gwl = modb + 2 * 3072;
  const float* gw = p.norm_ffn + layer * D;
  const float* rw = p.router_w + (size_t)layer * D * NEXP;
  const float rb = p.router_b[layer * NEXP + (lane & 31)];
  const int fr = lane & 15, fq = lane >> 4;
  bf16x8 wh[4][2], wl[4][2];
#pragma unroll
  for (int s = 0; s < 4; ++s)
#pragma unroll
    for (int n = 0; n < 2; ++n) {
      float w8[8];
#pragma unroll
      for (int i = 0; i < 8; ++i) w8[i] = rw[(size_t)(wv * 128 + s * 32 + fq * 8 + i) * NEXP + n * 16 + fr];
      split8(w8, wh[s][n], wl[s][n]);
    }
  if (tid_ < 64) hist[tid_] = 0;
  const int ngroups = ntok >> 4;
  int lg = 0, cur = 0;
  float4 xq[2][4], xn[2][4]; uint2 mq[2][4], mn[2][4];
  float4 mdn0 = {0.f, 0.f, 0.f, 0.f}, mdn1 = {0.f, 0.f, 0.f, 0.f};
  if (tid_ < 256) *reinterpret_cast<float4*>(gwl + tid_ * 4) = *reinterpret_cast<const float4*>(gw + tid_ * 4);
  if ((int)blockIdx.x < ngroups) { ROUTE_MODLOAD((int)blockIdx.x); ROUTE_MODSTORE(modb); ROUTE_LOAD(xq, mq, (int)blockIdx.x); }
  __syncthreads();
  for (int grp = blockIdx.x; grp < ngroups; grp += gridDim.x, ++lg, cur ^= 1) {
    const int ng = grp + (int)gridDim.x; const bool hasn = ng < ngroups;
    if (hasn) { ROUTE_MODLOAD(ng); ROUTE_LOAD(xn, mn, ng); }
    {
      const float* mcur = modb + cur * 3072;
#pragma unroll
      for (int tt = 0; tt < 2; ++tt) {
        const int row = grp * 16 + wv + 8 * tt;
        float* xr = stream_row(p, row);
        float v[16];
#pragma unroll
        for (int i = 0; i < 4; ++i) {
          const int c = i * 256 + lane * 4;
          float4 q = xq[tt][i]; const float4 g2 = *reinterpret_cast<const float4*>(mcur + c); const uint2 mm = mq[tt][i];
          q.x += g2.x * __uint_as_float(mm.x << 16); q.y += g2.y * __uint_as_float(mm.x & 0xffff0000u); q.z += g2.z * __uint_as_float(mm.y << 16); q.w += g2.w * __uint_as_float(mm.y & 0xffff0000u);
          *reinterpret_cast<float4*>(xr + c) = q;
          v[4 * i] = q.x; v[4 * i + 1] = q.y; v[4 * i + 2] = q.z; v[4 * i + 3] = q.w;
        }
        float ss = 0.f;
#pragma unroll
        for (int i = 0; i < 16; ++i) ss += v[i] * v[i];
        ss = wave_sum(ss, lane);
        const float rinv = rsqrtf(ss * (1.0f / D) + 1e-6f);
#pragma unroll
        for (int i = 0; i < 4; ++i) {
          const int c = i * 256 + lane * 4;
          const float4 g = *reinterpret_cast<const float4*>(gwl + c);
          const float4 sh = *reinterpret_cast<const float4*>(mcur + 1024 + c);
          const float4 sc = *reinterpret_cast<const float4*>(mcur + 2048 + c);
          const float f0 = v[4 * i] * rinv * g.x * (1.f + sc.x) + sh.x, f1 = v[4 * i + 1] * rinv * g.y * (1.f + sc.y) + sh.y;
          const float f2 = v[4 * i + 2] * rinv * g.z * (1.f + sc.z) + sh.z, f3 = v[4 * i + 3] * rinv * g.w * (1.f + sc.w) + sh.w;
          st_bf4(F + (size_t)row * D + c, f0, f1, f2, f3);
          *reinterpret_cast<float4*>(frow + (wv + 8 * tt) * RT_PITCH + c) = float4{f0, f1, f2, f3};
        }
      }
    }
    if (hasn) ROUTE_MODSTORE(modb + (cur ^ 1) * 3072);
    __syncthreads();
    {
      f32x4 acc0 = {0.f, 0.f, 0.f, 0.f}, acc1 = {0.f, 0.f, 0.f, 0.f};
#pragma unroll
      for (int s = 0; s < 4; ++s) {
        const float* fp = frow + fr * RT_PITCH + wv * 128 + s * 32 + fq * 8;
        const float4 x0 = *reinterpret_cast<const float4*>(fp), x1 = *reinterpret_cast<const float4*>(fp + 4);
        const float x8[8] = {x0.x, x0.y, x0.z, x0.w, x1.x, x1.y, x1.z, x1.w};
        bf16x8 xh, xl; split8(x8, xh, xl);
        acc0 = __builtin_amdgcn_mfma_f32_16x16x32_bf16(xl, wh[s][0], acc0, 0, 0, 0);
        acc1 = __builtin_amdgcn_mfma_f32_16x16x32_bf16(xl, wh[s][1], acc1, 0, 0, 0);
        acc0 = __builtin_amdgcn_mfma_f32_16x16x32_bf16(xh, wl[s][0], acc0, 0, 0, 0);
        acc1 = __builtin_amdgcn_mfma_f32_16x16x32_bf16(xh, wl[s][1], acc1, 0, 0, 0);
        acc0 = __builtin_amdgcn_mfma_f32_16x16x32_bf16(xh, wh[s][0], acc0, 0, 0, 0);
        acc1 = __builtin_amdgcn_mfma_f32_16x16x32_bf16(xh, wh[s][1], acc1, 0, 0, 0);
      }
#pragma unroll
      for (int r = 0; r < 4; ++r) {
        part[((4 * fq + r) * 8 + wv) * 32 + fr] = acc0[r];
        part[((4 * fq + r) * 8 + wv) * 32 + 16 + fr] = acc1[r];
      }
    }
    __syncthreads();
    {
      const int ee = lane & 31, tsel = wv + 8 * (lane >> 5);
      float acc = 0.f;
#pragma unroll
      for (int k2 = 0; k2 < 8; ++k2) acc += part[(tsel * 8 + k2) * 32 + ee];
      const float logit = acc + rb;
      int sel_e[4]; float sel_v[4];
      float cur = logit;
#pragma unroll
      for (int k = 0; k < 4; ++k) {
        float bv = cur; int bi = ee;
#pragma unroll
        for (int o = 16; o >= 1; o >>= 1) {
          const float ov = shx(bv, o, lane); const int oi = shx(bi, o, lane);
          if (ov > bv || (ov == bv && oi < bi)) { bv = ov; bi = oi; }
        }
        sel_e[k] = bi; sel_v[k] = bv;
        if (ee == bi) cur = -3.0e38f;
      }
      const float m0 = sel_v[0];
      const float e0 = 1.f, e1 = __expf(sel_v[1] - m0), e2 = __expf(sel_v[2] - m0), e3 = __expf(sel_v[3] - m0);
      const float inv = 1.f / (e0 + e1 + e2 + e3);
      if (ee < 4) {
        const int ex = (ee == 0) ? sel_e[0] : (ee == 1) ? sel_e[1] : (ee == 2) ? sel_e[2] : sel_e[3];
        const float gg = ((ee == 0) ? e0 : (ee == 1) ? e1 : (ee == 2) ? e2 : e3) * inv;
        const int lp = atomicAdd(&hist[ex], 1);
        sel[(lg * 16 + tsel) * 4 + ee] = ex | (lp << 8); selg[(lg * 16 + tsel) * 4 + ee] = gg;
      }
    }
#pragma unroll
    for (int tt = 0; tt < 2; ++tt)
#pragma unroll
      for (int i = 0; i < 4; ++i) { xq[tt][i] = xn[tt][i]; mq[tt][i] = mn[tt][i]; }
  }
  __syncthreads();
  if (tid_ < 32) hist[32 + tid_] = (int)__hip_atomic_fetch_add(&cnt[tid_], (unsigned)hist[tid_], __ATOMIC_RELAXED, __HIP_MEMORY_SCOPE_AGENT);
  __syncthreads();
  for (int i = tid_; i < lg * 64; i += NTHR) {
    const int g2 = i >> 6, w2 = (i >> 2) & 15, k2 = i & 3;
    const int row = (blockIdx.x + g2 * gridDim.x) * 16 + w2;
    const int pk = sel[i]; const int ex = pk & 255; const int pos = hist[32 + ex] + (pk >> 8);
    tke[row * 4 + k2] = ex; tkp[row * 4 + k2] = pos; tkg[row * 4 + k2] = selg[i];
    tlist[(size_t)ex * NTOK + pos] = row;
  }
}

__device__ __forceinline__ void dense_unit(GUnit& u, const bf16_t* A, int lda, int ar0, const bf16_t* Bt, int ldb, int br0, int tz) {
  u.a0 = (const char*)(A + (size_t)ar0 * lda); u.a1 = (const char*)(A + (size_t)(ar0 + 128) * lda);
  u.b0 = (const char*)(Bt + (size_t)br0 * ldb); u.b1 = (const char*)(Bt + (size_t)(br0 + 128) * ldb);
  u.va00 = stage_voff(tz, 0, lda); u.va01 = stage_voff(tz, 1, lda); u.va10 = u.va00; u.va11 = u.va01;
}

__device__ __forceinline__ void phase_inproj(const Params& p, int layer, LAS unsigned char* lds, unsigned long long* tk = nullptr, unsigned long long* te = nullptr) {
  const int G = gridDim.x, bid = blockIdx.x;
  const bf16_t* A = reinterpret_cast<const bf16_t*>(p.ws + WS_H);
  const bf16_t* Bt = reinterpret_cast<const bf16_t*>(p.ws + WS_WIN) + (size_t)layer * INW * 1024;
  bf16_t* P = reinterpret_cast<bf16_t*>(p.ws + WS_P);
  bf16_t* VT = reinterpret_cast<bf16_t*>(p.ws + WS_VT);
  bf16_t* KTw = reinterpret_cast<bf16_t*>(p.ws + WS_KT);
  const int tz = opaque_tid();
  LAS float* tab = (LAS float*)(lds + LDS_TAB);
  __syncthreads();
  { const float* ropec = reinterpret_cast<const float*>(p.ws + WS_ROPE);
    for (int i = tz; i < 2048; i += NTHR) tab[i] = ropec[i];
    if (tz < 256) { const int w = tz >> 6, d = tz & 63; const float* src = (w == 0) ? p.win_qn : (w == 1) ? p.win_kn : (w == 2) ? p.na_qn : p.na_kn; tab[2048 + tz] = src[layer * 64 + d]; } }
  __syncthreads();
  gemm_stream(lds, 16, tz, stage_voff(tz, 0, 1024), stage_voff(tz, 1, 1024),
    [&](int idx, GUnit& u) -> bool {
      int pm, pn;
      if (layer < DEPTH - 1) { if (!unit_next(idx * G + bid, NTOK / 256, INW / 256, pm, pn)) return false; }
      else {
        const int L = idx * G + bid;
        if (L < 64 * 23) { unit_next(L, 64, 23, pm, pn); }
        else { const int j = L - 64 * 23; if (j >= 8 * 7) return false; const int c = j % 7; pm = 64 + j / 7; pn = (c < 2) ? c : (c == 2) ? 4 : (c + 4); }
      }
      dense_unit(u, A, 1024, pm * 256, Bt, 1024, pn * 256, tz); u.i0 = pm; u.i1 = pn; u.i2 = 0; u.i3 = 0; return true;
    },
    [&](const GUnit& u, f32x4 (&acc)[2][2][4][2], int wr, int wc, int fr, int fq) {
      const int pn = u.i1, br0 = pn * 256, row0 = u.i0 * 256 + wr * 64 + fr, cq = wc * 32 + fq * 4;
      const bool is_head = (pn >= 2 && pn < 11);
      if (!is_head) {
        const bool gate = br0 >= C_GATE;
        const int c8 = wc * 32 + fq * 8;
#pragma unroll
        for (int ai = 0; ai < 2; ++ai)
#pragma unroll
          for (int m = 0; m < 4; ++m) {
            const unsigned ro = ((unsigned)(row0 + ai * 128 + m * 16) * INW + br0 + c8) * 2u;
#pragma unroll
            for (int bj = 0; bj < 2; ++bj) {
              f32x4 lo = acc[ai][bj][m][0], hi = acc[ai][bj][m][1];
              if (gate) { lo = f32x4{sigmoidf(lo[0]), sigmoidf(lo[1]), sigmoidf(lo[2]), sigmoidf(lo[3])}; hi = f32x4{sigmoidf(hi[0]), sigmoidf(hi[1]), sigmoidf(hi[2]), sigmoidf(hi[3])}; }
              stg_bf8(P, ro + bj * 256, lo, hi);
            }
          }
        return;
      }
      const int hidx = (pn - 2) * 4 + wc;
      const bool is_v = (hidx >= 10 && hidx < 12) || hidx >= 28;
      const bool lat = row0 < NLAT;
      if (is_v) {
        const int hv = (hidx < 12) ? (hidx - 10) : (2 + hidx - 28);
#pragma unroll
        for (int ai = 0; ai < 2; ++ai)
#pragma unroll
          for (int m = 0; m < 4; ++m) {
            const int grow = row0 + ai * 128 + m * 16;
            const int bb = lat ? (grow >> 11) : ((grow - NLAT) >> 8);
            const int tpos = lat ? (CTXL + (grow & 2047)) : ((grow - NLAT) & 255);
            const int pos = vt_pos(tpos & 31);
            const unsigned vo = ((unsigned)(bb * 10 + hv) * 72 + (unsigned)(tpos >> 5)) * 4096u + (unsigned)(((((pos >> 3) & 1) * 2 + (pos >> 4)) * 32 + fq * 4) * 8 + (pos & 7)) * 2u;
#pragma unroll
            for (int bj = 0; bj < 2; ++bj)
#pragma unroll
              for (int n = 0; n < 2; ++n)
#pragma unroll
                for (int j = 0; j < 4; ++j) stg<bf16_t>(VT, vo + (unsigned)(bj * 2048 + (n * 16 + j) * 16), f2bf(acc[ai][bj][m][n][j]));
          }
        return;
      }
      const int wsel = (hidx < 8) ? 0 : (hidx < 10) ? 1 : (hidx < 20) ? 2 : 3;
      f32x4 wv[2][2];
#pragma unroll
      for (int bj = 0; bj < 2; ++bj)
#pragma unroll
        for (int n = 0; n < 2; ++n) wv[bj][n] = *(const LAS f32x4*)(tab + 2048 + wsel * 64 + bj * 32 + n * 16 + fq * 4);
      const bool rope = (hidx < 10) && lat;
      const bool is_k = (wsel & 1) != 0;
      const int hkt = (hidx < 10) ? (hidx - 8) : (2 + hidx - 20);
      const int lane = fq * 16 + fr;
#pragma unroll
      for (int ai = 0; ai < 2; ++ai)
#pragma unroll
        for (int m = 0; m < 4; ++m) {
          const int grow = row0 + ai * 128 + m * 16;
          float ss = 0.f;
#pragma unroll
          for (int bj = 0; bj < 2; ++bj)
#pragma unroll
            for (int n = 0; n < 2; ++n)
#pragma unroll
              for (int j = 0; j < 4; ++j) ss += acc[ai][bj][m][n][j] * acc[ai][bj][m][n][j];
          ss += shx(ss, 16, lane); ss += shx32(ss, lane);
          const float rinv = rsqrtf(ss * (1.0f / 64.0f) + 1e-6f);
          f32x4 y[2][2];
#pragma unroll
          for (int bj = 0; bj < 2; ++bj)
#pragma unroll
            for (int n = 0; n < 2; ++n) y[bj][n] = acc[ai][bj][m][n] * rinv * wv[bj][n];
          if (rope) {
            const int t = grow & 2047;
#pragma unroll
            for (int bj = 0; bj < 2; ++bj) {
              const int pos = bj ? (t & 63) : (t >> 6);
              const f32x4 cs = *(const LAS f32x4*)(tab + pos * 16 + fq * 4), sn = *(const LAS f32x4*)(tab + 1024 + pos * 16 + fq * 4);
              const f32x4 t1 = y[bj][0], t2 = y[bj][1];
              y[bj][0] = t1 * cs - t2 * sn; y[bj][1] = t1 * sn + t2 * cs;
            }
          }
          if (is_k) {
            const int bb = lat ? (grow >> 11) : ((grow - NLAT) >> 8);
            const int tpos = lat ? (CTXL + (grow & 2047)) : ((grow - NLAT) & 255);
            const unsigned ko = ((unsigned)(bb * 10 + hkt) * 72 + (unsigned)(tpos >> 5)) * 4096u + (unsigned)((((fq >> 1) * 2) * 32 + (tpos & 31)) * 8 + (fq & 1) * 4) * 2u;
#pragma unroll
            for (int bj = 0; bj < 2; ++bj)
#pragma unroll
              for (int n = 0; n < 2; ++n) stg_bf4(KTw, ko + (unsigned)((n * 4 + bj) * 512), y[bj][n][0], y[bj][n][1], y[bj][n][2], y[bj][n][3]);
          } else {
            const unsigned ro = ((unsigned)grow * INW + C_WQ + hidx * 64 + fq * 4) * 2u;
#pragma unroll
            for (int bj = 0; bj < 2; ++bj)
#pragma unroll
              for (int n = 0; n < 2; ++n) stg_bf4(P, ro + (bj * 32 + n * 16) * 2, y[bj][n][0], y[bj][n][1], y[bj][n][2], y[bj][n][3]);
          }
        }
    }, tk, te);
}

__device__ __forceinline__ void glu_item(const Params& p, int layer, int pm, int pn, LAS unsigned char* lds) {
  const bf16_t* A = reinterpret_cast<const bf16_t*>(p.ws + WS_G);
  const bf16_t* Bt = reinterpret_cast<const bf16_t*>(p.ws + WS_WGLU) + (size_t)layer * 512 * 512;
  bf16_t* Y = reinterpret_cast<bf16_t*>(p.ws + WS_Y);
  const int tz = opaque_tid();
  if (tz == 0) {
    const int bb = (pm < 64) ? (pm >> 3) : (pm - 64);
    unsigned* cnt = reinterpret_cast<unsigned*>(p.ws + WS_CTL) + CW_SSMD + (layer * 8 + bb) * 64;
    unsigned spins = 0;
    while (__hip_atomic_load(cnt, __ATOMIC_RELAXED, __HIP_MEMORY_SCOPE_AGENT) < 16u) { __builtin_amdgcn_s_sleep(2); if (++spins > (1u << 22)) break; }
    __builtin_amdgcn_fence(__ATOMIC_ACQUIRE, "agent");
    asm volatile("s_waitcnt vmcnt(0)" ::: "memory");
  }
  __syncthreads();
  gemm_stream(lds, 8, tz, stage_voff(tz, 0, 512), stage_voff(tz, 1, 512),
    [&](int idx, GUnit& u) -> bool {
      if (idx > 0) return false;
      dense_unit(u, A, 512, pm * 256, Bt, 512, pn * 256, tz); u.i0 = pm; u.i1 = pn; u.i2 = 0; u.i3 = 0; return true;
    },
    [&](const GUnit& u, f32x4 (&acc)[2][2][4][2], int wr, int wc, int fr, int fq) {
      const int row0 = u.i0 * 256 + wr * 64 + fr, col = u.i1 * 256 + wc * 32 + fq * 8;
      uint4 gv[2][4][2];
#pragma unroll
      for (int ai = 0; ai < 2; ++ai)
#pragma unroll
        for (int m = 0; m < 4; ++m) {
          const unsigned ro = ((unsigned)(row0 + ai * 128 + m * 16) * 512 + col) * 2u;
#pragma unroll
          for (int bj = 0; bj < 2; ++bj) gv[ai][m][bj] = ldg<uint4>(A, ro + bj * 256);
        }
#pragma unroll
      for (int ai = 0; ai < 2; ++ai)
#pragma unroll
        for (int m = 0; m < 4; ++m) {
          const unsigned ro = ((unsigned)(row0 + ai * 128 + m * 16) * 1536 + col) * 2u;
#pragma unroll
          for (int bj = 0; bj < 2; ++bj) {
            f32x4 g0, g1; unpack8(gv[ai][m][bj], g0, g1);
            const f32x4 c0 = acc[ai][bj][m][0], c1 = acc[ai][bj][m][1];
            stg_bf8(Y, ro + bj * 256, f32x4{g0[0] * sigmoidf(c0[0]), g0[1] * sigmoidf(c0[1]), g0[2] * sigmoidf(c0[2]), g0[3] * sigmoidf(c0[3])},
                                      f32x4{g1[0] * sigmoidf(c1[0]), g1[1] * sigmoidf(c1[1]), g1[2] * sigmoidf(c1[2]), g1[3] * sigmoidf(c1[3])});
          }
        }
    });
}

__device__ __forceinline__ void phase_mixers(const Params& p, int layer, bool need_ctx, int* misc_i, unsigned char* lds_raw, LAS unsigned char* lds, int mrows, int rep) {
  unsigned* head = reinterpret_cast<unsigned*>(p.ws + WS_CTL) + CW_WQ + layer * 64 + rep * 16;
  const int nitems = 704 + 2 * (mrows >> 8);
  unsigned long long tph0 = 0; if (PROBE_PH == 20) tph0 = wall_clock64();
  for (;;) {
    __syncthreads();
    if (threadIdx.x == 0) misc_i[40] = (int)__hip_atomic_fetch_add(head, 1u, __ATOMIC_RELAXED, __HIP_MEMORY_SCOPE_AGENT);
    __syncthreads();
    const int qpos = misc_i[40];
    if (qpos >= nitems) break;
    const int nglu = nitems - 704;
    if (qpos >= 640 && qpos < 640 + nglu) { glu_item(p, layer, (qpos - 640) >> 1, (qpos - 640) & 1, lds); continue; }
    const int item = (qpos < 128) ? qpos : (qpos < 384 ? qpos + 256 : (qpos < 640 ? qpos - 256 : qpos - nglu));
    mixer_item(p, layer, item, need_ctx, lds_raw);
    if (PROBE_PH == 20 && item >= 128) { __syncthreads(); if (threadIdx.x == 0) atomicMax(reinterpret_cast<unsigned*>(p.ws + WS_CTL) + 12288 + layer, (unsigned)(wall_clock64() - tph0)); }
  }
}

__device__ __forceinline__ void phase_merge1(const Params& p, int layer, int mrows, LAS unsigned char* lds) {
  const int G = gridDim.x, bid = blockIdx.x;
  const bf16_t* Yb = reinterpret_cast<const bf16_t*>(p.ws + WS_Y);
  const bf16_t* P = reinterpret_cast<const bf16_t*>(p.ws + WS_P);
  const bf16_t* WB = reinterpret_cast<const bf16_t*>(p.ws + WS_WBR) + (size_t)(layer * 3) * 1024 * 512;
  bf16_t* SB = reinterpret_cast<bf16_t*>(p.ws + WS_SB);
  const int tz = opaque_tid();
  gemm_stream(lds, 8, tz, stage_voff(tz, 0, 512), stage_voff(tz, 1, 512),
    [&](int idx, GUnit& u) -> bool {
      const int ti = idx / 3, br = idx - ti * 3;
      int pm, pn; if (!unit_next(ti * G + bid, mrows / 256, 4, pm, pn)) return false;
      dense_unit(u, Yb + br * 512, 1536, pm * 256, WB + (size_t)br * 1024 * 512, 512, pn * 256, tz); u.i0 = pm; u.i1 = pn; u.i2 = br; u.i3 = (br > 0) ? GU_KEEP_ACC : 0; return true;
    },
    [&](const GUnit& u, f32x4 (&acc)[2][2][4][2], int wr, int wc, int fr, int fq) {
      const int row0 = u.i0 * 256 + wr * 64 + fr, col = u.i1 * 256 + wc * 32 + fq * 8, br = u.i2;
      if (br < 2) {
#pragma unroll
        for (int ai = 0; ai < 2; ++ai) {
          uint4 ga[4][2], gb[4][2];
#pragma unroll
          for (int m = 0; m < 4; ++m) {
            const unsigned go = ((unsigned)(row0 + ai * 128 + m * 16) * INW + C_GATE + br * 1024 + col) * 2u;
#pragma unroll
            for (int bj = 0; bj < 2; ++bj) { ga[m][bj] = ldg<uint4>(P, go + bj * 256); gb[m][bj] = ldg<uint4>(P, go + 2048 + bj * 256); }
          }
#pragma unroll
          for (int m = 0; m < 4; ++m)
#pragma unroll
            for (int bj = 0; bj < 2; ++bj) {
              f32x4 x0, x1, y0, y1; unpack8(ga[m][bj], x0, x1); unpack8(gb[m][bj], y0, y1);
#pragma unroll
              for (int j = 0; j < 4; ++j) {
                acc[ai][bj][m][0][j] *= x0[j] * __builtin_amdgcn_rcpf(fmaxf(y0[j], 1e-20f));
                acc[ai][bj][m][1][j] *= x1[j] * __builtin_amdgcn_rcpf(fmaxf(y1[j], 1e-20f));
              }
            }
        }
        return;
      }
#pragma unroll
      for (int ai = 0; ai < 2; ++ai) {
        uint4 ga[4][2];
#pragma unroll
        for (int m = 0; m < 4; ++m) {
          const unsigned go = ((unsigned)(row0 + ai * 128 + m * 16) * INW + C_GATE + 2 * 1024 + col) * 2u;
#pragma unroll
          for (int bj = 0; bj < 2; ++bj) ga[m][bj] = ldg<uint4>(P, go + bj * 256);
        }
#pragma unroll
        for (int m = 0; m < 4; ++m) {
          const unsigned so = ((unsigned)(row0 + ai * 128 + m * 16) * D + col) * 2u;
#pragma unroll
          for (int bj = 0; bj < 2; ++bj) {
            f32x4 x0, x1; unpack8(ga[m][bj], x0, x1);
            f32x4 c0 = acc[ai][bj][m][0], c1 = acc[ai][bj][m][1];
#pragma unroll
            for (int j = 0; j < 4; ++j) { c0[j] *= fmaxf(x0[j], 1e-20f); c1[j] *= fmaxf(x1[j], 1e-20f); }
            stg_bf8(SB, so + bj * 256, c0, c1);
          }
        }
      }
    });
}

__device__ __forceinline__ void phase_merge2(const Params& p, int layer, int mrows, LAS unsigned char* lds) {
  const int G = gridDim.x, bid = blockIdx.x;
  const bf16_t* A = reinterpret_cast<const bf16_t*>(p.ws + WS_SB);
  const bf16_t* Bt = reinterpret_cast<const bf16_t*>(p.ws + WS_WOUT) + (size_t)layer * 1024 * 1024;
  bf16_t* MB = reinterpret_cast<bf16_t*>(p.ws + WS_S) + (size_t)NTOK * D;
  const int tz = opaque_tid();
  gemm_stream(lds, 16, tz, stage_voff(tz, 0, 1024), stage_voff(tz, 1, 1024),
    [&](int idx, GUnit& u) -> bool {
      int pm, pn; if (!unit_next(idx * G + bid, mrows / 256, 4, pm, pn)) return false;
      dense_unit(u, A, 1024, pm * 256, Bt, 1024, pn * 256, tz); u.i0 = pm; u.i1 = pn; u.i2 = 0; u.i3 = 0; return true;
    },
    [&](const GUnit& u, f32x4 (&acc)[2][2][4][2], int wr, int wc, int fr, int fq) {
      const int row0 = u.i0 * 256 + wr * 64 + fr, col = u.i1 * 256 + wc * 32 + fq * 8;
#pragma unroll
      for (int ai = 0; ai < 2; ++ai)
#pragma unroll
        for (int m = 0; m < 4; ++m) {
          const unsigned so = ((unsigned)(row0 + ai * 128 + m * 16) * D + col) * 2u;
#pragma unroll
          for (int bj = 0; bj < 2; ++bj) stg_bf8(MB, so + bj * 256, acc[ai][bj][m][0], acc[ai][bj][m][1]);
        }
    });
}

__device__ __forceinline__ int moe_tables(const unsigned* cnt, int* est, int ntn) {
  __syncthreads();
  if (threadIdx.x == 0) { int s = 0, u = 0; for (int e = 0; e < NEXP; ++e) { est[e] = s; est[64 + e] = u; const int c = (int)cnt[e]; s += c; u += ((c + 255) >> 8) * ntn; } est[NEXP] = s; est[64 + NEXP] = u; }
  __syncthreads();
  return est[64 + NEXP];
}
__device__ __forceinline__ void moe_unit(const int* est, int total, int L, int& e, int& cnte, int& pmt, int& pnt) {
  int wgid = L; { const int q = total / 8, r = total % 8, xcd = wgid % 8, off = wgid / 8; wgid = (xcd < r ? xcd * (q + 1) : r * (q + 1) + (xcd - r) * q) + off; }
  e = 0; while (est[64 + e + 1] <= wgid) ++e;
  const int idx = wgid - est[64 + e]; cnte = est[e + 1] - est[e]; const int tm = (cnte + 255) >> 8;
  pmt = idx % tm; pnt = idx / tm;
}

__device__ __forceinline__ void phase_moe1(const Params& p, int layer, LAS unsigned char* lds, int* est) {
  const int G = gridDim.x, bid = blockIdx.x;
  const unsigned* cnt = reinterpret_cast<const unsigned*>(p.ws + WS_CTL) + CW_CNT + layer * 32;
  const int total = moe_tables(cnt, est, 8);
  const bf16_t* F = reinterpret_cast<const bf16_t*>(p.ws + WS_H);
  const int* tlist = reinterpret_cast<const int*>(p.ws + WS_TLIST);
  const bf16_t* WG = reinterpret_cast<const bf16_t*>(p.ws + WS_WGU) + (size_t)(layer * NEXP) * 2048 * 1024;
  bf16_t* ACT = reinterpret_cast<bf16_t*>(p.ws + WS_ACT);
  const int tz = opaque_tid();
  int R0, C0, R1, C1; stage_rc(tz * 16, R0, C0); stage_rc(tz * 16 + 8192, R1, C1);
  gemm_stream(lds, 16, tz, stage_voff(tz, 0, 1024), stage_voff(tz, 1, 1024),
    [&](int idx, GUnit& u) -> bool {
      const int L = bid + idx * G; if (L >= total) return false;
      int e, cnte, pmt, pnt; moe_unit(est, total, L, e, cnte, pmt, pnt);
      const int m0 = pmt * 256;
      const int* tl = tlist + (size_t)e * NTOK;
      const int r00 = m0 + R0, r01 = m0 + R1, r10 = m0 + 128 + R0, r11 = m0 + 128 + R1;
      const int t00 = (r00 < cnte) ? tl[r00] : 0, t01 = (r01 < cnte) ? tl[r01] : 0, t10 = (r10 < cnte) ? tl[r10] : 0, t11 = (r11 < cnte) ? tl[r11] : 0;
      u.a0 = (const char*)F; u.a1 = (const char*)F;
      u.va00 = (unsigned)(t00 * 1024 + C0) * 2u; u.va01 = (unsigned)(t01 * 1024 + C1) * 2u; u.va10 = (unsigned)(t10 * 1024 + C0) * 2u; u.va11 = (unsigned)(t11 * 1024 + C1) * 2u;
      const bf16_t* Bt = WG + (size_t)e * 2048 * 1024 + (size_t)(pnt * 256) * 1024;
      u.b0 = (const char*)Bt; u.b1 = (const char*)(Bt + (size_t)128 * 1024);
      u.i0 = e; u.i1 = cnte - m0; u.i2 = est[e] + m0; u.i3 = pnt; return true;
    },
    [&](const GUnit& u, f32x4 (&acc)[2][2][4][2], int wr, int wc, int fr, int fq) {
      const int cq = wc * 32 + fq * 8, r0 = wr * 64 + fr;
      const float* bg = p.b_gu + (size_t)(layer * NEXP + u.i0) * 2048 + u.i3 * 128 + cq;
      float4 bgv[2], buv[2];
#pragma unroll
      for (int n = 0; n < 2; ++n) { bgv[n] = *reinterpret_cast<const float4*>(bg + n * 4); buv[n] = *reinterpret_cast<const float4*>(bg + 1024 + n * 4); }
#pragma unroll
      for (int ai = 0; ai < 2; ++ai)
#pragma unroll
        for (int m = 0; m < 4; ++m) {
          const int r = r0 + ai * 128 + m * 16;
          if (r < u.i1) {
            const unsigned oo = ((unsigned)(u.i2 + r) * 1024 + u.i3 * 128 + cq) * 2u;
            f32x4 ov[2];
#pragma unroll
            for (int n = 0; n < 2; ++n) {
              const f32x4 gc = acc[ai][0][m][n], uc4 = acc[ai][1][m][n];
              const float gg[4] = {gc[0] + bgv[n].x, gc[1] + bgv[n].y, gc[2] + bgv[n].z, gc[3] + bgv[n].w};
              const float uu[4] = {uc4[0] + buv[n].x, uc4[1] + buv[n].y, uc4[2] + buv[n].z, uc4[3] + buv[n].w};
#pragma unroll
              for (int j = 0; j < 4; ++j) { const float g = fminf(gg[j], 7.0f); const float uc = fminf(fmaxf(uu[j], -7.0f), 7.0f); ov[n][j] = (uc + 1.0f) * (g * sigmoidf(1.702f * g)); }
            }
            stg_bf8(ACT, oo, ov[0], ov[1]);
          }
        }
    });
  if (G == 256) { const int rem = total & 255; if (rem && bid >= rem) conv_moe_tiles(p, layer + 1, CB_REST + (bid - rem) * CQ_H, CQ_H, reinterpret_cast<float*>((unsigned char*)lds)); }
}

__device__ __forceinline__ void phase_moe2(const Params& p, int layer, LAS unsigned char* lds, int* est) {
  const int G = gridDim.x, bid = blockIdx.x;
  const unsigned* cnt = reinterpret_cast<const unsigned*>(p.ws + WS_CTL) + CW_CNT + layer * 32;
  const int total = moe_tables(cnt, est, 4);
  const bf16_t* ACT = reinterpret_cast<const bf16_t*>(p.ws + WS_ACT);
  const bf16_t* WD = reinterpret_cast<const bf16_t*>(p.ws + WS_WDN) + (size_t)(layer * NEXP) * 1024 * 1024;
  bf16_t* YB = reinterpret_cast<bf16_t*>(p.ws + WS_YB);
  const int tz = opaque_tid();
  gemm_stream(lds, 16, tz, stage_voff(tz, 0, 1024), stage_voff(tz, 1, 1024),
    [&](int idx, GUnit& u) -> bool {
      const int L = bid + idx * G; if (L >= total) return false;
      int e, cnte, pmt, pnt; moe_unit(est, total, L, e, cnte, pmt, pnt);
      const int m0 = pmt * 256, arow0 = est[e] + m0;
      dense_unit(u, ACT, 1024, arow0, WD + (size_t)e * 1024 * 1024, 1024, pnt * 256, tz);
      u.i0 = e; u.i1 = cnte - m0; u.i2 = arow0; u.i3 = pnt; return true;
    },
    [&](const GUnit& u, f32x4 (&acc)[2][2][4][2], int wr, int wc, int fr, int fq) {
      const int cq = wc * 32 + fq * 8, r0 = wr * 64 + fr;
      const float* bd = p.b_dn + (size_t)(layer * NEXP + u.i0) * 1024 + u.i3 * 256 + cq;
      f32x4 bv[2][2];
#pragma unroll
      for (int bj = 0; bj < 2; ++bj)
#pragma unroll
        for (int n = 0; n < 2; ++n) { const float4 t4 = *reinterpret_cast<const float4*>(bd + bj * 128 + n * 4); bv[bj][n] = f32x4{t4.x, t4.y, t4.z, t4.w}; }
#pragma unroll
      for (int ai = 0; ai < 2; ++ai)
#pragma unroll
        for (int m = 0; m < 4; ++m) {
          const int r = r0 + ai * 128 + m * 16;
          if (r < u.i1) {
            const unsigned oo = ((unsigned)(u.i2 + r) * 1024 + u.i3 * 256 + cq) * 2u;
#pragma unroll
            for (int bj = 0; bj < 2; ++bj) stg_bf8(YB, oo + bj * 256, acc[ai][bj][m][0] + bv[bj][0], acc[ai][bj][m][1] + bv[bj][1]);
          }
        }
    });
  if (G == 256) { const int rem1 = (2 * total) & 255, nid1 = rem1 ? 256 - rem1 : 0, rem = total & 255;
    if (rem && bid >= rem) conv_moe_tiles(p, layer + 1, CB_REST + nid1 * CQ_H + (bid - rem) * CQ_I, CQ_I, reinterpret_cast<float*>((unsigned char*)lds)); }
}

__device__ __forceinline__ void phase_prologue(const Params& p, float* ldsf) {
  const int tid_ = opaque_tid();
  const int G = gridDim.x, bid = blockIdx.x;
  conv_mats<2>(p.w_in, reinterpret_cast<bf16_t*>(p.ws + WS_WIN), DEPTH, 1024, INW, ldsf, tid_);
  conv_mats<0>(p.w_glu, reinterpret_cast<bf16_t*>(p.ws + WS_WGLU), DEPTH, 512, 512, ldsf, tid_);
  conv_mats<0>(p.w_branch, reinterpret_cast<bf16_t*>(p.ws + WS_WBR), DEPTH * 3, 512, 1024, ldsf, tid_);
  conv_mats<0>(p.w_out, reinterpret_cast<bf16_t*>(p.ws + WS_WOUT), DEPTH, 1024, 1024, ldsf, tid_);
  conv_mats<1>(p.w_gu, reinterpret_cast<bf16_t*>(p.ws + WS_WGU), NEXP, 1024, 2048, ldsf, tid_);
  conv_mats<0>(p.w_dn, reinterpret_cast<bf16_t*>(p.ws + WS_WDN), NEXP, 1024, 1024, ldsf, tid_);
  mod_phase(p, ldsf);
  if (bid == 0) {
    float* rt = reinterpret_cast<float*>(p.ws + WS_ROPE);
    for (int i = tid_; i < 1024; i += NTHR) { const float ang = (float)(i >> 4) * powf(10000.0f, -(float)(i & 15) / 16.0f); rt[i] = cosf(ang); rt[1024 + i] = sinf(ang); }
  }
}

#ifndef ONLY
#define ONLY -1
#endif
#ifndef REP_PRO
#define REP_PRO 1
#endif
#ifndef REP_GEMM
#define REP_GEMM 1
#endif
#ifndef REP_PC
#define REP_PC 1
#endif
#ifndef REP_MOE
#define REP_MOE 1
#endif
#define PROBE_K 8
#define PROBE_T0(k) do { if (PROBE_PH == (k)) probe_t0 = wall_clock64(); } while (0)
#define PROBE_T1(k) do { if (PROBE_PH == (k)) probe_acc += wall_clock64() - probe_t0; } while (0)
#define PH_ON(idx, k) ((ONLY < 0 || ONLY == (k)) && p.ph_lo <= (idx) && (idx) < p.ph_hi)
#ifndef REP_BAR
#define REP_BAR 1
#endif
#ifndef REP_NORM
#define REP_NORM 1
#endif
#define PH_END(idx) do { if ((idx) + 1 < p.ph_hi) { for (int rb_ = 0; rb_ < REP_BAR; ++rb_) xcd_barrier(bar); } } while (0)

__global__ void __launch_bounds__(512, 2) fwd(Params p) {
  extern __shared__ __attribute__((aligned(16))) unsigned char lds_raw[];
  LAS unsigned char* shm = (LAS unsigned char*)lds_raw;
  unsigned* misc_u = reinterpret_cast<unsigned*>(lds_raw + LDS_MISC);
  int* misc_i = reinterpret_cast<int*>(lds_raw + LDS_MISC + 64);
  unsigned* ctl = reinterpret_cast<unsigned*>(p.ws + WS_CTL);
  if (threadIdx.x < 4) misc_u[threadIdx.x] = 0u;
  __syncthreads();
  XcdBarrier bar = xcd_barrier_post(ctl + CW_BAR, (volatile LAS unsigned*)misc_u);
  unsigned long long probe_t0 = 0, probe_acc = 0;

  if (PH_ON(0, 10)) { PROBE_T0(10); for (int rep = 0; rep < REP_PRO; ++rep) phase_prologue(p, reinterpret_cast<float*>(lds_raw)); PH_END(0); PROBE_T1(10); }

  for (int layer = 0; layer < DEPTH; ++layer) {
    const int pb = 1 + layer * 10;
    const bool need_ctx = layer < DEPTH - 1;
    const int mrows = need_ctx ? NTOK : NLAT;
    if (PH_ON(pb + 0, 0)) { PROBE_T0(0); if (layer > 0) { const unsigned* pc = ctl + CW_CNT + (layer - 1) * 32; int t2 = 0; for (int e = 0; e < NEXP; ++e) t2 += (((int)pc[e] + 255) >> 8) * 4; const int rem1 = (2 * t2) & 255, rem2 = t2 & 255; const int base = (gridDim.x == 256) ? (CB_REST + (rem1 ? 256 - rem1 : 0) * CQ_H + (rem2 ? 256 - rem2 : 0) * CQ_I) : 0; const int left = MOE_CT - base; if (left > 0) { const int per = (left + (int)gridDim.x - 1) / (int)gridDim.x; conv_moe_tiles(p, layer, base + (int)blockIdx.x * per, per, reinterpret_cast<float*>(lds_raw)); } } norm_phase(p, layer, layer > 0, misc_i); for (int rep = 1; rep < REP_NORM; ++rep) norm_phase(p, layer, false, misc_i); PH_END(pb + 0); PROBE_T1(0); }
    if (PH_ON(pb + 1, 1)) { PROBE_T0(1); for (int rep = 0; rep < REP_GEMM; ++rep) phase_inproj(p, layer, shm, (PROBE_PH == 16 || PROBE_PH == 18) ? &probe_acc : nullptr, (PROBE_PH == 17) ? &probe_acc : nullptr); if (gridDim.x == 256 && (int)blockIdx.x >= 120) conv_moe_tiles(p, layer + 1, ((int)blockIdx.x - 120) * CQ_B, CQ_B, reinterpret_cast<float*>(lds_raw)); PH_END(pb + 1); PROBE_T1(1); }
    if (PH_ON(pb + 3, 3)) { PROBE_T0(3); for (int rep = 0; rep < REP_PC; ++rep) phase_mixers(p, layer, need_ctx, misc_i, lds_raw, shm, mrows, rep); PH_END(pb + 3); PROBE_T1(3); }
    if (PH_ON(pb + 5, 5)) { PROBE_T0(5); for (int rep = 0; rep < REP_GEMM; ++rep) phase_merge1(p, layer, mrows, shm); if (gridDim.x == 256 && (int)blockIdx.x >= 32) conv_moe_tiles(p, layer + 1, CB_E + ((int)blockIdx.x - 32) * CQ_E, CQ_E, reinterpret_cast<float*>(lds_raw)); PH_END(pb + 5); PROBE_T1(5); }
    if (PH_ON(pb + 6, 6)) { PROBE_T0(6); phase_merge2(p, layer, mrows, shm); if (gridDim.x == 256 && (int)blockIdx.x >= 32) conv_moe_tiles(p, layer + 1, CB_F + ((int)blockIdx.x - 32) * CQ_F, CQ_F, reinterpret_cast<float*>(lds_raw)); PH_END(pb + 6); PROBE_T1(6); }
    if (PH_ON(pb + 7, 7)) { PROBE_T0(7); route_phase(p, layer, mrows, reinterpret_cast<float*>(lds_raw)); PH_END(pb + 7); PROBE_T1(7); }
    if (PH_ON(pb + 8, 8)) { PROBE_T0(8); for (int rep = 0; rep < REP_MOE; ++rep) phase_moe1(p, layer, shm, misc_i); PH_END(pb + 8); PROBE_T1(8); }
    if (PH_ON(pb + 9, 9)) { PROBE_T0(9); for (int rep = 0; rep < REP_MOE; ++rep) phase_moe2(p, layer, shm, misc_i); PH_END(pb + 9); PROBE_T1(9); }
  }
  if (PH_ON(41, 11)) { final_combine(p, misc_i); }
  if (PROBE_PH == 13 || PROBE_PH == 20) { const unsigned* w = reinterpret_cast<const unsigned*>(p.ws + WS_CTL) + 12288; probe_acc = (unsigned long long)__hip_atomic_load(w, __ATOMIC_RELAXED, __HIP_MEMORY_SCOPE_AGENT) + __hip_atomic_load(w + 1, __ATOMIC_RELAXED, __HIP_MEMORY_SCOPE_AGENT) + __hip_atomic_load(w + 2, __ATOMIC_RELAXED, __HIP_MEMORY_SCOPE_AGENT) + __hip_atomic_load(w + 3, __ATOMIC_RELAXED, __HIP_MEMORY_SCOPE_AGENT); }
  if (PROBE_PH == 19) probe_acc = (unsigned long long)__hip_atomic_load(reinterpret_cast<const unsigned*>(p.ws + WS_CTL) + 12288 + 8, __ATOMIC_RELAXED, __HIP_MEMORY_SCOPE_AGENT) / 256;
  if (PROBE_PH >= 0 && blockIdx.x == 0) { const unsigned long long te = wall_clock64(); while (wall_clock64() - te < PROBE_K * probe_acc) __builtin_amdgcn_s_sleep(8); }
}

extern "C" void kernel_launch(void* const* d_in, const int* in_sizes, int n_in, void* d_out, int out_size, void* d_ws, size_t ws_size, hipStream_t stream) {
  static int grid = 0;
  if (grid == 0) {
    if (n_in != 32 || out_size != NLAT * D || ws_size < WS_END) { fprintf(stderr, "kernel_launch: unexpected shapes (n_in %d out %d ws %zu need %zu)\n", n_in, out_size, ws_size, (size_t)WS_END); grid = -1; return; }
    int dev = 0, cus = 0, per_cu = 0;
    if (hipGetDevice(&dev) != hipSuccess || hipDeviceGetAttribute(&cus, hipDeviceAttributeMultiprocessorCount, dev) != hipSuccess) { grid = -1; return; }
    if (hipFuncSetAttribute((const void*)fwd, hipFuncAttributeMaxDynamicSharedMemorySize, LDS_BYTES) != hipSuccess) { fprintf(stderr, "kernel_launch: hipFuncSetAttribute failed\n"); grid = -1; return; }
    if (hipOccupancyMaxActiveBlocksPerMultiprocessor(&per_cu, (const void*)fwd, NTHR, LDS_BYTES) != hipSuccess || per_cu < 1) fprintf(stderr, "kernel_launch: occupancy query reports %d\n", per_cu);
    (void)hipGetLastError();
    grid = cus;
  }
  if (grid < 0) return;
  (void)hipMemsetAsync((char*)d_ws + WS_CTL, 0, CTL_BYTES, stream);
  Params p{};
  const float** f = reinterpret_cast<const float**>(&p);
  for (int i = 0; i < 32; ++i) f[i] = (const float*)d_in[i];
  p.out = (float*)d_out; p.ws = (unsigned char*)d_ws; p.ph_lo = 0; p.ph_hi = 42;
  hipLaunchKernelGGL(fwd, dim3(grid), dim3(NTHR), LDS_BYTES, stream, p);
}
```
